# Optimizing an MI355X kernel written in HIP

```python
import jax, jax.numpy as jnp
from jax import lax
import numpy as np

D_MODEL = 2048
BATCH = 4
SEQ = 2048
DEPTH = 2

D_MIX = D_MODEL
EPS = 1e-6
SWA_HEAD_DIM = 64
SWA_HEADS = D_MIX // 2 // SWA_HEAD_DIM
SWA_KV_HEADS = 4
SWA_GROUP = SWA_HEADS // SWA_KV_HEADS
SWA_WIDTH = SWA_HEADS * SWA_HEAD_DIM
SWA_KV_WIDTH = SWA_KV_HEADS * SWA_HEAD_DIM
WINDOW = 128
ROT_DIM = SWA_HEAD_DIM // 4
ROPE_THETA = 500000.0
SG_WIDTH = D_MIX // 4
SG_GROUPS = 8
SG_GROUP_DIM = SG_WIDTH // SG_GROUPS
SG_CHUNK = 128
GLA_HEADS = 4
GLA_WIDTH = D_MIX // 4
GLA_DV = GLA_WIDTH // GLA_HEADS
GLA_DK = GLA_DV // 2
GLA_KEY_WIDTH = GLA_HEADS * GLA_DK
GLA_GATE_RANK = 16
GLA_GATE_TAU = 16.0
GLA_CHUNK = 64
IN_SIZES = (SWA_WIDTH, SWA_KV_WIDTH, SWA_KV_WIDTH,
            SG_WIDTH, SG_WIDTH,
            GLA_KEY_WIDTH, GLA_KEY_WIDTH, GLA_WIDTH,
            GLA_GATE_RANK,
            D_MIX)
IN_PROJ_WIDTH = SWA_WIDTH + 2 * SWA_KV_WIDTH + 2 * SG_WIDTH + 2 * GLA_KEY_WIDTH + GLA_WIDTH + GLA_GATE_RANK + D_MIX

kernel_name = 'hybrid_swa_sgmlp_gla_parallel_heads'


def rms_norm(x, g):
    x32 = x.astype(jnp.float32)
    y = x32 * lax.rsqrt(jnp.mean(x32 * x32, axis=-1, keepdims=True) + EPS)
    return (y * g.astype(jnp.float32)).astype(x.dtype)


def partial_rope(t, positions):
    half = ROT_DIM // 2
    inv_freq = ROPE_THETA ** (-(jnp.arange(half, dtype=jnp.float32) * (2.0 / ROT_DIM)))
    ang = positions.astype(jnp.float32)[..., None] * inv_freq
    cos = jnp.cos(ang)[:, :, None, :]
    sin = jnp.sin(ang)[:, :, None, :]
    tr = t[..., :ROT_DIM].astype(jnp.float32)
    t1, t2 = tr[..., :half], tr[..., half:]
    rot = jnp.concatenate([t1 * cos - t2 * sin, t2 * cos + t1 * sin], axis=-1)
    return jnp.concatenate([rot.astype(t.dtype), t[..., ROT_DIM:]], axis=-1)


def sliding_window_attention(q, k, v, sinks):
    bsz, seq = q.shape[0], q.shape[1]
    nb = seq // WINDOW
    qb = q.reshape(bsz, nb, WINDOW, SWA_KV_HEADS, SWA_GROUP, SWA_HEAD_DIM).astype(jnp.float32)

    def band(t):
        tb = t.reshape(bsz, nb, WINDOW, SWA_KV_HEADS, SWA_HEAD_DIM)
        prev = jnp.pad(tb[:, :-1], ((0, 0), (1, 0), (0, 0), (0, 0), (0, 0)))
        return jnp.concatenate([prev, tb], axis=2).astype(jnp.float32)

    kb, vb = band(k), band(v)
    scores = jnp.einsum('bnqgrd,bnkgd->bngrqk', qb, kb) * (SWA_HEAD_DIM ** -0.5)
    qi = jnp.arange(WINDOW)[:, None]
    kj = jnp.arange(2 * WINDOW)[None, :]
    dist = qi + WINDOW - kj
    blk = jnp.arange(nb)[:, None, None]
    valid = (dist >= 0) & (dist < WINDOW) & (blk * WINDOW + kj[None] - WINDOW >= 0)
    scores = jnp.where(valid[None, :, None, None], scores, -jnp.inf)
    sink = sinks.astype(jnp.float32).reshape(1, 1, SWA_KV_HEADS, SWA_GROUP, 1, 1)
    m = jnp.maximum(scores.max(axis=-1, keepdims=True), sink)
    p = jnp.exp(scores - m)
    probs = p / (p.sum(axis=-1, keepdims=True) + jnp.exp(sink - m))
    out = jnp.einsum('bngrqk,bnkgd->bnqgrd', probs, vb)
    return out.reshape(bsz, seq, SWA_WIDTH).astype(q.dtype)


def chunked_spatial_gating(u, v, w_s, b_s, ln_g, ln_b):
    bsz, seq = v.shape[0], v.shape[1]
    nc = seq // SG_CHUNK
    v32 = v.astype(jnp.float32)
    mu = jnp.mean(v32, axis=-1, keepdims=True)
    var = jnp.mean(jnp.square(v32 - mu), axis=-1, keepdims=True)
    vn = (v32 - mu) * lax.rsqrt(var + EPS) * ln_g.astype(jnp.float32) + ln_b.astype(jnp.float32)
    vn = vn.reshape(bsz, nc, SG_CHUNK, SG_GROUPS, SG_GROUP_DIM)
    causal = jnp.tril(jnp.ones((SG_CHUNK, SG_CHUNK), dtype=bool))
    w = jnp.where(causal[None], w_s.astype(jnp.float32), 0.0)
    mixed = jnp.einsum('gts,bnsgc->bntgc', w, vn) + b_s.astype(jnp.float32).T[None, None, :, :, None]
    return (u.astype(jnp.float32) * mixed.reshape(bsz, seq, SG_WIDTH)).astype(u.dtype)


def gated_linear_attention(q, k, v, log_alpha):
    bsz, seq = q.shape[0], q.shape[1]
    nc = seq // GLA_CHUNK

    def to_chunks(t):
        return t.astype(jnp.float32).reshape(bsz, nc, GLA_CHUNK, GLA_HEADS, t.shape[-1]).transpose(1, 0, 3, 2, 4)

    causal = jnp.tril(jnp.ones((GLA_CHUNK, GLA_CHUNK), dtype=bool))

    def step(state, xs):
        qc, kc, vc, lac = xs
        b = jnp.cumsum(lac, axis=2)
        diff = b[:, :, :, None, :] - b[:, :, None, :, :]
        decay = jnp.exp(jnp.where(causal[:, :, None], diff, -jnp.inf))
        scores = jnp.einsum('bhtd,bhsd,bhtsd->bhts', qc, kc, decay)
        o = jnp.einsum('bhts,bhsv->bhtv', scores, vc) + jnp.einsum('bhtd,bhdv->bhtv', qc * jnp.exp(b), state)
        b_last = b[:, :, -1:, :]
        state = state * jnp.exp(b_last)[:, :, 0, :, None] + jnp.einsum('bhsd,bhsv->bhdv', kc * jnp.exp(b_last - b), vc)
        return state, o

    state0 = jnp.zeros((bsz, GLA_HEADS, GLA_DK, GLA_DV), dtype=jnp.float32)
    qs = to_chunks(q) * (GLA_DK ** -0.5)
    _, o = lax.scan(step, state0, (qs, to_chunks(k), to_chunks(v), to_chunks(log_alpha)))
    return o.transpose(1, 0, 3, 2, 4).reshape(bsz, seq, GLA_HEADS, GLA_DV)


def hybrid_layer(x, c, positions, w_mod, b_mod, g_pre, g_post, w_in, w_out, swa_sinks,
                 sg_w, sg_b, sg_ln_g, sg_ln_b, gla_w_gate_up, gla_b_gate, gla_norm_g):
    bsz, seq = x.shape[0], x.shape[1]
    mod = jax.nn.silu(c) @ w_mod + b_mod
    shift, scale, gate = jnp.split(mod, 3, axis=-1)
    h = rms_norm(x, g_pre) * (1.0 + scale[:, None, :]) + shift[:, None, :]
    proj = h @ w_in
    offsets = np.cumsum(IN_SIZES)[:-1].tolist()
    a_q, a_k, a_v, s_u, s_v, c_q, c_k, c_v, c_g, z = jnp.split(proj, offsets, axis=-1)
    a_q = partial_rope(a_q.reshape(bsz, seq, SWA_HEADS, SWA_HEAD_DIM), positions)
    a_k = partial_rope(a_k.reshape(bsz, seq, SWA_KV_HEADS, SWA_HEAD_DIM), positions)
    a_v = a_v.reshape(bsz, seq, SWA_KV_HEADS, SWA_HEAD_DIM)
    y_a = sliding_window_attention(a_q, a_k, a_v, swa_sinks)
    y_b = chunked_spatial_gating(jax.nn.gelu(s_u), jax.nn.gelu(s_v), sg_w, sg_b, sg_ln_g, sg_ln_b)
    gate_logits = (c_g @ gla_w_gate_up + gla_b_gate).astype(jnp.float32)
    log_alpha = jax.nn.log_sigmoid(gate_logits) / GLA_GATE_TAU
    o_c = gated_linear_attention(c_q.reshape(bsz, seq, GLA_HEADS, GLA_DK),
                                 c_k.reshape(bsz, seq, GLA_HEADS, GLA_DK),
                                 c_v.reshape(bsz, seq, GLA_HEADS, GLA_DV),
                                 log_alpha.reshape(bsz, seq, GLA_HEADS, GLA_DK))
    y_c = rms_norm(o_c, gla_norm_g).reshape(bsz, seq, GLA_WIDTH).astype(x.dtype)
    y = jnp.concatenate([y_a, y_b, y_c], axis=-1) * jax.nn.silu(z)
    out = y @ w_out
    return x + gate[:, None, :] * rms_norm(out, g_post)


def setup_inputs(seed: int = 0) -> dict:
    key = jax.random.key(seed)
    ks = jax.random.split(key, 17)
    nrm = jax.random.normal
    f32 = jnp.float32
    x = nrm(ks[0], (BATCH, SEQ, D_MODEL), f32)
    c = nrm(ks[1], (BATCH, D_MODEL), f32)
    positions = jax.random.randint(ks[2], (BATCH, 1), 0, 4096, dtype=jnp.int32) + jnp.arange(SEQ, dtype=jnp.int32)[None, :]
    w_mod = nrm(ks[3], (DEPTH, D_MODEL, 3 * D_MODEL), f32) * (0.5 * D_MODEL ** -0.5)
    b_mod = 0.01 * nrm(ks[4], (DEPTH, 3 * D_MODEL), f32)
    g_pre = 1.0 + 0.05 * nrm(ks[5], (DEPTH, D_MODEL), f32)
    g_post = 1.0 + 0.05 * nrm(ks[6], (DEPTH, D_MODEL), f32)
    w_in = nrm(ks[7], (DEPTH, D_MODEL, IN_PROJ_WIDTH), f32) * (D_MODEL ** -0.5)
    w_out = nrm(ks[8], (DEPTH, D_MIX, D_MODEL), f32) * (D_MIX ** -0.5)
    swa_sinks = 0.5 * nrm(ks[9], (DEPTH, SWA_HEADS), f32)
    sg_w = nrm(ks[10], (DEPTH, SG_GROUPS, SG_CHUNK, SG_CHUNK), f32) * (SG_CHUNK ** -0.5)
    sg_b = 1.0 + 0.1 * nrm(ks[11], (DEPTH, SG_GROUPS, SG_CHUNK), f32)
    sg_ln_g = 1.0 + 0.05 * nrm(ks[12], (DEPTH, SG_WIDTH), f32)
    sg_ln_b = 0.02 * nrm(ks[13], (DEPTH, SG_WIDTH), f32)
    gla_w_gate_up = nrm(ks[14], (DEPTH, GLA_GATE_RANK, GLA_KEY_WIDTH), f32) * (GLA_GATE_RANK ** -0.5)
    gla_b_gate = 0.1 * nrm(ks[15], (DEPTH, GLA_KEY_WIDTH), f32)
    gla_norm_g = 1.0 + 0.05 * nrm(ks[16], (DEPTH, GLA_DV), f32)
    return {'x': x, 'c': c, 'positions': positions, 'w_mod': w_mod, 'b_mod': b_mod,
            'g_pre': g_pre, 'g_post': g_post, 'w_in': w_in, 'w_out': w_out, 'swa_sinks': swa_sinks,
            'sg_w': sg_w, 'sg_b': sg_b, 'sg_ln_g': sg_ln_g, 'sg_ln_b': sg_ln_b,
            'gla_w_gate_up': gla_w_gate_up, 'gla_b_gate': gla_b_gate, 'gla_norm_g': gla_norm_g}


def reference(x, c, positions, w_mod, b_mod, g_pre, g_post, w_in, w_out, swa_sinks,
              sg_w, sg_b, sg_ln_g, sg_ln_b, gla_w_gate_up, gla_b_gate, gla_norm_g):
    for l in range(DEPTH):
        x = hybrid_layer(x, c, positions, w_mod[l], b_mod[l], g_pre[l], g_post[l], w_in[l], w_out[l],
                         swa_sinks[l], sg_w[l], sg_b[l], sg_ln_g[l], sg_ln_b[l],
                         gla_w_gate_up[l], gla_b_gate[l], gla_norm_g[l])
    return x
```

```cpp
#include <hip/hip_runtime.h>
#include <hip/hip_cooperative_groups.h>
#include <cstdio>
#include <cstdint>
namespace cg = cooperative_groups;

#ifndef MK_SINGLE
#define MK_SINGLE 0
#endif

#define LAS __attribute__((address_space(3)))
typedef unsigned short bf16_t;
typedef short bf16x8 __attribute__((ext_vector_type(8)));
typedef float f32x4 __attribute__((ext_vector_type(4)));
typedef float f32x2 __attribute__((ext_vector_type(2)));
typedef unsigned u32x4 __attribute__((ext_vector_type(4)));
typedef unsigned u32x2 __attribute__((ext_vector_type(2)));

constexpr int D = 2048, NB = 4, SEQ = 2048, M = NB * SEQ;
constexpr int NPROJ = 5632;
constexpr int NPAD = 5888;
constexpr int WIN_LD = 5648;
constexpr float EPS = 1e-6f;
constexpr int C_AQ = 0, C_AK = 1024, C_AV = 1280, C_SU = 1536, C_SV = 2048, C_CQ = 2560, C_CK = 2816, C_CV = 3072, C_Z = 3584;
constexpr float LOG2E = 1.4426950408889634f;

constexpr size_t MiB = 1u << 20;
constexpr size_t WS_WIN = 0, WIN_BYTES = (size_t)NPAD * D * 2;
constexpr size_t WS_WOUT = 46 * MiB, WOUT_BYTES = (size_t)D * D * 2;
constexpr size_t WS_H = 62 * MiB, WS_PROJ = 94 * MiB, WS_CG = 182 * MiB, WS_MOD = 183 * MiB, WS_Y = 184 * MiB, WS_OUT = 216 * MiB;
constexpr size_t WS_LOCT = 248 * MiB, WS_ST = 264 * MiB, WS_DEC = 272 * MiB, WS_END = 273 * MiB;

constexpr int LDS_BYTES = 135168;

struct Params {
    const float* x; const float* c; const int* pos; const float* w_mod; const float* b_mod; const float* g_pre; const float* g_post;
    const float* w_in; const float* w_out; const float* sinks; const float* sg_w; const float* sg_b; const float* sg_ln_g; const float* sg_ln_b;
    const float* gla_wup; const float* gla_bg; const float* gla_ng;
    float* out; unsigned char* ws; int ph_lo, ph_hi;
};

__device__ __forceinline__ unsigned cvt_pk_bf16(float lo, float hi) { unsigned r; asm("v_cvt_pk_bf16_f32 %0, %1, %2" : "=v"(r) : "v"(lo), "v"(hi)); return r; }
__device__ __forceinline__ float bf_lo(unsigned u) { return __builtin_bit_cast(float, u << 16); }
__device__ __forceinline__ float bf_hi(unsigned u) { return __builtin_bit_cast(float, u & 0xffff0000u); }
__device__ __forceinline__ float bf1(bf16_t v) { return __builtin_bit_cast(float, (unsigned)v << 16); }
__device__ __forceinline__ bf16_t f2bf(float f) { return (bf16_t)(cvt_pk_bf16(f, 0.f) & 0xffffu); }
__device__ __forceinline__ float fast_exp2(float x) { return __builtin_amdgcn_exp2f(x); }
__device__ __forceinline__ float fast_rcp(float x) { return __builtin_amdgcn_rcpf(x); }
__device__ __forceinline__ float silu_f(float x) { return x * fast_rcp(1.f + fast_exp2(-x * LOG2E)); }
__device__ __forceinline__ float gelu_tanh_f(float x) { const float u = 0.7978845608028654f * (x + 0.044715f * x * x * x); return x * fast_rcp(1.f + fast_exp2(-2.f * LOG2E * u)); }
__device__ __forceinline__ float wave_sum(float v) {
#pragma unroll
    for (int o = 1; o < 64; o <<= 1) v += __shfl_xor(v, o);
    return v;
}
#define MFMA16(a, b, c) __builtin_amdgcn_mfma_f32_16x16x32_bf16((a), (b), (c), 0, 0, 0)

namespace pg8 {
#define PG8_LAS __attribute__((address_space(3)))
constexpr int BM = 256, BK = 64, HALF = 128, HTB = HALF * BK * 2, STAGE_BYTES = 8 * HTB, NXCD = 8, WGM = 8;
__host__ __device__ __forceinline__ int lds_byte(int r, int c) { const int st = (r >> 4) * 2 + (c >> 5), rr = r & 15, cc = c & 31, ob = rr * 64 + cc * 2; return st * 1024 + (ob ^ (((ob >> 9) & 1) << 5)); }
__host__ __device__ __forceinline__ void stage_rc(int b, int& R, int& C) { const int st = b / 1024, sb = b % 1024, swz = sb ^ (((sb >> 9) & 1) << 5); R = (st >> 1) * 16 + swz / 64; C = (st & 1) * 32 + (swz % 64) / 2; }
__host__ __device__ __forceinline__ int perm32(int rho) { const int n = rho >> 4, i = rho & 15; return 8 * (i >> 2) + 4 * n + (i & 3); }
struct Unit { int pm, pn; };
struct Gemm { const bf16_t* A; const bf16_t* Bt; int M, N, K; };
struct StaticOrder {
    int nM, nN, nwg, G, c;
    __host__ __device__ void init(int M_, int N_, int G_, int c_) { nM = M_ / BM; nN = N_ / BM; nwg = nM * nN; G = G_; c = c_; }
    __host__ __device__ bool next(int i, Unit& u) const {
        const long L = (long)i * G + c; if (L >= nwg) return false;
        int wgid = (int)L; { const int q = nwg / NXCD, r = nwg % NXCD, xcd = wgid % NXCD, off = wgid / NXCD; wgid = (xcd < r ? xcd * (q + 1) : r * (q + 1) + (xcd - r) * q) + off; }
        const int nig = WGM * nN, gid = wgid / nig, fm = gid * WGM, gsz = (nM - fm) < WGM ? (nM - fm) : WGM;
        u.pm = fm + ((wgid % nig) % gsz); u.pn = (wgid % nig) / gsz; return true;
    }
    __device__ __forceinline__ void a_ready(const Unit&) const {}
    __device__ __forceinline__ void done(const Unit&) const {}
};

template <class Epi, class Sched, bool ALIGN_EPI = false, bool SP2 = false>
__device__ __forceinline__ void gemm_phase(PG8_LAS unsigned char* lds, const Gemm g, const Sched& S, const Epi& E, const int tid) {
    const int wid = __builtin_amdgcn_readfirstlane(tid >> 6), lane = tid & 63, wr = wid >> 2, wc = wid & 3, fr = lane & 15, fq = lane >> 4;
    const int K = g.K, nt = K / BK;
    unsigned voffA[2], voffB[2];
#pragma unroll
    for (int i = 0; i < 2; ++i) { int R, C; stage_rc(tid * 16 + i * 8192, R, C); const int Rb = Epi::PERM ? ((R & ~31) + perm32(R & 31)) : R;
        voffA[i] = (unsigned)(R * K + C) * 2u; voffB[i] = (unsigned)(Rb * K + C) * 2u; }
    const size_t kstep = (size_t)(BK * 2);
    const size_t hstep = (size_t)HALF * K * 2;
    const size_t tstep = 2 * hstep;
    const unsigned ldsw = (unsigned)wid * 1024u;
    const int aoff = lds_byte(wr * 64 + fr, fq * 8), boff = lds_byte(wc * 32 + fr, fq * 8);
#define PG8_SA(b, h) (((b) * 2 + (h)) * HTB)
#define PG8_SB(b, h) ((4 + (b) * 2 + (h)) * HTB)
#define PG8_STAGE(bufoff, gbase, voff) do { _Pragma("unroll") for (int _i = 0; _i < 2; ++_i) \
        __builtin_amdgcn_global_load_lds((const unsigned*)((const char*)(gbase) + (voff)[_i]), (PG8_LAS unsigned*)(lds + (bufoff) + ldsw + _i * 8192), 16, 0, 0); } while (0)
#define PG8_LDA(dst, b, h) do { _Pragma("unroll") for (int m = 0; m < 4; ++m) _Pragma("unroll") for (int k = 0; k < 2; ++k) dst[m][k] = *(const PG8_LAS bf16x8*)(lds + PG8_SA(b, h) + aoff + m * 2048 + k * 1024); } while (0)
#define PG8_LDB(dst, b, h) do { _Pragma("unroll") for (int n = 0; n < 2; ++n) _Pragma("unroll") for (int k = 0; k < 2; ++k) dst[n][k] = *(const PG8_LAS bf16x8*)(lds + PG8_SB(b, h) + boff + n * 2048 + k * 1024); } while (0)
#define PG8_MMA(ai, bj, At, Bt) do { __builtin_amdgcn_s_setprio(1); _Pragma("unroll") for (int m = 0; m < 4; ++m) _Pragma("unroll") for (int n = 0; n < 2; ++n) _Pragma("unroll") for (int k = 0; k < 2; ++k) \
        acc[ai][bj][m][n] = __builtin_amdgcn_mfma_f32_16x16x32_bf16(Bt[n][k], At[m][k], acc[ai][bj][m][n], 0, 0, 0); __builtin_amdgcn_s_setprio(0); } while (0)
#define PG8_WAIT_V(n) asm volatile("s_waitcnt vmcnt(" #n ")" ::: "memory")
#define PG8_WAIT_L(n) asm volatile("s_waitcnt lgkmcnt(" #n ")" ::: "memory")
#define PG8_BAR __builtin_amdgcn_s_barrier()
#define PG8_SCHED __builtin_amdgcn_sched_barrier(0)
    Unit cur, nxt; int ui = 0;
    if (!S.next(0, cur)) return;
    f32x4 acc[2][2][4][2];
#pragma unroll
    for (int a = 0; a < 2; ++a)
#pragma unroll
        for (int b = 0; b < 2; ++b)
#pragma unroll
            for (int m = 0; m < 4; ++m)
#pragma unroll
                for (int n = 0; n < 2; ++n) acc[a][b][m][n] = (f32x4){0.f, 0.f, 0.f, 0.f};
    bf16x8 At[4][2], B0[2][2], B1[2][2];
    const char* cA = (const char*)g.A + (size_t)cur.pm * tstep; const char* cB = (const char*)g.Bt + (size_t)cur.pn * tstep;
    S.a_ready(cur);
    if constexpr (SP2) {
        PG8_STAGE(PG8_SB(0, 0), cB, voffB); PG8_STAGE(PG8_SB(0, 1), cB + hstep, voffB); PG8_STAGE(PG8_SA(0, 0), cA, voffA); PG8_STAGE(PG8_SA(0, 1), cA + hstep, voffA);
        if (wr == 1) PG8_BAR;
        PG8_WAIT_V(2); PG8_BAR;
        PG8_STAGE(PG8_SB(1, 0), cB + kstep, voffB); PG8_STAGE(PG8_SA(1, 0), cA + kstep, voffA); PG8_STAGE(PG8_SB(1, 1), cB + hstep + kstep, voffB);
        PG8_WAIT_V(6); PG8_BAR;
    } else {
        PG8_STAGE(PG8_SB(0, 0), cB, voffB); PG8_STAGE(PG8_SA(0, 0), cA, voffA); PG8_STAGE(PG8_SB(0, 1), cB + hstep, voffB); PG8_STAGE(PG8_SA(0, 1), cA + hstep, voffA);
        if (wr == 1) PG8_BAR;
        PG8_WAIT_V(4); PG8_BAR;
        PG8_STAGE(PG8_SB(1, 0), cB + kstep, voffB); PG8_STAGE(PG8_SA(1, 0), cA + kstep, voffA); PG8_STAGE(PG8_SB(1, 1), cB + hstep + kstep, voffB);
        PG8_WAIT_V(6); PG8_BAR;
    }
    for (;;) {
        const bool has_next = S.next(ui + 1, nxt);
        const char* nA = has_next ? (const char*)g.A + (size_t)nxt.pm * tstep : cA; const char* nB = has_next ? (const char*)g.Bt + (size_t)nxt.pn * tstep : cB;
        for (int t = 0; t < nt; t += 2) {
            const bool last = (t == nt - 2);
            const char* a1 = cA + (size_t)(t + 1) * kstep;
            const char* a2 = last ? nA : cA + (size_t)(t + 2) * kstep; const char* b2 = last ? nB : cB + (size_t)(t + 2) * kstep;
            const char* a3 = a2 + kstep; const char* b3 = b2 + kstep;
            if (last && has_next) S.a_ready(nxt);
            if constexpr (SP2) {
            PG8_LDB(B0, 0, 0); PG8_LDB(B1, 0, 1); PG8_SCHED; PG8_LDA(At, 0, 0); PG8_STAGE(PG8_SA(1, 1), a1 + hstep, voffA);
            PG8_WAIT_V(8); PG8_WAIT_L(0); PG8_BAR; PG8_MMA(0, 0, At, B0); PG8_MMA(0, 1, At, B1); PG8_BAR; PG8_SCHED;
            PG8_LDA(At, 0, 1); PG8_STAGE(PG8_SB(0, 0), b2, voffB); PG8_STAGE(PG8_SB(0, 1), b2 + hstep, voffB); PG8_STAGE(PG8_SA(0, 0), a2, voffA);
            PG8_WAIT_V(8); PG8_WAIT_L(0); PG8_BAR; PG8_MMA(1, 0, At, B0); PG8_MMA(1, 1, At, B1); PG8_BAR; PG8_SCHED;
            PG8_LDB(B0, 1, 0); PG8_LDB(B1, 1, 1); PG8_SCHED; PG8_LDA(At, 1, 0); PG8_STAGE(PG8_SA(0, 1), a2 + hstep, voffA);
            PG8_WAIT_V(8); PG8_WAIT_L(0); PG8_BAR; PG8_MMA(0, 0, At, B0); PG8_MMA(0, 1, At, B1); PG8_BAR; PG8_SCHED;
            PG8_LDA(At, 1, 1); PG8_STAGE(PG8_SB(1, 0), b3, voffB); PG8_STAGE(PG8_SB(1, 1), b3 + hstep, voffB); PG8_STAGE(PG8_SA(1, 0), a3, voffA);
            PG8_WAIT_V(8); PG8_WAIT_L(0); PG8_BAR; PG8_MMA(1, 0, At, B0); PG8_MMA(1, 1, At, B1); PG8_BAR; PG8_SCHED;
            } else {
            PG8_LDB(B0, 0, 0); PG8_SCHED; PG8_LDA(At, 0, 0); PG8_STAGE(PG8_SA(1, 1), a1 + hstep, voffA);
            PG8_WAIT_L(8); PG8_BAR; PG8_WAIT_L(0); PG8_MMA(0, 0, At, B0); PG8_BAR; PG8_SCHED;
            PG8_LDB(B1, 0, 1); PG8_STAGE(PG8_SB(0, 0), b2, voffB);
            PG8_BAR; PG8_WAIT_L(0); PG8_MMA(0, 1, At, B1); PG8_BAR;
            PG8_LDA(At, 0, 1); PG8_STAGE(PG8_SA(0, 0), a2, voffA);
            PG8_BAR; PG8_WAIT_L(0); PG8_MMA(1, 0, At, B0); PG8_BAR; PG8_SCHED;
            PG8_STAGE(PG8_SB(0, 1), b2 + hstep, voffB);
            PG8_WAIT_V(6); PG8_BAR; PG8_MMA(1, 1, At, B1); PG8_BAR;
            PG8_LDB(B0, 1, 0); PG8_SCHED; PG8_LDA(At, 1, 0); PG8_STAGE(PG8_SA(0, 1), a2 + hstep, voffA);
            PG8_WAIT_L(8); PG8_BAR; PG8_WAIT_L(0); PG8_MMA(0, 0, At, B0); PG8_BAR; PG8_SCHED;
            PG8_LDB(B1, 1, 1); PG8_STAGE(PG8_SB(1, 0), b3, voffB);
            PG8_BAR; PG8_WAIT_L(0); PG8_MMA(0, 1, At, B1); PG8_BAR;
            PG8_LDA(At, 1, 1); PG8_STAGE(PG8_SA(1, 0), a3, voffA);
            PG8_BAR; PG8_WAIT_L(0); PG8_MMA(1, 0, At, B0); PG8_BAR; PG8_SCHED;
            PG8_STAGE(PG8_SB(1, 1), b3 + hstep, voffB);
            PG8_WAIT_V(6); PG8_BAR; PG8_MMA(1, 1, At, B1); PG8_BAR;
            }
        }
        if constexpr (ALIGN_EPI) { if (wr == 0) PG8_BAR; }
        E(acc, cur, wr, wc, fr, fq); S.done(cur);
        if (!has_next) break;
#pragma unroll
        for (int a = 0; a < 2; ++a)
#pragma unroll
            for (int b = 0; b < 2; ++b)
#pragma unroll
                for (int m = 0; m < 4; ++m)
#pragma unroll
                    for (int n = 0; n < 2; ++n) acc[a][b][m][n] = (f32x4){0.f, 0.f, 0.f, 0.f};
        cur = nxt; cA = nA; cB = nB; ++ui;
        if constexpr (ALIGN_EPI) { if (wr == 1) PG8_BAR; }
    }
    PG8_WAIT_V(0);
    if constexpr (!ALIGN_EPI) { if (wr == 0) PG8_BAR; }
    PG8_BAR;
#undef PG8_SA
#undef PG8_SB
#undef PG8_STAGE
#undef PG8_LDA
#undef PG8_LDB
#undef PG8_MMA
#undef PG8_WAIT_V
#undef PG8_WAIT_L
#undef PG8_BAR
#undef PG8_SCHED
}

struct EpiProj {
    static constexpr bool PERM = true;
    bf16_t* P; float* CG;
    template <int ACT> __device__ __forceinline__ void store_tile(const f32x4 (&acc)[2][2][4][2], bf16_t* base) const {
#pragma unroll
        for (int ai = 0; ai < 2; ++ai)
#pragma unroll
            for (int m = 0; m < 4; ++m) { bf16_t* rowp = base + (size_t)(ai * HALF + m * 16) * NPROJ;
#pragma unroll
                for (int bj = 0; bj < 2; ++bj) { f32x4 v0 = acc[ai][bj][m][0], v1 = acc[ai][bj][m][1];
                    if (ACT == 1) { for (int e = 0; e < 4; ++e) { v0[e] = gelu_tanh_f(v0[e]); v1[e] = gelu_tanh_f(v1[e]); } }
                    if (ACT == 2) { for (int e = 0; e < 4; ++e) { v0[e] = silu_f(v0[e]); v1[e] = silu_f(v1[e]); } }
                    u32x4 w; w.x = cvt_pk_bf16(v0[0], v0[1]); w.y = cvt_pk_bf16(v0[2], v0[3]); w.z = cvt_pk_bf16(v1[0], v1[1]); w.w = cvt_pk_bf16(v1[2], v1[3]);
                    *(u32x4*)(rowp + bj * HALF) = w; } }
    }
    __device__ __forceinline__ void operator()(const f32x4 (&acc)[2][2][4][2], const Unit& u, int wr, int wc, int fr, int fq) const {
        const int row0 = u.pm * BM + wr * 64 + fr;
        if (u.pn < 22) {
            bf16_t* base = P + (size_t)row0 * NPROJ + u.pn * BM + wc * 32 + 8 * fq;
            if (u.pn >= 6 && u.pn < 10) store_tile<1>(acc, base);
            else if (u.pn >= 14) store_tile<2>(acc, base);
            else store_tile<0>(acc, base);
        } else if (wc == 0 && fq < 2) {
#pragma unroll
            for (int ai = 0; ai < 2; ++ai)
#pragma unroll
                for (int m = 0; m < 4; ++m) { float* p = CG + (size_t)(row0 + ai * HALF + m * 16) * 16 + 8 * fq;
                    *(f32x4*)p = acc[ai][0][m][0]; *(f32x4*)(p + 4) = acc[ai][0][m][1]; }
        }
    }
};
struct EpiOut {
    static constexpr bool PERM = true;
    bf16_t* O;
    __device__ __forceinline__ void operator()(const f32x4 (&acc)[2][2][4][2], const Unit& u, int wr, int wc, int fr, int fq) const {
        bf16_t* base = O + (size_t)(u.pm * BM + wr * 64 + fr) * D + u.pn * BM + wc * 32 + 8 * fq;
#pragma unroll
        for (int ai = 0; ai < 2; ++ai)
#pragma unroll
            for (int m = 0; m < 4; ++m) { bf16_t* rowp = base + (size_t)(ai * HALF + m * 16) * D;
#pragma unroll
                for (int bj = 0; bj < 2; ++bj) { const f32x4 v0 = acc[ai][bj][m][0], v1 = acc[ai][bj][m][1];
                    u32x4 w; w.x = cvt_pk_bf16(v0[0], v0[1]); w.y = cvt_pk_bf16(v0[2], v0[3]); w.z = cvt_pk_bf16(v1[0], v1[1]); w.w = cvt_pk_bf16(v1[2], v1[3]);
                    *(u32x4*)(rowp + bj * HALF) = w; } }
    }
};
}

__device__ __forceinline__ void p0_transpose_item(const float* W, int ldw, int n_src0, bf16_t* WT, int row_dst0, int kb, float* scr, int lane) {
    const int k0 = 64 * kb;
#pragma unroll 8
    for (int i = 0; i < 32; ++i) { const int kk = 2 * i + (lane >> 5); scr[kk * 33 + (lane & 31)] = W[(size_t)(k0 + kk) * ldw + n_src0 + (lane & 31)]; }
    asm volatile("s_waitcnt lgkmcnt(0)" ::: "memory");
    const int c = lane & 7;
#pragma unroll
    for (int j = 0; j < 4; ++j) { const int n = (lane >> 3) + 8 * j; const float* s = scr + (8 * c) * 33 + n;
        u32x4 o; o.x = cvt_pk_bf16(s[0 * 33], s[1 * 33]); o.y = cvt_pk_bf16(s[2 * 33], s[3 * 33]); o.z = cvt_pk_bf16(s[4 * 33], s[5 * 33]); o.w = cvt_pk_bf16(s[6 * 33], s[7 * 33]);
        *(u32x4*)(WT + (size_t)(row_dst0 + n) * D + k0 + 8 * c) = o; }
    asm volatile("s_waitcnt lgkmcnt(0)" ::: "memory");
}

__device__ __forceinline__ void p0_prologue(const Params& p, unsigned char* lds, int tid, int wave, int lane, int bx) {
    const int G = gridDim.x;
    unsigned char* ws = p.ws;
    float* sc = (float*)lds;
    float* red = (float*)(lds + 32768);
    if (bx < 192 || G != 256) {
        for (int i = tid; i < 4 * D; i += 512) { const int b = i >> 11, k = i & (D - 1); sc[k * 4 + b] = silu_f(p.c[i]); }
        __syncthreads();
        for (int it = bx; it < 192; it += G) {
            const int l = it / 96, n0 = 64 * (it % 96);
            const int r4 = lane >> 4, c4 = lane & 15;
            const float* wp = p.w_mod + ((size_t)l * D + wave * 256 + r4) * 6144 + n0 + 4 * c4;
            f32x4 a0 = {0, 0, 0, 0}, a1 = a0, a2 = a0, a3 = a0;
#pragma unroll 8
            for (int i = 0; i < 64; ++i) {
                const f32x4 w = *(const f32x4*)(wp + (size_t)(4 * i) * 6144);
                const f32x4 s = *(const f32x4*)(sc + (wave * 256 + 4 * i + r4) * 4);
                a0 += w * s[0]; a1 += w * s[1]; a2 += w * s[2]; a3 += w * s[3];
            }
#pragma unroll
            for (int e = 0; e < 4; ++e) {
                a0[e] += __shfl_xor(a0[e], 16); a0[e] += __shfl_xor(a0[e], 32);
                a1[e] += __shfl_xor(a1[e], 16); a1[e] += __shfl_xor(a1[e], 32);
                a2[e] += __shfl_xor(a2[e], 16); a2[e] += __shfl_xor(a2[e], 32);
                a3[e] += __shfl_xor(a3[e], 16); a3[e] += __shfl_xor(a3[e], 32);
            }
            if (r4 == 0) {
                *(f32x4*)(red + (wave * 4 + 0) * 64 + 4 * c4) = a0; *(f32x4*)(red + (wave * 4 + 1) * 64 + 4 * c4) = a1;
                *(f32x4*)(red + (wave * 4 + 2) * 64 + 4 * c4) = a2; *(f32x4*)(red + (wave * 4 + 3) * 64 + 4 * c4) = a3;
            }
            __syncthreads();
            if (tid < 256) { const int b = tid >> 6, col = tid & 63; float s = p.b_mod[l * 6144 + n0 + col];
#pragma unroll
                for (int w = 0; w < 8; ++w) s += red[(w * 4 + b) * 64 + col];
                ((float*)(ws + WS_MOD))[(l * 4 + b) * 6144 + n0 + col] = s; }
            __syncthreads();
        }
    }
    __syncthreads();
    {
        const int gt = bx * 512 + tid, NT = G * 512;
        for (int i = gt; i < 2 * 256 * (D / 8); i += NT) {
            const int l = i / (256 * (D / 8)), r = i % (256 * (D / 8)), j = r / (D / 8), k8 = (r % (D / 8)) * 8;
            u32x4 o = {0u, 0u, 0u, 0u};
            if (j < 16) { const float* s = p.w_in + ((size_t)l * D + k8) * WIN_LD + 3584 + j;
                o.x = cvt_pk_bf16(s[0], s[WIN_LD]); o.y = cvt_pk_bf16(s[2 * WIN_LD], s[3 * WIN_LD]); o.z = cvt_pk_bf16(s[4 * WIN_LD], s[5 * WIN_LD]); o.w = cvt_pk_bf16(s[6 * WIN_LD], s[7 * WIN_LD]); }
            *(u32x4*)((bf16_t*)(ws + WS_WIN + (size_t)l * WIN_BYTES) + (size_t)(5632 + j) * D + k8) = o;
        }
    }
    {
        float* scr = (float*)(lds + wave * 16384);
        constexpr int PER_L = 32 * 240, NIT = 2 * PER_L;
        int base, cnt, stride;
        if (G == 256) { if (bx < 192) { base = 49 * bx; cnt = 49; } else { base = 9408 + (bx - 192) * 93; cnt = 93; } base += wave; stride = 8; }
        else { base = bx * 8 + wave; cnt = NIT; stride = G * 8; }
        const int end = (G == 256) ? (base - wave + cnt) : NIT;
        for (int it = base; it < end; it += stride) {
            const int l = it / PER_L, r = it % PER_L, kb = r / 240, j = r % 240;
            bf16_t* WinT = (bf16_t*)(ws + WS_WIN + (size_t)l * WIN_BYTES);
            bf16_t* WoT = (bf16_t*)(ws + WS_WOUT + (size_t)l * WOUT_BYTES);
            if (j < 112) p0_transpose_item(p.w_in + (size_t)l * D * WIN_LD, WIN_LD, 32 * j, WinT, 32 * j, kb, scr, lane);
            else if (j < 176) p0_transpose_item(p.w_in + (size_t)l * D * WIN_LD, WIN_LD, 3600 + 32 * (j - 112), WinT, 3584 + 32 * (j - 112), kb, scr, lane);
            else p0_transpose_item(p.w_out + (size_t)l * D * D, D, 32 * (j - 176), WoT, 32 * (j - 176), kb, scr, lane);
        }
    }
}

__device__ __forceinline__ void row_pass(const Params& p, int mode, int wave, int lane, int bx) {
    const int gw = bx * 8 + wave, NGW = gridDim.x * 8;
    unsigned char* ws = p.ws;
    const float* mod = (const float*)(ws + WS_MOD);
    const bf16_t* OUTB = (const bf16_t*)(ws + WS_OUT);
    bf16_t* H = (bf16_t*)(ws + WS_H);
    const int lpost = (mode == 2) ? 1 : 0, lpre = (mode == 0) ? 0 : 1;
    for (int r = gw; r < M; r += NGW) {
        const int b = r >> 11;
        f32x4 v[4][2];
        const float* xin = ((mode == 2) ? (const float*)p.out : p.x) + (size_t)r * D;
#pragma unroll
        for (int j = 0; j < 4; ++j) { v[j][0] = *(const f32x4*)(xin + 8 * lane + 512 * j); v[j][1] = *(const f32x4*)(xin + 8 * lane + 512 * j + 4); }
        if (mode >= 1) {
            f32x4 o[4][2]; float ss = 0.f;
#pragma unroll
            for (int j = 0; j < 4; ++j) { const u32x4 w = *(const u32x4*)(OUTB + (size_t)r * D + 8 * lane + 512 * j);
                o[j][0] = (f32x4){bf_lo(w.x), bf_hi(w.x), bf_lo(w.y), bf_hi(w.y)}; o[j][1] = (f32x4){bf_lo(w.z), bf_hi(w.z), bf_lo(w.w), bf_hi(w.w)};
#pragma unroll
                for (int h = 0; h < 2; ++h) ss += (o[j][h][0] * o[j][h][0] + o[j][h][1] * o[j][h][1]) + (o[j][h][2] * o[j][h][2] + o[j][h][3] * o[j][h][3]); }
            const float rstd = rsqrtf(wave_sum(ss) * (1.f / D) + EPS);
            const float* gate = mod + (size_t)(lpost * 4 + b) * 6144 + 4096; const float* gp = p.g_post + lpost * D;
            float* xo = p.out + (size_t)r * D;
#pragma unroll
            for (int j = 0; j < 4; ++j)
#pragma unroll
                for (int h = 0; h < 2; ++h) { const int col = 8 * lane + 512 * j + 4 * h;
                    const f32x4 g4 = *(const f32x4*)(gate + col), p4 = *(const f32x4*)(gp + col);
                    v[j][h] = v[j][h] + g4 * (o[j][h] * rstd) * p4;
                    *(f32x4*)(xo + col) = v[j][h]; }
        }
        if (mode <= 1) {
            float ss = 0.f;
#pragma unroll
            for (int j = 0; j < 4; ++j)
#pragma unroll
                for (int h = 0; h < 2; ++h) ss += (v[j][h][0] * v[j][h][0] + v[j][h][1] * v[j][h][1]) + (v[j][h][2] * v[j][h][2] + v[j][h][3] * v[j][h][3]);
            const float rstd = rsqrtf(wave_sum(ss) * (1.f / D) + EPS);
            const float* shift = mod + (size_t)(lpre * 4 + b) * 6144; const float* scale = shift + 2048; const float* gp = p.g_pre + lpre * D;
#pragma unroll
            for (int j = 0; j < 4; ++j) { f32x4 hh[2];
#pragma unroll
                for (int h = 0; h < 2; ++h) { const int col = 8 * lane + 512 * j + 4 * h;
                    const f32x4 s4 = *(const f32x4*)(scale + col), t4 = *(const f32x4*)(shift + col), p4 = *(const f32x4*)(gp + col);
                    hh[h] = (v[j][h] * rstd) * p4 * (s4 + 1.f) + t4; }
                u32x4 w; w.x = cvt_pk_bf16(hh[0][0], hh[0][1]); w.y = cvt_pk_bf16(hh[0][2], hh[0][3]); w.z = cvt_pk_bf16(hh[1][0], hh[1][1]); w.w = cvt_pk_bf16(hh[1][2], hh[1][3]);
                *(u32x4*)(H + (size_t)r * D + 8 * lane + 512 * j) = w; }
        }
    }
}

__device__ __forceinline__ void rope_cs(int pos, int i, float& cs, float& sn) {
    constexpr double F[8] = {0.15915494309189535, 0.03086376340470123, 0.005985185712713705, 0.001160663641240061,
                             0.00022507907903927653, 4.364795279280289e-05, 8.464330808241401e-06, 1.6414262627950345e-06};
    double rev = (double)pos * F[i]; rev -= __builtin_floor(rev);
    const float r = (float)rev;
    sn = __builtin_amdgcn_sinf(r); cs = __builtin_amdgcn_cosf(r);
}
constexpr int KS_LD = 72, VT_LD = 264;
__device__ __forceinline__ void attn_item(const Params& p, int l, int item, unsigned char* lds, int tid, int wave, int lane) {
    const int b = item >> 6, n = (item >> 2) & 15, g = item & 3;
    const int fr = lane & 15, fq = lane >> 4;
    bf16_t* Ks = (bf16_t*)lds;
    bf16_t* Vt = (bf16_t*)(lds + 256 * KS_LD * 2);
    const bf16_t* proj = (const bf16_t*)(p.ws + WS_PROJ);
    bf16_t* Y = (bf16_t*)(p.ws + WS_Y);
    {
        const int key = tid >> 1, half = tid & 1;
        const int s = n * 128 - 128 + key;
        u32x4 kv[4], vv[4];
#pragma unroll
        for (int c = 0; c < 4; ++c) { kv[c] = (u32x4){0u, 0u, 0u, 0u}; vv[c] = kv[c]; }
        if (s >= 0) {
            const bf16_t* kp = proj + (size_t)(b * SEQ + s) * NPROJ + C_AK + g * 64 + half * 32;
#pragma unroll
            for (int c = 0; c < 4; ++c) { kv[c] = *(const u32x4*)(kp + 8 * c); vv[c] = *(const u32x4*)(kp + 256 + 8 * c); }
            if (half == 0) {
                const int pos = p.pos[b * SEQ + s];
                unsigned a[4] = {kv[0].x, kv[0].y, kv[0].z, kv[0].w}, bb[4] = {kv[1].x, kv[1].y, kv[1].z, kv[1].w};
#pragma unroll
                for (int e = 0; e < 4; ++e) {
                    float c0, s0, c1, s1; rope_cs(pos, 2 * e, c0, s0); rope_cs(pos, 2 * e + 1, c1, s1);
                    const float t1a = bf_lo(a[e]), t1b = bf_hi(a[e]), t2a = bf_lo(bb[e]), t2b = bf_hi(bb[e]);
                    a[e] = cvt_pk_bf16(t1a * c0 - t2a * s0, t1b * c1 - t2b * s1);
                    bb[e] = cvt_pk_bf16(t2a * c0 + t1a * s0, t2b * c1 + t1b * s1);
                }
                kv[0] = (u32x4){a[0], a[1], a[2], a[3]}; kv[1] = (u32x4){bb[0], bb[1], bb[2], bb[3]};
            }
        }
#pragma unroll
        for (int c = 0; c < 4; ++c) *(u32x4*)(Ks + key * KS_LD + half * 32 + 8 * c) = kv[c];
#pragma unroll
        for (int c = 0; c < 4; ++c) { const unsigned w[4] = {vv[c].x, vv[c].y, vv[c].z, vv[c].w};
#pragma unroll
            for (int e = 0; e < 4; ++e) { const int hd = half * 32 + 8 * c + 2 * e;
                Vt[hd * VT_LD + key] = (bf16_t)(w[e] & 0xffffu); Vt[(hd + 1) * VT_LD + key] = (bf16_t)(w[e] >> 16); } }
    }
    __syncthreads();
    const int r = wave >> 1, qh = wave & 1, hq = g * 4 + r;
    const int tokq0 = b * SEQ + n * 128 + 64 * qh;
    bf16x8 qf[4][2];
#pragma unroll
    for (int nb = 0; nb < 4; ++nb) {
        const int tok = tokq0 + 16 * nb + fr;
        const bf16_t* qp = proj + (size_t)tok * NPROJ + C_AQ + hq * 64 + 8 * fq;
        u32x4 q0 = *(const u32x4*)qp, q1 = *(const u32x4*)(qp + 32);
        unsigned own[4] = {q0.x, q0.y, q0.z, q0.w}, par[4];
#pragma unroll
        for (int e = 0; e < 4; ++e) par[e] = __shfl_xor(own[e], 16);
        if (fq < 2) {
            const int pos = p.pos[tok];
            const float sg = (fq == 0) ? -1.f : 1.f;
#pragma unroll
            for (int e = 0; e < 4; ++e) {
                float c0, s0, c1, s1; rope_cs(pos, 2 * e, c0, s0); rope_cs(pos, 2 * e + 1, c1, s1);
                const float oa = bf_lo(own[e]), ob = bf_hi(own[e]), pa = bf_lo(par[e]), pb = bf_hi(par[e]);
                own[e] = cvt_pk_bf16((oa * c0 + sg * pa * s0) * 0.125f, (ob * c1 + sg * pb * s1) * 0.125f);
            }
        } else {
#pragma unroll
            for (int e = 0; e < 4; ++e) own[e] = cvt_pk_bf16(bf_lo(own[e]) * 0.125f, bf_hi(own[e]) * 0.125f);
        }
        unsigned o1[4] = {q1.x, q1.y, q1.z, q1.w};
#pragma unroll
        for (int e = 0; e < 4; ++e) o1[e] = cvt_pk_bf16(bf_lo(o1[e]) * 0.125f, bf_hi(o1[e]) * 0.125f);
        qf[nb][0] = __builtin_bit_cast(bf16x8, (u32x4){own[0], own[1], own[2], own[3]});
        qf[nb][1] = __builtin_bit_cast(bf16x8, (u32x4){o1[0], o1[1], o1[2], o1[3]});
    }
    const float sink2 = p.sinks[l * 16 + hq] * LOG2E;
    float m_[4], l_[4];
    f32x4 o[4][4];
#pragma unroll
    for (int nb = 0; nb < 4; ++nb) { m_[nb] = sink2; l_[nb] = 1.f;
#pragma unroll
        for (int hb = 0; hb < 4; ++hb) o[hb][nb] = (f32x4){0.f, 0.f, 0.f, 0.f}; }
    for (int step = 0; step < 6; ++step) {
        const int kj0 = 64 * qh + 32 * step;
        if (n == 0 && kj0 + 32 <= 128) continue;
        f32x4 s[2][4];
#pragma unroll
        for (int mb = 0; mb < 2; ++mb)
#pragma unroll
            for (int nb = 0; nb < 4; ++nb) s[mb][nb] = (f32x4){0.f, 0.f, 0.f, 0.f};
#pragma unroll
        for (int mb = 0; mb < 2; ++mb)
#pragma unroll
            for (int kk = 0; kk < 2; ++kk) {
                const bf16x8 a = *(const bf16x8*)(Ks + (kj0 + 16 * mb + fr) * KS_LD + 32 * kk + 8 * fq);
#pragma unroll
                for (int nb = 0; nb < 4; ++nb) s[mb][nb] = MFMA16(a, qf[nb][kk], s[mb][nb]);
            }
        bf16x8 pb[4];
#pragma unroll
        for (int nb = 0; nb < 4; ++nb) {
            const int qi = 64 * qh + 16 * nb + fr;
            float tmax = -1e30f;
#pragma unroll
            for (int mb = 0; mb < 2; ++mb)
#pragma unroll
                for (int j = 0; j < 4; ++j) {
                    const int kj = kj0 + 16 * mb + 4 * fq + j, dist = qi + 128 - kj;
                    const bool valid = (dist >= 0) && (dist < 128) && (n > 0 || kj >= 128);
                    const float v = valid ? s[mb][nb][j] * LOG2E : -1e30f;
                    s[mb][nb][j] = v; tmax = fmaxf(tmax, v);
                }
            tmax = fmaxf(tmax, __shfl_xor(tmax, 16)); tmax = fmaxf(tmax, __shfl_xor(tmax, 32));
            const float mnew = fmaxf(m_[nb], tmax), alpha = fast_exp2(m_[nb] - mnew);
            m_[nb] = mnew;
            float rs = 0.f;
#pragma unroll
            for (int mb = 0; mb < 2; ++mb)
#pragma unroll
                for (int j = 0; j < 4; ++j) { const float pv = fast_exp2(s[mb][nb][j] - mnew); s[mb][nb][j] = pv; rs += pv; }
            rs += __shfl_xor(rs, 16); rs += __shfl_xor(rs, 32);
            l_[nb] = l_[nb] * alpha + rs;
#pragma unroll
            for (int hb = 0; hb < 4; ++hb) o[hb][nb] = o[hb][nb] * alpha;
            pb[nb] = __builtin_bit_cast(bf16x8, (u32x4){cvt_pk_bf16(s[0][nb][0], s[0][nb][1]), cvt_pk_bf16(s[0][nb][2], s[0][nb][3]),
                                                        cvt_pk_bf16(s[1][nb][0], s[1][nb][1]), cvt_pk_bf16(s[1][nb][2], s[1][nb][3])});
        }
#pragma unroll
        for (int hb = 0; hb < 4; ++hb) {
            const bf16_t* vp = Vt + (16 * hb + fr) * VT_LD + kj0 + 4 * fq;
            const u32x2 a0 = *(const u32x2*)vp, a1 = *(const u32x2*)(vp + 16);
            const bf16x8 a = __builtin_bit_cast(bf16x8, (u32x4){a0.x, a0.y, a1.x, a1.y});
#pragma unroll
            for (int nb = 0; nb < 4; ++nb) o[hb][nb] = MFMA16(a, pb[nb], o[hb][nb]);
        }
    }
#pragma unroll
    for (int nb = 0; nb < 4; ++nb) {
        const int tok = tokq0 + 16 * nb + fr;
        const float inv = 1.f / l_[nb];
#pragma unroll
        for (int hb = 0; hb < 4; ++hb) {
            const int col = hq * 64 + 16 * hb + 4 * fq;
            const u32x2 z = *(const u32x2*)(proj + (size_t)tok * NPROJ + C_Z + col);
            u32x2 y; y.x = cvt_pk_bf16(o[hb][nb][0] * inv * bf_lo(z.x), o[hb][nb][1] * inv * bf_hi(z.x));
            y.y = cvt_pk_bf16(o[hb][nb][2] * inv * bf_lo(z.y), o[hb][nb][3] * inv * bf_hi(z.y));
            *(u32x2*)(Y + (size_t)tok * D + col) = y;
        }
    }
    __syncthreads();
}

constexpr int VN_LD = 136;
__device__ __forceinline__ void sg_item(const Params& p, int l, int item, unsigned char* lds, int tid, int wave, int lane) {
    const int b = item >> 7, c = (item >> 3) & 15, g = item & 7;
    const int fr = lane & 15, fq = lane >> 4;
    bf16_t* vnT = (bf16_t*)lds;
    float* st = (float*)(lds + 64 * VN_LD * 2);
    const bf16_t* proj = (const bf16_t*)(p.ws + WS_PROJ);
    bf16_t* Y = (bf16_t*)(p.ws + WS_Y);
    const int tok0 = b * SEQ + c * 128;
    {
        const int s = tid >> 2, qd = tid & 3;
        const bf16_t* vp = proj + (size_t)(tok0 + s) * NPROJ + C_SV + 128 * qd;
        float sum = 0.f, sq = 0.f;
#pragma unroll
        for (int i = 0; i < 16; ++i) { const u32x4 w = *(const u32x4*)(vp + 8 * i); const unsigned ww[4] = {w.x, w.y, w.z, w.w};
#pragma unroll
            for (int e = 0; e < 4; ++e) { const float a = bf_lo(ww[e]), bb = bf_hi(ww[e]); sum += a + bb; sq += a * a + bb * bb; } }
        sum += __shfl_xor(sum, 1); sum += __shfl_xor(sum, 2); sq += __shfl_xor(sq, 1); sq += __shfl_xor(sq, 2);
        const float mu = sum * (1.f / 512.f), var = fmaxf(sq * (1.f / 512.f) - mu * mu, 0.f);
        if (qd == 0) { st[2 * s] = mu; st[2 * s + 1] = rsqrtf(var + EPS); }
    }
    __syncthreads();
    {
        const int s = tid >> 2, part = tid & 3;
        const bf16_t* vp = proj + (size_t)(tok0 + s) * NPROJ + C_SV + 64 * g + 16 * part;
        const float mu = st[2 * s], rstd = st[2 * s + 1];
        const float* lg = p.sg_ln_g + l * 512 + 64 * g + 16 * part; const float* lb = p.sg_ln_b + l * 512 + 64 * g + 16 * part;
#pragma unroll
        for (int i = 0; i < 2; ++i) { const u32x4 w = *(const u32x4*)(vp + 8 * i); const unsigned ww[4] = {w.x, w.y, w.z, w.w};
#pragma unroll
            for (int e = 0; e < 4; ++e) { const int ch = 8 * i + 2 * e;
                vnT[(16 * part + ch) * VN_LD + s] = f2bf((bf_lo(ww[e]) - mu) * rstd * lg[ch] + lb[ch]);
                vnT[(16 * part + ch + 1) * VN_LD + s] = f2bf((bf_hi(ww[e]) - mu) * rstd * lg[ch + 1] + lb[ch + 1]); } }
    }
    __syncthreads();
    {
        const int t = 16 * wave + fr;
        f32x4 acc[4];
#pragma unroll
        for (int mb = 0; mb < 4; ++mb) acc[mb] = (f32x4){0.f, 0.f, 0.f, 0.f};
        const float* wrow = p.sg_w + ((size_t)(l * 8 + g) * 128 + t) * 128;
#pragma unroll
        for (int kk = 0; kk < 4; ++kk) {
            if (32 * kk <= 16 * wave + 15) {
                const int s0 = 32 * kk + 8 * fq;
                const f32x4 f0 = *(const f32x4*)(wrow + s0), f1 = *(const f32x4*)(wrow + s0 + 4);
                float w[8] = {f0[0], f0[1], f0[2], f0[3], f1[0], f1[1], f1[2], f1[3]};
#pragma unroll
                for (int e = 0; e < 8; ++e) w[e] = (s0 + e <= t) ? w[e] : 0.f;
                const bf16x8 bfr = __builtin_bit_cast(bf16x8, (u32x4){cvt_pk_bf16(w[0], w[1]), cvt_pk_bf16(w[2], w[3]), cvt_pk_bf16(w[4], w[5]), cvt_pk_bf16(w[6], w[7])});
#pragma unroll
                for (int mb = 0; mb < 4; ++mb) { const bf16x8 a = *(const bf16x8*)(vnT + (16 * mb + fr) * VN_LD + s0); acc[mb] = MFMA16(a, bfr, acc[mb]); }
            }
        }
        const float bias = p.sg_b[(l * 8 + g) * 128 + t];
        const int tok = tok0 + t;
#pragma unroll
        for (int mb = 0; mb < 4; ++mb) {
            const int col = 64 * g + 16 * mb + 4 * fq;
            const u32x2 u = *(const u32x2*)(proj + (size_t)tok * NPROJ + C_SU + col);
            const u32x2 z = *(const u32x2*)(proj + (size_t)tok * NPROJ + C_Z + 1024 + col);
            u32x2 y; y.x = cvt_pk_bf16(bf_lo(u.x) * (acc[mb][0] + bias) * bf_lo(z.x), bf_hi(u.x) * (acc[mb][1] + bias) * bf_hi(z.x));
            y.y = cvt_pk_bf16(bf_lo(u.y) * (acc[mb][2] + bias) * bf_lo(z.y), bf_hi(u.y) * (acc[mb][3] + bias) * bf_hi(z.y));
            *(u32x2*)(Y + (size_t)tok * D + 1024 + col) = y;
        }
    }
    __syncthreads();
}

constexpr int GL_LD = 72;
__device__ __forceinline__ void gla_b(const Params& p, int l, int h, int tok, int tid, int lane, float (&bc)[8], float (&bl)[8]) {
    const float* cgp = (const float*)(p.ws + WS_CG) + (size_t)tok * 16;
    const f32x4 c0 = *(const f32x4*)cgp, c1 = *(const f32x4*)(cgp + 4), c2 = *(const f32x4*)(cgp + 8), c3 = *(const f32x4*)(cgp + 12);
    const float cgv[16] = {c0[0], c0[1], c0[2], c0[3], c1[0], c1[1], c1[2], c1[3], c2[0], c2[1], c2[2], c2[3], c3[0], c3[1], c3[2], c3[3]};
#pragma unroll
    for (int i = 0; i < 8; ++i) {
        const int col = h * 64 + 8 * (tid >> 6) + i;
        float x = p.gla_bg[l * 256 + col];
#pragma unroll
        for (int r = 0; r < 16; ++r) x += cgv[r] * p.gla_wup[(l * 16 + r) * 256 + col];
        float la = (fminf(x, 0.f) - __logf(1.f + __expf(-fabsf(x)))) * (1.f / 16.f);
#pragma unroll
        for (int off = 1; off < 64; off <<= 1) { const float v = __shfl_up(la, off); if (lane >= off) la += v; }
        bc[i] = la; bl[i] = __shfl(la, 63);
    }
}
__device__ __forceinline__ void gla_stage_vT(const bf16_t* proj, int tok0, int h, bf16_t* vT, int tid) {
    const int t = tid >> 3, c8 = tid & 7;
    const bf16_t* vp = proj + (size_t)(tok0 + t) * NPROJ + C_CV + h * 128 + 16 * c8;
#pragma unroll
    for (int i = 0; i < 2; ++i) { const u32x4 w = *(const u32x4*)(vp + 8 * i); const unsigned ww[4] = {w.x, w.y, w.z, w.w};
#pragma unroll
        for (int e = 0; e < 4; ++e) { const int dv = 16 * c8 + 8 * i + 2 * e;
            vT[dv * GL_LD + t] = (bf16_t)(ww[e] & 0xffffu); vT[(dv + 1) * GL_LD + t] = (bf16_t)(ww[e] >> 16); } }
}
__device__ __forceinline__ void gla_local_item(const Params& p, int l, int item, unsigned char* lds, int tid, int wave, int lane) {
    const int bh = item >> 5, c = item & 31, b = bh >> 2, h = bh & 3;
    const int fr = lane & 15, fq = lane >> 4;
    const int tok0 = b * SEQ + c * 64;
    bf16_t* klT = (bf16_t*)lds;
    bf16_t* vT = (bf16_t*)(lds + 64 * GL_LD * 2);
    const bf16_t* proj = (const bf16_t*)(p.ws + WS_PROJ);
    float bc[8], bl[8];
    gla_b(p, l, h, tok0 + lane, tid, lane, bc, bl);
    {
        const u32x4 kw = *(const u32x4*)(proj + (size_t)(tok0 + lane) * NPROJ + C_CK + h * 64 + 8 * wave);
        const unsigned ww[4] = {kw.x, kw.y, kw.z, kw.w};
#pragma unroll
        for (int e = 0; e < 4; ++e) {
            klT[(8 * wave + 2 * e) * GL_LD + lane] = f2bf(bf_lo(ww[e]) * __expf(bl[2 * e] - bc[2 * e]));
            klT[(8 * wave + 2 * e + 1) * GL_LD + lane] = f2bf(bf_hi(ww[e]) * __expf(bl[2 * e + 1] - bc[2 * e + 1]));
        }
        if (lane == 63) { float* dec = (float*)(p.ws + WS_DEC) + (size_t)item * 64 + 8 * wave;
#pragma unroll
            for (int i = 0; i < 8; ++i) dec[i] = __expf(bl[i]); }
    }
    gla_stage_vT(proj, tok0, h, vT, tid);
    __syncthreads();
    {
        f32x4 acc[4];
#pragma unroll
        for (int mb = 0; mb < 4; ++mb) acc[mb] = (f32x4){0.f, 0.f, 0.f, 0.f};
#pragma unroll
        for (int kk = 0; kk < 2; ++kk) {
            const bf16x8 bfr = *(const bf16x8*)(vT + (16 * wave + fr) * GL_LD + 32 * kk + 8 * fq);
#pragma unroll
            for (int mb = 0; mb < 4; ++mb) { const bf16x8 a = *(const bf16x8*)(klT + (16 * mb + fr) * GL_LD + 32 * kk + 8 * fq); acc[mb] = MFMA16(a, bfr, acc[mb]); }
        }
        float* loct = (float*)(p.ws + WS_LOCT) + (size_t)item * 8192 + (16 * wave + fr) * 64 + 4 * fq;
#pragma unroll
        for (int mb = 0; mb < 4; ++mb) *(f32x4*)(loct + 16 * mb) = acc[mb];
    }
    __syncthreads();
}
__device__ __forceinline__ void gla_scan(const Params& p, int tid, int bx) {
    const float* loct = (const float*)(p.ws + WS_LOCT); const float* dec = (const float*)(p.ws + WS_DEC);
    bf16_t* ST = (bf16_t*)(p.ws + WS_ST);
    for (int e = bx * 512 + tid; e < 16 * 8192; e += gridDim.x * 512) {
        const int bh = e >> 13, r = e & 8191, dk = r & 63;
        float s = 0.f;
#pragma unroll 8
        for (int c = 0; c < 32; ++c) { const size_t it = (size_t)bh * 32 + c;
            ST[it * 8192 + r] = f2bf(s);
            s = s * dec[it * 64 + dk] + loct[it * 8192 + r]; }
    }
}
__device__ __forceinline__ void gla_out_item(const Params& p, int l, int item, unsigned char* lds, int tid, int wave, int lane) {
    const int bh = item >> 5, c = item & 31, b = bh >> 2, h = bh & 3;
    const int fr = lane & 15, fq = lane >> 4;
    const int tok0 = b * SEQ + c * 64;
    bf16_t* qd = (bf16_t*)lds;
    bf16_t* kd = (bf16_t*)(lds + 64 * GL_LD * 2);
    bf16_t* vT = (bf16_t*)(lds + 2 * 64 * GL_LD * 2);
    float* red = (float*)(lds + 4 * 64 * GL_LD * 2);
    const bf16_t* proj = (const bf16_t*)(p.ws + WS_PROJ);
    bf16_t* Y = (bf16_t*)(p.ws + WS_Y);
    float bc[8], bl[8];
    gla_b(p, l, h, tok0 + lane, tid, lane, bc, bl);
    {
        const bf16_t* rowp = proj + (size_t)(tok0 + lane) * NPROJ + h * 64 + 8 * wave;
        const u32x4 qw = *(const u32x4*)(rowp + C_CQ), kw = *(const u32x4*)(rowp + C_CK);
        const unsigned qq[4] = {qw.x, qw.y, qw.z, qw.w}, kk4[4] = {kw.x, kw.y, kw.z, kw.w};
        unsigned qo[4], ko[4];
#pragma unroll
        for (int e = 0; e < 4; ++e) {
            const float e0 = __expf(bc[2 * e]), e1 = __expf(bc[2 * e + 1]);
            qo[e] = cvt_pk_bf16(bf_lo(qq[e]) * 0.125f * e0, bf_hi(qq[e]) * 0.125f * e1);
            ko[e] = cvt_pk_bf16(bf_lo(kk4[e]) * fast_rcp(e0), bf_hi(kk4[e]) * fast_rcp(e1));
        }
        *(u32x4*)(qd + lane * GL_LD + 8 * wave) = (u32x4){qo[0], qo[1], qo[2], qo[3]};
        *(u32x4*)(kd + lane * GL_LD + 8 * wave) = (u32x4){ko[0], ko[1], ko[2], ko[3]};
    }
    gla_stage_vT(proj, tok0, h, vT, tid);
    __syncthreads();
    const int tb = wave & 3, dh = wave >> 2, t = 16 * tb + fr;
    bf16x8 bq[2];
#pragma unroll
    for (int kk = 0; kk < 2; ++kk) bq[kk] = *(const bf16x8*)(qd + t * GL_LD + 32 * kk + 8 * fq);
    f32x4 sc[4];
#pragma unroll
    for (int mb = 0; mb < 4; ++mb) {
        sc[mb] = (f32x4){0.f, 0.f, 0.f, 0.f};
        if (mb <= tb) {
#pragma unroll
            for (int kk = 0; kk < 2; ++kk) { const bf16x8 a = *(const bf16x8*)(kd + (16 * mb + fr) * GL_LD + 32 * kk + 8 * fq); sc[mb] = MFMA16(a, bq[kk], sc[mb]); }
#pragma unroll
            for (int j = 0; j < 4; ++j) if (16 * mb + 4 * fq + j > t) sc[mb][j] = 0.f;
        }
    }
    bf16x8 bp[2];
#pragma unroll
    for (int k2 = 0; k2 < 2; ++k2)
        bp[k2] = __builtin_bit_cast(bf16x8, (u32x4){cvt_pk_bf16(sc[2 * k2][0], sc[2 * k2][1]), cvt_pk_bf16(sc[2 * k2][2], sc[2 * k2][3]),
                                                    cvt_pk_bf16(sc[2 * k2 + 1][0], sc[2 * k2 + 1][1]), cvt_pk_bf16(sc[2 * k2 + 1][2], sc[2 * k2 + 1][3])});
    f32x4 acc[4];
    const bf16_t* ST = (const bf16_t*)(p.ws + WS_ST) + (size_t)item * 8192;
    float ssq = 0.f;
#pragma unroll
    for (int mb = 0; mb < 4; ++mb) {
        const int dvrow = 64 * dh + 16 * mb + fr;
        acc[mb] = (f32x4){0.f, 0.f, 0.f, 0.f};
#pragma unroll
        for (int k2 = 0; k2 < 2; ++k2) {
            const bf16_t* vp = vT + dvrow * GL_LD + 32 * k2 + 4 * fq;
            const u32x2 a0 = *(const u32x2*)vp, a1 = *(const u32x2*)(vp + 16);
            acc[mb] = MFMA16(__builtin_bit_cast(bf16x8, (u32x4){a0.x, a0.y, a1.x, a1.y}), bp[k2], acc[mb]);
        }
#pragma unroll
        for (int kk = 0; kk < 2; ++kk) { const bf16x8 a = *(const bf16x8*)(ST + dvrow * 64 + 32 * kk + 8 * fq); acc[mb] = MFMA16(a, bq[kk], acc[mb]); }
        ssq += (acc[mb][0] * acc[mb][0] + acc[mb][1] * acc[mb][1]) + (acc[mb][2] * acc[mb][2] + acc[mb][3] * acc[mb][3]);
    }
    ssq += __shfl_xor(ssq, 16); ssq += __shfl_xor(ssq, 32);
    if (fq == 0) red[dh * 64 + t] = ssq;
    __syncthreads();
    const float rstd = rsqrtf((red[t] + red[64 + t]) * (1.f / 128.f) + EPS);
    const int tok = tok0 + t;
#pragma unroll
    for (int mb = 0; mb < 4; ++mb) {
        const int dv = 64 * dh + 16 * mb + 4 * fq;
        const f32x4 g4 = *(const f32x4*)(p.gla_ng + l * 128 + dv);
        const int col = 1536 + h * 128 + dv;
        const u32x2 z = *(const u32x2*)(proj + (size_t)tok * NPROJ + C_Z + col);
        u32x2 y; y.x = cvt_pk_bf16(acc[mb][0] * rstd * g4[0] * bf_lo(z.x), acc[mb][1] * rstd * g4[1] * bf_hi(z.x));
        y.y = cvt_pk_bf16(acc[mb][2] * rstd * g4[2] * bf_lo(z.y), acc[mb][3] * rstd * g4[3] * bf_hi(z.y));
        *(u32x2*)(Y + (size_t)tok * D + col) = y;
    }
    __syncthreads();
}

constexpr int N_PHASES = 14;
__global__ void __launch_bounds__(512, 2) fwd_kernel(Params p) {
    extern __shared__ __attribute__((aligned(16))) unsigned char lds[];
    const int G = gridDim.x;
    const int lo = p.ph_lo, hi = p.ph_hi;
#ifndef PHMASK
#define PHMASK 0xffff
#endif
#define IN(k) (((PHMASK >> ((k) < 2 ? (k) : 2 + ((k) - 2) % 6)) & 1) && lo <= (k) && (k) < hi)
#define SEAM(k) do { if (IN(k) && IN((k) + 1)) { cg::this_grid().sync(); } } while (0)
#define FRESH() int tid = threadIdx.x; asm volatile("" : "+v"(tid)); int bx = blockIdx.x; asm volatile("" : "+s"(bx)); \
    const int lane = tid & 63, wave = __builtin_amdgcn_readfirstlane(tid >> 6); Params q = p; asm volatile("" : "+s"(q.ws)); (void)lane; (void)wave; (void)bx;
    if (IN(0)) { FRESH(); p0_prologue(q, lds, tid, wave, lane, bx); }
    SEAM(0);
    if (IN(1)) { FRESH(); row_pass(q, 0, wave, lane, bx); }
    SEAM(1);
#pragma unroll 1
    for (int l = 0; l < 2; ++l) {
        const int pb = 2 + 6 * l;
        if (IN(pb)) {
            FRESH();
            pg8::Gemm g{(const bf16_t*)(q.ws + WS_H), (const bf16_t*)(q.ws + WS_WIN + (size_t)l * WIN_BYTES), M, NPAD, D};
            pg8::StaticOrder S; S.init(M, NPAD, G, bx);
            pg8::EpiProj E{(bf16_t*)(q.ws + WS_PROJ), (float*)(q.ws + WS_CG)};
            pg8::gemm_phase<pg8::EpiProj, pg8::StaticOrder, true, true>((LAS unsigned char*)lds, g, S, E, tid);
        }
        SEAM(pb);
        if (IN(pb + 1)) {
#ifndef MIXMASK
#define MIXMASK 7
#endif
            if (MIXMASK & 1) { FRESH(); for (int it = bx; it < 256; it += G) attn_item(q, l, it, lds, tid, wave, lane); }
            if (MIXMASK & 2) { FRESH(); for (int it = bx; it < 512; it += G) sg_item(q, l, it, lds, tid, wave, lane); }
            if (MIXMASK & 4) { FRESH(); for (int it = bx; it < 512; it += G) gla_local_item(q, l, it, lds, tid, wave, lane); }
        }
        SEAM(pb + 1);
        if (IN(pb + 2)) { FRESH(); gla_scan(q, tid, bx); }
        SEAM(pb + 2);
        if (IN(pb + 3)) { FRESH(); for (int it = bx; it < 512; it += G) gla_out_item(q, l, it, lds, tid, wave, lane); }
        SEAM(pb + 3);
        if (IN(pb + 4)) {
            FRESH();
            pg8::Gemm g{(const bf16_t*)(q.ws + WS_Y), (const bf16_t*)(q.ws + WS_WOUT + (size_t)l * WOUT_BYTES), M, D, D};
            pg8::StaticOrder S; S.init(M, D, G, bx);
            pg8::EpiOut E{(bf16_t*)(q.ws + WS_OUT)};
            pg8::gemm_phase<pg8::EpiOut, pg8::StaticOrder, true, true>((LAS unsigned char*)lds, g, S, E, tid);
        }
        SEAM(pb + 4);
        if (IN(pb + 5)) { FRESH(); row_pass(q, l + 1, wave, lane, bx); }
        if (l == 0) SEAM(pb + 5);
    }
#undef IN
#undef SEAM
#undef FRESH
}

extern "C" void kernel_launch(void* const* d_in, const int* in_sizes, int n_in, void* d_out, int out_size, void* d_ws, size_t ws_size, hipStream_t stream) {
    static int grid = 0;
    if (grid == 0) {
        if (n_in != 17 || in_sizes[0] != M * D || out_size != M * D || ws_size < WS_END) { fprintf(stderr, "kernel_launch: unexpected shapes (n_in %d, in0 %d, out %d, ws %zu)\n", n_in, n_in > 0 ? in_sizes[0] : -1, out_size, ws_size); grid = -1; return; }
        int dev = 0, cus = 0, per_cu = 0;
        if (hipGetDevice(&dev) != hipSuccess || hipDeviceGetAttribute(&cus, hipDeviceAttributeMultiprocessorCount, dev) != hipSuccess) { grid = -1; return; }
        if (hipFuncSetAttribute((const void*)fwd_kernel, hipFuncAttributeMaxDynamicSharedMemorySize, LDS_BYTES) != hipSuccess) { fprintf(stderr, "kernel_launch: hipFuncSetAttribute failed\n"); grid = -1; return; }
        if (hipOccupancyMaxActiveBlocksPerMultiprocessor(&per_cu, (const void*)fwd_kernel, 512, LDS_BYTES) != hipSuccess || per_cu < 1) { fprintf(stderr, "kernel_launch: occupancy query says %d blocks per CU\n", per_cu); per_cu = 1; }
        (void)hipGetLastError();
        grid = cus;
    }
    if (grid < 0) return;
    Params p{};
    p.x = (const float*)d_in[0]; p.c = (const float*)d_in[1]; p.pos = (const int*)d_in[2]; p.w_mod = (const float*)d_in[3]; p.b_mod = (const float*)d_in[4];
    p.g_pre = (const float*)d_in[5]; p.g_post = (const float*)d_in[6]; p.w_in = (const float*)d_in[7]; p.w_out = (const float*)d_in[8]; p.sinks = (const float*)d_in[9];
    p.sg_w = (const float*)d_in[10]; p.sg_b = (const float*)d_in[11]; p.sg_ln_g = (const float*)d_in[12]; p.sg_ln_b = (const float*)d_in[13];
    p.gla_wup = (const float*)d_in[14]; p.gla_bg = (const float*)d_in[15]; p.gla_ng = (const float*)d_in[16];
    p.out = (float*)d_out; p.ws = (unsigned char*)d_ws;
#if MK_SINGLE
    p.ph_lo = 0; p.ph_hi = N_PHASES;
    void* args[] = {&p};
    hipError_t e = hipLaunchCooperativeKernel((const void*)fwd_kernel, dim3(grid), dim3(512), args, LDS_BYTES, stream);
    if (e != hipSuccess) fprintf(stderr, "kernel_launch: cooperative launch failed: %s (grid %d)\n", hipGetErrorString(e), grid);
#else
    for (int ph = 0; ph < N_PHASES; ++ph) {
        p.ph_lo = ph; p.ph_hi = ph + 1;
        hipLaunchKernelGGL(fwd_kernel, dim3(grid), dim3(512), LDS_BYTES, stream, p);
    }
#endif
}
```

```cpp
#include <hip/hip_runtime.h>
#include <hip/hip_cooperative_groups.h>
#include <cstdio>
#include <cstdint>
namespace cg = cooperative_groups;

#ifndef MK_SINGLE
#define MK_SINGLE 1
#endif

#define LAS __attribute__((address_space(3)))
typedef unsigned short bf16_t;
typedef short bf16x8 __attribute__((ext_vector_type(8)));
typedef float f32x4 __attribute__((ext_vector_type(4)));
typedef float f32x2 __attribute__((ext_vector_type(2)));
typedef unsigned u32x4 __attribute__((ext_vector_type(4)));
typedef unsigned u32x2 __attribute__((ext_vector_type(2)));

constexpr int D = 2048, NB = 4, SEQ = 2048, M = NB * SEQ;
constexpr int NPROJ = 5632;
constexpr int NPAD = 5888;
constexpr int WIN_LD = 5648;
constexpr float EPS = 1e-6f;
constexpr int C_AQ = 0, C_AK = 1024, C_AV = 1280, C_SU = 1536, C_SV = 2048, C_CQ = 2560, C_CK = 2816, C_CV = 3072, C_Z = 3584;
constexpr float LOG2E = 1.4426950408889634f;

constexpr size_t MiB = 1u << 20;
constexpr size_t WS_WIN = 0, WIN_BYTES = (size_t)NPAD * D * 2;
constexpr size_t WS_WOUT = 46 * MiB, WOUT_BYTES = (size_t)D * D * 2;
constexpr size_t WS_H = 62 * MiB, WS_PROJ = 94 * MiB, WS_CG = 182 * MiB, WS_MOD = 183 * MiB, WS_Y = 184 * MiB, WS_OUT = 216 * MiB;
constexpr size_t WS_LOCT = 248 * MiB, WS_ST = 264 * MiB, WS_DEC = 272 * MiB, WS_END = 273 * MiB;

constexpr int LDS_BYTES = 135168;

struct Params {
    const float* x; const float* c; const int* pos; const float* w_mod; const float* b_mod; const float* g_pre; const float* g_post;
    const float* w_in; const float* w_out; const float* sinks; const float* sg_w; const float* sg_b; const float* sg_ln_g; const float* sg_ln_b;
    const float* gla_wup; const float* gla_bg; const float* gla_ng;
    float* out; unsigned char* ws; int ph_lo, ph_hi;
};

__device__ __forceinline__ unsigned cvt_pk_bf16(float lo, float hi) { unsigned r; asm("v_cvt_pk_bf16_f32 %0, %1, %2" : "=v"(r) : "v"(lo), "v"(hi)); return r; }
__device__ __forceinline__ float bf_lo(unsigned u) { return __builtin_bit_cast(float, u << 16); }
__device__ __forceinline__ float bf_hi(unsigned u) { return __builtin_bit_cast(float, u & 0xffff0000u); }
__device__ __forceinline__ float bf1(bf16_t v) { return __builtin_bit_cast(float, (unsigned)v << 16); }
__device__ __forceinline__ bf16_t f2bf(float f) { return (bf16_t)(cvt_pk_bf16(f, 0.f) & 0xffffu); }
__device__ __forceinline__ float fast_exp2(float x) { return __builtin_amdgcn_exp2f(x); }
__device__ __forceinline__ float fast_rcp(float x) { return __builtin_amdgcn_rcpf(x); }
__device__ __forceinline__ float silu_f(float x) { return x * fast_rcp(1.f + fast_exp2(-x * LOG2E)); }
__device__ __forceinline__ float gelu_tanh_f(float x) { const float u = 0.7978845608028654f * (x + 0.044715f * x * x * x); return x * fast_rcp(1.f + fast_exp2(-2.f * LOG2E * u)); }
__device__ __forceinline__ float wave_sum(float v) {
#pragma unroll
    for (int o = 1; o < 64; o <<= 1) v += __shfl_xor(v, o);
    return v;
}
#define MFMA16(a, b, c) __builtin_amdgcn_mfma_f32_16x16x32_bf16((a), (b), (c), 0, 0, 0)

namespace pg8 {
#define PG8_LAS __attribute__((address_space(3)))
constexpr int BM = 256, BK = 64, HALF = 128, HTB = HALF * BK * 2, STAGE_BYTES = 8 * HTB, NXCD = 8, WGM = 8;
__host__ __device__ __forceinline__ int lds_byte(int r, int c) { const int st = (r >> 4) * 2 + (c >> 5), rr = r & 15, cc = c & 31, ob = rr * 64 + cc * 2; return st * 1024 + (ob ^ (((ob >> 9) & 1) << 5)); }
__host__ __device__ __forceinline__ void stage_rc(int b, int& R, int& C) { const int st = b / 1024, sb = b % 1024, swz = sb ^ (((sb >> 9) & 1) << 5); R = (st >> 1) * 16 + swz / 64; C = (st & 1) * 32 + (swz % 64) / 2; }
__host__ __device__ __forceinline__ int perm32(int rho) { const int n = rho >> 4, i = rho & 15; return 8 * (i >> 2) + 4 * n + (i & 3); }
struct Unit { int pm, pn; };
struct Gemm { const bf16_t* A; const bf16_t* Bt; int M, N, K; };
struct StaticOrder {
    int nM, nN, nwg, G, c;
    __host__ __device__ void init(int M_, int N_, int G_, int c_) { nM = M_ / BM; nN = N_ / BM; nwg = nM * nN; G = G_; c = c_; }
    __host__ __device__ bool next(int i, Unit& u) const {
        const long L = (long)i * G + c; if (L >= nwg) return false;
        int wgid = (int)L; { const int q = nwg / NXCD, r = nwg % NXCD, xcd = wgid % NXCD, off = wgid / NXCD; wgid = (xcd < r ? xcd * (q + 1) : r * (q + 1) + (xcd - r) * q) + off; }
        const int nig = WGM * nN, gid = wgid / nig, fm = gid * WGM, gsz = (nM - fm) < WGM ? (nM - fm) : WGM;
        u.pm = fm + ((wgid % nig) % gsz); u.pn = (wgid % nig) / gsz; return true;
    }
    __device__ __forceinline__ void a_ready(const Unit&) const {}
    __device__ __forceinline__ void done(const Unit&) const {}
};

template <class Epi, class Sched, bool ALIGN_EPI = false, bool SP2 = false>
__device__ __forceinline__ void gemm_phase(PG8_LAS unsigned char* lds, const Gemm g, const Sched& S, const Epi& E, const int tid) {
    const int wid = __builtin_amdgcn_readfirstlane(tid >> 6), lane = tid & 63, wr = wid >> 2, wc = wid & 3, fr = lane & 15, fq = lane >> 4;
    const int K = g.K, nt = K / BK;
    unsigned voffA[2], voffB[2];
#pragma unroll
    for (int i = 0; i < 2; ++i) { int R, C; stage_rc(tid * 16 + i * 8192, R, C); const int Rb = Epi::PERM ? ((R & ~31) + perm32(R & 31)) : R;
        voffA[i] = (unsigned)(R * K + C) * 2u; voffB[i] = (unsigned)(Rb * K + C) * 2u; }
    const size_t kstep = (size_t)(BK * 2);
    const size_t hstep = (size_t)HALF * K * 2;
    const size_t tstep = 2 * hstep;
    const unsigned ldsw = (unsigned)wid * 1024u;
    const int aoff = lds_byte(wr * 64 + fr, fq * 8), boff = lds_byte(wc * 32 + fr, fq * 8);
#define PG8_SA(b, h) (((b) * 2 + (h)) * HTB)
#define PG8_SB(b, h) ((4 + (b) * 2 + (h)) * HTB)
#define PG8_STAGE(bufoff, gbase, voff) do { _Pragma("unroll") for (int _i = 0; _i < 2; ++_i) \
        __builtin_amdgcn_global_load_lds((const unsigned*)((const char*)(gbase) + (voff)[_i]), (PG8_LAS unsigned*)(lds + (bufoff) + ldsw + _i * 8192), 16, 0, 0); } while (0)
#define PG8_LDA(dst, b, h) do { _Pragma("unroll") for (int m = 0; m < 4; ++m) _Pragma("unroll") for (int k = 0; k < 2; ++k) dst[m][k] = *(const PG8_LAS bf16x8*)(lds + PG8_SA(b, h) + aoff + m * 2048 + k * 1024); } while (0)
#define PG8_LDB(dst, b, h) do { _Pragma("unroll") for (int n = 0; n < 2; ++n) _Pragma("unroll") for (int k = 0; k < 2; ++k) dst[n][k] = *(const PG8_LAS bf16x8*)(lds + PG8_SB(b, h) + boff + n * 2048 + k * 1024); } while (0)
#define PG8_MMA(ai, bj, At, Bt) do { __builtin_amdgcn_s_setprio(1); _Pragma("unroll") for (int m = 0; m < 4; ++m) _Pragma("unroll") for (int n = 0; n < 2; ++n) _Pragma("unroll") for (int k = 0; k < 2; ++k) \
        acc[ai][bj][m][n] = __builtin_amdgcn_mfma_f32_16x16x32_bf16(Bt[n][k], At[m][k], acc[ai][bj][m][n], 0, 0, 0); __builtin_amdgcn_s_setprio(0); } while (0)
#define PG8_WAIT_V(n) asm volatile("s_waitcnt vmcnt(" #n ")" ::: "memory")
#define PG8_WAIT_L(n) asm volatile("s_waitcnt lgkmcnt(" #n ")" ::: "memory")
#define PG8_BAR __builtin_amdgcn_s_barrier()
#define PG8_SCHED __builtin_amdgcn_sched_barrier(0)
    Unit cur, nxt; int ui = 0;
    if (!S.next(0, cur)) return;
    f32x4 acc[2][2][4][2];
#pragma unroll
    for (int a = 0; a < 2; ++a)
#pragma unroll
        for (int b = 0; b < 2; ++b)
#pragma unroll
            for (int m = 0; m < 4; ++m)
#pragma unroll
                for (int n = 0; n < 2; ++n) acc[a][b][m][n] = (f32x4){0.f, 0.f, 0.f, 0.f};
    bf16x8 At[4][2], B0[2][2], B1[2][2];
    const char* cA = (const char*)g.A + (size_t)cur.pm * tstep; const char* cB = (const char*)g.Bt + (size_t)cur.pn * tstep;
    S.a_ready(cur);
    if constexpr (SP2) {
        PG8_STAGE(PG8_SB(0, 0), cB, voffB); PG8_STAGE(PG8_SB(0, 1), cB + hstep, voffB); PG8_STAGE(PG8_SA(0, 0), cA, voffA); PG8_STAGE(PG8_SA(0, 1), cA + hstep, voffA);
        if (wr == 1) PG8_BAR;
        PG8_WAIT_V(2); PG8_BAR;
        PG8_STAGE(PG8_SB(1, 0), cB + kstep, voffB); PG8_STAGE(PG8_SA(1, 0), cA + kstep, voffA); PG8_STAGE(PG8_SB(1, 1), cB + hstep + kstep, voffB);
        PG8_WAIT_V(6); PG8_BAR;
    } else {
        PG8_STAGE(PG8_SB(0, 0), cB, voffB); PG8_STAGE(PG8_SA(0, 0), cA, voffA); PG8_STAGE(PG8_SB(0, 1), cB + hstep, voffB); PG8_STAGE(PG8_SA(0, 1), cA + hstep, voffA);
        if (wr == 1) PG8_BAR;
        PG8_WAIT_V(4); PG8_BAR;
        PG8_STAGE(PG8_SB(1, 0), cB + kstep, voffB); PG8_STAGE(PG8_SA(1, 0), cA + kstep, voffA); PG8_STAGE(PG8_SB(1, 1), cB + hstep + kstep, voffB);
        PG8_WAIT_V(6); PG8_BAR;
    }
    for (;;) {
        const bool has_next = S.next(ui + 1, nxt);
        const char* nA = has_next ? (const char*)g.A + (size_t)nxt.pm * tstep : cA; const char* nB = has_next ? (const char*)g.Bt + (size_t)nxt.pn * tstep : cB;
        for (int t = 0; t < nt; t += 2) {
            const bool last = (t == nt - 2);
            const char* a1 = cA + (size_t)(t + 1) * kstep;
            const char* a2 = last ? nA : cA + (size_t)(t + 2) * kstep; const char* b2 = last ? nB : cB + (size_t)(t + 2) * kstep;
            const char* a3 = a2 + kstep; const char* b3 = b2 + kstep;
            if (last && has_next) S.a_ready(nxt);
            if constexpr (SP2) {
            PG8_LDB(B0, 0, 0); PG8_LDB(B1, 0, 1); PG8_SCHED; PG8_LDA(At, 0, 0); PG8_STAGE(PG8_SA(1, 1), a1 + hstep, voffA);
            PG8_WAIT_V(8); PG8_WAIT_L(0); PG8_BAR; PG8_MMA(0, 0, At, B0); PG8_MMA(0, 1, At, B1); PG8_BAR; PG8_SCHED;
            PG8_LDA(At, 0, 1); PG8_STAGE(PG8_SB(0, 0), b2, voffB); PG8_STAGE(PG8_SB(0, 1), b2 + hstep, voffB); PG8_STAGE(PG8_SA(0, 0), a2, voffA);
            PG8_WAIT_V(8); PG8_WAIT_L(0); PG8_BAR; PG8_MMA(1, 0, At, B0); PG8_MMA(1, 1, At, B1); PG8_BAR; PG8_SCHED;
            PG8_LDB(B0, 1, 0); PG8_LDB(B1, 1, 1); PG8_SCHED; PG8_LDA(At, 1, 0); PG8_STAGE(PG8_SA(0, 1), a2 + hstep, voffA);
            PG8_WAIT_V(8); PG8_WAIT_L(0); PG8_BAR; PG8_MMA(0, 0, At, B0); PG8_MMA(0, 1, At, B1); PG8_BAR; PG8_SCHED;
            PG8_LDA(At, 1, 1); PG8_STAGE(PG8_SB(1, 0), b3, voffB); PG8_STAGE(PG8_SB(1, 1), b3 + hstep, voffB); PG8_STAGE(PG8_SA(1, 0), a3, voffA);
            PG8_WAIT_V(8); PG8_WAIT_L(0); PG8_BAR; PG8_MMA(1, 0, At, B0); PG8_MMA(1, 1, At, B1); PG8_BAR; PG8_SCHED;
            } else {
            PG8_LDB(B0, 0, 0); PG8_SCHED; PG8_LDA(At, 0, 0); PG8_STAGE(PG8_SA(1, 1), a1 + hstep, voffA);
            PG8_WAIT_L(8); PG8_BAR; PG8_WAIT_L(0); PG8_MMA(0, 0, At, B0); PG8_BAR; PG8_SCHED;
            PG8_LDB(B1, 0, 1); PG8_STAGE(PG8_SB(0, 0), b2, voffB);
            PG8_BAR; PG8_WAIT_L(0); PG8_MMA(0, 1, At, B1); PG8_BAR;
            PG8_LDA(At, 0, 1); PG8_STAGE(PG8_SA(0, 0), a2, voffA);
            PG8_BAR; PG8_WAIT_L(0); PG8_MMA(1, 0, At, B0); PG8_BAR; PG8_SCHED;
            PG8_STAGE(PG8_SB(0, 1), b2 + hstep, voffB);
            PG8_WAIT_V(6); PG8_BAR; PG8_MMA(1, 1, At, B1); PG8_BAR;
            PG8_LDB(B0, 1, 0); PG8_SCHED; PG8_LDA(At, 1, 0); PG8_STAGE(PG8_SA(0, 1), a2 + hstep, voffA);
            PG8_WAIT_L(8); PG8_BAR; PG8_WAIT_L(0); PG8_MMA(0, 0, At, B0); PG8_BAR; PG8_SCHED;
            PG8_LDB(B1, 1, 1); PG8_STAGE(PG8_SB(1, 0), b3, voffB);
            PG8_BAR; PG8_WAIT_L(0); PG8_MMA(0, 1, At, B1); PG8_BAR;
            PG8_LDA(At, 1, 1); PG8_STAGE(PG8_SA(1, 0), a3, voffA);
            PG8_BAR; PG8_WAIT_L(0); PG8_MMA(1, 0, At, B0); PG8_BAR; PG8_SCHED;
            PG8_STAGE(PG8_SB(1, 1), b3 + hstep, voffB);
            PG8_WAIT_V(6); PG8_BAR; PG8_MMA(1, 1, At, B1); PG8_BAR;
            }
        }
        if constexpr (ALIGN_EPI) { if (wr == 0) PG8_BAR; }
        E(acc, cur, wr, wc, fr, fq); S.done(cur);
        if (!has_next) break;
#pragma unroll
        for (int a = 0; a < 2; ++a)
#pragma unroll
            for (int b = 0; b < 2; ++b)
#pragma unroll
                for (int m = 0; m < 4; ++m)
#pragma unroll
                    for (int n = 0; n < 2; ++n) acc[a][b][m][n] = (f32x4){0.f, 0.f, 0.f, 0.f};
        cur = nxt; cA = nA; cB = nB; ++ui;
        if constexpr (ALIGN_EPI) { if (wr == 1) PG8_BAR; }
    }
    PG8_WAIT_V(0);
    if constexpr (!ALIGN_EPI) { if (wr == 0) PG8_BAR; }
    PG8_BAR;
#undef PG8_SA
#undef PG8_SB
#undef PG8_STAGE
#undef PG8_LDA
#undef PG8_LDB
#undef PG8_MMA
#undef PG8_WAIT_V
#undef PG8_WAIT_L
#undef PG8_BAR
#undef PG8_SCHED
}

struct EpiProj {
    static constexpr bool PERM = true;
    bf16_t* P; float* CG;
    template <int ACT> __device__ __forceinline__ void store_tile(const f32x4 (&acc)[2][2][4][2], bf16_t* base) const {
#pragma unroll
        for (int ai = 0; ai < 2; ++ai)
#pragma unroll
            for (int m = 0; m < 4; ++m) { bf16_t* rowp = base + (size_t)(ai * HALF + m * 16) * NPROJ;
#pragma unroll
                for (int bj = 0; bj < 2; ++bj) { f32x4 v0 = acc[ai][bj][m][0], v1 = acc[ai][bj][m][1];
                    if (ACT == 1) { for (int e = 0; e < 4; ++e) { v0[e] = gelu_tanh_f(v0[e]); v1[e] = gelu_tanh_f(v1[e]); } }
                    if (ACT == 2) { for (int e = 0; e < 4; ++e) { v0[e] = silu_f(v0[e]); v1[e] = silu_f(v1[e]); } }
                    u32x4 w; w.x = cvt_pk_bf16(v0[0], v0[1]); w.y = cvt_pk_bf16(v0[2], v0[3]); w.z = cvt_pk_bf16(v1[0], v1[1]); w.w = cvt_pk_bf16(v1[2], v1[3]);
                    *(u32x4*)(rowp + bj * HALF) = w; } }
    }
    __device__ __forceinline__ void operator()(const f32x4 (&acc)[2][2][4][2], const Unit& u, int wr, int wc, int fr, int fq) const {
        const int row0 = u.pm * BM + wr * 64 + fr;
        if (u.pn < 22) {
            bf16_t* base = P + (size_t)row0 * NPROJ + u.pn * BM + wc * 32 + 8 * fq;
            if (u.pn >= 6 && u.pn < 10) store_tile<1>(acc, base);
            else if (u.pn >= 14) store_tile<2>(acc, base);
            else store_tile<0>(acc, base);
        } else if (wc == 0 && fq < 2) {
#pragma unroll
            for (int ai = 0; ai < 2; ++ai)
#pragma unroll
                for (int m = 0; m < 4; ++m) { float* p = CG + (size_t)(row0 + ai * HALF + m * 16) * 16 + 8 * fq;
                    *(f32x4*)p = acc[ai][0][m][0]; *(f32x4*)(p + 4) = acc[ai][0][m][1]; }
        }
    }
};
struct EpiOut {
    static constexpr bool PERM = true;
    bf16_t* O;
    __device__ __forceinline__ void operator()(const f32x4 (&acc)[2][2][4][2], const Unit& u, int wr, int wc, int fr, int fq) const {
        bf16_t* base = O + (size_t)(u.pm * BM + wr * 64 + fr) * D + u.pn * BM + wc * 32 + 8 * fq;
#pragma unroll
        for (int ai = 0; ai < 2; ++ai)
#pragma unroll
            for (int m = 0; m < 4; ++m) { bf16_t* rowp = base + (size_t)(ai * HALF + m * 16) * D;
#pragma unroll
                for (int bj = 0; bj < 2; ++bj) { const f32x4 v0 = acc[ai][bj][m][0], v1 = acc[ai][bj][m][1];
                    u32x4 w; w.x = cvt_pk_bf16(v0[0], v0[1]); w.y = cvt_pk_bf16(v0[2], v0[3]); w.z = cvt_pk_bf16(v1[0], v1[1]); w.w = cvt_pk_bf16(v1[2], v1[3]);
                    *(u32x4*)(rowp + bj * HALF) = w; } }
    }
};
}

__device__ __forceinline__ void p0_transpose_item(const float* W, int ldw, int n_src0, bf16_t* WT, int row_dst0, int kb, float* scr, int lane) {
    const int k0 = 64 * kb;
#pragma unroll 8
    for (int i = 0; i < 32; ++i) { const int kk = 2 * i + (lane >> 5); scr[kk * 33 + (lane & 31)] = W[(size_t)(k0 + kk) * ldw + n_src0 + (lane & 31)]; }
    asm volatile("s_waitcnt lgkmcnt(0)" ::: "memory");
    const int c = lane & 7;
#pragma unroll
    for (int j = 0; j < 4; ++j) { const int n = (lane >> 3) + 8 * j; const float* s = scr + (8 * c) * 33 + n;
        u32x4 o; o.x = cvt_pk_bf16(s[0 * 33], s[1 * 33]); o.y = cvt_pk_bf16(s[2 * 33], s[3 * 33]); o.z = cvt_pk_bf16(s[4 * 33], s[5 * 33]); o.w = cvt_pk_bf16(s[6 * 33], s[7 * 33]);
        *(u32x4*)(WT + (size_t)(row_dst0 + n) * D + k0 + 8 * c) = o; }
    asm volatile("s_waitcnt lgkmcnt(0)" ::: "memory");
}

__device__ __forceinline__ void p0_prologue(const Params& p, unsigned char* lds, int tid, int wave, int lane, int bx) {
    const int G = gridDim.x;
    unsigned char* ws = p.ws;
    float* sc = (float*)lds;
    float* red = (float*)(lds + 32768);
    if (bx < 192 || G != 256) {
        for (int i = tid; i < 4 * D; i += 512) { const int b = i >> 11, k = i & (D - 1); sc[k * 4 + b] = silu_f(p.c[i]); }
        __syncthreads();
        for (int it = bx; it < 192; it += G) {
            const int l = it / 96, n0 = 64 * (it % 96);
            const int r4 = lane >> 4, c4 = lane & 15;
            const float* wp = p.w_mod + ((size_t)l * D + wave * 256 + r4) * 6144 + n0 + 4 * c4;
            f32x4 a0 = {0, 0, 0, 0}, a1 = a0, a2 = a0, a3 = a0;
#pragma unroll 8
            for (int i = 0; i < 64; ++i) {
                const f32x4 w = *(const f32x4*)(wp + (size_t)(4 * i) * 6144);
                const f32x4 s = *(const f32x4*)(sc + (wave * 256 + 4 * i + r4) * 4);
                a0 += w * s[0]; a1 += w * s[1]; a2 += w * s[2]; a3 += w * s[3];
            }
#pragma unroll
            for (int e = 0; e < 4; ++e) {
                a0[e] += __shfl_xor(a0[e], 16); a0[e] += __shfl_xor(a0[e], 32);
                a1[e] += __shfl_xor(a1[e], 16); a1[e] += __shfl_xor(a1[e], 32);
                a2[e] += __shfl_xor(a2[e], 16); a2[e] += __shfl_xor(a2[e], 32);
                a3[e] += __shfl_xor(a3[e], 16); a3[e] += __shfl_xor(a3[e], 32);
            }
            if (r4 == 0) {
                *(f32x4*)(red + (wave * 4 + 0) * 64 + 4 * c4) = a0; *(f32x4*)(red + (wave * 4 + 1) * 64 + 4 * c4) = a1;
                *(f32x4*)(red + (wave * 4 + 2) * 64 + 4 * c4) = a2; *(f32x4*)(red + (wave * 4 + 3) * 64 + 4 * c4) = a3;
            }
            __syncthreads();
            if (tid < 256) { const int b = tid >> 6, col = tid & 63; float s = p.b_mod[l * 6144 + n0 + col];
#pragma unroll
                for (int w = 0; w < 8; ++w) s += red[(w * 4 + b) * 64 + col];
                ((float*)(ws + WS_MOD))[(l * 4 + b) * 6144 + n0 + col] = s; }
            __syncthreads();
        }
    }
    __syncthreads();
    {
        const int gt = bx * 512 + tid, NT = G * 512;
        for (int i = gt; i < 2 * 256 * (D / 8); i += NT) {
            const int l = i / (256 * (D / 8)), r = i % (256 * (D / 8)), j = r / (D / 8), k8 = (r % (D / 8)) * 8;
            u32x4 o = {0u, 0u, 0u, 0u};
            if (j < 16) { const float* s = p.w_in + ((size_t)l * D + k8) * WIN_LD + 3584 + j;
                o.x = cvt_pk_bf16(s[0], s[WIN_LD]); o.y = cvt_pk_bf16(s[2 * WIN_LD], s[3 * WIN_LD]); o.z = cvt_pk_bf16(s[4 * WIN_LD], s[5 * WIN_LD]); o.w = cvt_pk_bf16(s[6 * WIN_LD], s[7 * WIN_LD]); }
            *(u32x4*)((bf16_t*)(ws + WS_WIN + (size_t)l * WIN_BYTES) + (size_t)(5632 + j) * D + k8) = o;
        }
    }
    {
        float* scr = (float*)(lds + wave * 16384);
        constexpr int PER_L = 32 * 240, NIT = 2 * PER_L;
        int base, cnt, stride;
        if (G == 256) { if (bx < 192) { base = 49 * bx; cnt = 49; } else { base = 9408 + (bx - 192) * 93; cnt = 93; } base += wave; stride = 8; }
        else { base = bx * 8 + wave; cnt = NIT; stride = G * 8; }
        const int end = (G == 256) ? (base - wave + cnt) : NIT;
        for (int it = base; it < end; it += stride) {
            const int l = it / PER_L, r = it % PER_L, kb = r / 240, j = r % 240;
            bf16_t* WinT = (bf16_t*)(ws + WS_WIN + (size_t)l * WIN_BYTES);
            bf16_t* WoT = (bf16_t*)(ws + WS_WOUT + (size_t)l * WOUT_BYTES);
            if (j < 112) p0_transpose_item(p.w_in + (size_t)l * D * WIN_LD, WIN_LD, 32 * j, WinT, 32 * j, kb, scr, lane);
            else if (j < 176) p0_transpose_item(p.w_in + (size_t)l * D * WIN_LD, WIN_LD, 3600 + 32 * (j - 112), WinT, 3584 + 32 * (j - 112), kb, scr, lane);
            else p0_transpose_item(p.w_out + (size_t)l * D * D, D, 32 * (j - 176), WoT, 32 * (j - 176), kb, scr, lane);
        }
    }
}

__device__ __forceinline__ void row_pass(const Params& p, int mode, int wave, int lane, int bx) {
    const int gw = bx * 8 + wave, NGW = gridDim.x * 8;
    unsigned char* ws = p.ws;
    const float* mod = (const float*)(ws + WS_MOD);
    const bf16_t* OUTB = (const bf16_t*)(ws + WS_OUT);
    bf16_t* H = (bf16_t*)(ws + WS_H);
    const int lpost = (mode == 2) ? 1 : 0, lpre = (mode == 0) ? 0 : 1;
    for (int r = gw; r < M; r += NGW) {
        const int b = r >> 11;
        f32x4 v[4][2];
        const float* xin = ((mode == 2) ? (const float*)p.out : p.x) + (size_t)r * D;
#pragma unroll
        for (int j = 0; j < 4; ++j) { v[j][0] = *(const f32x4*)(xin + 8 * lane + 512 * j); v[j][1] = *(const f32x4*)(xin + 8 * lane + 512 * j + 4); }
        if (mode >= 1) {
            f32x4 o[4][2]; float ss = 0.f;
#pragma unroll
            for (int j = 0; j < 4; ++j) { const u32x4 w = *(const u32x4*)(OUTB + (size_t)r * D + 8 * lane + 512 * j);
                o[j][0] = (f32x4){bf_lo(w.x), bf_hi(w.x), bf_lo(w.y), bf_hi(w.y)}; o[j][1] = (f32x4){bf_lo(w.z), bf_hi(w.z), bf_lo(w.w), bf_hi(w.w)};
#pragma unroll
                for (int h = 0; h < 2; ++h) ss += (o[j][h][0] * o[j][h][0] + o[j][h][1] * o[j][h][1]) + (o[j][h][2] * o[j][h][2] + o[j][h][3] * o[j][h][3]); }
            const float rstd = rsqrtf(wave_sum(ss) * (1.f / D) + EPS);
            const float* gate = mod + (size_t)(lpost * 4 + b) * 6144 + 4096; const float* gp = p.g_post + lpost * D;
            float* xo = p.out + (size_t)r * D;
#pragma unroll
            for (int j = 0; j < 4; ++j)
#pragma unroll
                for (int h = 0; h < 2; ++h) { const int col = 8 * lane + 512 * j + 4 * h;
                    const f32x4 g4 = *(const f32x4*)(gate + col), p4 = *(const f32x4*)(gp + col);
                    v[j][h] = v[j][h] + g4 * (o[j][h] * rstd) * p4;
                    *(f32x4*)(xo + col) = v[j][h]; }
        }
        if (mode <= 1) {
            float ss = 0.f;
#pragma unroll
            for (int j = 0; j < 4; ++j)
#pragma unroll
                for (int h = 0; h < 2; ++h) ss += (v[j][h][0] * v[j][h][0] + v[j][h][1] * v[j][h][1]) + (v[j][h][2] * v[j][h][2] + v[j][h][3] * v[j][h][3]);
            const float rstd = rsqrtf(wave_sum(ss) * (1.f / D) + EPS);
            const float* shift = mod + (size_t)(lpre * 4 + b) * 6144; const float* scale = shift + 2048; const float* gp = p.g_pre + lpre * D;
#pragma unroll
            for (int j = 0; j < 4; ++j) { f32x4 hh[2];
#pragma unroll
                for (int h = 0; h < 2; ++h) { const int col = 8 * lane + 512 * j + 4 * h;
                    const f32x4 s4 = *(const f32x4*)(scale + col), t4 = *(const f32x4*)(shift + col), p4 = *(const f32x4*)(gp + col);
                    hh[h] = (v[j][h] * rstd) * p4 * (s4 + 1.f) + t4; }
                u32x4 w; w.x = cvt_pk_bf16(hh[0][0], hh[0][1]); w.y = cvt_pk_bf16(hh[0][2], hh[0][3]); w.z = cvt_pk_bf16(hh[1][0], hh[1][1]); w.w = cvt_pk_bf16(hh[1][2], hh[1][3]);
                *(u32x4*)(H + (size_t)r * D + 8 * lane + 512 * j) = w; }
        }
    }
}

__device__ __forceinline__ void rope_cs(int pos, int i, float& cs, float& sn) {
    constexpr double F[8] = {0.15915494309189535, 0.03086376340470123, 0.005985185712713705, 0.001160663641240061,
                             0.00022507907903927653, 4.364795279280289e-05, 8.464330808241401e-06, 1.6414262627950345e-06};
    double rev = (double)pos * F[i]; rev -= __builtin_floor(rev);
    const float r = (float)rev;
    sn = __builtin_amdgcn_sinf(r); cs = __builtin_amdgcn_cosf(r);
}
constexpr int KS_LD = 72, VT_LD = 264;
__device__ __forceinline__ void attn_item(const Params& p, int l, int item, unsigned char* lds, int tid, int wave, int lane) {
    const int b = item >> 6, n = (item >> 2) & 15, g = item & 3;
    const int fr = lane & 15, fq = lane >> 4;
    bf16_t* Ks = (bf16_t*)lds;
    bf16_t* Vt = (bf16_t*)(lds + 256 * KS_LD * 2);
    const bf16_t* proj = (const bf16_t*)(p.ws + WS_PROJ);
    bf16_t* Y = (bf16_t*)(p.ws + WS_Y);
    {
        const int key = tid >> 1, half = tid & 1;
        const int s = n * 128 - 128 + key;
        u32x4 kv[4], vv[4];
#pragma unroll
        for (int c = 0; c < 4; ++c) { kv[c] = (u32x4){0u, 0u, 0u, 0u}; vv[c] = kv[c]; }
        if (s >= 0) {
            const bf16_t* kp = proj + (size_t)(b * SEQ + s) * NPROJ + C_AK + g * 64 + half * 32;
#pragma unroll
            for (int c = 0; c < 4; ++c) { kv[c] = *(const u32x4*)(kp + 8 * c); vv[c] = *(const u32x4*)(kp + 256 + 8 * c); }
            if (half == 0) {
                const int pos = p.pos[b * SEQ + s];
                unsigned a[4] = {kv[0].x, kv[0].y, kv[0].z, kv[0].w}, bb[4] = {kv[1].x, kv[1].y, kv[1].z, kv[1].w};
#pragma unroll
                for (int e = 0; e < 4; ++e) {
                    float c0, s0, c1, s1; rope_cs(pos, 2 * e, c0, s0); rope_cs(pos, 2 * e + 1, c1, s1);
                    const float t1a = bf_lo(a[e]), t1b = bf_hi(a[e]), t2a = bf_lo(bb[e]), t2b = bf_hi(bb[e]);
                    a[e] = cvt_pk_bf16(t1a * c0 - t2a * s0, t1b * c1 - t2b * s1);
                    bb[e] = cvt_pk_bf16(t2a * c0 + t1a * s0, t2b * c1 + t1b * s1);
                }
                kv[0] = (u32x4){a[0], a[1], a[2], a[3]}; kv[1] = (u32x4){bb[0], bb[1], bb[2], bb[3]};
            }
        }
#pragma unroll
        for (int c = 0; c < 4; ++c) *(u32x4*)(Ks + key * KS_LD + half * 32 + 8 * c) = kv[c];
#pragma unroll
        for (int c = 0; c < 4; ++c) { const unsigned w[4] = {vv[c].x, vv[c].y, vv[c].z, vv[c].w};
#pragma unroll
            for (int e = 0; e < 4; ++e) { const int hd = half * 32 + 8 * c + 2 * e;
                Vt[hd * VT_LD + key] = (bf16_t)(w[e] & 0xffffu); Vt[(hd + 1) * VT_LD + key] = (bf16_t)(w[e] >> 16); } }
    }
    __syncthreads();
    const int r = wave >> 1, qh = wave & 1, hq = g * 4 + r;
    const int tokq0 = b * SEQ + n * 128 + 64 * qh;
    bf16x8 qf[4][2];
#pragma unroll
    for (int nb = 0; nb < 4; ++nb) {
        const int tok = tokq0 + 16 * nb + fr;
        const bf16_t* qp = proj + (size_t)tok * NPROJ + C_AQ + hq * 64 + 8 * fq;
        u32x4 q0 = *(const u32x4*)qp, q1 = *(const u32x4*)(qp + 32);
        unsigned own[4] = {q0.x, q0.y, q0.z, q0.w}, par[4];
#pragma unroll
        for (int e = 0; e < 4; ++e) par[e] = __shfl_xor(own[e], 16);
        if (fq < 2) {
            const int pos = p.pos[tok];
            const float sg = (fq == 0) ? -1.f : 1.f;
#pragma unroll
            for (int e = 0; e < 4; ++e) {
                float c0, s0, c1, s1; rope_cs(pos, 2 * e, c0, s0); rope_cs(pos, 2 * e + 1, c1, s1);
                const float oa = bf_lo(own[e]), ob = bf_hi(own[e]), pa = bf_lo(par[e]), pb = bf_hi(par[e]);
                own[e] = cvt_pk_bf16((oa * c0 + sg * pa * s0) * 0.125f, (ob * c1 + sg * pb * s1) * 0.125f);
            }
        } else {
#pragma unroll
            for (int e = 0; e < 4; ++e) own[e] = cvt_pk_bf16(bf_lo(own[e]) * 0.125f, bf_hi(own[e]) * 0.125f);
        }
        unsigned o1[4] = {q1.x, q1.y, q1.z, q1.w};
#pragma unroll
        for (int e = 0; e < 4; ++e) o1[e] = cvt_pk_bf16(bf_lo(o1[e]) * 0.125f, bf_hi(o1[e]) * 0.125f);
        qf[nb][0] = __builtin_bit_cast(bf16x8, (u32x4){own[0], own[1], own[2], own[3]});
        qf[nb][1] = __builtin_bit_cast(bf16x8, (u32x4){o1[0], o1[1], o1[2], o1[3]});
    }
    const float sink2 = p.sinks[l * 16 + hq] * LOG2E;
    float m_[4], l_[4];
    f32x4 o[4][4];
#pragma unroll
    for (int nb = 0; nb < 4; ++nb) { m_[nb] = sink2; l_[nb] = 1.f;
#pragma unroll
        for (int hb = 0; hb < 4; ++hb) o[hb][nb] = (f32x4){0.f, 0.f, 0.f, 0.f}; }
    for (int step = 0; step < 6; ++step) {
        const int kj0 = 64 * qh + 32 * step;
        if (n == 0 && kj0 + 32 <= 128) continue;
        f32x4 s[2][4];
#pragma unroll
        for (int mb = 0; mb < 2; ++mb)
#pragma unroll
            for (int nb = 0; nb < 4; ++nb) s[mb][nb] = (f32x4){0.f, 0.f, 0.f, 0.f};
#pragma unroll
        for (int mb = 0; mb < 2; ++mb)
#pragma unroll
            for (int kk = 0; kk < 2; ++kk) {
                const bf16x8 a = *(const bf16x8*)(Ks + (kj0 + 16 * mb + fr) * KS_LD + 32 * kk + 8 * fq);
#pragma unroll
                for (int nb = 0; nb < 4; ++nb) s[mb][nb] = MFMA16(a, qf[nb][kk], s[mb][nb]);
            }
        bf16x8 pb[4];
#pragma unroll
        for (int nb = 0; nb < 4; ++nb) {
            const int qi = 64 * qh + 16 * nb + fr;
            float tmax = -1e30f;
#pragma unroll
            for (int mb = 0; mb < 2; ++mb)
#pragma unroll
                for (int j = 0; j < 4; ++j) {
                    const int kj = kj0 + 16 * mb + 4 * fq + j, dist = qi + 128 - kj;
                    const bool valid = (dist >= 0) && (dist < 128) && (n > 0 || kj >= 128);
                    const float v = valid ? s[mb][nb][j] * LOG2E : -1e30f;
                    s[mb][nb][j] = v; tmax = fmaxf(tmax, v);
                }
            tmax = fmaxf(tmax, __shfl_xor(tmax, 16)); tmax = fmaxf(tmax, __shfl_xor(tmax, 32));
            const float mnew = fmaxf(m_[nb], tmax), alpha = fast_exp2(m_[nb] - mnew);
            m_[nb] = mnew;
            float rs = 0.f;
#pragma unroll
            for (int mb = 0; mb < 2; ++mb)
#pragma unroll
                for (int j = 0; j < 4; ++j) { const float pv = fast_exp2(s[mb][nb][j] - mnew); s[mb][nb][j] = pv; rs += pv; }
            rs += __shfl_xor(rs, 16); rs += __shfl_xor(rs, 32);
            l_[nb] = l_[nb] * alpha + rs;
#pragma unroll
            for (int hb = 0; hb < 4; ++hb) o[hb][nb] = o[hb][nb] * alpha;
            pb[nb] = __builtin_bit_cast(bf16x8, (u32x4){cvt_pk_bf16(s[0][nb][0], s[0][nb][1]), cvt_pk_bf16(s[0][nb][2], s[0][nb][3]),
                                                        cvt_pk_bf16(s[1][nb][0], s[1][nb][1]), cvt_pk_bf16(s[1][nb][2], s[1][nb][3])});
        }
#pragma unroll
        for (int hb = 0; hb < 4; ++hb) {
            const bf16_t* vp = Vt + (16 * hb + fr) * VT_LD + kj0 + 4 * fq;
            const u32x2 a0 = *(const u32x2*)vp, a1 = *(const u32x2*)(vp + 16);
            const bf16x8 a = __builtin_bit_cast(bf16x8, (u32x4){a0.x, a0.y, a1.x, a1.y});
#pragma unroll
            for (int nb = 0; nb < 4; ++nb) o[hb][nb] = MFMA16(a, pb[nb], o[hb][nb]);
        }
    }
#pragma unroll
    for (int nb = 0; nb < 4; ++nb) {
        const int tok = tokq0 + 16 * nb + fr;
        const float inv = 1.f / l_[nb];
#pragma unroll
        for (int hb = 0; hb < 4; ++hb) {
            const int col = hq * 64 + 16 * hb + 4 * fq;
            const u32x2 z = *(const u32x2*)(proj + (size_t)tok * NPROJ + C_Z + col);
            u32x2 y; y.x = cvt_pk_bf16(o[hb][nb][0] * inv * bf_lo(z.x), o[hb][nb][1] * inv * bf_hi(z.x));
            y.y = cvt_pk_bf16(o[hb][nb][2] * inv * bf_lo(z.y), o[hb][nb][3] * inv * bf_hi(z.y));
            *(u32x2*)(Y + (size_t)tok * D + col) = y;
        }
    }
    __syncthreads();
}

constexpr int VN_LD = 136;
__device__ __forceinline__ void sg_item(const Params& p, int l, int item, unsigned char* lds, int tid, int wave, int lane) {
    const int b = item >> 7, c = (item >> 3) & 15, g = item & 7;
    const int fr = lane & 15, fq = lane >> 4;
    bf16_t* vnT = (bf16_t*)lds;
    float* st = (float*)(lds + 64 * VN_LD * 2);
    const bf16_t* proj = (const bf16_t*)(p.ws + WS_PROJ);
    bf16_t* Y = (bf16_t*)(p.ws + WS_Y);
    const int tok0 = b * SEQ + c * 128;
    {
        const int s = tid >> 2, qd = tid & 3;
        const bf16_t* vp = proj + (size_t)(tok0 + s) * NPROJ + C_SV + 128 * qd;
        float sum = 0.f, sq = 0.f;
#pragma unroll
        for (int i = 0; i < 16; ++i) { const u32x4 w = *(const u32x4*)(vp + 8 * i); const unsigned ww[4] = {w.x, w.y, w.z, w.w};
#pragma unroll
            for (int e = 0; e < 4; ++e) { const float a = bf_lo(ww[e]), bb = bf_hi(ww[e]); sum += a + bb; sq += a * a + bb * bb; } }
        sum += __shfl_xor(sum, 1); sum += __shfl_xor(sum, 2); sq += __shfl_xor(sq, 1); sq += __shfl_xor(sq, 2);
        const float mu = sum * (1.f / 512.f), var = fmaxf(sq * (1.f / 512.f) - mu * mu, 0.f);
        if (qd == 0) { st[2 * s] = mu; st[2 * s + 1] = rsqrtf(var + EPS); }
    }
    __syncthreads();
    {
        const int s = tid >> 2, part = tid & 3;
        const bf16_t* vp = proj + (size_t)(tok0 + s) * NPROJ + C_SV + 64 * g + 16 * part;
        const float mu = st[2 * s], rstd = st[2 * s + 1];
        const float* lg = p.sg_ln_g + l * 512 + 64 * g + 16 * part; const float* lb = p.sg_ln_b + l * 512 + 64 * g + 16 * part;
#pragma unroll
        for (int i = 0; i < 2; ++i) { const u32x4 w = *(const u32x4*)(vp + 8 * i); const unsigned ww[4] = {w.x, w.y, w.z, w.w};
#pragma unroll
            for (int e = 0; e < 4; ++e) { const int ch = 8 * i + 2 * e;
                vnT[(16 * part + ch) * VN_LD + s] = f2bf((bf_lo(ww[e]) - mu) * rstd * lg[ch] + lb[ch]);
                vnT[(16 * part + ch + 1) * VN_LD + s] = f2bf((bf_hi(ww[e]) - mu) * rstd * lg[ch + 1] + lb[ch + 1]); } }
    }
    __syncthreads();
    {
        const int t = 16 * wave + fr;
        f32x4 acc[4];
#pragma unroll
        for (int mb = 0; mb < 4; ++mb) acc[mb] = (f32x4){0.f, 0.f, 0.f, 0.f};
        const float* wrow = p.sg_w + ((size_t)(l * 8 + g) * 128 + t) * 128;
#pragma unroll
        for (int kk = 0; kk < 4; ++kk) {
            if (32 * kk <= 16 * wave + 15) {
                const int s0 = 32 * kk + 8 * fq;
                const f32x4 f0 = *(const f32x4*)(wrow + s0), f1 = *(const f32x4*)(wrow + s0 + 4);
                float w[8] = {f0[0], f0[1], f0[2], f0[3], f1[0], f1[1], f1[2], f1[3]};
#pragma unroll
                for (int e = 0; e < 8; ++e) w[e] = (s0 + e <= t) ? w[e] : 0.f;
                const bf16x8 bfr = __builtin_bit_cast(bf16x8, (u32x4){cvt_pk_bf16(w[0], w[1]), cvt_pk_bf16(w[2], w[3]), cvt_pk_bf16(w[4], w[5]), cvt_pk_bf16(w[6], w[7])});
#pragma unroll
                for (int mb = 0; mb < 4; ++mb) { const bf16x8 a = *(const bf16x8*)(vnT + (16 * mb + fr) * VN_LD + s0); acc[mb] = MFMA16(a, bfr, acc[mb]); }
            }
        }
        const float bias = p.sg_b[(l * 8 + g) * 128 + t];
        const int tok = tok0 + t;
#pragma unroll
        for (int mb = 0; mb < 4; ++mb) {
            const int col = 64 * g + 16 * mb + 4 * fq;
            const u32x2 u = *(const u32x2*)(proj + (size_t)tok * NPROJ + C_SU + col);
            const u32x2 z = *(const u32x2*)(proj + (size_t)tok * NPROJ + C_Z + 1024 + col);
            u32x2 y; y.x = cvt_pk_bf16(bf_lo(u.x) * (acc[mb][0] + bias) * bf_lo(z.x), bf_hi(u.x) * (acc[mb][1] + bias) * bf_hi(z.x));
            y.y = cvt_pk_bf16(bf_lo(u.y) * (acc[mb][2] + bias) * bf_lo(z.y), bf_hi(u.y) * (acc[mb][3] + bias) * bf_hi(z.y));
            *(u32x2*)(Y + (size_t)tok * D + 1024 + col) = y;
        }
    }
    __syncthreads();
}

constexpr int GL_LD = 72;
__device__ __forceinline__ void gla_b(const Params& p, int l, int h, int tok, int tid, int lane, float (&bc)[8], float (&bl)[8]) {
    const float* cgp = (const float*)(p.ws + WS_CG) + (size_t)tok * 16;
    const f32x4 c0 = *(const f32x4*)cgp, c1 = *(const f32x4*)(cgp + 4), c2 = *(const f32x4*)(cgp + 8), c3 = *(const f32x4*)(cgp + 12);
    const float cgv[16] = {c0[0], c0[1], c0[2], c0[3], c1[0], c1[1], c1[2], c1[3], c2[0], c2[1], c2[2], c2[3], c3[0], c3[1], c3[2], c3[3]};
#pragma unroll
    for (int i = 0; i < 8; ++i) {
        const int col = h * 64 + 8 * (tid >> 6) + i;
        float x = p.gla_bg[l * 256 + col];
#pragma unroll
        for (int r = 0; r < 16; ++r) x += cgv[r] * p.gla_wup[(l * 16 + r) * 256 + col];
        float la = (fminf(x, 0.f) - __logf(1.f + __expf(-fabsf(x)))) * (1.f / 16.f);
#pragma unroll
        for (int off = 1; off < 64; off <<= 1) { const float v = __shfl_up(la, off); if (lane >= off) la += v; }
        bc[i] = la; bl[i] = __shfl(la, 63);
    }
}
__device__ __forceinline__ void gla_stage_vT(const bf16_t* proj, int tok0, int h, bf16_t* vT, int tid) {
    const int t = tid >> 3, c8 = tid & 7;
    const bf16_t* vp = proj + (size_t)(tok0 + t) * NPROJ + C_CV + h * 128 + 16 * c8;
#pragma unroll
    for (int i = 0; i < 2; ++i) { const u32x4 w = *(const u32x4*)(vp + 8 * i); const unsigned ww[4] = {w.x, w.y, w.z, w.w};
#pragma unroll
        for (int e = 0; e < 4; ++e) { const int dv = 16 * c8 + 8 * i + 2 * e;
            vT[dv * GL_LD + t] = (bf16_t)(ww[e] & 0xffffu); vT[(dv + 1) * GL_LD + t] = (bf16_t)(ww[e] >> 16); } }
}
__device__ __forceinline__ void gla_local_item(const Params& p, int l, int item, unsigned char* lds, int tid, int wave, int lane) {
    const int bh = item >> 5, c = item & 31, b = bh >> 2, h = bh & 3;
    const int fr = lane & 15, fq = lane >> 4;
    const int tok0 = b * SEQ + c * 64;
    bf16_t* klT = (bf16_t*)lds;
    bf16_t* vT = (bf16_t*)(lds + 64 * GL_LD * 2);
    const bf16_t* proj = (const bf16_t*)(p.ws + WS_PROJ);
    float bc[8], bl[8];
    gla_b(p, l, h, tok0 + lane, tid, lane, bc, bl);
    {
        const u32x4 kw = *(const u32x4*)(proj + (size_t)(tok0 + lane) * NPROJ + C_CK + h * 64 + 8 * wave);
        const unsigned ww[4] = {kw.x, kw.y, kw.z, kw.w};
#pragma unroll
        for (int e = 0; e < 4; ++e) {
            klT[(8 * wave + 2 * e) * GL_LD + lane] = f2bf(bf_lo(ww[e]) * __expf(bl[2 * e] - bc[2 * e]));
            klT[(8 * wave + 2 * e + 1) * GL_LD + lane] = f2bf(bf_hi(ww[e]) * __expf(bl[2 * e + 1] - bc[2 * e + 1]));
        }
        if (lane == 63) { float* dec = (float*)(p.ws + WS_DEC) + (size_t)item * 64 + 8 * wave;
#pragma unroll
            for (int i = 0; i < 8; ++i) dec[i] = __expf(bl[i]); }
    }
    gla_stage_vT(proj, tok0, h, vT, tid);
    __syncthreads();
    {
        f32x4 acc[4];
#pragma unroll
        for (int mb = 0; mb < 4; ++mb) acc[mb] = (f32x4){0.f, 0.f, 0.f, 0.f};
#pragma unroll
        for (int kk = 0; kk < 2; ++kk) {
            const bf16x8 bfr = *(const bf16x8*)(vT + (16 * wave + fr) * GL_LD + 32 * kk + 8 * fq);
#pragma unroll
            for (int mb = 0; mb < 4; ++mb) { const bf16x8 a = *(const bf16x8*)(klT + (16 * mb + fr) * GL_LD + 32 * kk + 8 * fq); acc[mb] = MFMA16(a, bfr, acc[mb]); }
        }
        float* loct = (float*)(p.ws + WS_LOCT) + (size_t)item * 8192 + (16 * wave + fr) * 64 + 4 * fq;
#pragma unroll
        for (int mb = 0; mb < 4; ++mb) *(f32x4*)(loct + 16 * mb) = acc[mb];
    }
    __syncthreads();
}
__device__ __forceinline__ void gla_scan(const Params& p, int tid, int bx) {
    const float* loct = (const float*)(p.ws + WS_LOCT); const float* dec = (const float*)(p.ws + WS_DEC);
    bf16_t* ST = (bf16_t*)(p.ws + WS_ST);
    for (int e = bx * 512 + tid; e < 16 * 8192; e += gridDim.x * 512) {
        const int bh = e >> 13, r = e & 8191, dk = r & 63;
        float s = 0.f;
#pragma unroll 8
        for (int c = 0; c < 32; ++c) { const size_t it = (size_t)bh * 32 + c;
            ST[it * 8192 + r] = f2bf(s);
            s = s * dec[it * 64 + dk] + loct[it * 8192 + r]; }
    }
}
__device__ __forceinline__ void gla_out_item(const Params& p, int l, int item, unsigned char* lds, int tid, int wave, int lane) {
    const int bh = item >> 5, c = item & 31, b = bh >> 2, h = bh & 3;
    const int fr = lane & 15, fq = lane >> 4;
    const int tok0 = b * SEQ + c * 64;
    bf16_t* qd = (bf16_t*)lds;
    bf16_t* kd = (bf16_t*)(lds + 64 * GL_LD * 2);
    bf16_t* vT = (bf16_t*)(lds + 2 * 64 * GL_LD * 2);
    float* red = (float*)(lds + 4 * 64 * GL_LD * 2);
    const bf16_t* proj = (const bf16_t*)(p.ws + WS_PROJ);
    bf16_t* Y = (bf16_t*)(p.ws + WS_Y);
    float bc[8], bl[8];
    gla_b(p, l, h, tok0 + lane, tid, lane, bc, bl);
    {
        const bf16_t* rowp = proj + (size_t)(tok0 + lane) * NPROJ + h * 64 + 8 * wave;
        const u32x4 qw = *(const u32x4*)(rowp + C_CQ), kw = *(const u32x4*)(rowp + C_CK);
        const unsigned qq[4] = {qw.x, qw.y, qw.z, qw.w}, kk4[4] = {kw.x, kw.y, kw.z, kw.w};
        unsigned qo[4], ko[4];
#pragma unroll
        for (int e = 0; e < 4; ++e) {
            const float e0 = __expf(bc[2 * e]), e1 = __expf(bc[2 * e + 1]);
            qo[e] = cvt_pk_bf16(bf_lo(qq[e]) * 0.125f * e0, bf_hi(qq[e]) * 0.125f * e1);
            ko[e] = cvt_pk_bf16(bf_lo(kk4[e]) * fast_rcp(e0), bf_hi(kk4[e]) * fast_rcp(e1));
        }
        *(u32x4*)(qd + lane * GL_LD + 8 * wave) = (u32x4){qo[0], qo[1], qo[2], qo[3]};
        *(u32x4*)(kd + lane * GL_LD + 8 * wave) = (u32x4){ko[0], ko[1], ko[2], ko[3]};
    }
    gla_stage_vT(proj, tok0, h, vT, tid);
    __syncthreads();
    const int tb = wave & 3, dh = wave >> 2, t = 16 * tb + fr;
    bf16x8 bq[2];
#pragma unroll
    for (int kk = 0; kk < 2; ++kk) bq[kk] = *(const bf16x8*)(qd + t * GL_LD + 32 * kk + 8 * fq);
    f32x4 sc[4];
#pragma unroll
    for (int mb = 0; mb < 4; ++mb) {
        sc[mb] = (f32x4){0.f, 0.f, 0.f, 0.f};
        if (mb <= tb) {
#pragma unroll
            for (int kk = 0; kk < 2; ++kk) { const bf16x8 a = *(const bf16x8*)(kd + (16 * mb + fr) * GL_LD + 32 * kk + 8 * fq); sc[mb] = MFMA16(a, bq[kk], sc[mb]); }
#pragma unroll
            for (int j = 0; j < 4; ++j) if (16 * mb + 4 * fq + j > t) sc[mb][j] = 0.f;
        }
    }
    bf16x8 bp[2];
#pragma unroll
    for (int k2 = 0; k2 < 2; ++k2)
        bp[k2] = __builtin_bit_cast(bf16x8, (u32x4){cvt_pk_bf16(sc[2 * k2][0], sc[2 * k2][1]), cvt_pk_bf16(sc[2 * k2][2], sc[2 * k2][3]),
                                                    cvt_pk_bf16(sc[2 * k2 + 1][0], sc[2 * k2 + 1][1]), cvt_pk_bf16(sc[2 * k2 + 1][2], sc[2 * k2 + 1][3])});
    f32x4 acc[4];
    const bf16_t* ST = (const bf16_t*)(p.ws + WS_ST) + (size_t)item * 8192;
    float ssq = 0.f;
#pragma unroll
    for (int mb = 0; mb < 4; ++mb) {
        const int dvrow = 64 * dh + 16 * mb + fr;
        acc[mb] = (f32x4){0.f, 0.f, 0.f, 0.f};
#pragma unroll
        for (int k2 = 0; k2 < 2; ++k2) {
            const bf16_t* vp = vT + dvrow * GL_LD + 32 * k2 + 4 * fq;
            const u32x2 a0 = *(const u32x2*)vp, a1 = *(const u32x2*)(vp + 16);
            acc[mb] = MFMA16(__builtin_bit_cast(bf16x8, (u32x4){a0.x, a0.y, a1.x, a1.y}), bp[k2], acc[mb]);
        }
#pragma unroll
        for (int kk = 0; kk < 2; ++kk) { const bf16x8 a = *(const bf16x8*)(ST + dvrow * 64 + 32 * kk + 8 * fq); acc[mb] = MFMA16(a, bq[kk], acc[mb]); }
        ssq += (acc[mb][0] * acc[mb][0] + acc[mb][1] * acc[mb][1]) + (acc[mb][2] * acc[mb][2] + acc[mb][3] * acc[mb][3]);
    }
    ssq += __shfl_xor(ssq, 16); ssq += __shfl_xor(ssq, 32);
    if (fq == 0) red[dh * 64 + t] = ssq;
    __syncthreads();
    const float rstd = rsqrtf((red[t] + red[64 + t]) * (1.f / 128.f) + EPS);
    const int tok = tok0 + t;
#pragma unroll
    for (int mb = 0; mb < 4; ++mb) {
        const int dv = 64 * dh + 16 * mb + 4 * fq;
        const f32x4 g4 = *(const f32x4*)(p.gla_ng + l * 128 + dv);
        const int col = 1536 + h * 128 + dv;
        const u32x2 z = *(const u32x2*)(proj + (size_t)tok * NPROJ + C_Z + col);
        u32x2 y; y.x = cvt_pk_bf16(acc[mb][0] * rstd * g4[0] * bf_lo(z.x), acc[mb][1] * rstd * g4[1] * bf_hi(z.x));
        y.y = cvt_pk_bf16(acc[mb][2] * rstd * g4[2] * bf_lo(z.y), acc[mb][3] * rstd * g4[3] * bf_hi(z.y));
        *(u32x2*)(Y + (size_t)tok * D + col) = y;
    }
    __syncthreads();
}

constexpr int N_PHASES = 14;
__global__ void __launch_bounds__(512, 2) fwd_kernel(Params p) {
    extern __shared__ __attribute__((aligned(16))) unsigned char lds[];
    const int G = gridDim.x;
    const int lo = p.ph_lo, hi = p.ph_hi;
#ifndef PHMASK
#define PHMASK 0xffff
#endif
#define IN(k) (((PHMASK >> ((k) < 2 ? (k) : 2 + ((k) - 2) % 6)) & 1) && lo <= (k) && (k) < hi)
#define SEAM(k) do { if (IN(k) && IN((k) + 1)) { cg::this_grid().sync(); } } while (0)
#define FRESH() int tid = threadIdx.x; asm volatile("" : "+v"(tid)); int bx = blockIdx.x; asm volatile("" : "+s"(bx)); \
    const int lane = tid & 63, wave = __builtin_amdgcn_readfirstlane(tid >> 6); Params q = p; asm volatile("" : "+s"(q.ws)); (void)lane; (void)wave; (void)bx;
    if (IN(0)) { FRESH(); p0_prologue(q, lds, tid, wave, lane, bx); }
    SEAM(0);
    if (IN(1)) { FRESH(); row_pass(q, 0, wave, lane, bx); }
    SEAM(1);
#pragma unroll 1
    for (int l = 0; l < 2; ++l) {
        const int pb = 2 + 6 * l;
        if (IN(pb)) {
            FRESH();
            pg8::Gemm g{(const bf16_t*)(q.ws + WS_H), (const bf16_t*)(q.ws + WS_WIN + (size_t)l * WIN_BYTES), M, NPAD, D};
            pg8::StaticOrder S; S.init(M, NPAD, G, bx);
            pg8::EpiProj E{(bf16_t*)(q.ws + WS_PROJ), (float*)(q.ws + WS_CG)};
            pg8::gemm_phase<pg8::EpiProj, pg8::StaticOrder, true, true>((LAS unsigned char*)lds, g, S, E, tid);
        }
        SEAM(pb);
        if (IN(pb + 1)) {
#ifndef MIXMASK
#define MIXMASK 7
#endif
            if (MIXMASK & 1) { FRESH(); for (int it = bx; it < 256; it += G) attn_item(q, l, it, lds, tid, wave, lane); }
            if (MIXMASK & 2) { FRESH(); for (int it = bx; it < 512; it += G) sg_item(q, l, it, lds, tid, wave, lane); }
            if (MIXMASK & 4) { FRESH(); for (int it = bx; it < 512; it += G) gla_local_item(q, l, it, lds, tid, wave, lane); }
        }
        SEAM(pb + 1);
        if (IN(pb + 2)) { FRESH(); gla_scan(q, tid, bx); }
        SEAM(pb + 2);
        if (IN(pb + 3)) { FRESH(); for (int it = bx; it < 512; it += G) gla_out_item(q, l, it, lds, tid, wave, lane); }
        SEAM(pb + 3);
        if (IN(pb + 4)) {
            FRESH();
            pg8::Gemm g{(const bf16_t*)(q.ws + WS_Y), (const bf16_t*)(q.ws + WS_WOUT + (size_t)l * WOUT_BYTES), M, D, D};
            pg8::StaticOrder S; S.init(M, D, G, bx);
            pg8::EpiOut E{(bf16_t*)(q.ws + WS_OUT)};
            pg8::gemm_phase<pg8::EpiOut, pg8::StaticOrder, true, true>((LAS unsigned char*)lds, g, S, E, tid);
        }
        SEAM(pb + 4);
        if (IN(pb + 5)) { FRESH(); row_pass(q, l + 1, wave, lane, bx); }
        if (l == 0) SEAM(pb + 5);
    }
#undef IN
#undef SEAM
#undef FRESH
}

extern "C" void kernel_launch(void* const* d_in, const int* in_sizes, int n_in, void* d_out, int out_size, void* d_ws, size_t ws_size, hipStream_t stream) {
    static int grid = 0;
    if (grid == 0) {
        if (n_in != 17 || in_sizes[0] != M * D || out_size != M * D || ws_size < WS_END) { fprintf(stderr, "kernel_launch: unexpected shapes (n_in %d, in0 %d, out %d, ws %zu)\n", n_in, n_in > 0 ? in_sizes[0] : -1, out_size, ws_size); grid = -1; return; }
        int dev = 0, cus = 0, per_cu = 0;
        if (hipGetDevice(&dev) != hipSuccess || hipDeviceGetAttribute(&cus, hipDeviceAttributeMultiprocessorCount, dev) != hipSuccess) { grid = -1; return; }
        if (hipFuncSetAttribute((const void*)fwd_kernel, hipFuncAttributeMaxDynamicSharedMemorySize, LDS_BYTES) != hipSuccess) { fprintf(stderr, "kernel_launch: hipFuncSetAttribute failed\n"); grid = -1; return; }
        if (hipOccupancyMaxActiveBlocksPerMultiprocessor(&per_cu, (const void*)fwd_kernel, 512, LDS_BYTES) != hipSuccess || per_cu < 1) { fprintf(stderr, "kernel_launch: occupancy query says %d blocks per CU\n", per_cu); per_cu = 1; }
        (void)hipGetLastError();
        grid = cus;
    }
    if (grid < 0) return;
    Params p{};
    p.x = (const float*)d_in[0]; p.c = (const float*)d_in[1]; p.pos = (const int*)d_in[2]; p.w_mod = (const float*)d_in[3]; p.b_mod = (const float*)d_in[4];
    p.g_pre = (const float*)d_in[5]; p.g_post = (const float*)d_in[6]; p.w_in = (const float*)d_in[7]; p.w_out = (const float*)d_in[8]; p.sinks = (const float*)d_in[9];
    p.sg_w = (const float*)d_in[10]; p.sg_b = (const float*)d_in[11]; p.sg_ln_g = (const float*)d_in[12]; p.sg_ln_b = (const float*)d_in[13];
    p.gla_wup = (const float*)d_in[14]; p.gla_bg = (const float*)d_in[15]; p.gla_ng = (const float*)d_in[16];
    p.out = (float*)d_out; p.ws = (unsigned char*)d_ws;
#if MK_SINGLE
    p.ph_lo = 0; p.ph_hi = N_PHASES;
    void* args[] = {&p};
    hipError_t e = hipLaunchCooperativeKernel((const void*)fwd_kernel, dim3(grid), dim3(512), args, LDS_BYTES, stream);
    if (e != hipSuccess) fprintf(stderr, "kernel_launch: cooperative launch failed: %s (grid %d)\n", hipGetErrorString(e), grid);
#else
    for (int ph = 0; ph < N_PHASES; ++ph) {
        p.ph_lo = ph; p.ph_hi = ph + 1;
        hipLaunchKernelGGL(fwd_kernel, dim3(grid), dim3(512), LDS_BYTES, stream, p);
    }
#endif
}
```

```cpp
#include <hip/hip_runtime.h>
#include <hip/hip_cooperative_groups.h>
#include <cstdio>
#include <cstdint>
namespace cg = cooperative_groups;

#ifndef REPS
#define REPS 0x11111111
#endif
#define REPN(k) ((REPS >> (4 * (k))) & 15)
#ifndef PMASK
#define PMASK 0ull
#endif
#ifndef MIXR
#define MIXR 0x111
#endif
#ifndef MK_SINGLE
#define MK_SINGLE 1
#endif

#define LAS __attribute__((address_space(3)))
typedef unsigned short bf16_t;
typedef short bf16x8 __attribute__((ext_vector_type(8)));
typedef float f32x4 __attribute__((ext_vector_type(4)));
typedef float f32x2 __attribute__((ext_vector_type(2)));
typedef unsigned u32x4 __attribute__((ext_vector_type(4)));
typedef unsigned u32x2 __attribute__((ext_vector_type(2)));

constexpr int D = 2048, NB = 4, SEQ = 2048, M = NB * SEQ;
constexpr int NPROJ = 5632;
constexpr int NPAD = 5888;
constexpr int WIN_LD = 5648;
constexpr float EPS = 1e-6f;
constexpr int C_AQ = 0, C_AK = 1024, C_AV = 1280, C_SU = 1536, C_SV = 2048, C_CQ = 2560, C_CK = 2816, C_CV = 3072, C_Z = 3584;
constexpr float LOG2E = 1.4426950408889634f;

constexpr size_t MiB = 1u << 20;
constexpr size_t WS_WIN = 0, WIN_BYTES = (size_t)NPAD * D * 2;
constexpr size_t WS_WOUT = 46 * MiB, WOUT_BYTES = (size_t)D * D * 2;
constexpr size_t WS_H = 62 * MiB, WS_PROJ = 94 * MiB, WS_CG = 182 * MiB, WS_MOD = 183 * MiB, WS_Y = 184 * MiB, WS_OUT = 216 * MiB;
constexpr size_t WS_LOCT = 248 * MiB, WS_ST = 264 * MiB, WS_DEC = 272 * MiB, WS_BAR = 273 * MiB, WS_QD = 274 * MiB, WS_KD = 278 * MiB, WS_VTG = 282 * MiB, WS_X1B = 290 * MiB, WS_SGST = 322 * MiB, WS_END = 323 * MiB;

constexpr int LDS_BYTES = 135168;

struct Params {
    const float* x; const float* c; const int* pos; const float* w_mod; const float* b_mod; const float* g_pre; const float* g_post;
    const float* w_in; const float* w_out; const float* sinks; const float* sg_w; const float* sg_b; const float* sg_ln_g; const float* sg_ln_b;
    const float* gla_wup; const float* gla_bg; const float* gla_ng;
    float* out; unsigned char* ws; int ph_lo, ph_hi;
};

__device__ __forceinline__ Params fresh_params(const Params& p) {
#if defined(__HIP_DEVICE_COMPILE__)
    typedef unsigned long long u64;
    const __attribute__((address_space(4))) u64* pp = (const __attribute__((address_space(4))) u64*)__builtin_amdgcn_kernarg_segment_ptr();
    asm volatile("" : "+s"(pp));
    Params q; u64* dst = (u64*)&q;
#pragma unroll
    for (int i = 0; i < (int)(sizeof(Params) / 8); ++i) dst[i] = pp[i];
    return q;
#else
    return p;
#endif
}
static_assert(sizeof(Params) % 8 == 0, "Params is copied in 8-byte words");

typedef __bf16 bf16x2_t __attribute__((ext_vector_type(2)));
__device__ __forceinline__ unsigned cvt_pk_bf16(float lo, float hi) { const f32x2 v = {lo, hi}; const bf16x2_t b = __builtin_convertvector(v, bf16x2_t); return __builtin_bit_cast(unsigned, b); }
__device__ __forceinline__ float bf_lo(unsigned u) { return __builtin_bit_cast(float, u << 16); }
__device__ __forceinline__ float bf_hi(unsigned u) { return __builtin_bit_cast(float, u & 0xffff0000u); }
__device__ __forceinline__ float bf1(bf16_t v) { return __builtin_bit_cast(float, (unsigned)v << 16); }
__device__ __forceinline__ bf16_t f2bf(float f) { return (bf16_t)(cvt_pk_bf16(f, 0.f) & 0xffffu); }
__device__ __forceinline__ float fast_exp2(float x) { return __builtin_amdgcn_exp2f(x); }
__device__ __forceinline__ float fast_rcp(float x) { return __builtin_amdgcn_rcpf(x); }
__device__ __forceinline__ float silu_f(float x) { return x * fast_rcp(1.f + fast_exp2(-x * LOG2E)); }
__device__ __forceinline__ float gelu_tanh_f(float x) { const float u = 0.7978845608028654f * (x + 0.044715f * x * x * x); return x * fast_rcp(1.f + fast_exp2(-2.f * LOG2E * u)); }
__device__ __forceinline__ float wave_sum(float v) {
#pragma unroll
    for (int o = 1; o < 64; o <<= 1) v += __shfl_xor(v, o);
    return v;
}

typedef short v4i16_t __attribute__((ext_vector_type(4)));
__device__ __forceinline__ bf16x8 tr_operand(const void* p0, const void* p1) {
    const v4i16_t a = __builtin_amdgcn_ds_read_tr16_b64_v4i16((__attribute__((address_space(3))) v4i16_t*)p0);
    const v4i16_t b = __builtin_amdgcn_ds_read_tr16_b64_v4i16((__attribute__((address_space(3))) v4i16_t*)p1);
    return __builtin_shufflevector(a, b, 0, 1, 2, 3, 4, 5, 6, 7);
}
#define MFMA16(a, b, c) __builtin_amdgcn_mfma_f32_16x16x32_bf16((a), (b), (c), 0, 0, 0)

namespace pg8 {
#define PG8_LAS __attribute__((address_space(3)))
constexpr int BM = 256, BK = 64, HALF = 128, HTB = HALF * BK * 2, STAGE_BYTES = 8 * HTB, NXCD = 8, WGM = 8;
__host__ __device__ __forceinline__ int lds_byte(int r, int c) { const int st = (r >> 4) * 2 + (c >> 5), rr = r & 15, cc = c & 31, ob = rr * 64 + cc * 2; return st * 1024 + (ob ^ (((ob >> 9) & 1) << 5)); }
__host__ __device__ __forceinline__ void stage_rc(int b, int& R, int& C) { const int st = b / 1024, sb = b % 1024, swz = sb ^ (((sb >> 9) & 1) << 5); R = (st >> 1) * 16 + swz / 64; C = (st & 1) * 32 + (swz % 64) / 2; }
__host__ __device__ __forceinline__ int perm32(int rho) { const int n = rho >> 4, i = rho & 15; return 8 * (i >> 2) + 4 * n + (i & 3); }
struct Unit { int pm, pn; };
struct Gemm { const bf16_t* A; const bf16_t* Bt; int M, N, K; };
struct StaticOrder {
    int nM, nN, nwg, G, c;
    __host__ __device__ void init(int M_, int N_, int G_, int c_) { nM = M_ / BM; nN = N_ / BM; nwg = nM * nN; G = G_; c = c_; }
    __host__ __device__ bool next(int i, Unit& u) const {
        const long L = (long)i * G + c; if (L >= nwg) return false;
        int wgid = (int)L; { const int q = nwg / NXCD, r = nwg % NXCD, xcd = wgid % NXCD, off = wgid / NXCD; wgid = (xcd < r ? xcd * (q + 1) : r * (q + 1) + (xcd - r) * q) + off; }
        const int nig = WGM * nN, gid = wgid / nig, fm = gid * WGM, gsz = (nM - fm) < WGM ? (nM - fm) : WGM;
        u.pm = fm + ((wgid % nig) % gsz); u.pn = (wgid % nig) / gsz; return true;
    }
    __device__ __forceinline__ void a_ready(const Unit&) const {}
    __device__ __forceinline__ void done(const Unit&) const {}
};

template <class Epi, class Sched, bool ALIGN_EPI = false, bool SP2 = false>
__device__ __forceinline__ void gemm_phase(PG8_LAS unsigned char* lds, const Gemm g, const Sched& S, const Epi& E, const int tid) {
    const int wid = __builtin_amdgcn_readfirstlane(tid >> 6), lane = tid & 63, wr = wid >> 2, wc = wid & 3, fr = lane & 15, fq = lane >> 4;
    const int K = g.K, nt = K / BK;
    unsigned voffA[2], voffB[2];
#pragma unroll
    for (int i = 0; i < 2; ++i) { int R, C; stage_rc(tid * 16 + i * 8192, R, C); const int Rb = Epi::PERM ? ((R & ~31) + perm32(R & 31)) : R;
        voffA[i] = (unsigned)(R * K + C) * 2u; voffB[i] = (unsigned)(Rb * K + C) * 2u; }
    const size_t kstep = (size_t)(BK * 2);
    const size_t hstep = (size_t)HALF * K * 2;
    const size_t tstep = 2 * hstep;
    const unsigned ldsw = (unsigned)wid * 1024u;
    const int aoff = lds_byte(wr * 64 + fr, fq * 8), boff = lds_byte(wc * 32 + fr, fq * 8);
#define PG8_SA(b, h) (((b) * 2 + (h)) * HTB)
#define PG8_SB(b, h) ((4 + (b) * 2 + (h)) * HTB)
#define PG8_STAGE(bufoff, gbase, voff) do { _Pragma("unroll") for (int _i = 0; _i < 2; ++_i) \
        __builtin_amdgcn_global_load_lds((const unsigned*)((const char*)(gbase) + (voff)[_i]), (PG8_LAS unsigned*)(lds + (bufoff) + ldsw + _i * 8192), 16, 0, 0); } while (0)
#define PG8_LDA(dst, b, h) do { _Pragma("unroll") for (int m = 0; m < 4; ++m) _Pragma("unroll") for (int k = 0; k < 2; ++k) dst[m][k] = *(const PG8_LAS bf16x8*)(lds + PG8_SA(b, h) + aoff + m * 2048 + k * 1024); } while (0)
#define PG8_LDB(dst, b, h) do { _Pragma("unroll") for (int n = 0; n < 2; ++n) _Pragma("unroll") for (int k = 0; k < 2; ++k) dst[n][k] = *(const PG8_LAS bf16x8*)(lds + PG8_SB(b, h) + boff + n * 2048 + k * 1024); } while (0)
#define PG8_MMA(ai, bj, At, Bt) do { __builtin_amdgcn_s_setprio(1); _Pragma("unroll") for (int m = 0; m < 4; ++m) _Pragma("unroll") for (int n = 0; n < 2; ++n) _Pragma("unroll") for (int k = 0; k < 2; ++k) \
        acc[ai][bj][m][n] = __builtin_amdgcn_mfma_f32_16x16x32_bf16(Bt[n][k], At[m][k], acc[ai][bj][m][n], 0, 0, 0); __builtin_amdgcn_s_setprio(0); } while (0)
#define PG8_WAIT_V(n) asm volatile("s_waitcnt vmcnt(" #n ")" ::: "memory")
#define PG8_WAIT_L(n) asm volatile("s_waitcnt lgkmcnt(" #n ")" ::: "memory")
#define PG8_BAR __builtin_amdgcn_s_barrier()
#define PG8_SCHED __builtin_amdgcn_sched_barrier(0)
    Unit cur, nxt; int ui = 0;
    if (!S.next(0, cur)) return;
    f32x4 acc[2][2][4][2];
#pragma unroll
    for (int a = 0; a < 2; ++a)
#pragma unroll
        for (int b = 0; b < 2; ++b)
#pragma unroll
            for (int m = 0; m < 4; ++m)
#pragma unroll
                for (int n = 0; n < 2; ++n) acc[a][b][m][n] = (f32x4){0.f, 0.f, 0.f, 0.f};
    bf16x8 At[4][2], B0[2][2], B1[2][2];
    const char* cA = (const char*)g.A + (size_t)cur.pm * tstep; const char* cB = (const char*)g.Bt + (size_t)cur.pn * tstep;
    S.a_ready(cur);
    if constexpr (SP2) {
        PG8_STAGE(PG8_SB(0, 0), cB, voffB); PG8_STAGE(PG8_SB(0, 1), cB + hstep, voffB); PG8_STAGE(PG8_SA(0, 0), cA, voffA); PG8_STAGE(PG8_SA(0, 1), cA + hstep, voffA);
        if (wr == 1) PG8_BAR;
        PG8_WAIT_V(2); PG8_BAR;
        PG8_STAGE(PG8_SB(1, 0), cB + kstep, voffB); PG8_STAGE(PG8_SA(1, 0), cA + kstep, voffA); PG8_STAGE(PG8_SB(1, 1), cB + hstep + kstep, voffB);
        PG8_WAIT_V(6); PG8_BAR;
    } else {
        PG8_STAGE(PG8_SB(0, 0), cB, voffB); PG8_STAGE(PG8_SA(0, 0), cA, voffA); PG8_STAGE(PG8_SB(0, 1), cB + hstep, voffB); PG8_STAGE(PG8_SA(0, 1), cA + hstep, voffA);
        if (wr == 1) PG8_BAR;
        PG8_WAIT_V(4); PG8_BAR;
        PG8_STAGE(PG8_SB(1, 0), cB + kstep, voffB); PG8_STAGE(PG8_SA(1, 0), cA + kstep, voffA); PG8_STAGE(PG8_SB(1, 1), cB + hstep + kstep, voffB);
        PG8_WAIT_V(6); PG8_BAR;
    }
    for (;;) {
        const bool has_next = S.next(ui + 1, nxt);
        const char* nA = has_next ? (const char*)g.A + (size_t)nxt.pm * tstep : cA; const char* nB = has_next ? (const char*)g.Bt + (size_t)nxt.pn * tstep : cB;
        for (int t = 0; t < nt; t += 2) {
            const bool last = (t == nt - 2);
            const char* a1 = cA + (size_t)(t + 1) * kstep;
            const char* a2 = last ? nA : cA + (size_t)(t + 2) * kstep; const char* b2 = last ? nB : cB + (size_t)(t + 2) * kstep;
            const char* a3 = a2 + kstep; const char* b3 = b2 + kstep;
            if (last && has_next) S.a_ready(nxt);
            if constexpr (SP2) {
            PG8_LDB(B0, 0, 0); PG8_LDB(B1, 0, 1); PG8_SCHED; PG8_LDA(At, 0, 0); PG8_STAGE(PG8_SA(1, 1), a1 + hstep, voffA);
            PG8_WAIT_V(8); PG8_WAIT_L(0); PG8_BAR; PG8_MMA(0, 0, At, B0); PG8_MMA(0, 1, At, B1); PG8_BAR; PG8_SCHED;
            PG8_LDA(At, 0, 1); PG8_STAGE(PG8_SB(0, 0), b2, voffB); PG8_STAGE(PG8_SB(0, 1), b2 + hstep, voffB); PG8_STAGE(PG8_SA(0, 0), a2, voffA);
            PG8_WAIT_V(8); PG8_WAIT_L(0); PG8_BAR; PG8_MMA(1, 0, At, B0); PG8_MMA(1, 1, At, B1); PG8_BAR; PG8_SCHED;
            PG8_LDB(B0, 1, 0); PG8_LDB(B1, 1, 1); PG8_SCHED; PG8_LDA(At, 1, 0); PG8_STAGE(PG8_SA(0, 1), a2 + hstep, voffA);
            PG8_WAIT_V(8); PG8_WAIT_L(0); PG8_BAR; PG8_MMA(0, 0, At, B0); PG8_MMA(0, 1, At, B1); PG8_BAR; PG8_SCHED;
            PG8_LDA(At, 1, 1); PG8_STAGE(PG8_SB(1, 0), b3, voffB); PG8_STAGE(PG8_SB(1, 1), b3 + hstep, voffB); PG8_STAGE(PG8_SA(1, 0), a3, voffA);
            PG8_WAIT_V(8); PG8_WAIT_L(0); PG8_BAR; PG8_MMA(1, 0, At, B0); PG8_MMA(1, 1, At, B1); PG8_BAR; PG8_SCHED;
            } else {
            PG8_LDB(B0, 0, 0); PG8_SCHED; PG8_LDA(At, 0, 0); PG8_STAGE(PG8_SA(1, 1), a1 + hstep, voffA);
            PG8_WAIT_L(8); PG8_BAR; PG8_WAIT_L(0); PG8_MMA(0, 0, At, B0); PG8_BAR; PG8_SCHED;
            PG8_LDB(B1, 0, 1); PG8_STAGE(PG8_SB(0, 0), b2, voffB);
            PG8_BAR; PG8_WAIT_L(0); PG8_MMA(0, 1, At, B1); PG8_BAR;
            PG8_LDA(At, 0, 1); PG8_STAGE(PG8_SA(0, 0), a2, voffA);
            PG8_BAR; PG8_WAIT_L(0); PG8_MMA(1, 0, At, B0); PG8_BAR; PG8_SCHED;
            PG8_STAGE(PG8_SB(0, 1), b2 + hstep, voffB);
            PG8_WAIT_V(6); PG8_BAR; PG8_MMA(1, 1, At, B1); PG8_BAR;
            PG8_LDB(B0, 1, 0); PG8_SCHED; PG8_LDA(At, 1, 0); PG8_STAGE(PG8_SA(0, 1), a2 + hstep, voffA);
            PG8_WAIT_L(8); PG8_BAR; PG8_WAIT_L(0); PG8_MMA(0, 0, At, B0); PG8_BAR; PG8_SCHED;
            PG8_LDB(B1, 1, 1); PG8_STAGE(PG8_SB(1, 0), b3, voffB);
            PG8_BAR; PG8_WAIT_L(0); PG8_MMA(0, 1, At, B1); PG8_BAR;
            PG8_LDA(At, 1, 1); PG8_STAGE(PG8_SA(1, 0), a3, voffA);
            PG8_BAR; PG8_WAIT_L(0); PG8_MMA(1, 0, At, B0); PG8_BAR; PG8_SCHED;
            PG8_STAGE(PG8_SB(1, 1), b3 + hstep, voffB);
            PG8_WAIT_V(6); PG8_BAR; PG8_MMA(1, 1, At, B1); PG8_BAR;
            }
        }
        if constexpr (ALIGN_EPI) { if (wr == 0) PG8_BAR; }
        E(acc, cur, wr, wc, fr, fq); S.done(cur);
        if (!has_next) break;
#pragma unroll
        for (int a = 0; a < 2; ++a)
#pragma unroll
            for (int b = 0; b < 2; ++b)
#pragma unroll
                for (int m = 0; m < 4; ++m)
#pragma unroll
                    for (int n = 0; n < 2; ++n) acc[a][b][m][n] = (f32x4){0.f, 0.f, 0.f, 0.f};
        cur = nxt; cA = nA; cB = nB; ++ui;
        if constexpr (ALIGN_EPI) { if (wr == 1) PG8_BAR; }
    }
    PG8_WAIT_V(0);
    if constexpr (!ALIGN_EPI) { if (wr == 0) PG8_BAR; }
    PG8_BAR;
#undef PG8_SA
#undef PG8_SB
#undef PG8_STAGE
#undef PG8_LDA
#undef PG8_LDB
#undef PG8_MMA
#undef PG8_WAIT_V
#undef PG8_WAIT_L
#undef PG8_BAR
#undef PG8_SCHED
}

struct EpiProj {
    static constexpr bool PERM = true;
    bf16_t* P; float* CG; float* SGST;
    template <int ACT> __device__ __forceinline__ void store_tile(const f32x4 (&acc)[2][2][4][2], bf16_t* base, float* stp, int fq) const {
#pragma unroll
        for (int ai = 0; ai < 2; ++ai)
#pragma unroll
            for (int m = 0; m < 4; ++m) { bf16_t* rowp = base + (size_t)(ai * HALF + m * 16) * NPROJ;
                float rs = 0.f, rq = 0.f;
#pragma unroll
                for (int bj = 0; bj < 2; ++bj) { f32x4 v0 = acc[ai][bj][m][0], v1 = acc[ai][bj][m][1];
                    if (ACT == 1) { for (int e = 0; e < 4; ++e) { v0[e] = gelu_tanh_f(v0[e]); v1[e] = gelu_tanh_f(v1[e]); } }
                    if (ACT == 2) { for (int e = 0; e < 4; ++e) { v0[e] = silu_f(v0[e]); v1[e] = silu_f(v1[e]); } }
                    if (ACT == 1) { rs += ((v0[0] + v0[1]) + (v0[2] + v0[3])) + ((v1[0] + v1[1]) + (v1[2] + v1[3]));
                        rq += ((v0[0] * v0[0] + v0[1] * v0[1]) + (v0[2] * v0[2] + v0[3] * v0[3])) + ((v1[0] * v1[0] + v1[1] * v1[1]) + (v1[2] * v1[2] + v1[3] * v1[3])); }
                    u32x4 w; w.x = cvt_pk_bf16(v0[0], v0[1]); w.y = cvt_pk_bf16(v0[2], v0[3]); w.z = cvt_pk_bf16(v1[0], v1[1]); w.w = cvt_pk_bf16(v1[2], v1[3]);
                    *(u32x4*)(rowp + bj * HALF) = w; }
                if (ACT == 1) { if (stp) { rs += __shfl_xor(rs, 16); rs += __shfl_xor(rs, 32); rq += __shfl_xor(rq, 16); rq += __shfl_xor(rq, 32);
                    if (fq == 0) *(f32x2*)(stp + (size_t)(ai * HALF + m * 16) * 16) = (f32x2){rs, rq}; } } }
    }
    __device__ __forceinline__ void operator()(const f32x4 (&acc)[2][2][4][2], const Unit& u, int wr, int wc, int fr, int fq) const {
        const int row0 = u.pm * BM + wr * 64 + fr;
        if (u.pn < 22) {
            bf16_t* base = P + (size_t)row0 * NPROJ + u.pn * BM + wc * 32 + 8 * fq;
            if (u.pn >= 6 && u.pn < 10) store_tile<1>(acc, base, (u.pn >= 8) ? SGST + (size_t)row0 * 16 + ((u.pn - 8) * 4 + wc) * 2 : nullptr, fq);
            else if (u.pn >= 14) store_tile<2>(acc, base, nullptr, fq);
            else store_tile<0>(acc, base, nullptr, fq);
        } else if (wc == 0 && fq < 2) {
#pragma unroll
            for (int ai = 0; ai < 2; ++ai)
#pragma unroll
                for (int m = 0; m < 4; ++m) { float* p = CG + (size_t)(row0 + ai * HALF + m * 16) * 16 + 8 * fq;
                    *(f32x4*)p = acc[ai][0][m][0]; *(f32x4*)(p + 4) = acc[ai][0][m][1]; }
        }
    }
};
struct EpiOut {
    static constexpr bool PERM = true;
    bf16_t* O;
    __device__ __forceinline__ void operator()(const f32x4 (&acc)[2][2][4][2], const Unit& u, int wr, int wc, int fr, int fq) const {
        bf16_t* base = O + (size_t)(u.pm * BM + wr * 64 + fr) * D + u.pn * BM + wc * 32 + 8 * fq;
#pragma unroll
        for (int ai = 0; ai < 2; ++ai)
#pragma unroll
            for (int m = 0; m < 4; ++m) { bf16_t* rowp = base + (size_t)(ai * HALF + m * 16) * D;
#pragma unroll
                for (int bj = 0; bj < 2; ++bj) { const f32x4 v0 = acc[ai][bj][m][0], v1 = acc[ai][bj][m][1];
                    u32x4 w; w.x = cvt_pk_bf16(v0[0], v0[1]); w.y = cvt_pk_bf16(v0[2], v0[3]); w.z = cvt_pk_bf16(v1[0], v1[1]); w.w = cvt_pk_bf16(v1[2], v1[3]);
                    *(u32x4*)(rowp + bj * HALF) = w; } }
    }
};
}

__device__ __forceinline__ void p0_transpose_item(const float* W, int ldw, int n_src0, bf16_t* WT, int row_dst0, int kb, float* scr, int lane) {
    const int k0 = 64 * kb;
    {   const int kr = lane >> 3, c4 = 4 * (lane & 7);
        const float* src = W + (size_t)(k0 + kr) * ldw + n_src0 + c4;
        f32x4 v[8];
#pragma unroll
        for (int i = 0; i < 8; ++i) v[i] = __builtin_nontemporal_load((const f32x4*)(src + (size_t)(8 * i) * ldw));
#pragma unroll
        for (int i = 0; i < 8; ++i) { float* d = scr + (8 * i + kr) * 33 + c4; d[0] = v[i][0]; d[1] = v[i][1]; d[2] = v[i][2]; d[3] = v[i][3]; }
    }
    asm volatile("s_waitcnt lgkmcnt(0)" ::: "memory");
    const int c = lane & 7;
#pragma unroll
    for (int j = 0; j < 4; ++j) { const int n = (lane >> 3) + 8 * j; const float* s = scr + (8 * c) * 33 + n;
        u32x4 o; o.x = cvt_pk_bf16(s[0 * 33], s[1 * 33]); o.y = cvt_pk_bf16(s[2 * 33], s[3 * 33]); o.z = cvt_pk_bf16(s[4 * 33], s[5 * 33]); o.w = cvt_pk_bf16(s[6 * 33], s[7 * 33]);
        *(u32x4*)(WT + (size_t)(row_dst0 + n) * D + k0 + 8 * c) = o; }
    asm volatile("s_waitcnt lgkmcnt(0)" ::: "memory");
}

__device__ __forceinline__ void mod_items(const Params& p, int l, unsigned char* lds, int tid, int wave, int lane, int bx) {
    const int G = gridDim.x;
    if (bx >= 192) return;
    float* sc = (float*)lds;
    float* red = (float*)(lds + 32768);
    for (int i = tid; i < 4 * D; i += 512) { const int b = i >> 11, k = i & (D - 1); sc[k * 4 + b] = silu_f(p.c[i]); }
    __syncthreads();
    for (int it = bx; it < 192; it += G) {
        const int n0 = 32 * it;
        const int r8 = lane >> 3, c4 = lane & 7;
        const float* wp = p.w_mod + ((size_t)l * D + wave * 256 + r8) * 6144 + n0 + 4 * c4;
        f32x4 a0 = {0, 0, 0, 0}, a1 = a0, a2 = a0, a3 = a0;
#pragma unroll 8
        for (int i = 0; i < 32; ++i) {
            const f32x4 w = __builtin_nontemporal_load((const f32x4*)(wp + (size_t)(8 * i) * 6144));
            const f32x4 s = *(const f32x4*)(sc + (wave * 256 + 8 * i + r8) * 4);
            a0 += w * s[0]; a1 += w * s[1]; a2 += w * s[2]; a3 += w * s[3];
        }
#pragma unroll
        for (int e = 0; e < 4; ++e) {
#pragma unroll
            for (int o = 8; o < 64; o <<= 1) { a0[e] += __shfl_xor(a0[e], o); a1[e] += __shfl_xor(a1[e], o); a2[e] += __shfl_xor(a2[e], o); a3[e] += __shfl_xor(a3[e], o); }
        }
        if (r8 == 0) {
            *(f32x4*)(red + (wave * 4 + 0) * 32 + 4 * c4) = a0; *(f32x4*)(red + (wave * 4 + 1) * 32 + 4 * c4) = a1;
            *(f32x4*)(red + (wave * 4 + 2) * 32 + 4 * c4) = a2; *(f32x4*)(red + (wave * 4 + 3) * 32 + 4 * c4) = a3;
        }
        __syncthreads();
        if (tid < 128) { const int b = tid >> 5, col = tid & 31; float s = p.b_mod[l * 6144 + n0 + col];
#pragma unroll
            for (int w = 0; w < 8; ++w) s += red[(w * 4 + b) * 32 + col];
            ((float*)(p.ws + WS_MOD))[(l * 4 + b) * 6144 + n0 + col] = s; }
        __syncthreads();
    }
}

__device__ __forceinline__ void p0_convert(const Params& p, unsigned char* lds, int tid, int wave, int lane, int bx) {
    const int G = gridDim.x;
    unsigned char* ws = p.ws;
    {
        const int gt = bx * 512 + tid, NT = G * 512;
        for (int i = gt; i < 2 * 256 * (D / 8); i += NT) {
            const int l = i / (256 * (D / 8)), r = i % (256 * (D / 8)), j = r / (D / 8), k8 = (r % (D / 8)) * 8;
            u32x4 o = {0u, 0u, 0u, 0u};
            if (j < 16) { const float* s = p.w_in + ((size_t)l * D + k8) * WIN_LD + 3584 + j;
                o.x = cvt_pk_bf16(s[0], s[WIN_LD]); o.y = cvt_pk_bf16(s[2 * WIN_LD], s[3 * WIN_LD]); o.z = cvt_pk_bf16(s[4 * WIN_LD], s[5 * WIN_LD]); o.w = cvt_pk_bf16(s[6 * WIN_LD], s[7 * WIN_LD]); }
            *(u32x4*)((bf16_t*)(ws + WS_WIN + (size_t)l * WIN_BYTES) + (size_t)(5632 + j) * D + k8) = o;
        }
    }
    {
        float* scr = (float*)(lds + wave * 16384);
        constexpr int PER_L = 32 * 240, NIT = 2 * PER_L;
        int base, end, stride;
        if (G == 256) { if (bx < 192) { base = 55 * bx; end = base + 55; } else { base = 10560 + (bx - 192) * 75; end = base + 75; } base += wave; stride = 8; }
        else { base = bx * 8 + wave; end = NIT; stride = G * 8; }
        for (int it = base; it < end; it += stride) {
            const int l = it / PER_L, r = it % PER_L, kb = r / 240, j = r % 240;
            bf16_t* WinT = (bf16_t*)(ws + WS_WIN + (size_t)l * WIN_BYTES);
            bf16_t* WoT = (bf16_t*)(ws + WS_WOUT + (size_t)l * WOUT_BYTES);
            if (j < 112) p0_transpose_item(p.w_in + (size_t)l * D * WIN_LD, WIN_LD, 32 * j, WinT, 32 * j, kb, scr, lane);
            else if (j < 176) p0_transpose_item(p.w_in + (size_t)l * D * WIN_LD, WIN_LD, 3600 + 32 * (j - 112), WinT, 3584 + 32 * (j - 112), kb, scr, lane);
            else p0_transpose_item(p.w_out + (size_t)l * D * D, D, 32 * (j - 176), WoT, 32 * (j - 176), kb, scr, lane);
        }
    }
}

__device__ __forceinline__ void row_pass(const Params& p, int mode, int wave, int lane, int bx) {
    const int gw = bx * 8 + wave, NGW = gridDim.x * 8;
    unsigned char* ws = p.ws;
    const float* mod = (const float*)(ws + WS_MOD);
    const bf16_t* OUTB = (const bf16_t*)(ws + WS_OUT);
    bf16_t* H = (bf16_t*)(ws + WS_H);
    const int lpost = (mode == 2) ? 1 : 0, lpre = (mode == 0) ? 0 : 1;
    for (int gi = gw; gi < M / 4; gi += NGW) {
        const int r0 = 4 * gi, b = r0 >> 11;
        f32x4 gg[4][2], aa[4][2], tt[4][2];
        if (mode >= 1) {
            const float* gate = mod + (size_t)(lpost * 4 + b) * 6144 + 4096; const float* gp = p.g_post + lpost * D;
#pragma unroll
            for (int j = 0; j < 4; ++j)
#pragma unroll
                for (int h = 0; h < 2; ++h) { const int col = 8 * lane + 512 * j + 4 * h; gg[j][h] = *(const f32x4*)(gate + col) * *(const f32x4*)(gp + col); }
        }
        if (mode <= 1) {
            const float* shift = mod + (size_t)(lpre * 4 + b) * 6144; const float* scale = shift + 2048; const float* gp = p.g_pre + lpre * D;
#pragma unroll
            for (int j = 0; j < 4; ++j)
#pragma unroll
                for (int h = 0; h < 2; ++h) { const int col = 8 * lane + 512 * j + 4 * h;
                    aa[j][h] = *(const f32x4*)(gp + col) * (*(const f32x4*)(scale + col) + 1.f); tt[j][h] = *(const f32x4*)(shift + col); }
        }
#pragma unroll 1
        for (int k = 0; k < 4; ++k) {
            const int r = r0 + k;
            f32x4 v[4][2];
            if (mode == 2) {
                const bf16_t* x1b = (const bf16_t*)(ws + WS_X1B) + (size_t)r * D;
#pragma unroll
                for (int j = 0; j < 4; ++j) { const u32x4 w = *(const u32x4*)(x1b + 8 * lane + 512 * j);
                    v[j][0] = (f32x4){bf_lo(w.x), bf_hi(w.x), bf_lo(w.y), bf_hi(w.y)}; v[j][1] = (f32x4){bf_lo(w.z), bf_hi(w.z), bf_lo(w.w), bf_hi(w.w)}; }
            } else {
                const float* xin = p.x + (size_t)r * D;
#pragma unroll
                for (int j = 0; j < 4; ++j) { v[j][0] = *(const f32x4*)(xin + 8 * lane + 512 * j); v[j][1] = *(const f32x4*)(xin + 8 * lane + 512 * j + 4); }
            }
            if (mode >= 1) {
                f32x4 o[4][2]; float ss = 0.f;
#pragma unroll
                for (int j = 0; j < 4; ++j) { const u32x4 w = *(const u32x4*)(OUTB + (size_t)r * D + 8 * lane + 512 * j);
                    o[j][0] = (f32x4){bf_lo(w.x), bf_hi(w.x), bf_lo(w.y), bf_hi(w.y)}; o[j][1] = (f32x4){bf_lo(w.z), bf_hi(w.z), bf_lo(w.w), bf_hi(w.w)};
#pragma unroll
                    for (int h = 0; h < 2; ++h) ss += (o[j][h][0] * o[j][h][0] + o[j][h][1] * o[j][h][1]) + (o[j][h][2] * o[j][h][2] + o[j][h][3] * o[j][h][3]); }
                const float rstd = rsqrtf(wave_sum(ss) * (1.f / D) + EPS);
                float* xo = p.out + (size_t)r * D;
#pragma unroll
                for (int j = 0; j < 4; ++j)
#pragma unroll
                    for (int h = 0; h < 2; ++h) { const int col = 8 * lane + 512 * j + 4 * h;
                        v[j][h] = v[j][h] + gg[j][h] * (o[j][h] * rstd);
                        if (mode == 2) *(f32x4*)(xo + col) = v[j][h]; }
                if (mode == 1) {
                    bf16_t* x1b = (bf16_t*)(ws + WS_X1B) + (size_t)r * D;
#pragma unroll
                    for (int j = 0; j < 4; ++j) { u32x4 w; w.x = cvt_pk_bf16(v[j][0][0], v[j][0][1]); w.y = cvt_pk_bf16(v[j][0][2], v[j][0][3]); w.z = cvt_pk_bf16(v[j][1][0], v[j][1][1]); w.w = cvt_pk_bf16(v[j][1][2], v[j][1][3]);
                        *(u32x4*)(x1b + 8 * lane + 512 * j) = w;
                        v[j][0] = (f32x4){bf_lo(w.x), bf_hi(w.x), bf_lo(w.y), bf_hi(w.y)}; v[j][1] = (f32x4){bf_lo(w.z), bf_hi(w.z), bf_lo(w.w), bf_hi(w.w)}; }
                }
            }
            if (mode <= 1) {
                float ss = 0.f;
#pragma unroll
                for (int j = 0; j < 4; ++j)
#pragma unroll
                    for (int h = 0; h < 2; ++h) ss += (v[j][h][0] * v[j][h][0] + v[j][h][1] * v[j][h][1]) + (v[j][h][2] * v[j][h][2] + v[j][h][3] * v[j][h][3]);
                const float rstd = rsqrtf(wave_sum(ss) * (1.f / D) + EPS);
#pragma unroll
                for (int j = 0; j < 4; ++j) { f32x4 hh[2];
#pragma unroll
                    for (int h = 0; h < 2; ++h) hh[h] = (v[j][h] * rstd) * aa[j][h] + tt[j][h];
                    u32x4 w; w.x = cvt_pk_bf16(hh[0][0], hh[0][1]); w.y = cvt_pk_bf16(hh[0][2], hh[0][3]); w.z = cvt_pk_bf16(hh[1][0], hh[1][1]); w.w = cvt_pk_bf16(hh[1][2], hh[1][3]);
                    *(u32x4*)(H + (size_t)r * D + 8 * lane + 512 * j) = w; }
            }
        }
    }
}

__device__ __forceinline__ void rope_cs(int pos, int i, float& cs, float& sn) {
    constexpr double F[8] = {0.15915494309189535, 0.03086376340470123, 0.005985185712713705, 0.001160663641240061,
                             0.00022507907903927653, 4.364795279280289e-05, 8.464330808241401e-06, 1.6414262627950345e-06};
    double rev = (double)pos * F[i]; rev -= __builtin_floor(rev);
    const float r = (float)rev;
    sn = __builtin_amdgcn_sinf(r); cs = __builtin_amdgcn_cosf(r);
}
constexpr int KS_LD = 72, VS_LD = 72;
__device__ __forceinline__ void attn_item(const Params& p, int l, int item, unsigned char* lds, int tid, int wave, int lane) {
    const int b = item >> 6, n = (item >> 2) & 15, g = item & 3;
    const int fr = lane & 15, fq = lane >> 4;
    bf16_t* Ks = (bf16_t*)lds;
    bf16_t* Vs = (bf16_t*)(lds + 256 * KS_LD * 2);
    const bf16_t* proj = (const bf16_t*)(p.ws + WS_PROJ);
    bf16_t* Y = (bf16_t*)(p.ws + WS_Y);
    const int r = wave >> 1, qh = wave & 1, hq = g * 4 + r;
    const int tokq0 = b * SEQ + n * 128 + 64 * qh;
    u32x4 qraw[4][2]; int qpos[4];
#pragma unroll
    for (int nb = 0; nb < 4; ++nb) {
        const int tok = tokq0 + 16 * nb + fr;
        const bf16_t* qp = proj + (size_t)tok * NPROJ + C_AQ + hq * 64 + 8 * fq;
        qraw[nb][0] = *(const u32x4*)qp; qraw[nb][1] = *(const u32x4*)(qp + 32); qpos[nb] = p.pos[tok];
    }
    {
        const int key = tid >> 1, half = tid & 1;
        const int s = n * 128 - 128 + key;
        u32x4 kv[4], vv[4];
#pragma unroll
        for (int c = 0; c < 4; ++c) { kv[c] = (u32x4){0u, 0u, 0u, 0u}; vv[c] = kv[c]; }
        if (s >= 0) {
            const bf16_t* kp = proj + (size_t)(b * SEQ + s) * NPROJ + C_AK + g * 64 + half * 32;
#pragma unroll
            for (int c = 0; c < 4; ++c) { kv[c] = *(const u32x4*)(kp + 8 * c); vv[c] = *(const u32x4*)(kp + 256 + 8 * c); }
            if (half == 0) {
                const int pos = p.pos[b * SEQ + s];
                unsigned a[4] = {kv[0].x, kv[0].y, kv[0].z, kv[0].w}, bb[4] = {kv[1].x, kv[1].y, kv[1].z, kv[1].w};
#pragma unroll
                for (int e = 0; e < 4; ++e) {
                    float c0, s0, c1, s1; rope_cs(pos, 2 * e, c0, s0); rope_cs(pos, 2 * e + 1, c1, s1);
                    const float t1a = bf_lo(a[e]), t1b = bf_hi(a[e]), t2a = bf_lo(bb[e]), t2b = bf_hi(bb[e]);
                    a[e] = cvt_pk_bf16(t1a * c0 - t2a * s0, t1b * c1 - t2b * s1);
                    bb[e] = cvt_pk_bf16(t2a * c0 + t1a * s0, t2b * c1 + t1b * s1);
                }
                kv[0] = (u32x4){a[0], a[1], a[2], a[3]}; kv[1] = (u32x4){bb[0], bb[1], bb[2], bb[3]};
            }
        }
#pragma unroll
        for (int c = 0; c < 4; ++c) *(u32x4*)(Ks + key * KS_LD + half * 32 + 8 * c) = kv[c];
#pragma unroll
        for (int c = 0; c < 4; ++c) *(u32x4*)(Vs + key * VS_LD + half * 32 + 8 * c) = vv[c];
    }
    __syncthreads();
    bf16x8 qf[4][2];
#pragma unroll
    for (int nb = 0; nb < 4; ++nb) {
        const u32x4 q0 = qraw[nb][0], q1 = qraw[nb][1];
        unsigned own[4] = {q0.x, q0.y, q0.z, q0.w}, par[4];
#pragma unroll
        for (int e = 0; e < 4; ++e) par[e] = __shfl_xor(own[e], 16);
        if (fq < 2) {
            const int pos = qpos[nb];
            const float sg = (fq == 0) ? -1.f : 1.f;
#pragma unroll
            for (int e = 0; e < 4; ++e) {
                float c0, s0, c1, s1; rope_cs(pos, 2 * e, c0, s0); rope_cs(pos, 2 * e + 1, c1, s1);
                const float oa = bf_lo(own[e]), ob = bf_hi(own[e]), pa = bf_lo(par[e]), pb = bf_hi(par[e]);
                own[e] = cvt_pk_bf16((oa * c0 + sg * pa * s0) * 0.125f, (ob * c1 + sg * pb * s1) * 0.125f);
            }
        } else {
#pragma unroll
            for (int e = 0; e < 4; ++e) own[e] = cvt_pk_bf16(bf_lo(own[e]) * 0.125f, bf_hi(own[e]) * 0.125f);
        }
        unsigned o1[4] = {q1.x, q1.y, q1.z, q1.w};
#pragma unroll
        for (int e = 0; e < 4; ++e) o1[e] = cvt_pk_bf16(bf_lo(o1[e]) * 0.125f, bf_hi(o1[e]) * 0.125f);
        qf[nb][0] = __builtin_bit_cast(bf16x8, (u32x4){own[0], own[1], own[2], own[3]});
        qf[nb][1] = __builtin_bit_cast(bf16x8, (u32x4){o1[0], o1[1], o1[2], o1[3]});
    }
    const float sink2 = p.sinks[l * 16 + hq] * LOG2E;
    float m_[4], l_[4];
    f32x4 o[4][4];
#pragma unroll
    for (int nb = 0; nb < 4; ++nb) { m_[nb] = sink2; l_[nb] = 1.f;
#pragma unroll
        for (int hb = 0; hb < 4; ++hb) o[hb][nb] = (f32x4){0.f, 0.f, 0.f, 0.f}; }
    for (int step = 0; step < 6; ++step) {
        const int kj0 = 64 * qh + 32 * step;
        if (n == 0 && kj0 + 32 <= 128) continue;
        f32x4 s[2][4];
#pragma unroll
        for (int mb = 0; mb < 2; ++mb)
#pragma unroll
            for (int nb = 0; nb < 4; ++nb) s[mb][nb] = (f32x4){0.f, 0.f, 0.f, 0.f};
#pragma unroll
        for (int mb = 0; mb < 2; ++mb)
#pragma unroll
            for (int kk = 0; kk < 2; ++kk) {
                const bf16x8 a = *(const bf16x8*)(Ks + (kj0 + 16 * mb + fr) * KS_LD + 32 * kk + 8 * fq);
#pragma unroll
                for (int nb = 0; nb < 4; ++nb) s[mb][nb] = MFMA16(a, qf[nb][kk], s[mb][nb]);
            }
        bf16x8 pb[4];
#pragma unroll
        for (int nb = 0; nb < 4; ++nb) {
            const int qi = 64 * qh + 16 * nb + fr;
            float tmax = -1e30f;
#pragma unroll
            for (int mb = 0; mb < 2; ++mb)
#pragma unroll
                for (int j = 0; j < 4; ++j) {
                    const int kj = kj0 + 16 * mb + 4 * fq + j, dist = qi + 128 - kj;
                    const bool valid = (dist >= 0) && (dist < 128) && (n > 0 || kj >= 128);
                    const float v = valid ? s[mb][nb][j] * LOG2E : -1e30f;
                    s[mb][nb][j] = v; tmax = fmaxf(tmax, v);
                }
            tmax = fmaxf(tmax, __shfl_xor(tmax, 16)); tmax = fmaxf(tmax, __shfl_xor(tmax, 32));
            const float mnew = fmaxf(m_[nb], tmax), alpha = fast_exp2(m_[nb] - mnew);
            m_[nb] = mnew;
            float rs = 0.f;
#pragma unroll
            for (int mb = 0; mb < 2; ++mb)
#pragma unroll
                for (int j = 0; j < 4; ++j) { const float pv = fast_exp2(s[mb][nb][j] - mnew); s[mb][nb][j] = pv; rs += pv; }
            rs += __shfl_xor(rs, 16); rs += __shfl_xor(rs, 32);
            l_[nb] = l_[nb] * alpha + rs;
#pragma unroll
            for (int hb = 0; hb < 4; ++hb) o[hb][nb] = o[hb][nb] * alpha;
            pb[nb] = __builtin_bit_cast(bf16x8, (u32x4){cvt_pk_bf16(s[0][nb][0], s[0][nb][1]), cvt_pk_bf16(s[0][nb][2], s[0][nb][3]),
                                                        cvt_pk_bf16(s[1][nb][0], s[1][nb][1]), cvt_pk_bf16(s[1][nb][2], s[1][nb][3])});
        }
#pragma unroll
        for (int hb = 0; hb < 4; ++hb) {
            const bf16_t* vp = Vs + (kj0 + 4 * fq + (fr >> 2)) * VS_LD + 32 * (hb >> 1) + 8 * (fr & 3) + 4 * (hb & 1);
            const bf16x8 a = tr_operand(vp, vp + 16 * VS_LD);
#pragma unroll
            for (int nb = 0; nb < 4; ++nb) o[hb][nb] = MFMA16(a, pb[nb], o[hb][nb]);
        }
    }
#pragma unroll
    for (int nb = 0; nb < 4; ++nb) {
        const int tok = tokq0 + 16 * nb + fr;
        const float inv = 1.f / l_[nb];
#pragma unroll
        for (int hp = 0; hp < 2; ++hp) {
            const int col = hq * 64 + 32 * hp + 8 * fq;
            const u32x4 z = *(const u32x4*)(proj + (size_t)tok * NPROJ + C_Z + col);
            const f32x4 a = o[2 * hp][nb] * inv, b2 = o[2 * hp + 1][nb] * inv;
            u32x4 y; y.x = cvt_pk_bf16(a[0] * bf_lo(z.x), a[1] * bf_hi(z.x)); y.y = cvt_pk_bf16(a[2] * bf_lo(z.y), a[3] * bf_hi(z.y));
            y.z = cvt_pk_bf16(b2[0] * bf_lo(z.z), b2[1] * bf_hi(z.z)); y.w = cvt_pk_bf16(b2[2] * bf_lo(z.w), b2[3] * bf_hi(z.w));
            *(u32x4*)(Y + (size_t)tok * D + col) = y;
        }
    }
    __syncthreads();
}

constexpr int VN_LD = 72;
__device__ __forceinline__ void sg_pair_item(const Params& p, int l, int pitem, unsigned char* lds, int tid, int wave, int lane) {
    const int b2 = pitem >> 7, c = (pitem >> 3) & 15, g = pitem & 7;
    const int fr = lane & 15, fq = lane >> 4;
    bf16_t* vnT = (bf16_t*)lds;
    const bf16_t* proj = (const bf16_t*)(p.ws + WS_PROJ);
    bf16_t* Y = (bf16_t*)(p.ws + WS_Y);
    const int s = tid >> 2, qd = tid & 3;
    const int t = 16 * wave + fr;
    int tok0[2];
    tok0[0] = b2 * SEQ + c * 128; tok0[1] = (b2 + 2) * SEQ + c * 128;
    u32x4 vw[2][2]; f32x4 stq[2]; u32x4 uf[2][2], zf[2][2];
#pragma unroll
    for (int q2 = 0; q2 < 2; ++q2) {
        const bf16_t* vp = proj + (size_t)(tok0[q2] + s) * NPROJ + C_SV;
        vw[q2][0] = *(const u32x4*)(vp + 64 * g + 16 * qd); vw[q2][1] = *(const u32x4*)(vp + 64 * g + 16 * qd + 8);
        stq[q2] = *(const f32x4*)((const float*)(p.ws + WS_SGST) + (size_t)(tok0[q2] + s) * 16 + 4 * qd);
#pragma unroll
        for (int mp = 0; mp < 2; ++mp) { const int col = 64 * g + 32 * mp + 8 * fq; const size_t ro = (size_t)(tok0[q2] + t) * NPROJ;
            uf[q2][mp] = *(const u32x4*)(proj + ro + C_SU + col); zf[q2][mp] = *(const u32x4*)(proj + ro + C_Z + 1024 + col); }
    }
    f32x4 wf[4][2];
    {   const float* wrow = p.sg_w + ((size_t)(l * 8 + g) * 128 + t) * 128;
#pragma unroll
        for (int kk = 0; kk < 4; ++kk) if (32 * kk <= 16 * wave + 15) { wf[kk][0] = *(const f32x4*)(wrow + 32 * kk + 8 * fq); wf[kk][1] = *(const f32x4*)(wrow + 32 * kk + 8 * fq + 4); } }
    const float bias = p.sg_b[(l * 8 + g) * 128 + t];
    float lgv[16], lbv[16];
    {   const float* lg = p.sg_ln_g + l * 512 + 64 * g + 16 * qd; const float* lb = p.sg_ln_b + l * 512 + 64 * g + 16 * qd;
#pragma unroll
        for (int i = 0; i < 4; ++i) { const f32x4 a = *(const f32x4*)(lg + 4 * i), bb = *(const f32x4*)(lb + 4 * i);
#pragma unroll
            for (int e = 0; e < 4; ++e) { lgv[4 * i + e] = a[e]; lbv[4 * i + e] = bb[e]; } } }
#pragma unroll
    for (int q2 = 0; q2 < 2; ++q2) {
        float sum = stq[q2][0] + stq[q2][2], sq = stq[q2][1] + stq[q2][3];
        sum += __shfl_xor(sum, 1); sum += __shfl_xor(sum, 2); sq += __shfl_xor(sq, 1); sq += __shfl_xor(sq, 2);
        const float mu = sum * (1.f / 512.f), var = fmaxf(sq * (1.f / 512.f) - mu * mu, 0.f), rstd = rsqrtf(var + EPS);
        bf16_t* vq = vnT + q2 * 128 * VN_LD + s * VN_LD + 16 * qd;
#pragma unroll
        for (int i = 0; i < 2; ++i) { const unsigned ww[4] = {vw[q2][i].x, vw[q2][i].y, vw[q2][i].z, vw[q2][i].w}; unsigned o4[4];
#pragma unroll
            for (int e = 0; e < 4; ++e) { const int ch = 8 * i + 2 * e;
                o4[e] = cvt_pk_bf16((bf_lo(ww[e]) - mu) * rstd * lgv[ch] + lbv[ch], (bf_hi(ww[e]) - mu) * rstd * lgv[ch + 1] + lbv[ch + 1]); }
            *(u32x4*)(vq + 8 * i) = (u32x4){o4[0], o4[1], o4[2], o4[3]}; }
    }
    __syncthreads();
    {
        f32x4 acc[2][4];
#pragma unroll
        for (int q2 = 0; q2 < 2; ++q2)
#pragma unroll
            for (int mb = 0; mb < 4; ++mb) acc[q2][mb] = (f32x4){0.f, 0.f, 0.f, 0.f};
#pragma unroll
        for (int kk = 0; kk < 4; ++kk) {
            if (32 * kk <= 16 * wave + 15) {
                const int s0 = 32 * kk + 8 * fq;
                float w[8] = {wf[kk][0][0], wf[kk][0][1], wf[kk][0][2], wf[kk][0][3], wf[kk][1][0], wf[kk][1][1], wf[kk][1][2], wf[kk][1][3]};
#pragma unroll
                for (int e = 0; e < 8; ++e) w[e] = (s0 + e <= t) ? w[e] : 0.f;
                const bf16x8 bfr = __builtin_bit_cast(bf16x8, (u32x4){cvt_pk_bf16(w[0], w[1]), cvt_pk_bf16(w[2], w[3]), cvt_pk_bf16(w[4], w[5]), cvt_pk_bf16(w[6], w[7])});
#pragma unroll
                for (int q2 = 0; q2 < 2; ++q2)
#pragma unroll
                    for (int mb = 0; mb < 4; ++mb) {
                        const bf16_t* ap = vnT + (q2 * 128 + s0 + (fr >> 2)) * VN_LD + 32 * (mb >> 1) + 8 * (fr & 3) + 4 * (mb & 1);
                        acc[q2][mb] = MFMA16(tr_operand(ap, ap + 4 * VN_LD), bfr, acc[q2][mb]); }
            }
        }
#pragma unroll
        for (int q2 = 0; q2 < 2; ++q2)
#pragma unroll
            for (int mp = 0; mp < 2; ++mp) {
                const int col = 64 * g + 32 * mp + 8 * fq;
                const u32x4 u = uf[q2][mp], z = zf[q2][mp];
                const f32x4 a = acc[q2][2 * mp] + bias, b3 = acc[q2][2 * mp + 1] + bias;
                u32x4 y; y.x = cvt_pk_bf16(bf_lo(u.x) * a[0] * bf_lo(z.x), bf_hi(u.x) * a[1] * bf_hi(z.x)); y.y = cvt_pk_bf16(bf_lo(u.y) * a[2] * bf_lo(z.y), bf_hi(u.y) * a[3] * bf_hi(z.y));
                y.z = cvt_pk_bf16(bf_lo(u.z) * b3[0] * bf_lo(z.z), bf_hi(u.z) * b3[1] * bf_hi(z.z)); y.w = cvt_pk_bf16(bf_lo(u.w) * b3[2] * bf_lo(z.w), bf_hi(u.w) * b3[3] * bf_hi(z.w));
                *(u32x4*)(Y + (size_t)(tok0[q2] + t) * D + 1024 + col) = y;
            }
    }
    __syncthreads();
}

constexpr int GL_LD = 72;
struct CgRow { f32x4 c0, c1, c2, c3; };
__device__ __forceinline__ CgRow gla_load_cg(const Params& p, int tok) {
    const float* cgp = (const float*)(p.ws + WS_CG) + (size_t)tok * 16;
    CgRow r; r.c0 = *(const f32x4*)cgp; r.c1 = *(const f32x4*)(cgp + 4); r.c2 = *(const f32x4*)(cgp + 8); r.c3 = *(const f32x4*)(cgp + 12); return r;
}
__device__ __forceinline__ float wave_scan_incl(float v) {
#define SCAN_STEP(ctrl, rmask) v += __builtin_bit_cast(float, __builtin_amdgcn_update_dpp(0, __builtin_bit_cast(int, v), (ctrl), (rmask), 0xf, false))
    SCAN_STEP(0x111, 0xf); SCAN_STEP(0x112, 0xf); SCAN_STEP(0x114, 0xf); SCAN_STEP(0x118, 0xf);
    SCAN_STEP(0x142, 0xa); SCAN_STEP(0x143, 0xc);
#undef SCAN_STEP
    return v;
}
__device__ __forceinline__ void gla_b(const float* wl, const CgRow& cr, int wave, int lane, float (&bc)[8], float (&bl)[8]) {
    const f32x4 c0 = cr.c0, c1 = cr.c1, c2 = cr.c2, c3 = cr.c3;
    const float cgv[16] = {c0[0], c0[1], c0[2], c0[3], c1[0], c1[1], c1[2], c1[3], c2[0], c2[1], c2[2], c2[3], c3[0], c3[1], c3[2], c3[3]};
    float x[8];
    {   const f32x4 b0 = *(const f32x4*)(wl + 1024 + 8 * wave), b1 = *(const f32x4*)(wl + 1024 + 8 * wave + 4);
#pragma unroll
        for (int e = 0; e < 4; ++e) { x[e] = b0[e]; x[4 + e] = b1[e]; } }
#pragma unroll
    for (int r = 0; r < 16; ++r) {
        const f32x4 w0 = *(const f32x4*)(wl + r * 64 + 8 * wave), w1 = *(const f32x4*)(wl + r * 64 + 8 * wave + 4);
#pragma unroll
        for (int e = 0; e < 4; ++e) { x[e] += cgv[r] * w0[e]; x[4 + e] += cgv[r] * w1[e]; }
    }
#pragma unroll
    for (int i = 0; i < 8; ++i) {
        float la = (fminf(x[i], 0.f) - __logf(1.f + __expf(-fabsf(x[i])))) * (1.f / 16.f);
        la = wave_scan_incl(la);
        bc[i] = la; bl[i] = __builtin_bit_cast(float, __builtin_amdgcn_readlane(__builtin_bit_cast(int, la), 63));
    }
}
struct VPair { u32x4 a, b; };
__device__ __forceinline__ VPair gla_load_v(const bf16_t* proj, int tok0, int h, int tid) {
    const int t = tid >> 3, c8 = tid & 7;
    const bf16_t* vp = proj + (size_t)(tok0 + t) * NPROJ + C_CV + h * 128 + 16 * c8;
    VPair r; r.a = *(const u32x4*)vp; r.b = *(const u32x4*)(vp + 8); return r;
}
__device__ __forceinline__ void gla_store_vT(const VPair& v, bf16_t* vT, int tid) {
    const int t = tid >> 3, c8 = tid & 7;
#pragma unroll
    for (int i = 0; i < 2; ++i) { const u32x4 w = i ? v.b : v.a; const unsigned ww[4] = {w.x, w.y, w.z, w.w};
#pragma unroll
        for (int e = 0; e < 4; ++e) { const int dv = 16 * c8 + 8 * i + 2 * e;
            vT[dv * GL_LD + t] = (bf16_t)(ww[e] & 0xffffu); vT[(dv + 1) * GL_LD + t] = (bf16_t)(ww[e] >> 16); } }
}
__device__ __forceinline__ void gla_local_item(const Params& p, int l, int item, unsigned char* lds, int tid, int wave, int lane) {
    const int bh = item >> 5, c = item & 31, b = bh >> 2, h = bh & 3;
    const int fr = lane & 15, fq = lane >> 4;
    const int tok0 = b * SEQ + c * 64;
    bf16_t* klT = (bf16_t*)lds;
    bf16_t* vT = (bf16_t*)(lds + 64 * GL_LD * 2);
    const bf16_t* proj = (const bf16_t*)(p.ws + WS_PROJ);
    const CgRow cr = gla_load_cg(p, tok0 + lane);
    const bf16_t* rowp = proj + (size_t)(tok0 + lane) * NPROJ + h * 64 + 8 * wave;
    const u32x4 qw = *(const u32x4*)(rowp + C_CQ), kw = *(const u32x4*)(rowp + C_CK);
    const VPair vpre = gla_load_v(proj, tok0, h, tid);
    float* wl = (float*)(lds + 3 * 64 * GL_LD * 2);
    if (tid < 256) *(f32x4*)(wl + (tid >> 4) * 64 + 4 * (tid & 15)) = *(const f32x4*)(p.gla_wup + (size_t)(l * 16 + (tid >> 4)) * 256 + h * 64 + 4 * (tid & 15));
    else if (tid < 272) *(f32x4*)(wl + 1024 + 4 * (tid - 256)) = *(const f32x4*)(p.gla_bg + l * 256 + h * 64 + 4 * (tid - 256));
    __syncthreads();
    float bc[8], bl[8];
    gla_b(wl, cr, wave, lane, bc, bl);
    {
        const unsigned qq[4] = {qw.x, qw.y, qw.z, qw.w}, ww[4] = {kw.x, kw.y, kw.z, kw.w};
        unsigned qo[4], ko[4];
#pragma unroll
        for (int e = 0; e < 4; ++e) {
            klT[(8 * wave + 2 * e) * GL_LD + lane] = f2bf(bf_lo(ww[e]) * __expf(bl[2 * e] - bc[2 * e]));
            klT[(8 * wave + 2 * e + 1) * GL_LD + lane] = f2bf(bf_hi(ww[e]) * __expf(bl[2 * e + 1] - bc[2 * e + 1]));
            const float e0 = __expf(bc[2 * e]), e1 = __expf(bc[2 * e + 1]);
            qo[e] = cvt_pk_bf16(bf_lo(qq[e]) * 0.125f * e0, bf_hi(qq[e]) * 0.125f * e1);
            ko[e] = cvt_pk_bf16(bf_lo(ww[e]) * fast_rcp(e0), bf_hi(ww[e]) * fast_rcp(e1));
        }
        *(u32x4*)((bf16_t*)(p.ws + WS_QD) + (size_t)item * 4096 + lane * 64 + 8 * wave) = (u32x4){qo[0], qo[1], qo[2], qo[3]};
        *(u32x4*)((bf16_t*)(p.ws + WS_KD) + (size_t)item * 4096 + lane * 64 + 8 * wave) = (u32x4){ko[0], ko[1], ko[2], ko[3]};
        if (lane == 63) { float* dec = (float*)(p.ws + WS_DEC) + (size_t)item * 64 + 8 * wave;
#pragma unroll
            for (int i = 0; i < 8; ++i) dec[i] = __expf(bl[i]); }
    }
    gla_store_vT(vpre, vT, tid);
    __syncthreads();
    {
        f32x4 acc[4];
#pragma unroll
        for (int mb = 0; mb < 4; ++mb) acc[mb] = (f32x4){0.f, 0.f, 0.f, 0.f};
#pragma unroll
        for (int kk = 0; kk < 2; ++kk) {
            const bf16x8 bfr = *(const bf16x8*)(vT + (16 * wave + fr) * GL_LD + 32 * kk + 8 * fq);
#pragma unroll
            for (int mb = 0; mb < 4; ++mb) { const bf16x8 a = *(const bf16x8*)(klT + (16 * mb + fr) * GL_LD + 32 * kk + 8 * fq); acc[mb] = MFMA16(a, bfr, acc[mb]); }
        }
        float* loct = (float*)(p.ws + WS_LOCT) + (size_t)item * 8192 + (16 * wave + fr) * 64 + 4 * fq;
#pragma unroll
        for (int mb = 0; mb < 4; ++mb) *(f32x4*)(loct + 16 * mb) = acc[mb];
        const int dv = tid >> 2, qd4 = tid & 3;
        const u32x4 t0 = *(const u32x4*)(vT + dv * GL_LD + 16 * qd4), t1 = *(const u32x4*)(vT + dv * GL_LD + 16 * qd4 + 8);
        bf16_t* vg = (bf16_t*)(p.ws + WS_VTG) + (size_t)item * 8192 + dv * 64 + 16 * qd4;
        *(u32x4*)vg = t0; *(u32x4*)(vg + 8) = t1;
    }
    __syncthreads();
}
__device__ __forceinline__ void gla_scan(const Params& p, int tid, int bx) {
    const float* loct = (const float*)(p.ws + WS_LOCT); const float* dec = (const float*)(p.ws + WS_DEC);
    bf16_t* ST = (bf16_t*)(p.ws + WS_ST);
    for (int e = bx * 512 + tid; e < 16 * 8192; e += gridDim.x * 512) {
        const int bh = e >> 13, r = e & 8191, dk = r & 63;
        float lo[32], de[32];
#pragma unroll
        for (int c = 0; c < 32; ++c) { const size_t it = (size_t)bh * 32 + c; lo[c] = loct[it * 8192 + r]; de[c] = dec[it * 64 + dk]; }
        float s = 0.f;
#pragma unroll
        for (int c = 0; c < 32; ++c) { const size_t it = (size_t)bh * 32 + c;
            ST[it * 8192 + r] = f2bf(s);
            s = s * de[c] + lo[c]; }
    }
}
constexpr int GO_LD = 72;
constexpr int GO_QD = 0, GO_KD = 64 * GO_LD, GO_ST = 2 * 64 * GO_LD, GO_VT = GO_ST + 128 * GO_LD, GO_IMG = GO_VT + 128 * GO_LD;
__device__ __forceinline__ void gla_out_pair(const Params& p, int l, int pit, unsigned char* lds, int tid, int wave, int lane) {
    const int bh2 = pit >> 5, c = pit & 31, h = bh2 & 3;
    const int fr = lane & 15, fq = lane >> 4;
    bf16_t* img = (bf16_t*)lds;
    float* red = (float*)(lds + 2 * GO_IMG * 2);
    const bf16_t* proj = (const bf16_t*)(p.ws + WS_PROJ);
    bf16_t* Y = (bf16_t*)(p.ws + WS_Y);
    const int tb = wave & 3, dh = wave >> 2, t = 16 * tb + fr;
    int item[2], tok[2];
    item[0] = bh2 * 32 + c; item[1] = (bh2 + 8) * 32 + c;
    tok[0] = (bh2 >> 2) * SEQ + c * 64 + t; tok[1] = ((bh2 >> 2) + 2) * SEQ + c * 64 + t;
    {
        const int r8 = tid >> 3, ch = (tid & 7) * 8;
        u32x4 cq[2], ck[2], cs[2][2], cv[2][2];
#pragma unroll
        for (int q2 = 0; q2 < 2; ++q2) {
            cq[q2] = *(const u32x4*)((const bf16_t*)(p.ws + WS_QD) + (size_t)item[q2] * 4096 + r8 * 64 + ch);
            ck[q2] = *(const u32x4*)((const bf16_t*)(p.ws + WS_KD) + (size_t)item[q2] * 4096 + r8 * 64 + ch);
#pragma unroll
            for (int i = 0; i < 2; ++i) {
                cs[q2][i] = *(const u32x4*)((const bf16_t*)(p.ws + WS_ST) + (size_t)item[q2] * 8192 + (r8 + 64 * i) * 64 + ch);
                cv[q2][i] = *(const u32x4*)((const bf16_t*)(p.ws + WS_VTG) + (size_t)item[q2] * 8192 + (r8 + 64 * i) * 64 + ch);
            }
        }
#pragma unroll
        for (int q2 = 0; q2 < 2; ++q2) {
            bf16_t* im = img + q2 * GO_IMG;
            *(u32x4*)(im + GO_QD + r8 * GO_LD + ch) = cq[q2]; *(u32x4*)(im + GO_KD + r8 * GO_LD + ch) = ck[q2];
#pragma unroll
            for (int i = 0; i < 2; ++i) { *(u32x4*)(im + GO_ST + (r8 + 64 * i) * GO_LD + ch) = cs[q2][i]; *(u32x4*)(im + GO_VT + (r8 + 64 * i) * GO_LD + ch) = cv[q2][i]; }
        }
    }
    u32x4 zf[2][2]; f32x4 gf[4];
#pragma unroll
    for (int mp = 0; mp < 2; ++mp) {
        const int dv = 64 * dh + 32 * mp + 8 * fq;
        gf[2 * mp] = *(const f32x4*)(p.gla_ng + l * 128 + dv); gf[2 * mp + 1] = *(const f32x4*)(p.gla_ng + l * 128 + dv + 4);
#pragma unroll
        for (int q2 = 0; q2 < 2; ++q2) zf[q2][mp] = *(const u32x4*)(proj + (size_t)tok[q2] * NPROJ + C_Z + 1536 + h * 128 + dv);
    }
    __syncthreads();
    f32x4 acc[2][4];
#pragma unroll
    for (int q2 = 0; q2 < 2; ++q2) {
        const bf16_t* im = img + q2 * GO_IMG;
        bf16x8 bq[2];
#pragma unroll
        for (int kk = 0; kk < 2; ++kk) bq[kk] = *(const bf16x8*)(im + GO_QD + t * GO_LD + 32 * kk + 8 * fq);
        f32x4 sc[4];
#pragma unroll
        for (int mb = 0; mb < 4; ++mb) {
            sc[mb] = (f32x4){0.f, 0.f, 0.f, 0.f};
            if (mb <= tb) {
#pragma unroll
                for (int kk = 0; kk < 2; ++kk) { const bf16x8 a = *(const bf16x8*)(im + GO_KD + (16 * mb + fr) * GO_LD + 32 * kk + 8 * fq); sc[mb] = MFMA16(a, bq[kk], sc[mb]); }
#pragma unroll
                for (int j = 0; j < 4; ++j) if (16 * mb + 4 * fq + j > t) sc[mb][j] = 0.f;
            }
        }
        bf16x8 bp[2];
#pragma unroll
        for (int k2 = 0; k2 < 2; ++k2)
            bp[k2] = __builtin_bit_cast(bf16x8, (u32x4){cvt_pk_bf16(sc[2 * k2][0], sc[2 * k2][1]), cvt_pk_bf16(sc[2 * k2][2], sc[2 * k2][3]),
                                                        cvt_pk_bf16(sc[2 * k2 + 1][0], sc[2 * k2 + 1][1]), cvt_pk_bf16(sc[2 * k2 + 1][2], sc[2 * k2 + 1][3])});
        float ssq = 0.f;
#pragma unroll
        for (int mb = 0; mb < 4; ++mb) {
            const int dvrow = 64 * dh + 32 * (mb >> 1) + 8 * (fr >> 2) + 4 * (mb & 1) + (fr & 3);
            acc[q2][mb] = (f32x4){0.f, 0.f, 0.f, 0.f};
#pragma unroll
            for (int k2 = 0; k2 < 2; ++k2) {
                const bf16_t* vp = im + GO_VT + dvrow * GO_LD + 32 * k2 + 4 * fq;
                const u32x2 a0 = *(const u32x2*)vp, a1 = *(const u32x2*)(vp + 16);
                acc[q2][mb] = MFMA16(__builtin_bit_cast(bf16x8, (u32x4){a0.x, a0.y, a1.x, a1.y}), bp[k2], acc[q2][mb]);
            }
#pragma unroll
            for (int kk = 0; kk < 2; ++kk) { const bf16x8 a = *(const bf16x8*)(im + GO_ST + dvrow * GO_LD + 32 * kk + 8 * fq); acc[q2][mb] = MFMA16(a, bq[kk], acc[q2][mb]); }
            ssq += (acc[q2][mb][0] * acc[q2][mb][0] + acc[q2][mb][1] * acc[q2][mb][1]) + (acc[q2][mb][2] * acc[q2][mb][2] + acc[q2][mb][3] * acc[q2][mb][3]);
        }
        ssq += __shfl_xor(ssq, 16); ssq += __shfl_xor(ssq, 32);
        if (fq == 0) red[(q2 * 2 + dh) * 64 + t] = ssq;
    }
    __syncthreads();
#pragma unroll
    for (int q2 = 0; q2 < 2; ++q2) {
        const float rstd = rsqrtf((red[(q2 * 2) * 64 + t] + red[(q2 * 2 + 1) * 64 + t]) * (1.f / 128.f) + EPS);
#pragma unroll
        for (int mp = 0; mp < 2; ++mp) {
            const int col = 1536 + h * 128 + 64 * dh + 32 * mp + 8 * fq;
            const u32x4 z = zf[q2][mp];
            const f32x4 a = acc[q2][2 * mp] * rstd * gf[2 * mp], b3 = acc[q2][2 * mp + 1] * rstd * gf[2 * mp + 1];
            u32x4 y; y.x = cvt_pk_bf16(a[0] * bf_lo(z.x), a[1] * bf_hi(z.x)); y.y = cvt_pk_bf16(a[2] * bf_lo(z.y), a[3] * bf_hi(z.y));
            y.z = cvt_pk_bf16(b3[0] * bf_lo(z.z), b3[1] * bf_hi(z.z)); y.w = cvt_pk_bf16(b3[2] * bf_lo(z.w), b3[3] * bf_hi(z.w));
            *(u32x4*)(Y + (size_t)tok[q2] * D + col) = y;
        }
    }
    __syncthreads();
}

#define XB_TMO      128
#define XB_XCNT(j)  (256  + 64 * (j))
#define XB_XSUB(j)  (1280 + 64 * (j))
#define XB_XGEN(j)  (2304 + 64 * (j))
#define XB_TOP      3328
#define XB_TOPGEN   3392
#define XCD_BAR_WORDS 3456
#define XB_SPIN_CAP (1u << 18)
__device__ __forceinline__ unsigned xb_ld(unsigned* p)              { return __hip_atomic_load(p, __ATOMIC_RELAXED, __HIP_MEMORY_SCOPE_AGENT); }
__device__ __forceinline__ unsigned xb_add(unsigned* p, unsigned v) { return __hip_atomic_fetch_add(p, v, __ATOMIC_RELAXED, __HIP_MEMORY_SCOPE_AGENT); }
__device__ __forceinline__ unsigned xb_xcc_id() { return (unsigned)__builtin_amdgcn_s_getreg((3 << 11) | 20) & 0xFu; }
#define XB_SPIN(cond, bar) do { unsigned _sp = 0; while (cond) { __builtin_amdgcn_s_sleep(1); \
    if ((++_sp & 255u) == 0u) { if (xb_ld(&(bar)[XB_TMO])) break; if (_sp > XB_SPIN_CAP) { atomicAdd(&(bar)[XB_TMO], 1u); break; } } } } while (0)
__device__ __forceinline__ void xcd_barrier_complete(unsigned* bar, unsigned x, unsigned& nloc, unsigned& nx) {
    const unsigned G = gridDim.x * gridDim.y * gridDim.z;
    unsigned sum, cnt, mine, sp = 0u;
    for (;;) {
        sum = 0u; cnt = 0u; mine = 0u;
#pragma unroll
        for (unsigned j = 0; j < 16; ++j) { const unsigned c = xb_ld(&bar[XB_XCNT(j)]); sum += c; cnt += (c > 0u) ? 1u : 0u; mine = (j == x) ? c : mine; }
        if (sum == G) break;
        __builtin_amdgcn_s_sleep(1);
        if ((++sp & 255u) == 0u) { if (xb_ld(&bar[XB_TMO])) break; if (sp > XB_SPIN_CAP) { atomicAdd(&bar[XB_TMO], 1u); break; } }
    }
    nloc = mine > 0u ? mine : 1u; nx = cnt > 0u ? cnt : 1u;
}
__device__ __forceinline__ void xcd_barrier(unsigned* bar, volatile LAS unsigned* st) {
    asm volatile("s_waitcnt vmcnt(0)" ::: "memory");
    __syncthreads();
    if (threadIdx.x == 0) {
        __builtin_amdgcn_s_waitcnt(0);
        const unsigned x = xb_xcc_id();
        unsigned nloc = st[0], nx = st[1];
        if (nloc == 0u) { xcd_barrier_complete(bar, x, nloc, nx); st[0] = nloc; st[1] = nx; }
        const unsigned old = xb_add(&bar[XB_XSUB(x)], 1u);
        const unsigned gen = old / nloc;
        if (old + 1u == (gen + 1u) * nloc) {
            __builtin_amdgcn_fence(__ATOMIC_RELEASE, "agent");
            asm volatile("s_waitcnt vmcnt(0)" ::: "memory");
            const unsigned og = xb_add(&bar[XB_TOP], 1u);
            const unsigned tg = og / nx;
            if (og + 1u == (tg + 1u) * nx) xb_add(&bar[XB_TOPGEN], 1u);
            else XB_SPIN(xb_ld(&bar[XB_TOPGEN]) == tg, bar);
            __builtin_amdgcn_fence(__ATOMIC_ACQUIRE, "agent");
            xb_add(&bar[XB_XGEN(x)], 1u);
            asm volatile("s_waitcnt vmcnt(0)" ::: "memory");
        } else {
            XB_SPIN(xb_ld(&bar[XB_XGEN(x)]) == gen, bar);
            __builtin_amdgcn_fence(__ATOMIC_ACQUIRE, "agent");
            asm volatile("s_waitcnt vmcnt(0)" ::: "memory");
        }
    }
    __syncthreads();
}

constexpr int N_PHASES = 14;
__global__ void __launch_bounds__(512, 2) fwd_kernel(Params p) {
    extern __shared__ __attribute__((aligned(16))) unsigned char lds[];
    const int G = gridDim.x;
    const int lo = p.ph_lo, hi = p.ph_hi;
    unsigned* const xbar = (unsigned*)(p.ws + WS_BAR);
    volatile LAS unsigned* const xst = (volatile LAS unsigned*)((LAS unsigned char*)lds + 131072 + 64);
    if (threadIdx.x < 2) xst[threadIdx.x] = 0u;
    __syncthreads();
    if (lo < 0) cg::this_grid().sync();
    if (hi - lo > 1 && threadIdx.x == 0) (void)xb_add(&xbar[XB_XCNT(xb_xcc_id())], 1u);
#ifndef PHMASK
#define PHMASK 0xffff
#endif
#define IN(k) (((PHMASK >> ((k) < 2 ? (k) : 2 + ((k) - 2) % 6)) & 1) && lo <= (k) && (k) < hi)
#define SEAM(k) do { STAMP(2 * (k)); if (IN(k) && IN((k) + 1)) { xcd_barrier(xbar, xst); } STAMP(2 * (k) + 1); } while (0)
#define FRESH() int tid = threadIdx.x; asm volatile("" : "+v"(tid)); int bx = blockIdx.x; asm volatile("" : "+s"(bx)); \
    const int lane = tid & 63, wave = __builtin_amdgcn_readfirstlane(tid >> 6); \
    const Params q = fresh_params(p); (void)lane; (void)wave; (void)bx;
    unsigned long long tacc = 0ull, tprev = (PMASK != 0ull) ? __builtin_amdgcn_s_memrealtime() : 0ull;
#define STAMP(idx) do { if (PMASK != 0ull) { const unsigned long long now_ = __builtin_amdgcn_s_memrealtime(); if ((PMASK >> (idx)) & 1ull) tacc += now_ - tprev; tprev = now_; } } while (0)
    if (IN(0)) for (int rep = 0; rep < REPN(0); ++rep) { FRESH(); mod_items(q, 0, lds, tid, wave, lane, bx); __syncthreads(); }
    SEAM(0);
    if (IN(1)) for (int rep = 0; rep < REPN(1); ++rep) { FRESH(); mod_items(q, 1, lds, tid, wave, lane, bx); __syncthreads(); STAMP(32); p0_convert(q, lds, tid, wave, lane, bx); STAMP(33); row_pass(q, 0, wave, lane, bx); }
    SEAM(1);
#pragma unroll 1
    for (int l = 0; l < 2; ++l) {
        const int pb = 2 + 6 * l;
        if (IN(pb)) for (int rep = 0; rep < REPN(2); ++rep) {
            FRESH();
            pg8::Gemm g{(const bf16_t*)(q.ws + WS_H), (const bf16_t*)(q.ws + WS_WIN + (size_t)l * WIN_BYTES), M, NPAD, D};
            pg8::StaticOrder S; S.init(M, NPAD, G, bx);
            pg8::EpiProj E{(bf16_t*)(q.ws + WS_PROJ), (float*)(q.ws + WS_CG), (float*)(q.ws + WS_SGST)};
            pg8::gemm_phase<pg8::EpiProj, pg8::StaticOrder, true, true>((LAS unsigned char*)lds, g, S, E, tid);
        }
        SEAM(pb);
        if (IN(pb + 1)) for (int rep = 0; rep < REPN(3); ++rep) {
#ifndef MIXMASK
#define MIXMASK 7
#endif
            for (int rr = 0; rr < ((MIXR >> 0) & 15); ++rr) { FRESH(); for (int it = bx; it < 256; it += G) attn_item(q, l, it, lds, tid, wave, lane); }
            STAMP(36 + 4 * l); for (int rr = 0; rr < ((MIXR >> 4) & 15); ++rr) { FRESH(); for (int it = bx; it < 256; it += G) sg_pair_item(q, l, it, lds, tid, wave, lane); } STAMP(37 + 4 * l);
            for (int rr = 0; rr < ((MIXR >> 8) & 15); ++rr) { FRESH(); for (int it = bx; it < 512; it += G) gla_local_item(q, l, it, lds, tid, wave, lane); }
        }
        SEAM(pb + 1);
        if (IN(pb + 2)) for (int rep = 0; rep < REPN(4); ++rep) { FRESH(); gla_scan(q, tid, bx); }
        SEAM(pb + 2);
        if (IN(pb + 3)) for (int rep = 0; rep < REPN(5); ++rep) { FRESH(); for (int it = bx; it < 256; it += G) gla_out_pair(q, l, it, lds, tid, wave, lane); }
        SEAM(pb + 3);
        if (IN(pb + 4)) for (int rep = 0; rep < REPN(6); ++rep) {
            FRESH();
            pg8::Gemm g{(const bf16_t*)(q.ws + WS_Y), (const bf16_t*)(q.ws + WS_WOUT + (size_t)l * WOUT_BYTES), M, D, D};
            pg8::StaticOrder S; S.init(M, D, G, bx);
            pg8::EpiOut E{(bf16_t*)(q.ws + WS_OUT)};
            pg8::gemm_phase<pg8::EpiOut, pg8::StaticOrder, true, true>((LAS unsigned char*)lds, g, S, E, tid);
        }
        SEAM(pb + 4);
        if (IN(pb + 5)) { FRESH(); row_pass(q, l + 1, wave, lane, bx); }
        if (l == 0) SEAM(pb + 5);
    }
    STAMP(26);
    if (PMASK != 0ull) { if (blockIdx.x == 0 && threadIdx.x == 0) { const unsigned long long t0 = __builtin_amdgcn_s_memrealtime(); while (__builtin_amdgcn_s_memrealtime() - t0 < tacc) __builtin_amdgcn_s_sleep(8); } }
#undef IN
#undef SEAM
#undef FRESH
}

extern "C" void kernel_launch(void* const* d_in, const int* in_sizes, int n_in, void* d_out, int out_size, void* d_ws, size_t ws_size, hipStream_t stream) {
    static int grid = 0;
    if (grid == 0) {
        if (n_in != 17 || in_sizes[0] != M * D || out_size != M * D || ws_size < WS_END) { fprintf(stderr, "kernel_launch: unexpected shapes (n_in %d, in0 %d, out %d, ws %zu)\n", n_in, n_in > 0 ? in_sizes[0] : -1, out_size, ws_size); grid = -1; return; }
        int dev = 0, cus = 0, per_cu = 0;
        if (hipGetDevice(&dev) != hipSuccess || hipDeviceGetAttribute(&cus, hipDeviceAttributeMultiprocessorCount, dev) != hipSuccess) { grid = -1; return; }
        if (hipFuncSetAttribute((const void*)fwd_kernel, hipFuncAttributeMaxDynamicSharedMemorySize, LDS_BYTES) != hipSuccess) { fprintf(stderr, "kernel_launch: hipFuncSetAttribute failed\n"); grid = -1; return; }
        if (hipOccupancyMaxActiveBlocksPerMultiprocessor(&per_cu, (const void*)fwd_kernel, 512, LDS_BYTES) != hipSuccess || per_cu < 1) { fprintf(stderr, "kernel_launch: occupancy query says %d blocks per CU\n", per_cu); per_cu = 1; }
        (void)hipGetLastError();
        grid = cus;
    }
    if (grid < 0) return;
    Params p{};
    p.x = (const float*)d_in[0]; p.c = (const float*)d_in[1]; p.pos = (const int*)d_in[2]; p.w_mod = (const float*)d_in[3]; p.b_mod = (const float*)d_in[4];
    p.g_pre = (const float*)d_in[5]; p.g_post = (const float*)d_in[6]; p.w_in = (const float*)d_in[7]; p.w_out = (const float*)d_in[8]; p.sinks = (const float*)d_in[9];
    p.sg_w = (const float*)d_in[10]; p.sg_b = (const float*)d_in[11]; p.sg_ln_g = (const float*)d_in[12]; p.sg_ln_b = (const float*)d_in[13];
    p.gla_wup = (const float*)d_in[14]; p.gla_bg = (const float*)d_in[15]; p.gla_ng = (const float*)d_in[16];
    p.out = (float*)d_out; p.ws = (unsigned char*)d_ws;
#if MK_SINGLE
    if (hipMemsetAsync((char*)d_ws + WS_BAR, 0, XCD_BAR_WORDS * 4, stream) != hipSuccess) { fprintf(stderr, "kernel_launch: memset failed\n"); return; }
    p.ph_lo = 0; p.ph_hi = N_PHASES;
    void* args[] = {&p};
    hipError_t e = hipLaunchCooperativeKernel((const void*)fwd_kernel, dim3(grid), dim3(512), args, LDS_BYTES, stream);
    if (e != hipSuccess) fprintf(stderr, "kernel_launch: cooperative launch failed: %s (grid %d)\n", hipGetErrorString(e), grid);
#else
    for (int ph = 0; ph < N_PHASES; ++ph) {
        p.ph_lo = ph; p.ph_hi = ph + 1;
        hipLaunchKernelGGL(fwd_kernel, dim3(grid), dim3(512), LDS_BYTES, stream, p);
    }
#endif
}
```

```cpp
#include <hip/hip_runtime.h>
#include <hip/hip_cooperative_groups.h>
#include <cstdio>
#include <cstdint>
namespace cg = cooperative_groups;

#ifndef REPS
#define REPS 0x11111111
#endif
#define REPN(k) ((REPS >> (4 * (k))) & 15)
#ifndef PMASK
#define PMASK 0ull
#endif
#ifndef MIXR
#define MIXR 0x111
#endif
#ifndef MK_SINGLE
#define MK_SINGLE 1
#endif

#define LAS __attribute__((address_space(3)))
typedef unsigned short bf16_t;
typedef short bf16x8 __attribute__((ext_vector_type(8)));
typedef float f32x4 __attribute__((ext_vector_type(4)));
typedef float f32x2 __attribute__((ext_vector_type(2)));
typedef unsigned u32x4 __attribute__((ext_vector_type(4)));
typedef unsigned u32x2 __attribute__((ext_vector_type(2)));

constexpr int D = 2048, NB = 4, SEQ = 2048, M = NB * SEQ;
constexpr int NPROJ = 5632;
constexpr int NPAD = 5888;
constexpr int WIN_LD = 5648;
constexpr float EPS = 1e-6f;
constexpr int C_AQ = 0, C_AK = 1024, C_AV = 1280, C_SU = 1536, C_SV = 2048, C_CQ = 2560, C_CK = 2816, C_CV = 3072, C_Z = 3584;
constexpr float LOG2E = 1.4426950408889634f;

constexpr size_t MiB = 1u << 20;
constexpr size_t WS_WIN = 0, WIN_BYTES = (size_t)NPAD * D * 2;
constexpr size_t WS_WOUT = 46 * MiB, WOUT_BYTES = (size_t)D * D * 2;
constexpr size_t WS_H = 62 * MiB, WS_PROJ = 94 * MiB, WS_CG = 182 * MiB, WS_MOD = 183 * MiB, WS_Y = 184 * MiB, WS_OUT = 216 * MiB;
constexpr size_t WS_LOCT = 248 * MiB, WS_ST = 264 * MiB, WS_DEC = 272 * MiB, WS_BAR = 273 * MiB, WS_QD = 274 * MiB, WS_KD = 278 * MiB, WS_VTG = 282 * MiB, WS_X1B = 290 * MiB, WS_SGST = 322 * MiB, WS_SGW = 323 * MiB, WS_END = 324 * MiB;

constexpr int LDS_BYTES = 135168;

struct Params {
    const float* x; const float* c; const int* pos; const float* w_mod; const float* b_mod; const float* g_pre; const float* g_post;
    const float* w_in; const float* w_out; const float* sinks; const float* sg_w; const float* sg_b; const float* sg_ln_g; const float* sg_ln_b;
    const float* gla_wup; const float* gla_bg; const float* gla_ng;
    float* out; unsigned char* ws; int ph_lo, ph_hi;
};

__device__ __forceinline__ Params fresh_params(const Params& p) {
#if defined(__HIP_DEVICE_COMPILE__)
    typedef unsigned long long u64;
    const __attribute__((address_space(4))) u64* pp = (const __attribute__((address_space(4))) u64*)__builtin_amdgcn_kernarg_segment_ptr();
    asm volatile("" : "+s"(pp));
    Params q; u64* dst = (u64*)&q;
#pragma unroll
    for (int i = 0; i < (int)(sizeof(Params) / 8); ++i) dst[i] = pp[i];
    return q;
#else
    return p;
#endif
}
static_assert(sizeof(Params) % 8 == 0, "Params is copied in 8-byte words");

typedef __bf16 bf16x2_t __attribute__((ext_vector_type(2)));
__device__ __forceinline__ unsigned cvt_pk_bf16(float lo, float hi) { const f32x2 v = {lo, hi}; const bf16x2_t b = __builtin_convertvector(v, bf16x2_t); return __builtin_bit_cast(unsigned, b); }
__device__ __forceinline__ float bf_lo(unsigned u) { return __builtin_bit_cast(float, u << 16); }
__device__ __forceinline__ float bf_hi(unsigned u) { return __builtin_bit_cast(float, u & 0xffff0000u); }
__device__ __forceinline__ float bf1(bf16_t v) { return __builtin_bit_cast(float, (unsigned)v << 16); }
__device__ __forceinline__ bf16_t f2bf(float f) { return (bf16_t)(cvt_pk_bf16(f, 0.f) & 0xffffu); }
__device__ __forceinline__ float fast_exp2(float x) { return __builtin_amdgcn_exp2f(x); }
__device__ __forceinline__ float fast_rcp(float x) { return __builtin_amdgcn_rcpf(x); }
__device__ __forceinline__ float silu_f(float x) { return x * fast_rcp(1.f + fast_exp2(-x * LOG2E)); }
__device__ __forceinline__ float gelu_tanh_f(float x) { const float u = 0.7978845608028654f * (x + 0.044715f * x * x * x); return x * fast_rcp(1.f + fast_exp2(-2.f * LOG2E * u)); }
__device__ __forceinline__ float wave_sum(float v) {
#pragma unroll
    for (int o = 1; o < 64; o <<= 1) v += __shfl_xor(v, o);
    return v;
}

typedef short v4i16_t __attribute__((ext_vector_type(4)));
__device__ __forceinline__ bf16x8 tr_operand(const void* p0, const void* p1) {
    const v4i16_t a = __builtin_amdgcn_ds_read_tr16_b64_v4i16((__attribute__((address_space(3))) v4i16_t*)p0);
    const v4i16_t b = __builtin_amdgcn_ds_read_tr16_b64_v4i16((__attribute__((address_space(3))) v4i16_t*)p1);
    return __builtin_shufflevector(a, b, 0, 1, 2, 3, 4, 5, 6, 7);
}
#define MFMA16(a, b, c) __builtin_amdgcn_mfma_f32_16x16x32_bf16((a), (b), (c), 0, 0, 0)

namespace pg8 {
#define PG8_LAS __attribute__((address_space(3)))
constexpr int BM = 256, BK = 64, HALF = 128, HTB = HALF * BK * 2, STAGE_BYTES = 8 * HTB, NXCD = 8, WGM = 8;
__host__ __device__ __forceinline__ int lds_byte(int r, int c) { const int st = (r >> 4) * 2 + (c >> 5), rr = r & 15, cc = c & 31, ob = rr * 64 + cc * 2; return st * 1024 + (ob ^ (((ob >> 9) & 1) << 5)); }
__host__ __device__ __forceinline__ void stage_rc(int b, int& R, int& C) { const int st = b / 1024, sb = b % 1024, swz = sb ^ (((sb >> 9) & 1) << 5); R = (st >> 1) * 16 + swz / 64; C = (st & 1) * 32 + (swz % 64) / 2; }
__host__ __device__ __forceinline__ int perm32(int rho) { const int n = rho >> 4, i = rho & 15; return 8 * (i >> 2) + 4 * n + (i & 3); }
struct Unit { int pm, pn; };
struct Gemm { const bf16_t* A; const bf16_t* Bt; int M, N, K; };
struct StaticOrder {
    int nM, nN, nwg, G, c;
    __host__ __device__ void init(int M_, int N_, int G_, int c_) { nM = M_ / BM; nN = N_ / BM; nwg = nM * nN; G = G_; c = c_; }
    __host__ __device__ bool next(int i, Unit& u) const {
        const long L = (long)i * G + c; if (L >= nwg) return false;
        int wgid = (int)L; { const int q = nwg / NXCD, r = nwg % NXCD, xcd = wgid % NXCD, off = wgid / NXCD; wgid = (xcd < r ? xcd * (q + 1) : r * (q + 1) + (xcd - r) * q) + off; }
        const int nig = WGM * nN, gid = wgid / nig, fm = gid * WGM, gsz = (nM - fm) < WGM ? (nM - fm) : WGM;
        u.pm = fm + ((wgid % nig) % gsz); u.pn = (wgid % nig) / gsz; return true;
    }
    __device__ __forceinline__ void a_ready(const Unit&) const {}
    __device__ __forceinline__ void done(const Unit&) const {}
};

template <class Epi, class Sched, bool ALIGN_EPI = false, bool SP2 = false>
__device__ __forceinline__ void gemm_phase(PG8_LAS unsigned char* lds, const Gemm g, const Sched& S, const Epi& E, const int tid) {
    const int wid = __builtin_amdgcn_readfirstlane(tid >> 6), lane = tid & 63, wr = wid >> 2, wc = wid & 3, fr = lane & 15, fq = lane >> 4;
    const int K = g.K, nt = K / BK;
    unsigned voffA[2], voffB[2];
#pragma unroll
    for (int i = 0; i < 2; ++i) { int R, C; stage_rc(tid * 16 + i * 8192, R, C); const int Rb = Epi::PERM ? ((R & ~31) + perm32(R & 31)) : R;
        voffA[i] = (unsigned)(R * K + C) * 2u; voffB[i] = (unsigned)(Rb * K + C) * 2u; }
    const size_t kstep = (size_t)(BK * 2);
    const size_t hstep = (size_t)HALF * K * 2;
    const size_t tstep = 2 * hstep;
    const unsigned ldsw = (unsigned)wid * 1024u;
    const int aoff = lds_byte(wr * 64 + fr, fq * 8), boff = lds_byte(wc * 32 + fr, fq * 8);
#define PG8_SA(b, h) (((b) * 2 + (h)) * HTB)
#define PG8_SB(b, h) ((4 + (b) * 2 + (h)) * HTB)
#define PG8_STAGE(bufoff, gbase, voff) do { _Pragma("unroll") for (int _i = 0; _i < 2; ++_i) \
        __builtin_amdgcn_global_load_lds((const unsigned*)((const char*)(gbase) + (voff)[_i]), (PG8_LAS unsigned*)(lds + (bufoff) + ldsw + _i * 8192), 16, 0, 0); } while (0)
#define PG8_LDA(dst, b, h) do { _Pragma("unroll") for (int m = 0; m < 4; ++m) _Pragma("unroll") for (int k = 0; k < 2; ++k) dst[m][k] = *(const PG8_LAS bf16x8*)(lds + PG8_SA(b, h) + aoff + m * 2048 + k * 1024); } while (0)
#define PG8_LDB(dst, b, h) do { _Pragma("unroll") for (int n = 0; n < 2; ++n) _Pragma("unroll") for (int k = 0; k < 2; ++k) dst[n][k] = *(const PG8_LAS bf16x8*)(lds + PG8_SB(b, h) + boff + n * 2048 + k * 1024); } while (0)
#define PG8_MMA(ai, bj, At, Bt) do { __builtin_amdgcn_s_setprio(1); _Pragma("unroll") for (int m = 0; m < 4; ++m) _Pragma("unroll") for (int n = 0; n < 2; ++n) _Pragma("unroll") for (int k = 0; k < 2; ++k) \
        acc[ai][bj][m][n] = __builtin_amdgcn_mfma_f32_16x16x32_bf16(Bt[n][k], At[m][k], acc[ai][bj][m][n], 0, 0, 0); __builtin_amdgcn_s_setprio(0); } while (0)
#define PG8_WAIT_V(n) asm volatile("s_waitcnt vmcnt(" #n ")" ::: "memory")
#define PG8_WAIT_L(n) asm volatile("s_waitcnt lgkmcnt(" #n ")" ::: "memory")
#define PG8_BAR __builtin_amdgcn_s_barrier()
#define PG8_SCHED __builtin_amdgcn_sched_barrier(0)
    Unit cur, nxt; int ui = 0;
    if (!S.next(0, cur)) return;
    f32x4 acc[2][2][4][2];
#pragma unroll
    for (int a = 0; a < 2; ++a)
#pragma unroll
        for (int b = 0; b < 2; ++b)
#pragma unroll
            for (int m = 0; m < 4; ++m)
#pragma unroll
                for (int n = 0; n < 2; ++n) acc[a][b][m][n] = (f32x4){0.f, 0.f, 0.f, 0.f};
    bf16x8 At[4][2], B0[2][2], B1[2][2];
    const char* cA = (const char*)g.A + (size_t)cur.pm * tstep; const char* cB = (const char*)g.Bt + (size_t)cur.pn * tstep;
    S.a_ready(cur);
    if constexpr (SP2) {
        PG8_STAGE(PG8_SB(0, 0), cB, voffB); PG8_STAGE(PG8_SB(0, 1), cB + hstep, voffB); PG8_STAGE(PG8_SA(0, 0), cA, voffA); PG8_STAGE(PG8_SA(0, 1), cA + hstep, voffA);
        if (wr == 1) PG8_BAR;
        PG8_WAIT_V(2); PG8_BAR;
        PG8_STAGE(PG8_SB(1, 0), cB + kstep, voffB); PG8_STAGE(PG8_SA(1, 0), cA + kstep, voffA); PG8_STAGE(PG8_SB(1, 1), cB + hstep + kstep, voffB);
        PG8_WAIT_V(6); PG8_BAR;
    } else {
        PG8_STAGE(PG8_SB(0, 0), cB, voffB); PG8_STAGE(PG8_SA(0, 0), cA, voffA); PG8_STAGE(PG8_SB(0, 1), cB + hstep, voffB); PG8_STAGE(PG8_SA(0, 1), cA + hstep, voffA);
        if (wr == 1) PG8_BAR;
        PG8_WAIT_V(4); PG8_BAR;
        PG8_STAGE(PG8_SB(1, 0), cB + kstep, voffB); PG8_STAGE(PG8_SA(1, 0), cA + kstep, voffA); PG8_STAGE(PG8_SB(1, 1), cB + hstep + kstep, voffB);
        PG8_WAIT_V(6); PG8_BAR;
    }
    for (;;) {
        const bool has_next = S.next(ui + 1, nxt);
        const char* nA = has_next ? (const char*)g.A + (size_t)nxt.pm * tstep : cA; const char* nB = has_next ? (const char*)g.Bt + (size_t)nxt.pn * tstep : cB;
        for (int t = 0; t < nt; t += 2) {
            const bool last = (t == nt - 2);
            const char* a1 = cA + (size_t)(t + 1) * kstep;
            const char* a2 = last ? nA : cA + (size_t)(t + 2) * kstep; const char* b2 = last ? nB : cB + (size_t)(t + 2) * kstep;
            const char* a3 = a2 + kstep; const char* b3 = b2 + kstep;
            if (last && has_next) S.a_ready(nxt);
            if constexpr (SP2) {
            PG8_LDB(B0, 0, 0); PG8_LDB(B1, 0, 1); PG8_SCHED; PG8_LDA(At, 0, 0); PG8_STAGE(PG8_SA(1, 1), a1 + hstep, voffA);
            PG8_WAIT_V(8); PG8_WAIT_L(0); PG8_BAR; PG8_MMA(0, 0, At, B0); PG8_MMA(0, 1, At, B1); PG8_BAR; PG8_SCHED;
            PG8_LDA(At, 0, 1); PG8_STAGE(PG8_SB(0, 0), b2, voffB); PG8_STAGE(PG8_SB(0, 1), b2 + hstep, voffB); PG8_STAGE(PG8_SA(0, 0), a2, voffA);
            PG8_WAIT_V(8); PG8_WAIT_L(0); PG8_BAR; PG8_MMA(1, 0, At, B0); PG8_MMA(1, 1, At, B1); PG8_BAR; PG8_SCHED;
            PG8_LDB(B0, 1, 0); PG8_LDB(B1, 1, 1); PG8_SCHED; PG8_LDA(At, 1, 0); PG8_STAGE(PG8_SA(0, 1), a2 + hstep, voffA);
            PG8_WAIT_V(8); PG8_WAIT_L(0); PG8_BAR; PG8_MMA(0, 0, At, B0); PG8_MMA(0, 1, At, B1); PG8_BAR; PG8_SCHED;
            PG8_LDA(At, 1, 1); PG8_STAGE(PG8_SB(1, 0), b3, voffB); PG8_STAGE(PG8_SB(1, 1), b3 + hstep, voffB); PG8_STAGE(PG8_SA(1, 0), a3, voffA);
            PG8_WAIT_V(8); PG8_WAIT_L(0); PG8_BAR; PG8_MMA(1, 0, At, B0); PG8_MMA(1, 1, At, B1); PG8_BAR; PG8_SCHED;
            } else {
            PG8_LDB(B0, 0, 0); PG8_SCHED; PG8_LDA(At, 0, 0); PG8_STAGE(PG8_SA(1, 1), a1 + hstep, voffA);
            PG8_WAIT_L(8); PG8_BAR; PG8_WAIT_L(0); PG8_MMA(0, 0, At, B0); PG8_BAR; PG8_SCHED;
            PG8_LDB(B1, 0, 1); PG8_STAGE(PG8_SB(0, 0), b2, voffB);
            PG8_BAR; PG8_WAIT_L(0); PG8_MMA(0, 1, At, B1); PG8_BAR;
            PG8_LDA(At, 0, 1); PG8_STAGE(PG8_SA(0, 0), a2, voffA);
            PG8_BAR; PG8_WAIT_L(0); PG8_MMA(1, 0, At, B0); PG8_BAR; PG8_SCHED;
            PG8_STAGE(PG8_SB(0, 1), b2 + hstep, voffB);
            PG8_WAIT_V(6); PG8_BAR; PG8_MMA(1, 1, At, B1); PG8_BAR;
            PG8_LDB(B0, 1, 0); PG8_SCHED; PG8_LDA(At, 1, 0); PG8_STAGE(PG8_SA(0, 1), a2 + hstep, voffA);
            PG8_WAIT_L(8); PG8_BAR; PG8_WAIT_L(0); PG8_MMA(0, 0, At, B0); PG8_BAR; PG8_SCHED;
            PG8_LDB(B1, 1, 1); PG8_STAGE(PG8_SB(1, 0), b3, voffB);
            PG8_BAR; PG8_WAIT_L(0); PG8_MMA(0, 1, At, B1); PG8_BAR;
            PG8_LDA(At, 1, 1); PG8_STAGE(PG8_SA(1, 0), a3, voffA);
            PG8_BAR; PG8_WAIT_L(0); PG8_MMA(1, 0, At, B0); PG8_BAR; PG8_SCHED;
            PG8_STAGE(PG8_SB(1, 1), b3 + hstep, voffB);
            PG8_WAIT_V(6); PG8_BAR; PG8_MMA(1, 1, At, B1); PG8_BAR;
            }
        }
        if constexpr (ALIGN_EPI) { if (wr == 0) PG8_BAR; }
        E(acc, cur, wr, wc, fr, fq); S.done(cur);
        if (!has_next) break;
#pragma unroll
        for (int a = 0; a < 2; ++a)
#pragma unroll
            for (int b = 0; b < 2; ++b)
#pragma unroll
                for (int m = 0; m < 4; ++m)
#pragma unroll
                    for (int n = 0; n < 2; ++n) acc[a][b][m][n] = (f32x4){0.f, 0.f, 0.f, 0.f};
        cur = nxt; cA = nA; cB = nB; ++ui;
        if constexpr (ALIGN_EPI) { if (wr == 1) PG8_BAR; }
    }
    PG8_WAIT_V(0);
    if constexpr (!ALIGN_EPI) { if (wr == 0) PG8_BAR; }
    PG8_BAR;
#undef PG8_SA
#undef PG8_SB
#undef PG8_STAGE
#undef PG8_LDA
#undef PG8_LDB
#undef PG8_MMA
#undef PG8_WAIT_V
#undef PG8_WAIT_L
#undef PG8_BAR
#undef PG8_SCHED
}

struct EpiProj {
    static constexpr bool PERM = true;
    bf16_t* P; float* CG; float* SGST;
    template <int ACT> __device__ __forceinline__ void store_tile(const f32x4 (&acc)[2][2][4][2], bf16_t* base, float* stp, int fq) const {
#pragma unroll
        for (int ai = 0; ai < 2; ++ai)
#pragma unroll
            for (int m = 0; m < 4; ++m) { bf16_t* rowp = base + (size_t)(ai * HALF + m * 16) * NPROJ;
                float rs = 0.f, rq = 0.f;
#pragma unroll
                for (int bj = 0; bj < 2; ++bj) { f32x4 v0 = acc[ai][bj][m][0], v1 = acc[ai][bj][m][1];
                    if (ACT == 1) { for (int e = 0; e < 4; ++e) { v0[e] = gelu_tanh_f(v0[e]); v1[e] = gelu_tanh_f(v1[e]); } }
                    if (ACT == 2) { for (int e = 0; e < 4; ++e) { v0[e] = silu_f(v0[e]); v1[e] = silu_f(v1[e]); } }
                    if (ACT == 1) { rs += ((v0[0] + v0[1]) + (v0[2] + v0[3])) + ((v1[0] + v1[1]) + (v1[2] + v1[3]));
                        rq += ((v0[0] * v0[0] + v0[1] * v0[1]) + (v0[2] * v0[2] + v0[3] * v0[3])) + ((v1[0] * v1[0] + v1[1] * v1[1]) + (v1[2] * v1[2] + v1[3] * v1[3])); }
                    u32x4 w; w.x = cvt_pk_bf16(v0[0], v0[1]); w.y = cvt_pk_bf16(v0[2], v0[3]); w.z = cvt_pk_bf16(v1[0], v1[1]); w.w = cvt_pk_bf16(v1[2], v1[3]);
                    *(u32x4*)(rowp + bj * HALF) = w; }
                if (ACT == 1) { if (stp) { rs += __shfl_xor(rs, 16); rs += __shfl_xor(rs, 32); rq += __shfl_xor(rq, 16); rq += __shfl_xor(rq, 32);
                    if (fq == 0) *(f32x2*)(stp + (size_t)(ai * HALF + m * 16) * 16) = (f32x2){rs, rq}; } } }
    }
    __device__ __forceinline__ void operator()(const f32x4 (&acc)[2][2][4][2], const Unit& u, int wr, int wc, int fr, int fq) const {
        const int row0 = u.pm * BM + wr * 64 + fr;
        if (u.pn < 22) {
            bf16_t* base = P + (size_t)row0 * NPROJ + u.pn * BM + wc * 32 + 8 * fq;
            if (u.pn >= 6 && u.pn < 10) store_tile<1>(acc, base, (u.pn >= 8) ? SGST + (size_t)row0 * 16 + ((u.pn - 8) * 4 + wc) * 2 : nullptr, fq);
            else if (u.pn >= 14) store_tile<2>(acc, base, nullptr, fq);
            else store_tile<0>(acc, base, nullptr, fq);
        } else if (wc == 0 && fq < 2) {
#pragma unroll
            for (int ai = 0; ai < 2; ++ai)
#pragma unroll
                for (int m = 0; m < 4; ++m) { float* p = CG + (size_t)(row0 + ai * HALF + m * 16) * 16 + 8 * fq;
                    *(f32x4*)p = acc[ai][0][m][0]; *(f32x4*)(p + 4) = acc[ai][0][m][1]; }
        }
    }
};
struct EpiOut {
    static constexpr bool PERM = true;
    bf16_t* O;
    __device__ __forceinline__ void operator()(const f32x4 (&acc)[2][2][4][2], const Unit& u, int wr, int wc, int fr, int fq) const {
        bf16_t* base = O + (size_t)(u.pm * BM + wr * 64 + fr) * D + u.pn * BM + wc * 32 + 8 * fq;
#pragma unroll
        for (int ai = 0; ai < 2; ++ai)
#pragma unroll
            for (int m = 0; m < 4; ++m) { bf16_t* rowp = base + (size_t)(ai * HALF + m * 16) * D;
#pragma unroll
                for (int bj = 0; bj < 2; ++bj) { const f32x4 v0 = acc[ai][bj][m][0], v1 = acc[ai][bj][m][1];
                    u32x4 w; w.x = cvt_pk_bf16(v0[0], v0[1]); w.y = cvt_pk_bf16(v0[2], v0[3]); w.z = cvt_pk_bf16(v1[0], v1[1]); w.w = cvt_pk_bf16(v1[2], v1[3]);
                    *(u32x4*)(rowp + bj * HALF) = w; } }
    }
};
}

__device__ __forceinline__ void p0_transpose_item(const float* W, int ldw, int n_src0, bf16_t* WT, int row_dst0, int kb, float* scr, int lane) {
    const int k0 = 64 * kb;
    {   const int kr = lane >> 3, c4 = 4 * (lane & 7);
        const float* src = W + (size_t)(k0 + kr) * ldw + n_src0 + c4;
        f32x4 v[8];
#pragma unroll
        for (int i = 0; i < 8; ++i) v[i] = __builtin_nontemporal_load((const f32x4*)(src + (size_t)(8 * i) * ldw));
#pragma unroll
        for (int i = 0; i < 8; ++i) { float* d = scr + (8 * i + kr) * 33 + c4; d[0] = v[i][0]; d[1] = v[i][1]; d[2] = v[i][2]; d[3] = v[i][3]; }
    }
    asm volatile("s_waitcnt lgkmcnt(0)" ::: "memory");
    const int c = lane & 7;
#pragma unroll
    for (int j = 0; j < 4; ++j) { const int n = (lane >> 3) + 8 * j; const float* s = scr + (8 * c) * 33 + n;
        u32x4 o; o.x = cvt_pk_bf16(s[0 * 33], s[1 * 33]); o.y = cvt_pk_bf16(s[2 * 33], s[3 * 33]); o.z = cvt_pk_bf16(s[4 * 33], s[5 * 33]); o.w = cvt_pk_bf16(s[6 * 33], s[7 * 33]);
        *(u32x4*)(WT + (size_t)(row_dst0 + n) * D + k0 + 8 * c) = o; }
    asm volatile("s_waitcnt lgkmcnt(0)" ::: "memory");
}

__device__ __forceinline__ void mod_items(const Params& p, int l, unsigned char* lds, int tid, int wave, int lane, int bx) {
    const int G = gridDim.x;
    if (bx >= 192) return;
    float* sc = (float*)lds;
    float* red = (float*)(lds + 32768);
    for (int i = tid; i < 4 * D; i += 512) { const int b = i >> 11, k = i & (D - 1); sc[k * 4 + b] = silu_f(p.c[i]); }
    __syncthreads();
    for (int it = bx; it < 192; it += G) {
        const int n0 = 32 * it;
        const int r8 = lane >> 3, c4 = lane & 7;
        const float* wp = p.w_mod + ((size_t)l * D + wave * 256 + r8) * 6144 + n0 + 4 * c4;
        f32x4 a0 = {0, 0, 0, 0}, a1 = a0, a2 = a0, a3 = a0;
#pragma unroll 8
        for (int i = 0; i < 32; ++i) {
            const f32x4 w = __builtin_nontemporal_load((const f32x4*)(wp + (size_t)(8 * i) * 6144));
            const f32x4 s = *(const f32x4*)(sc + (wave * 256 + 8 * i + r8) * 4);
            a0 += w * s[0]; a1 += w * s[1]; a2 += w * s[2]; a3 += w * s[3];
        }
#pragma unroll
        for (int e = 0; e < 4; ++e) {
#pragma unroll
            for (int o = 8; o < 64; o <<= 1) { a0[e] += __shfl_xor(a0[e], o); a1[e] += __shfl_xor(a1[e], o); a2[e] += __shfl_xor(a2[e], o); a3[e] += __shfl_xor(a3[e], o); }
        }
        if (r8 == 0) {
            *(f32x4*)(red + (wave * 4 + 0) * 32 + 4 * c4) = a0; *(f32x4*)(red + (wave * 4 + 1) * 32 + 4 * c4) = a1;
            *(f32x4*)(red + (wave * 4 + 2) * 32 + 4 * c4) = a2; *(f32x4*)(red + (wave * 4 + 3) * 32 + 4 * c4) = a3;
        }
        __syncthreads();
        if (tid < 128) { const int b = tid >> 5, col = tid & 31; float s = p.b_mod[l * 6144 + n0 + col];
#pragma unroll
            for (int w = 0; w < 8; ++w) s += red[(w * 4 + b) * 32 + col];
            ((float*)(p.ws + WS_MOD))[(l * 4 + b) * 6144 + n0 + col] = s; }
        __syncthreads();
    }
}

__device__ __forceinline__ void p0_convert(const Params& p, unsigned char* lds, int tid, int wave, int lane, int bx) {
    const int G = gridDim.x;
    unsigned char* ws = p.ws;
    {
        const int gt = bx * 512 + tid, NT = G * 512;
        for (int i = gt; i < 2 * 256 * (D / 8); i += NT) {
            const int l = i / (256 * (D / 8)), r = i % (256 * (D / 8)), j = r / (D / 8), k8 = (r % (D / 8)) * 8;
            u32x4 o = {0u, 0u, 0u, 0u};
            if (j < 16) { const float* s = p.w_in + ((size_t)l * D + k8) * WIN_LD + 3584 + j;
                o.x = cvt_pk_bf16(s[0], s[WIN_LD]); o.y = cvt_pk_bf16(s[2 * WIN_LD], s[3 * WIN_LD]); o.z = cvt_pk_bf16(s[4 * WIN_LD], s[5 * WIN_LD]); o.w = cvt_pk_bf16(s[6 * WIN_LD], s[7 * WIN_LD]); }
            *(u32x4*)((bf16_t*)(ws + WS_WIN + (size_t)l * WIN_BYTES) + (size_t)(5632 + j) * D + k8) = o;
        }
    }
    {
        const int gt = bx * 512 + tid;
        if (gt < 2 * 8 * 128 * 16) {
            const int t = (gt >> 4) & 127, s0 = (gt & 15) * 8;
            const float* src = p.sg_w + (size_t)gt * 8;
            const f32x4 f0 = *(const f32x4*)src, f1 = *(const f32x4*)(src + 4);
            float w[8] = {f0[0], f0[1], f0[2], f0[3], f1[0], f1[1], f1[2], f1[3]};
#pragma unroll
            for (int e = 0; e < 8; ++e) w[e] = (s0 + e <= t) ? w[e] : 0.f;
            *(u32x4*)((bf16_t*)(ws + WS_SGW) + (size_t)gt * 8) = (u32x4){cvt_pk_bf16(w[0], w[1]), cvt_pk_bf16(w[2], w[3]), cvt_pk_bf16(w[4], w[5]), cvt_pk_bf16(w[6], w[7])};
        }
    }
    {
        float* scr = (float*)(lds + wave * 16384);
        constexpr int PER_L = 32 * 240, NIT = 2 * PER_L;
        int base, end, stride;
        if (G == 256) { if (bx < 192) { base = 55 * bx; end = base + 55; } else { base = 10560 + (bx - 192) * 75; end = base + 75; } base += wave; stride = 8; }
        else { base = bx * 8 + wave; end = NIT; stride = G * 8; }
        for (int it = base; it < end; it += stride) {
            const int l = it / PER_L, r = it % PER_L, kb = r / 240, j = r % 240;
            bf16_t* WinT = (bf16_t*)(ws + WS_WIN + (size_t)l * WIN_BYTES);
            bf16_t* WoT = (bf16_t*)(ws + WS_WOUT + (size_t)l * WOUT_BYTES);
            if (j < 112) p0_transpose_item(p.w_in + (size_t)l * D * WIN_LD, WIN_LD, 32 * j, WinT, 32 * j, kb, scr, lane);
            else if (j < 176) p0_transpose_item(p.w_in + (size_t)l * D * WIN_LD, WIN_LD, 3600 + 32 * (j - 112), WinT, 3584 + 32 * (j - 112), kb, scr, lane);
            else p0_transpose_item(p.w_out + (size_t)l * D * D, D, 32 * (j - 176), WoT, 32 * (j - 176), kb, scr, lane);
        }
    }
}

__device__ __forceinline__ void row_pass(const Params& p, int mode, int wave, int lane, int bx) {
    const int gw = bx * 8 + wave, NGW = gridDim.x * 8;
    unsigned char* ws = p.ws;
    const float* mod = (const float*)(ws + WS_MOD);
    const bf16_t* OUTB = (const bf16_t*)(ws + WS_OUT);
    bf16_t* H = (bf16_t*)(ws + WS_H);
    const int lpost = (mode == 2) ? 1 : 0, lpre = (mode == 0) ? 0 : 1;
    for (int gi = gw; gi < M / 4; gi += NGW) {
        const int r0 = 4 * gi, b = r0 >> 11;
        f32x4 gg[4][2], aa[4][2], tt[4][2];
        if (mode >= 1) {
            const float* gate = mod + (size_t)(lpost * 4 + b) * 6144 + 4096; const float* gp = p.g_post + lpost * D;
#pragma unroll
            for (int j = 0; j < 4; ++j)
#pragma unroll
                for (int h = 0; h < 2; ++h) { const int col = 8 * lane + 512 * j + 4 * h; gg[j][h] = *(const f32x4*)(gate + col) * *(const f32x4*)(gp + col); }
        }
        if (mode <= 1) {
            const float* shift = mod + (size_t)(lpre * 4 + b) * 6144; const float* scale = shift + 2048; const float* gp = p.g_pre + lpre * D;
#pragma unroll
            for (int j = 0; j < 4; ++j)
#pragma unroll
                for (int h = 0; h < 2; ++h) { const int col = 8 * lane + 512 * j + 4 * h;
                    aa[j][h] = *(const f32x4*)(gp + col) * (*(const f32x4*)(scale + col) + 1.f); tt[j][h] = *(const f32x4*)(shift + col); }
        }
#pragma unroll 1
        for (int k = 0; k < 4; ++k) {
            const int r = r0 + k;
            f32x4 v[4][2];
            if (mode == 2) {
                const bf16_t* x1b = (const bf16_t*)(ws + WS_X1B) + (size_t)r * D;
#pragma unroll
                for (int j = 0; j < 4; ++j) { const u32x4 w = *(const u32x4*)(x1b + 8 * lane + 512 * j);
                    v[j][0] = (f32x4){bf_lo(w.x), bf_hi(w.x), bf_lo(w.y), bf_hi(w.y)}; v[j][1] = (f32x4){bf_lo(w.z), bf_hi(w.z), bf_lo(w.w), bf_hi(w.w)}; }
            } else {
                const float* xin = p.x + (size_t)r * D;
#pragma unroll
                for (int j = 0; j < 4; ++j) { v[j][0] = *(const f32x4*)(xin + 8 * lane + 512 * j); v[j][1] = *(const f32x4*)(xin + 8 * lane + 512 * j + 4); }
            }
            if (mode >= 1) {
                f32x4 o[4][2]; float ss = 0.f;
#pragma unroll
                for (int j = 0; j < 4; ++j) { const u32x4 w = *(const u32x4*)(OUTB + (size_t)r * D + 8 * lane + 512 * j);
                    o[j][0] = (f32x4){bf_lo(w.x), bf_hi(w.x), bf_lo(w.y), bf_hi(w.y)}; o[j][1] = (f32x4){bf_lo(w.z), bf_hi(w.z), bf_lo(w.w), bf_hi(w.w)};
#pragma unroll
                    for (int h = 0; h < 2; ++h) ss += (o[j][h][0] * o[j][h][0] + o[j][h][1] * o[j][h][1]) + (o[j][h][2] * o[j][h][2] + o[j][h][3] * o[j][h][3]); }
                const float rstd = rsqrtf(wave_sum(ss) * (1.f / D) + EPS);
                float* xo = p.out + (size_t)r * D;
#pragma unroll
                for (int j = 0; j < 4; ++j)
#pragma unroll
                    for (int h = 0; h < 2; ++h) { const int col = 8 * lane + 512 * j + 4 * h;
                        v[j][h] = v[j][h] + gg[j][h] * (o[j][h] * rstd);
                        if (mode == 2) *(f32x4*)(xo + col) = v[j][h]; }
                if (mode == 1) {
                    bf16_t* x1b = (bf16_t*)(ws + WS_X1B) + (size_t)r * D;
#pragma unroll
                    for (int j = 0; j < 4; ++j) { u32x4 w; w.x = cvt_pk_bf16(v[j][0][0], v[j][0][1]); w.y = cvt_pk_bf16(v[j][0][2], v[j][0][3]); w.z = cvt_pk_bf16(v[j][1][0], v[j][1][1]); w.w = cvt_pk_bf16(v[j][1][2], v[j][1][3]);
                        *(u32x4*)(x1b + 8 * lane + 512 * j) = w;
                        v[j][0] = (f32x4){bf_lo(w.x), bf_hi(w.x), bf_lo(w.y), bf_hi(w.y)}; v[j][1] = (f32x4){bf_lo(w.z), bf_hi(w.z), bf_lo(w.w), bf_hi(w.w)}; }
                }
            }
            if (mode <= 1) {
                float ss = 0.f;
#pragma unroll
                for (int j = 0; j < 4; ++j)
#pragma unroll
                    for (int h = 0; h < 2; ++h) ss += (v[j][h][0] * v[j][h][0] + v[j][h][1] * v[j][h][1]) + (v[j][h][2] * v[j][h][2] + v[j][h][3] * v[j][h][3]);
                const float rstd = rsqrtf(wave_sum(ss) * (1.f / D) + EPS);
#pragma unroll
                for (int j = 0; j < 4; ++j) { f32x4 hh[2];
#pragma unroll
                    for (int h = 0; h < 2; ++h) hh[h] = (v[j][h] * rstd) * aa[j][h] + tt[j][h];
                    u32x4 w; w.x = cvt_pk_bf16(hh[0][0], hh[0][1]); w.y = cvt_pk_bf16(hh[0][2], hh[0][3]); w.z = cvt_pk_bf16(hh[1][0], hh[1][1]); w.w = cvt_pk_bf16(hh[1][2], hh[1][3]);
                    *(u32x4*)(H + (size_t)r * D + 8 * lane + 512 * j) = w; }
            }
        }
    }
}

__device__ __forceinline__ void rope_cs(int pos, int i, float& cs, float& sn) {
    constexpr double F[8] = {0.15915494309189535, 0.03086376340470123, 0.005985185712713705, 0.001160663641240061,
                             0.00022507907903927653, 4.364795279280289e-05, 8.464330808241401e-06, 1.6414262627950345e-06};
    double rev = (double)pos * F[i]; rev -= __builtin_floor(rev);
    const float r = (float)rev;
    sn = __builtin_amdgcn_sinf(r); cs = __builtin_amdgcn_cosf(r);
}
constexpr int KS_LD = 72, VS_LD = 72;
__device__ __forceinline__ void attn_item(const Params& p, int l, int item, unsigned char* lds, int tid, int wave, int lane) {
    const int b = item >> 6, n = (item >> 2) & 15, g = item & 3;
    const int fr = lane & 15, fq = lane >> 4;
    bf16_t* Ks = (bf16_t*)lds;
    bf16_t* Vs = (bf16_t*)(lds + 256 * KS_LD * 2);
    const bf16_t* proj = (const bf16_t*)(p.ws + WS_PROJ);
    bf16_t* Y = (bf16_t*)(p.ws + WS_Y);
    const int r = wave >> 1, qh = wave & 1, hq = g * 4 + r;
    const int tokq0 = b * SEQ + n * 128 + 64 * qh;
    u32x4 qraw[4][2]; int qpos[4];
#pragma unroll
    for (int nb = 0; nb < 4; ++nb) {
        const int tok = tokq0 + 16 * nb + fr;
        const bf16_t* qp = proj + (size_t)tok * NPROJ + C_AQ + hq * 64 + 8 * fq;
        qraw[nb][0] = *(const u32x4*)qp; qraw[nb][1] = *(const u32x4*)(qp + 32); qpos[nb] = p.pos[tok];
    }
    {
        const int key = tid >> 1, half = tid & 1;
        const int s = n * 128 - 128 + key;
        u32x4 kv[4], vv[4];
#pragma unroll
        for (int c = 0; c < 4; ++c) { kv[c] = (u32x4){0u, 0u, 0u, 0u}; vv[c] = kv[c]; }
        if (s >= 0) {
            const bf16_t* kp = proj + (size_t)(b * SEQ + s) * NPROJ + C_AK + g * 64 + half * 32;
#pragma unroll
            for (int c = 0; c < 4; ++c) { kv[c] = *(const u32x4*)(kp + 8 * c); vv[c] = *(const u32x4*)(kp + 256 + 8 * c); }
            if (half == 0) {
                const int pos = p.pos[b * SEQ + s];
                unsigned a[4] = {kv[0].x, kv[0].y, kv[0].z, kv[0].w}, bb[4] = {kv[1].x, kv[1].y, kv[1].z, kv[1].w};
#pragma unroll
                for (int e = 0; e < 4; ++e) {
                    float c0, s0, c1, s1; rope_cs(pos, 2 * e, c0, s0); rope_cs(pos, 2 * e + 1, c1, s1);
                    const float t1a = bf_lo(a[e]), t1b = bf_hi(a[e]), t2a = bf_lo(bb[e]), t2b = bf_hi(bb[e]);
                    a[e] = cvt_pk_bf16(t1a * c0 - t2a * s0, t1b * c1 - t2b * s1);
                    bb[e] = cvt_pk_bf16(t2a * c0 + t1a * s0, t2b * c1 + t1b * s1);
                }
                kv[0] = (u32x4){a[0], a[1], a[2], a[3]}; kv[1] = (u32x4){bb[0], bb[1], bb[2], bb[3]};
            }
        }
#pragma unroll
        for (int c = 0; c < 4; ++c) *(u32x4*)(Ks + key * KS_LD + half * 32 + 8 * c) = kv[c];
#pragma unroll
        for (int c = 0; c < 4; ++c) *(u32x4*)(Vs + key * VS_LD + half * 32 + 8 * c) = vv[c];
    }
    __syncthreads();
    bf16x8 qf[4][2];
#pragma unroll
    for (int nb = 0; nb < 4; ++nb) {
        const u32x4 q0 = qraw[nb][0], q1 = qraw[nb][1];
        unsigned own[4] = {q0.x, q0.y, q0.z, q0.w}, par[4];
#pragma unroll
        for (int e = 0; e < 4; ++e) par[e] = __shfl_xor(own[e], 16);
        if (fq < 2) {
            const int pos = qpos[nb];
            const float sg = (fq == 0) ? -1.f : 1.f;
#pragma unroll
            for (int e = 0; e < 4; ++e) {
                float c0, s0, c1, s1; rope_cs(pos, 2 * e, c0, s0); rope_cs(pos, 2 * e + 1, c1, s1);
                const float oa = bf_lo(own[e]), ob = bf_hi(own[e]), pa = bf_lo(par[e]), pb = bf_hi(par[e]);
                own[e] = cvt_pk_bf16((oa * c0 + sg * pa * s0) * 0.125f, (ob * c1 + sg * pb * s1) * 0.125f);
            }
        } else {
#pragma unroll
            for (int e = 0; e < 4; ++e) own[e] = cvt_pk_bf16(bf_lo(own[e]) * 0.125f, bf_hi(own[e]) * 0.125f);
        }
        unsigned o1[4] = {q1.x, q1.y, q1.z, q1.w};
#pragma unroll
        for (int e = 0; e < 4; ++e) o1[e] = cvt_pk_bf16(bf_lo(o1[e]) * 0.125f, bf_hi(o1[e]) * 0.125f);
        qf[nb][0] = __builtin_bit_cast(bf16x8, (u32x4){own[0], own[1], own[2], own[3]});
        qf[nb][1] = __builtin_bit_cast(bf16x8, (u32x4){o1[0], o1[1], o1[2], o1[3]});
    }
    const float sink2 = p.sinks[l * 16 + hq] * LOG2E;
    float m_[4], l_[4];
    f32x4 o[4][4];
#pragma unroll
    for (int nb = 0; nb < 4; ++nb) { m_[nb] = sink2; l_[nb] = 1.f;
#pragma unroll
        for (int hb = 0; hb < 4; ++hb) o[hb][nb] = (f32x4){0.f, 0.f, 0.f, 0.f}; }
    for (int step = 0; step < 6; ++step) {
        const int kj0 = 64 * qh + 32 * step;
        if (n == 0 && kj0 + 32 <= 128) continue;
        f32x4 s[2][4];
#pragma unroll
        for (int mb = 0; mb < 2; ++mb)
#pragma unroll
            for (int nb = 0; nb < 4; ++nb) s[mb][nb] = (f32x4){0.f, 0.f, 0.f, 0.f};
#pragma unroll
        for (int mb = 0; mb < 2; ++mb)
#pragma unroll
            for (int kk = 0; kk < 2; ++kk) {
                const bf16x8 a = *(const bf16x8*)(Ks + (kj0 + 16 * mb + fr) * KS_LD + 32 * kk + 8 * fq);
#pragma unroll
                for (int nb = 0; nb < 4; ++nb) s[mb][nb] = MFMA16(a, qf[nb][kk], s[mb][nb]);
            }
        bf16x8 pb[4];
#pragma unroll
        for (int nb = 0; nb < 4; ++nb) {
            const int qi = 64 * qh + 16 * nb + fr;
            float tmax = -1e30f;
#pragma unroll
            for (int mb = 0; mb < 2; ++mb)
#pragma unroll
                for (int j = 0; j < 4; ++j) {
                    const int kj = kj0 + 16 * mb + 4 * fq + j, dist = qi + 128 - kj;
                    const bool valid = (dist >= 0) && (dist < 128) && (n > 0 || kj >= 128);
                    const float v = valid ? s[mb][nb][j] * LOG2E : -1e30f;
                    s[mb][nb][j] = v; tmax = fmaxf(tmax, v);
                }
            tmax = fmaxf(tmax, __shfl_xor(tmax, 16)); tmax = fmaxf(tmax, __shfl_xor(tmax, 32));
            const float mnew = fmaxf(m_[nb], tmax), alpha = fast_exp2(m_[nb] - mnew);
            m_[nb] = mnew;
            float rs = 0.f;
#pragma unroll
            for (int mb = 0; mb < 2; ++mb)
#pragma unroll
                for (int j = 0; j < 4; ++j) { const float pv = fast_exp2(s[mb][nb][j] - mnew); s[mb][nb][j] = pv; rs += pv; }
            rs += __shfl_xor(rs, 16); rs += __shfl_xor(rs, 32);
            l_[nb] = l_[nb] * alpha + rs;
#pragma unroll
            for (int hb = 0; hb < 4; ++hb) o[hb][nb] = o[hb][nb] * alpha;
            pb[nb] = __builtin_bit_cast(bf16x8, (u32x4){cvt_pk_bf16(s[0][nb][0], s[0][nb][1]), cvt_pk_bf16(s[0][nb][2], s[0][nb][3]),
                                                        cvt_pk_bf16(s[1][nb][0], s[1][nb][1]), cvt_pk_bf16(s[1][nb][2], s[1][nb][3])});
        }
#pragma unroll
        for (int hb = 0; hb < 4; ++hb) {
            const bf16_t* vp = Vs + (kj0 + 4 * fq + (fr >> 2)) * VS_LD + 32 * (hb >> 1) + 8 * (fr & 3) + 4 * (hb & 1);
            const bf16x8 a = tr_operand(vp, vp + 16 * VS_LD);
#pragma unroll
            for (int nb = 0; nb < 4; ++nb) o[hb][nb] = MFMA16(a, pb[nb], o[hb][nb]);
        }
    }
#pragma unroll
    for (int nb = 0; nb < 4; ++nb) {
        const int tok = tokq0 + 16 * nb + fr;
        const float inv = 1.f / l_[nb];
#pragma unroll
        for (int hp = 0; hp < 2; ++hp) {
            const int col = hq * 64 + 32 * hp + 8 * fq;
            const u32x4 z = *(const u32x4*)(proj + (size_t)tok * NPROJ + C_Z + col);
            const f32x4 a = o[2 * hp][nb] * inv, b2 = o[2 * hp + 1][nb] * inv;
            u32x4 y; y.x = cvt_pk_bf16(a[0] * bf_lo(z.x), a[1] * bf_hi(z.x)); y.y = cvt_pk_bf16(a[2] * bf_lo(z.y), a[3] * bf_hi(z.y));
            y.z = cvt_pk_bf16(b2[0] * bf_lo(z.z), b2[1] * bf_hi(z.z)); y.w = cvt_pk_bf16(b2[2] * bf_lo(z.w), b2[3] * bf_hi(z.w));
            *(u32x4*)(Y + (size_t)tok * D + col) = y;
        }
    }
    __syncthreads();
}

constexpr int VN_LD = 72;
__device__ __forceinline__ void sg_pair_item(const Params& p, int l, int pitem, unsigned char* lds, int tid, int wave, int lane) {
    const int b2 = pitem >> 7, c = (pitem >> 3) & 15, g = pitem & 7;
    const int fr = lane & 15, fq = lane >> 4;
    bf16_t* vnT = (bf16_t*)lds;
    const bf16_t* proj = (const bf16_t*)(p.ws + WS_PROJ);
    bf16_t* Y = (bf16_t*)(p.ws + WS_Y);
    const int s = tid >> 2, qd = tid & 3;
    const int t = 16 * wave + fr;
    int tok0[2];
    tok0[0] = b2 * SEQ + c * 128; tok0[1] = (b2 + 2) * SEQ + c * 128;
    u32x4 vw[2][2]; f32x4 stq[2]; u32x4 uf[2][2], zf[2][2];
#pragma unroll
    for (int q2 = 0; q2 < 2; ++q2) {
        const bf16_t* vp = proj + (size_t)(tok0[q2] + s) * NPROJ + C_SV;
        vw[q2][0] = *(const u32x4*)(vp + 64 * g + 16 * qd); vw[q2][1] = *(const u32x4*)(vp + 64 * g + 16 * qd + 8);
        stq[q2] = *(const f32x4*)((const float*)(p.ws + WS_SGST) + (size_t)(tok0[q2] + s) * 16 + 4 * qd);
#pragma unroll
        for (int mp = 0; mp < 2; ++mp) { const int col = 64 * g + 32 * mp + 8 * fq; const size_t ro = (size_t)(tok0[q2] + t) * NPROJ;
            uf[q2][mp] = *(const u32x4*)(proj + ro + C_SU + col); zf[q2][mp] = *(const u32x4*)(proj + ro + C_Z + 1024 + col); }
    }
    bf16x8 wf[4];
    {   const bf16_t* wrow = (const bf16_t*)(p.ws + WS_SGW) + ((size_t)(l * 8 + g) * 128 + t) * 128;
#pragma unroll
        for (int kk = 0; kk < 4; ++kk) if (32 * kk <= 16 * wave + 15) wf[kk] = *(const bf16x8*)(wrow + 32 * kk + 8 * fq); }
    const float bias = p.sg_b[(l * 8 + g) * 128 + t];
    float lgv[16], lbv[16];
    {   const float* lg = p.sg_ln_g + l * 512 + 64 * g + 16 * qd; const float* lb = p.sg_ln_b + l * 512 + 64 * g + 16 * qd;
#pragma unroll
        for (int i = 0; i < 4; ++i) { const f32x4 a = *(const f32x4*)(lg + 4 * i), bb = *(const f32x4*)(lb + 4 * i);
#pragma unroll
            for (int e = 0; e < 4; ++e) { lgv[4 * i + e] = a[e]; lbv[4 * i + e] = bb[e]; } } }
#pragma unroll
    for (int q2 = 0; q2 < 2; ++q2) {
        float sum = stq[q2][0] + stq[q2][2], sq = stq[q2][1] + stq[q2][3];
        sum += __shfl_xor(sum, 1); sum += __shfl_xor(sum, 2); sq += __shfl_xor(sq, 1); sq += __shfl_xor(sq, 2);
        const float mu = sum * (1.f / 512.f), var = fmaxf(sq * (1.f / 512.f) - mu * mu, 0.f), rstd = rsqrtf(var + EPS);
        bf16_t* vq = vnT + q2 * 128 * VN_LD + s * VN_LD + 16 * qd;
#pragma unroll
        for (int i = 0; i < 2; ++i) { const unsigned ww[4] = {vw[q2][i].x, vw[q2][i].y, vw[q2][i].z, vw[q2][i].w}; unsigned o4[4];
#pragma unroll
            for (int e = 0; e < 4; ++e) { const int ch = 8 * i + 2 * e;
                o4[e] = cvt_pk_bf16((bf_lo(ww[e]) - mu) * rstd * lgv[ch] + lbv[ch], (bf_hi(ww[e]) - mu) * rstd * lgv[ch + 1] + lbv[ch + 1]); }
            *(u32x4*)(vq + 8 * i) = (u32x4){o4[0], o4[1], o4[2], o4[3]}; }
    }
    __syncthreads();
    {
        f32x4 acc[2][4];
#pragma unroll
        for (int q2 = 0; q2 < 2; ++q2)
#pragma unroll
            for (int mb = 0; mb < 4; ++mb) acc[q2][mb] = (f32x4){0.f, 0.f, 0.f, 0.f};
#pragma unroll
        for (int kk = 0; kk < 4; ++kk) {
            if (32 * kk <= 16 * wave + 15) {
                const int s0 = 32 * kk + 8 * fq;
                const bf16x8 bfr = wf[kk];
#pragma unroll
                for (int q2 = 0; q2 < 2; ++q2)
#pragma unroll
                    for (int mb = 0; mb < 4; ++mb) {
                        const bf16_t* ap = vnT + (q2 * 128 + s0 + (fr >> 2)) * VN_LD + 32 * (mb >> 1) + 8 * (fr & 3) + 4 * (mb & 1);
                        acc[q2][mb] = MFMA16(tr_operand(ap, ap + 4 * VN_LD), bfr, acc[q2][mb]); }
            }
        }
#pragma unroll
        for (int q2 = 0; q2 < 2; ++q2)
#pragma unroll
            for (int mp = 0; mp < 2; ++mp) {
                const int col = 64 * g + 32 * mp + 8 * fq;
                const u32x4 u = uf[q2][mp], z = zf[q2][mp];
                const f32x4 a = acc[q2][2 * mp] + bias, b3 = acc[q2][2 * mp + 1] + bias;
                u32x4 y; y.x = cvt_pk_bf16(bf_lo(u.x) * a[0] * bf_lo(z.x), bf_hi(u.x) * a[1] * bf_hi(z.x)); y.y = cvt_pk_bf16(bf_lo(u.y) * a[2] * bf_lo(z.y), bf_hi(u.y) * a[3] * bf_hi(z.y));
                y.z = cvt_pk_bf16(bf_lo(u.z) * b3[0] * bf_lo(z.z), bf_hi(u.z) * b3[1] * bf_hi(z.z)); y.w = cvt_pk_bf16(bf_lo(u.w) * b3[2] * bf_lo(z.w), bf_hi(u.w) * b3[3] * bf_hi(z.w));
                *(u32x4*)(Y + (size_t)(tok0[q2] + t) * D + 1024 + col) = y;
            }
    }
    __syncthreads();
}

constexpr int GL_LD = 72;
struct CgRow { f32x4 c0, c1, c2, c3; };
__device__ __forceinline__ CgRow gla_load_cg(const Params& p, int tok) {
    const float* cgp = (const float*)(p.ws + WS_CG) + (size_t)tok * 16;
    CgRow r; r.c0 = *(const f32x4*)cgp; r.c1 = *(const f32x4*)(cgp + 4); r.c2 = *(const f32x4*)(cgp + 8); r.c3 = *(const f32x4*)(cgp + 12); return r;
}
__device__ __forceinline__ float wave_scan_incl(float v) {
#define SCAN_STEP(ctrl, rmask) v += __builtin_bit_cast(float, __builtin_amdgcn_update_dpp(0, __builtin_bit_cast(int, v), (ctrl), (rmask), 0xf, false))
    SCAN_STEP(0x111, 0xf); SCAN_STEP(0x112, 0xf); SCAN_STEP(0x114, 0xf); SCAN_STEP(0x118, 0xf);
    SCAN_STEP(0x142, 0xa); SCAN_STEP(0x143, 0xc);
#undef SCAN_STEP
    return v;
}
__device__ __forceinline__ void gla_b(const float* wl, const CgRow& cr, int wave, int lane, float (&bc)[8], float (&bl)[8]) {
    const f32x4 c0 = cr.c0, c1 = cr.c1, c2 = cr.c2, c3 = cr.c3;
    const float cgv[16] = {c0[0], c0[1], c0[2], c0[3], c1[0], c1[1], c1[2], c1[3], c2[0], c2[1], c2[2], c2[3], c3[0], c3[1], c3[2], c3[3]};
    float x[8];
    {   const f32x4 b0 = *(const f32x4*)(wl + 1024 + 8 * wave), b1 = *(const f32x4*)(wl + 1024 + 8 * wave + 4);
#pragma unroll
        for (int e = 0; e < 4; ++e) { x[e] = b0[e]; x[4 + e] = b1[e]; } }
#pragma unroll
    for (int r = 0; r < 16; ++r) {
        const f32x4 w0 = *(const f32x4*)(wl + r * 64 + 8 * wave), w1 = *(const f32x4*)(wl + r * 64 + 8 * wave + 4);
#pragma unroll
        for (int e = 0; e < 4; ++e) { x[e] += cgv[r] * w0[e]; x[4 + e] += cgv[r] * w1[e]; }
    }
#pragma unroll
    for (int i = 0; i < 8; ++i) {
        float la = (fminf(x[i], 0.f) - __logf(1.f + __expf(-fabsf(x[i])))) * (1.f / 16.f);
        la = wave_scan_incl(la);
        bc[i] = la; bl[i] = __builtin_bit_cast(float, __builtin_amdgcn_readlane(__builtin_bit_cast(int, la), 63));
    }
}
struct VPair { u32x4 a, b; };
__device__ __forceinline__ VPair gla_load_v(const bf16_t* proj, int tok0, int h, int tid) {
    const int t = tid >> 3, c8 = tid & 7;
    const bf16_t* vp = proj + (size_t)(tok0 + t) * NPROJ + C_CV + h * 128 + 16 * c8;
    VPair r; r.a = *(const u32x4*)vp; r.b = *(const u32x4*)(vp + 8); return r;
}
__device__ __forceinline__ void gla_store_vT(const VPair& v, bf16_t* vT, int tid) {
    const int t = tid >> 3, c8 = tid & 7;
#pragma unroll
    for (int i = 0; i < 2; ++i) { const u32x4 w = i ? v.b : v.a; const unsigned ww[4] = {w.x, w.y, w.z, w.w};
#pragma unroll
        for (int e = 0; e < 4; ++e) { const int dv = 16 * c8 + 8 * i + 2 * e;
            vT[dv * GL_LD + t] = (bf16_t)(ww[e] & 0xffffu); vT[(dv + 1) * GL_LD + t] = (bf16_t)(ww[e] >> 16); } }
}
__device__ __forceinline__ void gla_local_item(const Params& p, int l, int item, unsigned char* lds, int tid, int wave, int lane) {
    const int bh = item >> 5, c = item & 31, b = bh >> 2, h = bh & 3;
    const int fr = lane & 15, fq = lane >> 4;
    const int tok0 = b * SEQ + c * 64;
    bf16_t* klT = (bf16_t*)lds;
    bf16_t* vT = (bf16_t*)(lds + 64 * GL_LD * 2);
    const bf16_t* proj = (const bf16_t*)(p.ws + WS_PROJ);
    const CgRow cr = gla_load_cg(p, tok0 + lane);
    const bf16_t* rowp = proj + (size_t)(tok0 + lane) * NPROJ + h * 64 + 8 * wave;
    const u32x4 qw = *(const u32x4*)(rowp + C_CQ), kw = *(const u32x4*)(rowp + C_CK);
    const VPair vpre = gla_load_v(proj, tok0, h, tid);
    float* wl = (float*)(lds + 3 * 64 * GL_LD * 2);
    if (tid < 256) *(f32x4*)(wl + (tid >> 4) * 64 + 4 * (tid & 15)) = *(const f32x4*)(p.gla_wup + (size_t)(l * 16 + (tid >> 4)) * 256 + h * 64 + 4 * (tid & 15));
    else if (tid < 272) *(f32x4*)(wl + 1024 + 4 * (tid - 256)) = *(const f32x4*)(p.gla_bg + l * 256 + h * 64 + 4 * (tid - 256));
    __syncthreads();
    float bc[8], bl[8];
    gla_b(wl, cr, wave, lane, bc, bl);
    {
        const unsigned qq[4] = {qw.x, qw.y, qw.z, qw.w}, ww[4] = {kw.x, kw.y, kw.z, kw.w};
        unsigned qo[4], ko[4];
#pragma unroll
        for (int e = 0; e < 4; ++e) {
            klT[(8 * wave + 2 * e) * GL_LD + lane] = f2bf(bf_lo(ww[e]) * __expf(bl[2 * e] - bc[2 * e]));
            klT[(8 * wave + 2 * e + 1) * GL_LD + lane] = f2bf(bf_hi(ww[e]) * __expf(bl[2 * e + 1] - bc[2 * e + 1]));
            const float e0 = __expf(bc[2 * e]), e1 = __expf(bc[2 * e + 1]);
            qo[e] = cvt_pk_bf16(bf_lo(qq[e]) * 0.125f * e0, bf_hi(qq[e]) * 0.125f * e1);
            ko[e] = cvt_pk_bf16(bf_lo(ww[e]) * fast_rcp(e0), bf_hi(ww[e]) * fast_rcp(e1));
        }
        *(u32x4*)((bf16_t*)(p.ws + WS_QD) + (size_t)item * 4096 + lane * 64 + 8 * wave) = (u32x4){qo[0], qo[1], qo[2], qo[3]};
        *(u32x4*)((bf16_t*)(p.ws + WS_KD) + (size_t)item * 4096 + lane * 64 + 8 * wave) = (u32x4){ko[0], ko[1], ko[2], ko[3]};
        if (lane == 63) { float* dec = (float*)(p.ws + WS_DEC) + (size_t)item * 64 + 8 * wave;
#pragma unroll
            for (int i = 0; i < 8; ++i) dec[i] = __expf(bl[i]); }
    }
    gla_store_vT(vpre, vT, tid);
    __syncthreads();
    {
        f32x4 acc[4];
#pragma unroll
        for (int mb = 0; mb < 4; ++mb) acc[mb] = (f32x4){0.f, 0.f, 0.f, 0.f};
#pragma unroll
        for (int kk = 0; kk < 2; ++kk) {
            const bf16x8 bfr = *(const bf16x8*)(vT + (16 * wave + fr) * GL_LD + 32 * kk + 8 * fq);
#pragma unroll
            for (int mb = 0; mb < 4; ++mb) { const bf16x8 a = *(const bf16x8*)(klT + (16 * mb + fr) * GL_LD + 32 * kk + 8 * fq); acc[mb] = MFMA16(a, bfr, acc[mb]); }
        }
        float* loct = (float*)(p.ws + WS_LOCT) + (size_t)item * 8192 + (16 * wave + fr) * 64 + 4 * fq;
#pragma unroll
        for (int mb = 0; mb < 4; ++mb) *(f32x4*)(loct + 16 * mb) = acc[mb];
        const int dv = tid >> 2, qd4 = tid & 3;
        const u32x4 t0 = *(const u32x4*)(vT + dv * GL_LD + 16 * qd4), t1 = *(const u32x4*)(vT + dv * GL_LD + 16 * qd4 + 8);
        bf16_t* vg = (bf16_t*)(p.ws + WS_VTG) + (size_t)item * 8192 + dv * 64 + 16 * qd4;
        *(u32x4*)vg = t0; *(u32x4*)(vg + 8) = t1;
    }
    __syncthreads();
}
__device__ __forceinline__ void gla_scan(const Params& p, int tid, int bx) {
    const float* loct = (const float*)(p.ws + WS_LOCT); const float* dec = (const float*)(p.ws + WS_DEC);
    bf16_t* ST = (bf16_t*)(p.ws + WS_ST);
    for (int e = bx * 512 + tid; e < 16 * 8192; e += gridDim.x * 512) {
        const int bh = e >> 13, r = e & 8191, dk = r & 63;
        float lo[32], de[32];
#pragma unroll
        for (int c = 0; c < 32; ++c) { const size_t it = (size_t)bh * 32 + c; lo[c] = loct[it * 8192 + r]; de[c] = dec[it * 64 + dk]; }
        float s = 0.f;
#pragma unroll
        for (int c = 0; c < 32; ++c) { const size_t it = (size_t)bh * 32 + c;
            ST[it * 8192 + r] = f2bf(s);
            s = s * de[c] + lo[c]; }
    }
}
constexpr int GO_LD = 72;
constexpr int GO_QD = 0, GO_KD = 64 * GO_LD, GO_ST = 2 * 64 * GO_LD, GO_VT = GO_ST + 128 * GO_LD, GO_IMG = GO_VT + 128 * GO_LD;
__device__ __forceinline__ void gla_out_pair(const Params& p, int l, int pit, unsigned char* lds, int tid, int wave, int lane) {
    const int bh2 = pit >> 5, c = pit & 31, h = bh2 & 3;
    const int fr = lane & 15, fq = lane >> 4;
    bf16_t* img = (bf16_t*)lds;
    float* red = (float*)(lds + 2 * GO_IMG * 2);
    const bf16_t* proj = (const bf16_t*)(p.ws + WS_PROJ);
    bf16_t* Y = (bf16_t*)(p.ws + WS_Y);
    const int tb = wave & 3, dh = wave >> 2, t = 16 * tb + fr;
    int item[2], tok[2];
    item[0] = bh2 * 32 + c; item[1] = (bh2 + 8) * 32 + c;
    tok[0] = (bh2 >> 2) * SEQ + c * 64 + t; tok[1] = ((bh2 >> 2) + 2) * SEQ + c * 64 + t;
    {
        const int r8 = tid >> 3, ch = (tid & 7) * 8;
        u32x4 cq[2], ck[2], cs[2][2], cv[2][2];
#pragma unroll
        for (int q2 = 0; q2 < 2; ++q2) {
            cq[q2] = *(const u32x4*)((const bf16_t*)(p.ws + WS_QD) + (size_t)item[q2] * 4096 + r8 * 64 + ch);
            ck[q2] = *(const u32x4*)((const bf16_t*)(p.ws + WS_KD) + (size_t)item[q2] * 4096 + r8 * 64 + ch);
#pragma unroll
            for (int i = 0; i < 2; ++i) {
                cs[q2][i] = *(const u32x4*)((const bf16_t*)(p.ws + WS_ST) + (size_t)item[q2] * 8192 + (r8 + 64 * i) * 64 + ch);
                cv[q2][i] = *(const u32x4*)((const bf16_t*)(p.ws + WS_VTG) + (size_t)item[q2] * 8192 + (r8 + 64 * i) * 64 + ch);
            }
        }
#pragma unroll
        for (int q2 = 0; q2 < 2; ++q2) {
            bf16_t* im = img + q2 * GO_IMG;
            *(u32x4*)(im + GO_QD + r8 * GO_LD + ch) = cq[q2]; *(u32x4*)(im + GO_KD + r8 * GO_LD + ch) = ck[q2];
#pragma unroll
            for (int i = 0; i < 2; ++i) { *(u32x4*)(im + GO_ST + (r8 + 64 * i) * GO_LD + ch) = cs[q2][i]; *(u32x4*)(im + GO_VT + (r8 + 64 * i) * GO_LD + ch) = cv[q2][i]; }
        }
    }
    u32x4 zf[2][2]; f32x4 gf[4];
#pragma unroll
    for (int mp = 0; mp < 2; ++mp) {
        const int dv = 64 * dh + 32 * mp + 8 * fq;
        gf[2 * mp] = *(const f32x4*)(p.gla_ng + l * 128 + dv); gf[2 * mp + 1] = *(const f32x4*)(p.gla_ng + l * 128 + dv + 4);
#pragma unroll
        for (int q2 = 0; q2 < 2; ++q2) zf[q2][mp] = *(const u32x4*)(proj + (size_t)tok[q2] * NPROJ + C_Z + 1536 + h * 128 + dv);
    }
    __syncthreads();
    f32x4 acc[2][4];
#pragma unroll
    for (int q2 = 0; q2 < 2; ++q2) {
        const bf16_t* im = img + q2 * GO_IMG;
        bf16x8 bq[2];
#pragma unroll
        for (int kk = 0; kk < 2; ++kk) bq[kk] = *(const bf16x8*)(im + GO_QD + t * GO_LD + 32 * kk + 8 * fq);
        f32x4 sc[4];
#pragma unroll
        for (int mb = 0; mb < 4; ++mb) {
            sc[mb] = (f32x4){0.f, 0.f, 0.f, 0.f};
            if (mb <= tb) {
#pragma unroll
                for (int kk = 0; kk < 2; ++kk) { const bf16x8 a = *(const bf16x8*)(im + GO_KD + (16 * mb + fr) * GO_LD + 32 * kk + 8 * fq); sc[mb] = MFMA16(a, bq[kk], sc[mb]); }
#pragma unroll
                for (int j = 0; j < 4; ++j) if (16 * mb + 4 * fq + j > t) sc[mb][j] = 0.f;
            }
        }
        bf16x8 bp[2];
#pragma unroll
        for (int k2 = 0; k2 < 2; ++k2)
            bp[k2] = __builtin_bit_cast(bf16x8, (u32x4){cvt_pk_bf16(sc[2 * k2][0], sc[2 * k2][1]), cvt_pk_bf16(sc[2 * k2][2], sc[2 * k2][3]),
                                                        cvt_pk_bf16(sc[2 * k2 + 1][0], sc[2 * k2 + 1][1]), cvt_pk_bf16(sc[2 * k2 + 1][2], sc[2 * k2 + 1][3])});
        float ssq = 0.f;
#pragma unroll
        for (int mb = 0; mb < 4; ++mb) {
            const int dvrow = 64 * dh + 32 * (mb >> 1) + 8 * (fr >> 2) + 4 * (mb & 1) + (fr & 3);
            acc[q2][mb] = (f32x4){0.f, 0.f, 0.f, 0.f};
#pragma unroll
            for (int k2 = 0; k2 < 2; ++k2) {
                const bf16_t* vp = im + GO_VT + dvrow * GO_LD + 32 * k2 + 4 * fq;
                const u32x2 a0 = *(const u32x2*)vp, a1 = *(const u32x2*)(vp + 16);
                acc[q2][mb] = MFMA16(__builtin_bit_cast(bf16x8, (u32x4){a0.x, a0.y, a1.x, a1.y}), bp[k2], acc[q2][mb]);
            }
#pragma unroll
            for (int kk = 0; kk < 2; ++kk) { const bf16x8 a = *(const bf16x8*)(im + GO_ST + dvrow * GO_LD + 32 * kk + 8 * fq); acc[q2][mb] = MFMA16(a, bq[kk], acc[q2][mb]); }
            ssq += (acc[q2][mb][0] * acc[q2][mb][0] + acc[q2][mb][1] * acc[q2][mb][1]) + (acc[q2][mb][2] * acc[q2][mb][2] + acc[q2][mb][3] * acc[q2][mb][3]);
        }
        ssq += __shfl_xor(ssq, 16); ssq += __shfl_xor(ssq, 32);
        if (fq == 0) red[(q2 * 2 + dh) * 64 + t] = ssq;
    }
    __syncthreads();
#pragma unroll
    for (int q2 = 0; q2 < 2; ++q2) {
        const float rstd = rsqrtf((red[(q2 * 2) * 64 + t] + red[(q2 * 2 + 1) * 64 + t]) * (1.f / 128.f) + EPS);
#pragma unroll
        for (int mp = 0; mp < 2; ++mp) {
            const int col = 1536 + h * 128 + 64 * dh + 32 * mp + 8 * fq;
            const u32x4 z = zf[q2][mp];
            const f32x4 a = acc[q2][2 * mp] * rstd * gf[2 * mp], b3 = acc[q2][2 * mp + 1] * rstd * gf[2 * mp + 1];
            u32x4 y; y.x = cvt_pk_bf16(a[0] * bf_lo(z.x), a[1] * bf_hi(z.x)); y.y = cvt_pk_bf16(a[2] * bf_lo(z.y), a[3] * bf_hi(z.y));
            y.z = cvt_pk_bf16(b3[0] * bf_lo(z.z), b3[1] * bf_hi(z.z)); y.w = cvt_pk_bf16(b3[2] * bf_lo(z.w), b3[3] * bf_hi(z.w));
            *(u32x4*)(Y + (size_t)tok[q2] * D + col) = y;
        }
    }
    __syncthreads();
}

#define XB_TMO      128
#define XB_XCNT(j)  (256  + 64 * (j))
#define XB_XSUB(j)  (1280 + 64 * (j))
#define XB_XGEN(j)  (2304 + 64 * (j))
#define XB_TOP      3328
#define XB_TOPGEN   3392
#define XCD_BAR_WORDS 3456
#define XB_SPIN_CAP (1u << 18)
__device__ __forceinline__ unsigned xb_ld(unsigned* p)              { return __hip_atomic_load(p, __ATOMIC_RELAXED, __HIP_MEMORY_SCOPE_AGENT); }
__device__ __forceinline__ unsigned xb_add(unsigned* p, unsigned v) { return __hip_atomic_fetch_add(p, v, __ATOMIC_RELAXED, __HIP_MEMORY_SCOPE_AGENT); }
__device__ __forceinline__ unsigned xb_xcc_id() { return (unsigned)__builtin_amdgcn_s_getreg((3 << 11) | 20) & 0xFu; }
#define XB_SPIN(cond, bar) do { unsigned _sp = 0; while (cond) { __builtin_amdgcn_s_sleep(1); \
    if ((++_sp & 255u) == 0u) { if (xb_ld(&(bar)[XB_TMO])) break; if (_sp > XB_SPIN_CAP) { atomicAdd(&(bar)[XB_TMO], 1u); break; } } } } while (0)
__device__ __forceinline__ void xcd_barrier_complete(unsigned* bar, unsigned x, unsigned& nloc, unsigned& nx) {
    const unsigned G = gridDim.x * gridDim.y * gridDim.z;
    unsigned sum, cnt, mine, sp = 0u;
    for (;;) {
        sum = 0u; cnt = 0u; mine = 0u;
#pragma unroll
        for (unsigned j = 0; j < 16; ++j) { const unsigned c = xb_ld(&bar[XB_XCNT(j)]); sum += c; cnt += (c > 0u) ? 1u : 0u; mine = (j == x) ? c : mine; }
        if (sum == G) break;
        __builtin_amdgcn_s_sleep(1);
        if ((++sp & 255u) == 0u) { if (xb_ld(&bar[XB_TMO])) break; if (sp > XB_SPIN_CAP) { atomicAdd(&bar[XB_TMO], 1u); break; } }
    }
    nloc = mine > 0u ? mine : 1u; nx = cnt > 0u ? cnt : 1u;
}
__device__ __forceinline__ void xcd_barrier(unsigned* bar, volatile LAS unsigned* st) {
    asm volatile("s_waitcnt vmcnt(0)" ::: "memory");
    __syncthreads();
    if (threadIdx.x == 0) {
        __builtin_amdgcn_s_waitcnt(0);
        const unsigned x = xb_xcc_id();
        unsigned nloc = st[0], nx = st[1];
        if (nloc == 0u) { xcd_barrier_complete(bar, x, nloc, nx); st[0] = nloc; st[1] = nx; }
        const unsigned old = xb_add(&bar[XB_XSUB(x)], 1u);
        const unsigned gen = old / nloc;
        if (old + 1u == (gen + 1u) * nloc) {
            __builtin_amdgcn_fence(__ATOMIC_RELEASE, "agent");
            asm volatile("s_waitcnt vmcnt(0)" ::: "memory");
            const unsigned og = xb_add(&bar[XB_TOP], 1u);
            const unsigned tg = og / nx;
            if (og + 1u == (tg + 1u) * nx) xb_add(&bar[XB_TOPGEN], 1u);
            else XB_SPIN(xb_ld(&bar[XB_TOPGEN]) == tg, bar);
            __builtin_amdgcn_fence(__ATOMIC_ACQUIRE, "agent");
            xb_add(&bar[XB_XGEN(x)], 1u);
            asm volatile("s_waitcnt vmcnt(0)" ::: "memory");
        } else {
            XB_SPIN(xb_ld(&bar[XB_XGEN(x)]) == gen, bar);
            __builtin_amdgcn_fence(__ATOMIC_ACQUIRE, "agent");
            asm volatile("s_waitcnt vmcnt(0)" ::: "memory");
        }
    }
    __syncthreads();
}

constexpr int N_PHASES = 14;
__global__ void __launch_bounds__(512, 2) fwd_kernel(Params p) {
    extern __shared__ __attribute__((aligned(16))) unsigned char lds[];
    const int G = gridDim.x;
    const int lo = p.ph_lo, hi = p.ph_hi;
    unsigned* const xbar = (unsigned*)(p.ws + WS_BAR);
    volatile LAS unsigned* const xst = (volatile LAS unsigned*)((LAS unsigned char*)lds + 131072 + 64);
    if (threadIdx.x < 2) xst[threadIdx.x] = 0u;
    __syncthreads();
    if (lo < 0) cg::this_grid().sync();
    if (hi - lo > 1 && threadIdx.x == 0) (void)xb_add(&xbar[XB_XCNT(xb_xcc_id())], 1u);
#ifndef PHMASK
#define PHMASK 0xffff
#endif
#define IN(k) (((PHMASK >> ((k) < 2 ? (k) : 2 + ((k) - 2) % 6)) & 1) && lo <= (k) && (k) < hi)
#define SEAM(k) do { STAMP(2 * (k)); if (IN(k) && IN((k) + 1)) { xcd_barrier(xbar, xst); } STAMP(2 * (k) + 1); } while (0)
#define FRESH() int tid = threadIdx.x; asm volatile("" : "+v"(tid)); int bx = blockIdx.x; asm volatile("" : "+s"(bx)); \
    const int lane = tid & 63, wave = __builtin_amdgcn_readfirstlane(tid >> 6); \
    const Params q = fresh_params(p); (void)lane; (void)wave; (void)bx;
    unsigned long long tacc = 0ull, tprev = (PMASK != 0ull) ? __builtin_amdgcn_s_memrealtime() : 0ull;
#define STAMP(idx) do { if (PMASK != 0ull) { const unsigned long long now_ = __builtin_amdgcn_s_memrealtime(); if ((PMASK >> (idx)) & 1ull) tacc += now_ - tprev; tprev = now_; } } while (0)
    if (IN(0)) for (int rep = 0; rep < REPN(0); ++rep) { FRESH(); mod_items(q, 0, lds, tid, wave, lane, bx); __syncthreads(); }
    SEAM(0);
    if (IN(1)) for (int rep = 0; rep < REPN(1); ++rep) { FRESH(); mod_items(q, 1, lds, tid, wave, lane, bx); __syncthreads(); STAMP(32); p0_convert(q, lds, tid, wave, lane, bx); STAMP(33); row_pass(q, 0, wave, lane, bx); }
    SEAM(1);
#pragma unroll 1
    for (int l = 0; l < 2; ++l) {
        const int pb = 2 + 6 * l;
        if (IN(pb)) for (int rep = 0; rep < REPN(2); ++rep) {
            FRESH();
            pg8::Gemm g{(const bf16_t*)(q.ws + WS_H), (const bf16_t*)(q.ws + WS_WIN + (size_t)l * WIN_BYTES), M, NPAD, D};
            pg8::StaticOrder S; S.init(M, NPAD, G, bx);
            pg8::EpiProj E{(bf16_t*)(q.ws + WS_PROJ), (float*)(q.ws + WS_CG), (float*)(q.ws + WS_SGST)};
            pg8::gemm_phase<pg8::EpiProj, pg8::StaticOrder, true, true>((LAS unsigned char*)lds, g, S, E, tid);
        }
        SEAM(pb);
        if (IN(pb + 1)) for (int rep = 0; rep < REPN(3); ++rep) {
#ifndef MIXMASK
#define MIXMASK 7
#endif
            for (int rr = 0; rr < ((MIXR >> 0) & 15); ++rr) { FRESH(); for (int it = bx; it < 256; it += G) attn_item(q, l, it, lds, tid, wave, lane); }
            STAMP(36 + 4 * l); for (int rr = 0; rr < ((MIXR >> 4) & 15); ++rr) { FRESH(); for (int it = bx; it < 256; it += G) sg_pair_item(q, l, it, lds, tid, wave, lane); } STAMP(37 + 4 * l);
            for (int rr = 0; rr < ((MIXR >> 8) & 15); ++rr) { FRESH(); for (int it = bx; it < 512; it += G) gla_local_item(q, l, it, lds, tid, wave, lane); }
        }
        SEAM(pb + 1);
        if (IN(pb + 2)) for (int rep = 0; rep < REPN(4); ++rep) { FRESH(); gla_scan(q, tid, bx); }
        SEAM(pb + 2);
        if (IN(pb + 3)) for (int rep = 0; rep < REPN(5); ++rep) { FRESH(); for (int it = bx; it < 256; it += G) gla_out_pair(q, l, it, lds, tid, wave, lane); }
        SEAM(pb + 3);
        if (IN(pb + 4)) for (int rep = 0; rep < REPN(6); ++rep) {
            FRESH();
            pg8::Gemm g{(const bf16_t*)(q.ws + WS_Y), (const bf16_t*)(q.ws + WS_WOUT + (size_t)l * WOUT_BYTES), M, D, D};
            pg8::StaticOrder S; S.init(M, D, G, bx);
            pg8::EpiOut E{(bf16_t*)(q.ws + WS_OUT)};
            pg8::gemm_phase<pg8::EpiOut, pg8::StaticOrder, true, true>((LAS unsigned char*)lds, g, S, E, tid);
        }
        SEAM(pb + 4);
        if (IN(pb + 5)) { FRESH(); row_pass(q, l + 1, wave, lane, bx); }
        if (l == 0) SEAM(pb + 5);
    }
    STAMP(26);
    if (PMASK != 0ull) { if (blockIdx.x == 0 && threadIdx.x == 0) { const unsigned long long t0 = __builtin_amdgcn_s_memrealtime(); while (__builtin_amdgcn_s_memrealtime() - t0 < tacc) __builtin_amdgcn_s_sleep(8); } }
#undef IN
#undef SEAM
#undef FRESH
}

extern "C" void kernel_launch(void* const* d_in, const int* in_sizes, int n_in, void* d_out, int out_size, void* d_ws, size_t ws_size, hipStream_t stream) {
    static int grid = 0;
    if (grid == 0) {
        if (n_in != 17 || in_sizes[0] != M * D || out_size != M * D || ws_size < WS_END) { fprintf(stderr, "kernel_launch: unexpected shapes (n_in %d, in0 %d, out %d, ws %zu)\n", n_in, n_in > 0 ? in_sizes[0] : -1, out_size, ws_size); grid = -1; return; }
        int dev = 0, cus = 0, per_cu = 0;
        if (hipGetDevice(&dev) != hipSuccess || hipDeviceGetAttribute(&cus, hipDeviceAttributeMultiprocessorCount, dev) != hipSuccess) { grid = -1; return; }
        if (hipFuncSetAttribute((const void*)fwd_kernel, hipFuncAttributeMaxDynamicSharedMemorySize, LDS_BYTES) != hipSuccess) { fprintf(stderr, "kernel_launch: hipFuncSetAttribute failed\n"); grid = -1; return; }
        if (hipOccupancyMaxActiveBlocksPerMultiprocessor(&per_cu, (const void*)fwd_kernel, 512, LDS_BYTES) != hipSuccess || per_cu < 1) { fprintf(stderr, "kernel_launch: occupancy query says %d blocks per CU\n", per_cu); per_cu = 1; }
        (void)hipGetLastError();
        grid = cus;
    }
    if (grid < 0) return;
    Params p{};
    p.x = (const float*)d_in[0]; p.c = (const float*)d_in[1]; p.pos = (const int*)d_in[2]; p.w_mod = (const float*)d_in[3]; p.b_mod = (const float*)d_in[4];
    p.g_pre = (const float*)d_in[5]; p.g_post = (const float*)d_in[6]; p.w_in = (const float*)d_in[7]; p.w_out = (const float*)d_in[8]; p.sinks = (const float*)d_in[9];
    p.sg_w = (const float*)d_in[10]; p.sg_b = (const float*)d_in[11]; p.sg_ln_g = (const float*)d_in[12]; p.sg_ln_b = (const float*)d_in[13];
    p.gla_wup = (const float*)d_in[14]; p.gla_bg = (const float*)d_in[15]; p.gla_ng = (const float*)d_in[16];
    p.out = (float*)d_out; p.ws = (unsigned char*)d_ws;
#if MK_SINGLE
    if (hipMemsetAsync((char*)d_ws + WS_BAR, 0, XCD_BAR_WORDS * 4, stream) != hipSuccess) { fprintf(stderr, "kernel_launch: memset failed\n"); return; }
    p.ph_lo = 0; p.ph_hi = N_PHASES;
    void* args[] = {&p};
    hipError_t e = hipLaunchCooperativeKernel((const void*)fwd_kernel, dim3(grid), dim3(512), args, LDS_BYTES, stream);
    if (e != hipSuccess) fprintf(stderr, "kernel_launch: cooperative launch failed: %s (grid %d)\n", hipGetErrorString(e), grid);
#else
    for (int ph = 0; ph < N_PHASES; ++ph) {
        p.ph_lo = ph; p.ph_hi = ph + 1;
        hipLaunchKernelGGL(fwd_kernel, dim3(grid), dim3(512), LDS_BYTES, stream, p);
    }
#endif
}
```

```cpp
#include <hip/hip_runtime.h>
#include <hip/hip_cooperative_groups.h>
#include <cstdio>
#include <cstdint>
namespace cg = cooperative_groups;

#ifndef REPS
#define REPS 0x11111111
#endif
#define REPN(k) ((REPS >> (4 * (k))) & 15)
#ifndef PMASK
#define PMASK 0ull
#endif
#ifndef MIXR
#define MIXR 0x111
#endif
#ifndef MK_SINGLE
#define MK_SINGLE 1
#endif

#define LAS __attribute__((address_space(3)))
typedef unsigned short bf16_t;
typedef short bf16x8 __attribute__((ext_vector_type(8)));
typedef float f32x4 __attribute__((ext_vector_type(4)));
typedef float f32x2 __attribute__((ext_vector_type(2)));
typedef unsigned u32x4 __attribute__((ext_vector_type(4)));
typedef unsigned u32x2 __attribute__((ext_vector_type(2)));

constexpr int D = 2048, NB = 4, SEQ = 2048, M = NB * SEQ;
constexpr int NPROJ = 5632;
constexpr int NPAD = 5888;
constexpr int WIN_LD = 5648;
constexpr float EPS = 1e-6f;
constexpr int C_AQ = 0, C_AK = 1024, C_AV = 1280, C_SU = 1536, C_SV = 2048, C_CQ = 2560, C_CK = 2816, C_CV = 3072, C_Z = 3584;
constexpr float LOG2E = 1.4426950408889634f;

constexpr size_t MiB = 1u << 20;
constexpr size_t WS_WIN = 0, WIN_BYTES = (size_t)NPAD * D * 2;
constexpr size_t WS_WOUT = 46 * MiB, WOUT_BYTES = (size_t)D * D * 2;
constexpr size_t WS_H = 62 * MiB, WS_PROJ = 94 * MiB, WS_CG = 182 * MiB, WS_MOD = 183 * MiB, WS_Y = 184 * MiB, WS_OUT = 216 * MiB;
constexpr size_t WS_LOCT = 248 * MiB, WS_ST = 264 * MiB, WS_DEC = 272 * MiB, WS_BAR = 273 * MiB, WS_QD = 274 * MiB, WS_KD = 278 * MiB, WS_VTG = 282 * MiB, WS_X1B = 290 * MiB, WS_SGST = 322 * MiB, WS_SGW = 323 * MiB, WS_END = 324 * MiB;

constexpr int LDS_BYTES = 135168;

struct Params {
    const float* x; const float* c; const int* pos; const float* w_mod; const float* b_mod; const float* g_pre; const float* g_post;
    const float* w_in; const float* w_out; const float* sinks; const float* sg_w; const float* sg_b; const float* sg_ln_g; const float* sg_ln_b;
    const float* gla_wup; const float* gla_bg; const float* gla_ng;
    float* out; unsigned char* ws; int ph_lo, ph_hi;
};

__device__ __forceinline__ Params fresh_params(const Params& p) {
#if defined(__HIP_DEVICE_COMPILE__)
    typedef unsigned long long u64;
    const __attribute__((address_space(4))) u64* pp = (const __attribute__((address_space(4))) u64*)__builtin_amdgcn_kernarg_segment_ptr();
    asm volatile("" : "+s"(pp));
    Params q; u64* dst = (u64*)&q;
#pragma unroll
    for (int i = 0; i < (int)(sizeof(Params) / 8); ++i) dst[i] = pp[i];
    return q;
#else
    return p;
#endif
}
static_assert(sizeof(Params) % 8 == 0, "Params is copied in 8-byte words");

typedef __bf16 bf16x2_t __attribute__((ext_vector_type(2)));
__device__ __forceinline__ unsigned cvt_pk_bf16(float lo, float hi) { const f32x2 v = {lo, hi}; const bf16x2_t b = __builtin_convertvector(v, bf16x2_t); return __builtin_bit_cast(unsigned, b); }
__device__ __forceinline__ float bf_lo(unsigned u) { return __builtin_bit_cast(float, u << 16); }
__device__ __forceinline__ float bf_hi(unsigned u) { return __builtin_bit_cast(float, u & 0xffff0000u); }
__device__ __forceinline__ float bf1(bf16_t v) { return __builtin_bit_cast(float, (unsigned)v << 16); }
__device__ __forceinline__ bf16_t f2bf(float f) { return (bf16_t)(cvt_pk_bf16(f, 0.f) & 0xffffu); }
__device__ __forceinline__ float fast_exp2(float x) { return __builtin_amdgcn_exp2f(x); }
__device__ __forceinline__ float fast_rcp(float x) { return __builtin_amdgcn_rcpf(x); }
__device__ __forceinline__ float silu_f(float x) { return x * fast_rcp(1.f + fast_exp2(-x * LOG2E)); }
__device__ __forceinline__ float gelu_tanh_f(float x) { const float u = 0.7978845608028654f * (x + 0.044715f * x * x * x); return x * fast_rcp(1.f + fast_exp2(-2.f * LOG2E * u)); }
__device__ __forceinline__ float wave_sum(float v) {
#pragma unroll
    for (int o = 1; o < 64; o <<= 1) v += __shfl_xor(v, o);
    return v;
}

typedef short v4i16_t __attribute__((ext_vector_type(4)));
__device__ __forceinline__ bf16x8 tr_operand(const void* p0, const void* p1) {
    const v4i16_t a = __builtin_amdgcn_ds_read_tr16_b64_v4i16((__attribute__((address_space(3))) v4i16_t*)p0);
    const v4i16_t b = __builtin_amdgcn_ds_read_tr16_b64_v4i16((__attribute__((address_space(3))) v4i16_t*)p1);
    return __builtin_shufflevector(a, b, 0, 1, 2, 3, 4, 5, 6, 7);
}
#define MFMA16(a, b, c) __builtin_amdgcn_mfma_f32_16x16x32_bf16((a), (b), (c), 0, 0, 0)

namespace pg8 {
#define PG8_LAS __attribute__((address_space(3)))
constexpr int BM = 256, BK = 64, HALF = 128, HTB = HALF * BK * 2, STAGE_BYTES = 8 * HTB, NXCD = 8, WGM = 8;
__host__ __device__ __forceinline__ int lds_byte(int r, int c) { const int st = (r >> 4) * 2 + (c >> 5), rr = r & 15, cc = c & 31, ob = rr * 64 + cc * 2; return st * 1024 + (ob ^ (((ob >> 9) & 1) << 5)); }
__host__ __device__ __forceinline__ void stage_rc(int b, int& R, int& C) { const int st = b / 1024, sb = b % 1024, swz = sb ^ (((sb >> 9) & 1) << 5); R = (st >> 1) * 16 + swz / 64; C = (st & 1) * 32 + (swz % 64) / 2; }
__host__ __device__ __forceinline__ int perm32(int rho) { const int n = rho >> 4, i = rho & 15; return 8 * (i >> 2) + 4 * n + (i & 3); }
struct Unit { int pm, pn; };
struct Gemm { const bf16_t* A; const bf16_t* Bt; int M, N, K; };
struct StaticOrder {
    int nM, nN, nwg, G, c;
    __host__ __device__ void init(int M_, int N_, int G_, int c_) { nM = M_ / BM; nN = N_ / BM; nwg = nM * nN; G = G_; c = c_; }
    __host__ __device__ bool next(int i, Unit& u) const {
        const long L = (long)i * G + c; if (L >= nwg) return false;
        int wgid = (int)L; { const int q = nwg / NXCD, r = nwg % NXCD, xcd = wgid % NXCD, off = wgid / NXCD; wgid = (xcd < r ? xcd * (q + 1) : r * (q + 1) + (xcd - r) * q) + off; }
        const int nig = WGM * nN, gid = wgid / nig, fm = gid * WGM, gsz = (nM - fm) < WGM ? (nM - fm) : WGM;
        u.pm = fm + ((wgid % nig) % gsz); u.pn = (wgid % nig) / gsz; return true;
    }
    __device__ __forceinline__ void a_ready(const Unit&) const {}
    __device__ __forceinline__ void done(const Unit&) const {}
};

template <class Epi, class Sched, bool ALIGN_EPI = false, bool SP2 = false>
__device__ __forceinline__ void gemm_phase(PG8_LAS unsigned char* lds, const Gemm g, const Sched& S, const Epi& E, const int tid) {
    const int wid = __builtin_amdgcn_readfirstlane(tid >> 6), lane = tid & 63, wr = wid >> 2, wc = wid & 3, fr = lane & 15, fq = lane >> 4;
    const int K = g.K, nt = K / BK;
    unsigned voffA[2], voffB[2];
#pragma unroll
    for (int i = 0; i < 2; ++i) { int R, C; stage_rc(tid * 16 + i * 8192, R, C); const int Rb = Epi::PERM ? ((R & ~31) + perm32(R & 31)) : R;
        voffA[i] = (unsigned)(R * K + C) * 2u; voffB[i] = (unsigned)(Rb * K + C) * 2u; }
    const size_t kstep = (size_t)(BK * 2);
    const size_t hstep = (size_t)HALF * K * 2;
    const size_t tstep = 2 * hstep;
    const unsigned ldsw = (unsigned)wid * 1024u;
    const int aoff = lds_byte(wr * 64 + fr, fq * 8), boff = lds_byte(wc * 32 + fr, fq * 8);
#define PG8_SA(b, h) (((b) * 2 + (h)) * HTB)
#define PG8_SB(b, h) ((4 + (b) * 2 + (h)) * HTB)
#define PG8_STAGE(bufoff, gbase, voff) do { _Pragma("unroll") for (int _i = 0; _i < 2; ++_i) \
        __builtin_amdgcn_global_load_lds((const unsigned*)((const char*)(gbase) + (voff)[_i]), (PG8_LAS unsigned*)(lds + (bufoff) + ldsw + _i * 8192), 16, 0, 0); } while (0)
#define PG8_LDA(dst, b, h) do { _Pragma("unroll") for (int m = 0; m < 4; ++m) _Pragma("unroll") for (int k = 0; k < 2; ++k) dst[m][k] = *(const PG8_LAS bf16x8*)(lds + PG8_SA(b, h) + aoff + m * 2048 + k * 1024); } while (0)
#define PG8_LDB(dst, b, h) do { _Pragma("unroll") for (int n = 0; n < 2; ++n) _Pragma("unroll") for (int k = 0; k < 2; ++k) dst[n][k] = *(const PG8_LAS bf16x8*)(lds + PG8_SB(b, h) + boff + n * 2048 + k * 1024); } while (0)
#define PG8_MMA(ai, bj, At, Bt) do { __builtin_amdgcn_s_setprio(1); _Pragma("unroll") for (int m = 0; m < 4; ++m) _Pragma("unroll") for (int n = 0; n < 2; ++n) _Pragma("unroll") for (int k = 0; k < 2; ++k) \
        acc[ai][bj][m][n] = __builtin_amdgcn_mfma_f32_16x16x32_bf16(Bt[n][k], At[m][k], acc[ai][bj][m][n], 0, 0, 0); __builtin_amdgcn_s_setprio(0); } while (0)
#define PG8_WAIT_V(n) asm volatile("s_waitcnt vmcnt(" #n ")" ::: "memory")
#define PG8_WAIT_L(n) asm volatile("s_waitcnt lgkmcnt(" #n ")" ::: "memory")
#define PG8_BAR __builtin_amdgcn_s_barrier()
#define PG8_SCHED __builtin_amdgcn_sched_barrier(0)
    Unit cur, nxt; int ui = 0;
    if (!S.next(0, cur)) return;
    f32x4 acc[2][2][4][2];
#pragma unroll
    for (int a = 0; a < 2; ++a)
#pragma unroll
        for (int b = 0; b < 2; ++b)
#pragma unroll
            for (int m = 0; m < 4; ++m)
#pragma unroll
                for (int n = 0; n < 2; ++n) acc[a][b][m][n] = (f32x4){0.f, 0.f, 0.f, 0.f};
    bf16x8 At[4][2], B0[2][2], B1[2][2];
    const char* cA = (const char*)g.A + (size_t)cur.pm * tstep; const char* cB = (const char*)g.Bt + (size_t)cur.pn * tstep;
    S.a_ready(cur);
    if constexpr (SP2) {
        PG8_STAGE(PG8_SB(0, 0), cB, voffB); PG8_STAGE(PG8_SB(0, 1), cB + hstep, voffB); PG8_STAGE(PG8_SA(0, 0), cA, voffA); PG8_STAGE(PG8_SA(0, 1), cA + hstep, voffA);
        if (wr == 1) PG8_BAR;
        PG8_WAIT_V(2); PG8_BAR;
        PG8_STAGE(PG8_SB(1, 0), cB + kstep, voffB); PG8_STAGE(PG8_SA(1, 0), cA + kstep, voffA); PG8_STAGE(PG8_SB(1, 1), cB + hstep + kstep, voffB);
        PG8_WAIT_V(6); PG8_BAR;
    } else {
        PG8_STAGE(PG8_SB(0, 0), cB, voffB); PG8_STAGE(PG8_SA(0, 0), cA, voffA); PG8_STAGE(PG8_SB(0, 1), cB + hstep, voffB); PG8_STAGE(PG8_SA(0, 1), cA + hstep, voffA);
        if (wr == 1) PG8_BAR;
        PG8_WAIT_V(4); PG8_BAR;
        PG8_STAGE(PG8_SB(1, 0), cB + kstep, voffB); PG8_STAGE(PG8_SA(1, 0), cA + kstep, voffA); PG8_STAGE(PG8_SB(1, 1), cB + hstep + kstep, voffB);
        PG8_WAIT_V(6); PG8_BAR;
    }
    for (;;) {
        const bool has_next = S.next(ui + 1, nxt);
        const char* nA = has_next ? (const char*)g.A + (size_t)nxt.pm * tstep : cA; const char* nB = has_next ? (const char*)g.Bt + (size_t)nxt.pn * tstep : cB;
        for (int t = 0; t < nt; t += 2) {
            const bool last = (t == nt - 2);
            const char* a1 = cA + (size_t)(t + 1) * kstep;
            const char* a2 = last ? nA : cA + (size_t)(t + 2) * kstep; const char* b2 = last ? nB : cB + (size_t)(t + 2) * kstep;
            const char* a3 = a2 + kstep; const char* b3 = b2 + kstep;
            if (last && has_next) S.a_ready(nxt);
            if constexpr (SP2) {
            PG8_LDB(B0, 0, 0); PG8_LDB(B1, 0, 1); PG8_SCHED; PG8_LDA(At, 0, 0); PG8_STAGE(PG8_SA(1, 1), a1 + hstep, voffA);
            PG8_WAIT_V(8); PG8_WAIT_L(0); PG8_BAR; PG8_MMA(0, 0, At, B0); PG8_MMA(0, 1, At, B1); PG8_BAR; PG8_SCHED;
            PG8_LDA(At, 0, 1); PG8_STAGE(PG8_SB(0, 0), b2, voffB); PG8_STAGE(PG8_SB(0, 1), b2 + hstep, voffB); PG8_STAGE(PG8_SA(0, 0), a2, voffA);
            PG8_WAIT_V(8); PG8_WAIT_L(0); PG8_BAR; PG8_MMA(1, 0, At, B0); PG8_MMA(1, 1, At, B1); PG8_BAR; PG8_SCHED;
            PG8_LDB(B0, 1, 0); PG8_LDB(B1, 1, 1); PG8_SCHED; PG8_LDA(At, 1, 0); PG8_STAGE(PG8_SA(0, 1), a2 + hstep, voffA);
            PG8_WAIT_V(8); PG8_WAIT_L(0); PG8_BAR; PG8_MMA(0, 0, At, B0); PG8_MMA(0, 1, At, B1); PG8_BAR; PG8_SCHED;
            PG8_LDA(At, 1, 1); PG8_STAGE(PG8_SB(1, 0), b3, voffB); PG8_STAGE(PG8_SB(1, 1), b3 + hstep, voffB); PG8_STAGE(PG8_SA(1, 0), a3, voffA);
            PG8_WAIT_V(8); PG8_WAIT_L(0); PG8_BAR; PG8_MMA(1, 0, At, B0); PG8_MMA(1, 1, At, B1); PG8_BAR; PG8_SCHED;
            } else {
            PG8_LDB(B0, 0, 0); PG8_SCHED; PG8_LDA(At, 0, 0); PG8_STAGE(PG8_SA(1, 1), a1 + hstep, voffA);
            PG8_WAIT_L(8); PG8_BAR; PG8_WAIT_L(0); PG8_MMA(0, 0, At, B0); PG8_BAR; PG8_SCHED;
            PG8_LDB(B1, 0, 1); PG8_STAGE(PG8_SB(0, 0), b2, voffB);
            PG8_BAR; PG8_WAIT_L(0); PG8_MMA(0, 1, At, B1); PG8_BAR;
            PG8_LDA(At, 0, 1); PG8_STAGE(PG8_SA(0, 0), a2, voffA);
            PG8_BAR; PG8_WAIT_L(0); PG8_MMA(1, 0, At, B0); PG8_BAR; PG8_SCHED;
            PG8_STAGE(PG8_SB(0, 1), b2 + hstep, voffB);
            PG8_WAIT_V(6); PG8_BAR; PG8_MMA(1, 1, At, B1); PG8_BAR;
            PG8_LDB(B0, 1, 0); PG8_SCHED; PG8_LDA(At, 1, 0); PG8_STAGE(PG8_SA(0, 1), a2 + hstep, voffA);
            PG8_WAIT_L(8); PG8_BAR; PG8_WAIT_L(0); PG8_MMA(0, 0, At, B0); PG8_BAR; PG8_SCHED;
            PG8_LDB(B1, 1, 1); PG8_STAGE(PG8_SB(1, 0), b3, voffB);
            PG8_BAR; PG8_WAIT_L(0); PG8_MMA(0, 1, At, B1); PG8_BAR;
            PG8_LDA(At, 1, 1); PG8_STAGE(PG8_SA(1, 0), a3, voffA);
            PG8_BAR; PG8_WAIT_L(0); PG8_MMA(1, 0, At, B0); PG8_BAR; PG8_SCHED;
            PG8_STAGE(PG8_SB(1, 1), b3 + hstep, voffB);
            PG8_WAIT_V(6); PG8_BAR; PG8_MMA(1, 1, At, B1); PG8_BAR;
            }
        }
        if constexpr (ALIGN_EPI) { if (wr == 0) PG8_BAR; }
        E(acc, cur, wr, wc, fr, fq); S.done(cur);
        if (!has_next) break;
#pragma unroll
        for (int a = 0; a < 2; ++a)
#pragma unroll
            for (int b = 0; b < 2; ++b)
#pragma unroll
                for (int m = 0; m < 4; ++m)
#pragma unroll
                    for (int n = 0; n < 2; ++n) acc[a][b][m][n] = (f32x4){0.f, 0.f, 0.f, 0.f};
        cur = nxt; cA = nA; cB = nB; ++ui;
        if constexpr (ALIGN_EPI) { if (wr == 1) PG8_BAR; }
    }
    PG8_WAIT_V(0);
    if constexpr (!ALIGN_EPI) { if (wr == 0) PG8_BAR; }
    PG8_BAR;
#undef PG8_SA
#undef PG8_SB
#undef PG8_STAGE
#undef PG8_LDA
#undef PG8_LDB
#undef PG8_MMA
#undef PG8_WAIT_V
#undef PG8_WAIT_L
#undef PG8_BAR
#undef PG8_SCHED
}

struct EpiProj {
    static constexpr bool PERM = true;
    bf16_t* P; float* CG; float* SGST;
    template <int ACT> __device__ __forceinline__ void store_tile(const f32x4 (&acc)[2][2][4][2], bf16_t* base, float* stp, int fq) const {
#pragma unroll
        for (int ai = 0; ai < 2; ++ai)
#pragma unroll
            for (int m = 0; m < 4; ++m) { bf16_t* rowp = base + (size_t)(ai * HALF + m * 16) * NPROJ;
                float rs = 0.f, rq = 0.f;
#pragma unroll
                for (int bj = 0; bj < 2; ++bj) { f32x4 v0 = acc[ai][bj][m][0], v1 = acc[ai][bj][m][1];
                    if (ACT == 1) { for (int e = 0; e < 4; ++e) { v0[e] = gelu_tanh_f(v0[e]); v1[e] = gelu_tanh_f(v1[e]); } }
                    if (ACT == 2) { for (int e = 0; e < 4; ++e) { v0[e] = silu_f(v0[e]); v1[e] = silu_f(v1[e]); } }
                    if (ACT == 1) { rs += ((v0[0] + v0[1]) + (v0[2] + v0[3])) + ((v1[0] + v1[1]) + (v1[2] + v1[3]));
                        rq += ((v0[0] * v0[0] + v0[1] * v0[1]) + (v0[2] * v0[2] + v0[3] * v0[3])) + ((v1[0] * v1[0] + v1[1] * v1[1]) + (v1[2] * v1[2] + v1[3] * v1[3])); }
                    u32x4 w; w.x = cvt_pk_bf16(v0[0], v0[1]); w.y = cvt_pk_bf16(v0[2], v0[3]); w.z = cvt_pk_bf16(v1[0], v1[1]); w.w = cvt_pk_bf16(v1[2], v1[3]);
                    *(u32x4*)(rowp + bj * HALF) = w; }
                if (ACT == 1) { if (stp) { rs += __shfl_xor(rs, 16); rs += __shfl_xor(rs, 32); rq += __shfl_xor(rq, 16); rq += __shfl_xor(rq, 32);
                    if (fq == 0) *(f32x2*)(stp + (size_t)(ai * HALF + m * 16) * 16) = (f32x2){rs, rq}; } } }
    }
    __device__ __forceinline__ void operator()(const f32x4 (&acc)[2][2][4][2], const Unit& u, int wr, int wc, int fr, int fq) const {
        const int row0 = u.pm * BM + wr * 64 + fr;
        if (u.pn < 22) {
            bf16_t* base = P + (size_t)row0 * NPROJ + u.pn * BM + wc * 32 + 8 * fq;
            if (u.pn >= 6 && u.pn < 10) store_tile<1>(acc, base, (u.pn >= 8) ? SGST + (size_t)row0 * 16 + ((u.pn - 8) * 4 + wc) * 2 : nullptr, fq);
            else if (u.pn >= 14) store_tile<2>(acc, base, nullptr, fq);
            else store_tile<0>(acc, base, nullptr, fq);
        } else if (wc == 0 && fq < 2) {
#pragma unroll
            for (int ai = 0; ai < 2; ++ai)
#pragma unroll
                for (int m = 0; m < 4; ++m) { float* p = CG + (size_t)(row0 + ai * HALF + m * 16) * 16 + 8 * fq;
                    *(f32x4*)p = acc[ai][0][m][0]; *(f32x4*)(p + 4) = acc[ai][0][m][1]; }
        }
    }
};
struct EpiOut {
    static constexpr bool PERM = true;
    bf16_t* O;
    __device__ __forceinline__ void operator()(const f32x4 (&acc)[2][2][4][2], const Unit& u, int wr, int wc, int fr, int fq) const {
        bf16_t* base = O + (size_t)(u.pm * BM + wr * 64 + fr) * D + u.pn * BM + wc * 32 + 8 * fq;
#pragma unroll
        for (int ai = 0; ai < 2; ++ai)
#pragma unroll
            for (int m = 0; m < 4; ++m) { bf16_t* rowp = base + (size_t)(ai * HALF + m * 16) * D;
#pragma unroll
                for (int bj = 0; bj < 2; ++bj) { const f32x4 v0 = acc[ai][bj][m][0], v1 = acc[ai][bj][m][1];
                    u32x4 w; w.x = cvt_pk_bf16(v0[0], v0[1]); w.y = cvt_pk_bf16(v0[2], v0[3]); w.z = cvt_pk_bf16(v1[0], v1[1]); w.w = cvt_pk_bf16(v1[2], v1[3]);
                    *(u32x4*)(rowp + bj * HALF) = w; } }
    }
};
}

__device__ __forceinline__ void p0_transpose_item(const float* W, int ldw, int n_src0, bf16_t* WT, int row_dst0, int kb, float* scr, int lane) {
    const int k0 = 64 * kb;
    {   const int kr = lane >> 3, c4 = 4 * (lane & 7);
        const float* src = W + (size_t)(k0 + kr) * ldw + n_src0 + c4;
        f32x4 v[8];
#pragma unroll
        for (int i = 0; i < 8; ++i) v[i] = __builtin_nontemporal_load((const f32x4*)(src + (size_t)(8 * i) * ldw));
#pragma unroll
        for (int i = 0; i < 8; ++i) { float* d = scr + (8 * i + kr) * 33 + c4; d[0] = v[i][0]; d[1] = v[i][1]; d[2] = v[i][2]; d[3] = v[i][3]; }
    }
    asm volatile("s_waitcnt lgkmcnt(0)" ::: "memory");
    const int c = lane & 7;
#pragma unroll
    for (int j = 0; j < 4; ++j) { const int n = (lane >> 3) + 8 * j; const float* s = scr + (8 * c) * 33 + n;
        u32x4 o; o.x = cvt_pk_bf16(s[0 * 33], s[1 * 33]); o.y = cvt_pk_bf16(s[2 * 33], s[3 * 33]); o.z = cvt_pk_bf16(s[4 * 33], s[5 * 33]); o.w = cvt_pk_bf16(s[6 * 33], s[7 * 33]);
        *(u32x4*)(WT + (size_t)(row_dst0 + n) * D + k0 + 8 * c) = o; }
    asm volatile("s_waitcnt lgkmcnt(0)" ::: "memory");
}

__device__ __forceinline__ void mod_items(const Params& p, int l, unsigned char* lds, int tid, int wave, int lane, int bx) {
    const int G = gridDim.x;
    if (bx >= 192) return;
    float* sc = (float*)lds;
    float* red = (float*)(lds + 32768);
    for (int i = tid; i < 4 * D; i += 512) { const int b = i >> 11, k = i & (D - 1); sc[k * 4 + b] = silu_f(p.c[i]); }
    __syncthreads();
    for (int it = bx; it < 192; it += G) {
        const int n0 = 32 * it;
        const int r8 = lane >> 3, c4 = lane & 7;
        const float* wp = p.w_mod + ((size_t)l * D + wave * 256 + r8) * 6144 + n0 + 4 * c4;
        f32x4 a0 = {0, 0, 0, 0}, a1 = a0, a2 = a0, a3 = a0;
#pragma unroll 8
        for (int i = 0; i < 32; ++i) {
            const f32x4 w = __builtin_nontemporal_load((const f32x4*)(wp + (size_t)(8 * i) * 6144));
            const f32x4 s = *(const f32x4*)(sc + (wave * 256 + 8 * i + r8) * 4);
            a0 += w * s[0]; a1 += w * s[1]; a2 += w * s[2]; a3 += w * s[3];
        }
#pragma unroll
        for (int e = 0; e < 4; ++e) {
#pragma unroll
            for (int o = 8; o < 64; o <<= 1) { a0[e] += __shfl_xor(a0[e], o); a1[e] += __shfl_xor(a1[e], o); a2[e] += __shfl_xor(a2[e], o); a3[e] += __shfl_xor(a3[e], o); }
        }
        if (r8 == 0) {
            *(f32x4*)(red + (wave * 4 + 0) * 32 + 4 * c4) = a0; *(f32x4*)(red + (wave * 4 + 1) * 32 + 4 * c4) = a1;
            *(f32x4*)(red + (wave * 4 + 2) * 32 + 4 * c4) = a2; *(f32x4*)(red + (wave * 4 + 3) * 32 + 4 * c4) = a3;
        }
        __syncthreads();
        if (tid < 128) { const int b = tid >> 5, col = tid & 31; float s = p.b_mod[l * 6144 + n0 + col];
#pragma unroll
            for (int w = 0; w < 8; ++w) s += red[(w * 4 + b) * 32 + col];
            ((float*)(p.ws + WS_MOD))[(l * 4 + b) * 6144 + n0 + col] = s; }
        __syncthreads();
    }
}

__device__ __forceinline__ void p0_convert(const Params& p, unsigned char* lds, int tid, int wave, int lane, int bx) {
    const int G = gridDim.x;
    unsigned char* ws = p.ws;
    {
        const int gt = bx * 512 + tid, NT = G * 512;
        for (int i = gt; i < 2 * 256 * (D / 8); i += NT) {
            const int l = i / (256 * (D / 8)), r = i % (256 * (D / 8)), j = r / (D / 8), k8 = (r % (D / 8)) * 8;
            u32x4 o = {0u, 0u, 0u, 0u};
            if (j < 16) { const float* s = p.w_in + ((size_t)l * D + k8) * WIN_LD + 3584 + j;
                o.x = cvt_pk_bf16(s[0], s[WIN_LD]); o.y = cvt_pk_bf16(s[2 * WIN_LD], s[3 * WIN_LD]); o.z = cvt_pk_bf16(s[4 * WIN_LD], s[5 * WIN_LD]); o.w = cvt_pk_bf16(s[6 * WIN_LD], s[7 * WIN_LD]); }
            *(u32x4*)((bf16_t*)(ws + WS_WIN + (size_t)l * WIN_BYTES) + (size_t)(5632 + j) * D + k8) = o;
        }
    }
    {
        const int gt = bx * 512 + tid;
        if (gt < 2 * 8 * 128 * 16) {
            const int t = (gt >> 4) & 127, s0 = (gt & 15) * 8;
            const float* src = p.sg_w + (size_t)gt * 8;
            const f32x4 f0 = *(const f32x4*)src, f1 = *(const f32x4*)(src + 4);
            float w[8] = {f0[0], f0[1], f0[2], f0[3], f1[0], f1[1], f1[2], f1[3]};
#pragma unroll
            for (int e = 0; e < 8; ++e) w[e] = (s0 + e <= t) ? w[e] : 0.f;
            *(u32x4*)((bf16_t*)(ws + WS_SGW) + (size_t)gt * 8) = (u32x4){cvt_pk_bf16(w[0], w[1]), cvt_pk_bf16(w[2], w[3]), cvt_pk_bf16(w[4], w[5]), cvt_pk_bf16(w[6], w[7])};
        }
    }
    {
        float* scr = (float*)(lds + wave * 16384);
        constexpr int PER_L = 32 * 240, NIT = 2 * PER_L;
        int base, end, stride;
        if (G == 256) { if (bx < 192) { base = 55 * bx; end = base + 55; } else { base = 10560 + (bx - 192) * 75; end = base + 75; } base += wave; stride = 8; }
        else { base = bx * 8 + wave; end = NIT; stride = G * 8; }
        for (int it = base; it < end; it += stride) {
            const int l = it / PER_L, r = it % PER_L, kb = r / 240, j = r % 240;
            bf16_t* WinT = (bf16_t*)(ws + WS_WIN + (size_t)l * WIN_BYTES);
            bf16_t* WoT = (bf16_t*)(ws + WS_WOUT + (size_t)l * WOUT_BYTES);
            if (j < 112) p0_transpose_item(p.w_in + (size_t)l * D * WIN_LD, WIN_LD, 32 * j, WinT, 32 * j, kb, scr, lane);
            else if (j < 176) p0_transpose_item(p.w_in + (size_t)l * D * WIN_LD, WIN_LD, 3600 + 32 * (j - 112), WinT, 3584 + 32 * (j - 112), kb, scr, lane);
            else p0_transpose_item(p.w_out + (size_t)l * D * D, D, 32 * (j - 176), WoT, 32 * (j - 176), kb, scr, lane);
        }
    }
}

__device__ __forceinline__ void row_pass(const Params& p, int mode, int wave, int lane, int bx) {
    const int gw = bx * 8 + wave, NGW = gridDim.x * 8;
    unsigned char* ws = p.ws;
    const float* mod = (const float*)(ws + WS_MOD);
    const bf16_t* OUTB = (const bf16_t*)(ws + WS_OUT);
    bf16_t* H = (bf16_t*)(ws + WS_H);
    const int lpost = (mode == 2) ? 1 : 0, lpre = (mode == 0) ? 0 : 1;
    for (int gi = gw; gi < M / 4; gi += NGW) {
        const int r0 = 4 * gi, b = r0 >> 11;
        f32x4 gg[4][2], aa[4][2], tt[4][2];
        if (mode >= 1) {
            const float* gate = mod + (size_t)(lpost * 4 + b) * 6144 + 4096; const float* gp = p.g_post + lpost * D;
#pragma unroll
            for (int j = 0; j < 4; ++j)
#pragma unroll
                for (int h = 0; h < 2; ++h) { const int col = 8 * lane + 512 * j + 4 * h; gg[j][h] = *(const f32x4*)(gate + col) * *(const f32x4*)(gp + col); }
        }
        if (mode <= 1) {
            const float* shift = mod + (size_t)(lpre * 4 + b) * 6144; const float* scale = shift + 2048; const float* gp = p.g_pre + lpre * D;
#pragma unroll
            for (int j = 0; j < 4; ++j)
#pragma unroll
                for (int h = 0; h < 2; ++h) { const int col = 8 * lane + 512 * j + 4 * h;
                    aa[j][h] = *(const f32x4*)(gp + col) * (*(const f32x4*)(scale + col) + 1.f); tt[j][h] = *(const f32x4*)(shift + col); }
        }
#pragma unroll 1
        for (int k = 0; k < 4; ++k) {
            const int r = r0 + k;
            f32x4 v[4][2];
            if (mode == 2) {
                const bf16_t* x1b = (const bf16_t*)(ws + WS_X1B) + (size_t)r * D;
#pragma unroll
                for (int j = 0; j < 4; ++j) { const u32x4 w = *(const u32x4*)(x1b + 8 * lane + 512 * j);
                    v[j][0] = (f32x4){bf_lo(w.x), bf_hi(w.x), bf_lo(w.y), bf_hi(w.y)}; v[j][1] = (f32x4){bf_lo(w.z), bf_hi(w.z), bf_lo(w.w), bf_hi(w.w)}; }
            } else {
                const float* xin = p.x + (size_t)r * D;
#pragma unroll
                for (int j = 0; j < 4; ++j) { v[j][0] = *(const f32x4*)(xin + 8 * lane + 512 * j); v[j][1] = *(const f32x4*)(xin + 8 * lane + 512 * j + 4); }
            }
            if (mode >= 1) {
                f32x4 o[4][2]; float ss = 0.f;
#pragma unroll
                for (int j = 0; j < 4; ++j) { const u32x4 w = *(const u32x4*)(OUTB + (size_t)r * D + 8 * lane + 512 * j);
                    o[j][0] = (f32x4){bf_lo(w.x), bf_hi(w.x), bf_lo(w.y), bf_hi(w.y)}; o[j][1] = (f32x4){bf_lo(w.z), bf_hi(w.z), bf_lo(w.w), bf_hi(w.w)};
#pragma unroll
                    for (int h = 0; h < 2; ++h) ss += (o[j][h][0] * o[j][h][0] + o[j][h][1] * o[j][h][1]) + (o[j][h][2] * o[j][h][2] + o[j][h][3] * o[j][h][3]); }
                const float rstd = rsqrtf(wave_sum(ss) * (1.f / D) + EPS);
                float* xo = p.out + (size_t)r * D;
#pragma unroll
                for (int j = 0; j < 4; ++j)
#pragma unroll
                    for (int h = 0; h < 2; ++h) { const int col = 8 * lane + 512 * j + 4 * h;
                        v[j][h] = v[j][h] + gg[j][h] * (o[j][h] * rstd);
                        if (mode == 2) *(f32x4*)(xo + col) = v[j][h]; }
                if (mode == 1) {
                    bf16_t* x1b = (bf16_t*)(ws + WS_X1B) + (size_t)r * D;
#pragma unroll
                    for (int j = 0; j < 4; ++j) { u32x4 w; w.x = cvt_pk_bf16(v[j][0][0], v[j][0][1]); w.y = cvt_pk_bf16(v[j][0][2], v[j][0][3]); w.z = cvt_pk_bf16(v[j][1][0], v[j][1][1]); w.w = cvt_pk_bf16(v[j][1][2], v[j][1][3]);
                        *(u32x4*)(x1b + 8 * lane + 512 * j) = w;
                        v[j][0] = (f32x4){bf_lo(w.x), bf_hi(w.x), bf_lo(w.y), bf_hi(w.y)}; v[j][1] = (f32x4){bf_lo(w.z), bf_hi(w.z), bf_lo(w.w), bf_hi(w.w)}; }
                }
            }
            if (mode <= 1) {
                float ss = 0.f;
#pragma unroll
                for (int j = 0; j < 4; ++j)
#pragma unroll
                    for (int h = 0; h < 2; ++h) ss += (v[j][h][0] * v[j][h][0] + v[j][h][1] * v[j][h][1]) + (v[j][h][2] * v[j][h][2] + v[j][h][3] * v[j][h][3]);
                const float rstd = rsqrtf(wave_sum(ss) * (1.f / D) + EPS);
#pragma unroll
                for (int j = 0; j < 4; ++j) { f32x4 hh[2];
#pragma unroll
                    for (int h = 0; h < 2; ++h) hh[h] = (v[j][h] * rstd) * aa[j][h] + tt[j][h];
                    u32x4 w; w.x = cvt_pk_bf16(hh[0][0], hh[0][1]); w.y = cvt_pk_bf16(hh[0][2], hh[0][3]); w.z = cvt_pk_bf16(hh[1][0], hh[1][1]); w.w = cvt_pk_bf16(hh[1][2], hh[1][3]);
                    *(u32x4*)(H + (size_t)r * D + 8 * lane + 512 * j) = w; }
            }
        }
    }
}

__device__ __forceinline__ void rope_cs(int pos, int i, float& cs, float& sn) {
    constexpr float F[8] = {0.15915494309189535f, 0.03086376340470123f, 0.005985185712713705f, 0.001160663641240061f,
                            0.00022507907903927653f, 4.364795279280289e-05f, 8.464330808241401e-06f, 1.6414262627950345e-06f};
    const float rev = (float)pos * F[i];
    const float r = __builtin_amdgcn_fractf(rev);
    sn = __builtin_amdgcn_sinf(r); cs = __builtin_amdgcn_cosf(r);
}
constexpr int KS_LD = 72, VS_LD = 72;
__device__ __forceinline__ void attn_item(const Params& p, int l, int item, unsigned char* lds, int tid, int wave, int lane) {
    const int b = item >> 6, n = (item >> 2) & 15, g = item & 3;
    const int fr = lane & 15, fq = lane >> 4;
    bf16_t* Ks = (bf16_t*)lds;
    bf16_t* Vs = (bf16_t*)(lds + 256 * KS_LD * 2);
    const bf16_t* proj = (const bf16_t*)(p.ws + WS_PROJ);
    bf16_t* Y = (bf16_t*)(p.ws + WS_Y);
    const int r = wave >> 1, qh = wave & 1, hq = g * 4 + r;
    const int tokq0 = b * SEQ + n * 128 + 64 * qh;
    u32x4 qraw[4][2]; int qpos[4];
#pragma unroll
    for (int nb = 0; nb < 4; ++nb) {
        const int tok = tokq0 + 16 * nb + fr;
        const bf16_t* qp = proj + (size_t)tok * NPROJ + C_AQ + hq * 64 + 8 * fq;
        qraw[nb][0] = *(const u32x4*)qp; qraw[nb][1] = *(const u32x4*)(qp + 32); qpos[nb] = p.pos[tok];
    }
    {
        const int key = tid >> 1, half = tid & 1;
        const int s = n * 128 - 128 + key;
        u32x4 kv[4], vv[4];
#pragma unroll
        for (int c = 0; c < 4; ++c) { kv[c] = (u32x4){0u, 0u, 0u, 0u}; vv[c] = kv[c]; }
        if (s >= 0) {
            const bf16_t* kp = proj + (size_t)(b * SEQ + s) * NPROJ + C_AK + g * 64 + half * 32;
#pragma unroll
            for (int c = 0; c < 4; ++c) { kv[c] = *(const u32x4*)(kp + 8 * c); vv[c] = *(const u32x4*)(kp + 256 + 8 * c); }
            if (half == 0) {
                const int pos = p.pos[b * SEQ + s];
                unsigned a[4] = {kv[0].x, kv[0].y, kv[0].z, kv[0].w}, bb[4] = {kv[1].x, kv[1].y, kv[1].z, kv[1].w};
#pragma unroll
                for (int e = 0; e < 4; ++e) {
                    float c0, s0, c1, s1; rope_cs(pos, 2 * e, c0, s0); rope_cs(pos, 2 * e + 1, c1, s1);
                    const float t1a = bf_lo(a[e]), t1b = bf_hi(a[e]), t2a = bf_lo(bb[e]), t2b = bf_hi(bb[e]);
                    a[e] = cvt_pk_bf16(t1a * c0 - t2a * s0, t1b * c1 - t2b * s1);
                    bb[e] = cvt_pk_bf16(t2a * c0 + t1a * s0, t2b * c1 + t1b * s1);
                }
                kv[0] = (u32x4){a[0], a[1], a[2], a[3]}; kv[1] = (u32x4){bb[0], bb[1], bb[2], bb[3]};
            }
        }
#pragma unroll
        for (int c = 0; c < 4; ++c) *(u32x4*)(Ks + key * KS_LD + half * 32 + 8 * c) = kv[c];
#pragma unroll
        for (int c = 0; c < 4; ++c) *(u32x4*)(Vs + key * VS_LD + half * 32 + 8 * c) = vv[c];
    }
    __syncthreads();
    bf16x8 qf[4][2];
#pragma unroll
    for (int nb = 0; nb < 4; ++nb) {
        const u32x4 q0 = qraw[nb][0], q1 = qraw[nb][1];
        unsigned own[4] = {q0.x, q0.y, q0.z, q0.w}, par[4];
#pragma unroll
        for (int e = 0; e < 4; ++e) par[e] = __shfl_xor(own[e], 16);
        if (fq < 2) {
            const int pos = qpos[nb];
            const float sg = (fq == 0) ? -1.f : 1.f;
#pragma unroll
            for (int e = 0; e < 4; ++e) {
                float c0, s0, c1, s1; rope_cs(pos, 2 * e, c0, s0); rope_cs(pos, 2 * e + 1, c1, s1);
                const float oa = bf_lo(own[e]), ob = bf_hi(own[e]), pa = bf_lo(par[e]), pb = bf_hi(par[e]);
                own[e] = cvt_pk_bf16((oa * c0 + sg * pa * s0) * 0.125f, (ob * c1 + sg * pb * s1) * 0.125f);
            }
        } else {
#pragma unroll
            for (int e = 0; e < 4; ++e) own[e] = cvt_pk_bf16(bf_lo(own[e]) * 0.125f, bf_hi(own[e]) * 0.125f);
        }
        unsigned o1[4] = {q1.x, q1.y, q1.z, q1.w};
#pragma unroll
        for (int e = 0; e < 4; ++e) o1[e] = cvt_pk_bf16(bf_lo(o1[e]) * 0.125f, bf_hi(o1[e]) * 0.125f);
        qf[nb][0] = __builtin_bit_cast(bf16x8, (u32x4){own[0], own[1], own[2], own[3]});
        qf[nb][1] = __builtin_bit_cast(bf16x8, (u32x4){o1[0], o1[1], o1[2], o1[3]});
    }
    const float sink2 = p.sinks[l * 16 + hq] * LOG2E;
    float m_[4], l_[4];
    f32x4 o[4][4];
#pragma unroll
    for (int nb = 0; nb < 4; ++nb) { m_[nb] = sink2; l_[nb] = 1.f;
#pragma unroll
        for (int hb = 0; hb < 4; ++hb) o[hb][nb] = (f32x4){0.f, 0.f, 0.f, 0.f}; }
    for (int step = 0; step < 6; ++step) {
        const int kj0 = 64 * qh + 32 * step;
        if (n == 0 && kj0 + 32 <= 128) continue;
        f32x4 s[2][4];
#pragma unroll
        for (int mb = 0; mb < 2; ++mb)
#pragma unroll
            for (int nb = 0; nb < 4; ++nb) s[mb][nb] = (f32x4){0.f, 0.f, 0.f, 0.f};
#pragma unroll
        for (int mb = 0; mb < 2; ++mb)
#pragma unroll
            for (int kk = 0; kk < 2; ++kk) {
                const bf16x8 a = *(const bf16x8*)(Ks + (kj0 + 16 * mb + fr) * KS_LD + 32 * kk + 8 * fq);
#pragma unroll
                for (int nb = 0; nb < 4; ++nb) s[mb][nb] = MFMA16(a, qf[nb][kk], s[mb][nb]);
            }
        bf16x8 pb[4];
#pragma unroll
        for (int nb = 0; nb < 4; ++nb) {
            const int qi = 64 * qh + 16 * nb + fr;
            float tmax = -1e30f;
#pragma unroll
            for (int mb = 0; mb < 2; ++mb)
#pragma unroll
                for (int j = 0; j < 4; ++j) {
                    const int kj = kj0 + 16 * mb + 4 * fq + j, dist = qi + 128 - kj;
                    const bool valid = (dist >= 0) && (dist < 128) && (n > 0 || kj >= 128);
                    const float v = valid ? s[mb][nb][j] * LOG2E : -1e30f;
                    s[mb][nb][j] = v; tmax = fmaxf(tmax, v);
                }
            tmax = fmaxf(tmax, __shfl_xor(tmax, 16)); tmax = fmaxf(tmax, __shfl_xor(tmax, 32));
            const float mnew = fmaxf(m_[nb], tmax), alpha = fast_exp2(m_[nb] - mnew);
            m_[nb] = mnew;
            float rs = 0.f;
#pragma unroll
            for (int mb = 0; mb < 2; ++mb)
#pragma unroll
                for (int j = 0; j < 4; ++j) { const float pv = fast_exp2(s[mb][nb][j] - mnew); s[mb][nb][j] = pv; rs += pv; }
            rs += __shfl_xor(rs, 16); rs += __shfl_xor(rs, 32);
            l_[nb] = l_[nb] * alpha + rs;
#pragma unroll
            for (int hb = 0; hb < 4; ++hb) o[hb][nb] = o[hb][nb] * alpha;
            pb[nb] = __builtin_bit_cast(bf16x8, (u32x4){cvt_pk_bf16(s[0][nb][0], s[0][nb][1]), cvt_pk_bf16(s[0][nb][2], s[0][nb][3]),
                                                        cvt_pk_bf16(s[1][nb][0], s[1][nb][1]), cvt_pk_bf16(s[1][nb][2], s[1][nb][3])});
        }
#pragma unroll
        for (int hb = 0; hb < 4; ++hb) {
            const bf16_t* vp = Vs + (kj0 + 4 * fq + (fr >> 2)) * VS_LD + 32 * (hb >> 1) + 8 * (fr & 3) + 4 * (hb & 1);
            const bf16x8 a = tr_operand(vp, vp + 16 * VS_LD);
#pragma unroll
            for (int nb = 0; nb < 4; ++nb) o[hb][nb] = MFMA16(a, pb[nb], o[hb][nb]);
        }
    }
#pragma unroll
    for (int nb = 0; nb < 4; ++nb) {
        const int tok = tokq0 + 16 * nb + fr;
        const float inv = 1.f / l_[nb];
#pragma unroll
        for (int hp = 0; hp < 2; ++hp) {
            const int col = hq * 64 + 32 * hp + 8 * fq;
            const u32x4 z = *(const u32x4*)(proj + (size_t)tok * NPROJ + C_Z + col);
            const f32x4 a = o[2 * hp][nb] * inv, b2 = o[2 * hp + 1][nb] * inv;
            u32x4 y; y.x = cvt_pk_bf16(a[0] * bf_lo(z.x), a[1] * bf_hi(z.x)); y.y = cvt_pk_bf16(a[2] * bf_lo(z.y), a[3] * bf_hi(z.y));
            y.z = cvt_pk_bf16(b2[0] * bf_lo(z.z), b2[1] * bf_hi(z.z)); y.w = cvt_pk_bf16(b2[2] * bf_lo(z.w), b2[3] * bf_hi(z.w));
            *(u32x4*)(Y + (size_t)tok * D + col) = y;
        }
    }
    __syncthreads();
}

constexpr int VN_LD = 72;
__device__ __forceinline__ void sg_pair_item(const Params& p, int l, int pitem, unsigned char* lds, int tid, int wave, int lane) {
    const int b2 = pitem >> 7, c = (pitem >> 3) & 15, g = pitem & 7;
    const int fr = lane & 15, fq = lane >> 4;
    bf16_t* vnT = (bf16_t*)lds;
    const bf16_t* proj = (const bf16_t*)(p.ws + WS_PROJ);
    bf16_t* Y = (bf16_t*)(p.ws + WS_Y);
    const int s = tid >> 2, qd = tid & 3;
    const int t = 16 * wave + fr;
    int tok0[2];
    tok0[0] = b2 * SEQ + c * 128; tok0[1] = (b2 + 2) * SEQ + c * 128;
    u32x4 vw[2][2]; f32x4 stq[2]; u32x4 uf[2][2], zf[2][2];
#pragma unroll
    for (int q2 = 0; q2 < 2; ++q2) {
        const bf16_t* vp = proj + (size_t)(tok0[q2] + s) * NPROJ + C_SV;
        vw[q2][0] = *(const u32x4*)(vp + 64 * g + 16 * qd); vw[q2][1] = *(const u32x4*)(vp + 64 * g + 16 * qd + 8);
        stq[q2] = *(const f32x4*)((const float*)(p.ws + WS_SGST) + (size_t)(tok0[q2] + s) * 16 + 4 * qd);
#pragma unroll
        for (int mp = 0; mp < 2; ++mp) { const int col = 64 * g + 32 * mp + 8 * fq; const size_t ro = (size_t)(tok0[q2] + t) * NPROJ;
            uf[q2][mp] = *(const u32x4*)(proj + ro + C_SU + col); zf[q2][mp] = *(const u32x4*)(proj + ro + C_Z + 1024 + col); }
    }
    bf16x8 wf[4];
    {   const bf16_t* wrow = (const bf16_t*)(p.ws + WS_SGW) + ((size_t)(l * 8 + g) * 128 + t) * 128;
#pragma unroll
        for (int kk = 0; kk < 4; ++kk) if (32 * kk <= 16 * wave + 15) wf[kk] = *(const bf16x8*)(wrow + 32 * kk + 8 * fq); }
    const float bias = p.sg_b[(l * 8 + g) * 128 + t];
    float lgv[16], lbv[16];
    {   const float* lg = p.sg_ln_g + l * 512 + 64 * g + 16 * qd; const float* lb = p.sg_ln_b + l * 512 + 64 * g + 16 * qd;
#pragma unroll
        for (int i = 0; i < 4; ++i) { const f32x4 a = *(const f32x4*)(lg + 4 * i), bb = *(const f32x4*)(lb + 4 * i);
#pragma unroll
            for (int e = 0; e < 4; ++e) { lgv[4 * i + e] = a[e]; lbv[4 * i + e] = bb[e]; } } }
#pragma unroll
    for (int q2 = 0; q2 < 2; ++q2) {
        float sum = stq[q2][0] + stq[q2][2], sq = stq[q2][1] + stq[q2][3];
        sum += __shfl_xor(sum, 1); sum += __shfl_xor(sum, 2); sq += __shfl_xor(sq, 1); sq += __shfl_xor(sq, 2);
        const float mu = sum * (1.f / 512.f), var = fmaxf(sq * (1.f / 512.f) - mu * mu, 0.f), rstd = rsqrtf(var + EPS);
        bf16_t* vq = vnT + q2 * 128 * VN_LD + s * VN_LD + 16 * qd;
#pragma unroll
        for (int i = 0; i < 2; ++i) { const unsigned ww[4] = {vw[q2][i].x, vw[q2][i].y, vw[q2][i].z, vw[q2][i].w}; unsigned o4[4];
#pragma unroll
            for (int e = 0; e < 4; ++e) { const int ch = 8 * i + 2 * e;
                o4[e] = cvt_pk_bf16((bf_lo(ww[e]) - mu) * rstd * lgv[ch] + lbv[ch], (bf_hi(ww[e]) - mu) * rstd * lgv[ch + 1] + lbv[ch + 1]); }
            *(u32x4*)(vq + 8 * i) = (u32x4){o4[0], o4[1], o4[2], o4[3]}; }
    }
    __syncthreads();
    {
        f32x4 acc[2][4];
#pragma unroll
        for (int q2 = 0; q2 < 2; ++q2)
#pragma unroll
            for (int mb = 0; mb < 4; ++mb) acc[q2][mb] = (f32x4){0.f, 0.f, 0.f, 0.f};
#pragma unroll
        for (int kk = 0; kk < 4; ++kk) {
            if (32 * kk <= 16 * wave + 15) {
                const int s0 = 32 * kk + 8 * fq;
                const bf16x8 bfr = wf[kk];
#pragma unroll
                for (int q2 = 0; q2 < 2; ++q2)
#pragma unroll
                    for (int mb = 0; mb < 4; ++mb) {
                        const bf16_t* ap = vnT + (q2 * 128 + s0 + (fr >> 2)) * VN_LD + 32 * (mb >> 1) + 8 * (fr & 3) + 4 * (mb & 1);
                        acc[q2][mb] = MFMA16(tr_operand(ap, ap + 4 * VN_LD), bfr, acc[q2][mb]); }
            }
        }
#pragma unroll
        for (int q2 = 0; q2 < 2; ++q2)
#pragma unroll
            for (int mp = 0; mp < 2; ++mp) {
                const int col = 64 * g + 32 * mp + 8 * fq;
                const u32x4 u = uf[q2][mp], z = zf[q2][mp];
                const f32x4 a = acc[q2][2 * mp] + bias, b3 = acc[q2][2 * mp + 1] + bias;
                u32x4 y; y.x = cvt_pk_bf16(bf_lo(u.x) * a[0] * bf_lo(z.x), bf_hi(u.x) * a[1] * bf_hi(z.x)); y.y = cvt_pk_bf16(bf_lo(u.y) * a[2] * bf_lo(z.y), bf_hi(u.y) * a[3] * bf_hi(z.y));
                y.z = cvt_pk_bf16(bf_lo(u.z) * b3[0] * bf_lo(z.z), bf_hi(u.z) * b3[1] * bf_hi(z.z)); y.w = cvt_pk_bf16(bf_lo(u.w) * b3[2] * bf_lo(z.w), bf_hi(u.w) * b3[3] * bf_hi(z.w));
                *(u32x4*)(Y + (size_t)(tok0[q2] + t) * D + 1024 + col) = y;
            }
    }
    __syncthreads();
}

constexpr int GL_LD = 72;
struct CgRow { f32x4 c0, c1, c2, c3; };
__device__ __forceinline__ CgRow gla_load_cg(const Params& p, int tok) {
    const float* cgp = (const float*)(p.ws + WS_CG) + (size_t)tok * 16;
    CgRow r; r.c0 = *(const f32x4*)cgp; r.c1 = *(const f32x4*)(cgp + 4); r.c2 = *(const f32x4*)(cgp + 8); r.c3 = *(const f32x4*)(cgp + 12); return r;
}
__device__ __forceinline__ float wave_scan_incl(float v) {
#define SCAN_STEP(ctrl, rmask) v += __builtin_bit_cast(float, __builtin_amdgcn_update_dpp(0, __builtin_bit_cast(int, v), (ctrl), (rmask), 0xf, false))
    SCAN_STEP(0x111, 0xf); SCAN_STEP(0x112, 0xf); SCAN_STEP(0x114, 0xf); SCAN_STEP(0x118, 0xf);
    SCAN_STEP(0x142, 0xa); SCAN_STEP(0x143, 0xc);
#undef SCAN_STEP
    return v;
}
__device__ __forceinline__ void gla_b(const float* wl, const CgRow& cr, int wave, int lane, float (&bc)[8], float (&bl)[8]) {
    const f32x4 c0 = cr.c0, c1 = cr.c1, c2 = cr.c2, c3 = cr.c3;
    const float cgv[16] = {c0[0], c0[1], c0[2], c0[3], c1[0], c1[1], c1[2], c1[3], c2[0], c2[1], c2[2], c2[3], c3[0], c3[1], c3[2], c3[3]};
    float x[8];
    {   const f32x4 b0 = *(const f32x4*)(wl + 1024 + 8 * wave), b1 = *(const f32x4*)(wl + 1024 + 8 * wave + 4);
#pragma unroll
        for (int e = 0; e < 4; ++e) { x[e] = b0[e]; x[4 + e] = b1[e]; } }
#pragma unroll
    for (int r = 0; r < 16; ++r) {
        const f32x4 w0 = *(const f32x4*)(wl + r * 64 + 8 * wave), w1 = *(const f32x4*)(wl + r * 64 + 8 * wave + 4);
#pragma unroll
        for (int e = 0; e < 4; ++e) { x[e] += cgv[r] * w0[e]; x[4 + e] += cgv[r] * w1[e]; }
    }
#pragma unroll
    for (int i = 0; i < 8; ++i) {
        float la = (fminf(x[i], 0.f) - __logf(1.f + __expf(-fabsf(x[i])))) * (1.f / 16.f);
        la = wave_scan_incl(la);
        bc[i] = la; bl[i] = __builtin_bit_cast(float, __builtin_amdgcn_readlane(__builtin_bit_cast(int, la), 63));
    }
}
struct VPair { u32x4 a, b; };
__device__ __forceinline__ VPair gla_load_v(const bf16_t* proj, int tok0, int h, int tid) {
    const int t = tid >> 3, c8 = tid & 7;
    const bf16_t* vp = proj + (size_t)(tok0 + t) * NPROJ + C_CV + h * 128 + 16 * c8;
    VPair r; r.a = *(const u32x4*)vp; r.b = *(const u32x4*)(vp + 8); return r;
}
__device__ __forceinline__ void gla_store_vT(const VPair& v, bf16_t* vT, int tid) {
    const int t = tid >> 3, c8 = tid & 7;
#pragma unroll
    for (int i = 0; i < 2; ++i) { const u32x4 w = i ? v.b : v.a; const unsigned ww[4] = {w.x, w.y, w.z, w.w};
#pragma unroll
        for (int e = 0; e < 4; ++e) { const int dv = 16 * c8 + 8 * i + 2 * e;
            vT[dv * GL_LD + t] = (bf16_t)(ww[e] & 0xffffu); vT[(dv + 1) * GL_LD + t] = (bf16_t)(ww[e] >> 16); } }
}
__device__ __forceinline__ void gla_local_item(const Params& p, int l, int item, unsigned char* lds, int tid, int wave, int lane) {
    const int bh = item >> 5, c = item & 31, b = bh >> 2, h = bh & 3;
    const int fr = lane & 15, fq = lane >> 4;
    const int tok0 = b * SEQ + c * 64;
    bf16_t* klT = (bf16_t*)lds;
    bf16_t* vT = (bf16_t*)(lds + 64 * GL_LD * 2);
    const bf16_t* proj = (const bf16_t*)(p.ws + WS_PROJ);
    const CgRow cr = gla_load_cg(p, tok0 + lane);
    const bf16_t* rowp = proj + (size_t)(tok0 + lane) * NPROJ + h * 64 + 8 * wave;
    const u32x4 qw = *(const u32x4*)(rowp + C_CQ), kw = *(const u32x4*)(rowp + C_CK);
    const VPair vpre = gla_load_v(proj, tok0, h, tid);
    float* wl = (float*)(lds + 3 * 64 * GL_LD * 2);
    if (tid < 256) *(f32x4*)(wl + (tid >> 4) * 64 + 4 * (tid & 15)) = *(const f32x4*)(p.gla_wup + (size_t)(l * 16 + (tid >> 4)) * 256 + h * 64 + 4 * (tid & 15));
    else if (tid < 272) *(f32x4*)(wl + 1024 + 4 * (tid - 256)) = *(const f32x4*)(p.gla_bg + l * 256 + h * 64 + 4 * (tid - 256));
    __syncthreads();
    float bc[8], bl[8];
    gla_b(wl, cr, wave, lane, bc, bl);
    {
        const unsigned qq[4] = {qw.x, qw.y, qw.z, qw.w}, ww[4] = {kw.x, kw.y, kw.z, kw.w};
        unsigned qo[4], ko[4];
#pragma unroll
        for (int e = 0; e < 4; ++e) {
            klT[(8 * wave + 2 * e) * GL_LD + lane] = f2bf(bf_lo(ww[e]) * __expf(bl[2 * e] - bc[2 * e]));
            klT[(8 * wave + 2 * e + 1) * GL_LD + lane] = f2bf(bf_hi(ww[e]) * __expf(bl[2 * e + 1] - bc[2 * e + 1]));
            const float e0 = __expf(bc[2 * e]), e1 = __expf(bc[2 * e + 1]);
            qo[e] = cvt_pk_bf16(bf_lo(qq[e]) * 0.125f * e0, bf_hi(qq[e]) * 0.125f * e1);
            ko[e] = cvt_pk_bf16(bf_lo(ww[e]) * fast_rcp(e0), bf_hi(ww[e]) * fast_rcp(e1));
        }
        *(u32x4*)((bf16_t*)(p.ws + WS_QD) + (size_t)item * 4096 + lane * 64 + 8 * wave) = (u32x4){qo[0], qo[1], qo[2], qo[3]};
        *(u32x4*)((bf16_t*)(p.ws + WS_KD) + (size_t)item * 4096 + lane * 64 + 8 * wave) = (u32x4){ko[0], ko[1], ko[2], ko[3]};
        if (lane == 63) { float* dec = (float*)(p.ws + WS_DEC) + (size_t)item * 64 + 8 * wave;
#pragma unroll
            for (int i = 0; i < 8; ++i) dec[i] = __expf(bl[i]); }
    }
    gla_store_vT(vpre, vT, tid);
    __syncthreads();
    {
        f32x4 acc[4];
#pragma unroll
        for (int mb = 0; mb < 4; ++mb) acc[mb] = (f32x4){0.f, 0.f, 0.f, 0.f};
#pragma unroll
        for (int kk = 0; kk < 2; ++kk) {
            const bf16x8 bfr = *(const bf16x8*)(vT + (16 * wave + fr) * GL_LD + 32 * kk + 8 * fq);
#pragma unroll
            for (int mb = 0; mb < 4; ++mb) { const bf16x8 a = *(const bf16x8*)(klT + (16 * mb + fr) * GL_LD + 32 * kk + 8 * fq); acc[mb] = MFMA16(a, bfr, acc[mb]); }
        }
        float* loct = (float*)(p.ws + WS_LOCT) + (size_t)item * 8192 + (16 * wave + fr) * 64 + 4 * fq;
#pragma unroll
        for (int mb = 0; mb < 4; ++mb) *(f32x4*)(loct + 16 * mb) = acc[mb];
        const int dv = tid >> 2, qd4 = tid & 3;
        const u32x4 t0 = *(const u32x4*)(vT + dv * GL_LD + 16 * qd4), t1 = *(const u32x4*)(vT + dv * GL_LD + 16 * qd4 + 8);
        bf16_t* vg = (bf16_t*)(p.ws + WS_VTG) + (size_t)item * 8192 + dv * 64 + 16 * qd4;
        *(u32x4*)vg = t0; *(u32x4*)(vg + 8) = t1;
    }
    __syncthreads();
}
__device__ __forceinline__ void gla_scan(const Params& p, int tid, int bx) {
    const float* loct = (const float*)(p.ws + WS_LOCT); const float* dec = (const float*)(p.ws + WS_DEC);
    bf16_t* ST = (bf16_t*)(p.ws + WS_ST);
    for (int e = bx * 512 + tid; e < 16 * 8192; e += gridDim.x * 512) {
        const int bh = e >> 13, r = e & 8191, dk = r & 63;
        float lo[32], de[32];
#pragma unroll
        for (int c = 0; c < 32; ++c) { const size_t it = (size_t)bh * 32 + c; lo[c] = loct[it * 8192 + r]; de[c] = dec[it * 64 + dk]; }
        float s = 0.f;
#pragma unroll
        for (int c = 0; c < 32; ++c) { const size_t it = (size_t)bh * 32 + c;
            ST[it * 8192 + r] = f2bf(s);
            s = s * de[c] + lo[c]; }
    }
}
constexpr int GO_LD = 72;
constexpr int GO_QD = 0, GO_KD = 64 * GO_LD, GO_ST = 2 * 64 * GO_LD, GO_VT = GO_ST + 128 * GO_LD, GO_IMG = GO_VT + 128 * GO_LD;
__device__ __forceinline__ void gla_out_pair(const Params& p, int l, int pit, unsigned char* lds, int tid, int wave, int lane) {
    const int bh2 = pit >> 5, c = pit & 31, h = bh2 & 3;
    const int fr = lane & 15, fq = lane >> 4;
    bf16_t* img = (bf16_t*)lds;
    float* red = (float*)(lds + 2 * GO_IMG * 2);
    const bf16_t* proj = (const bf16_t*)(p.ws + WS_PROJ);
    bf16_t* Y = (bf16_t*)(p.ws + WS_Y);
    const int tb = wave & 3, dh = wave >> 2, t = 16 * tb + fr;
    int item[2], tok[2];
    item[0] = bh2 * 32 + c; item[1] = (bh2 + 8) * 32 + c;
    tok[0] = (bh2 >> 2) * SEQ + c * 64 + t; tok[1] = ((bh2 >> 2) + 2) * SEQ + c * 64 + t;
    {
        const int r8 = tid >> 3, ch = (tid & 7) * 8;
        u32x4 cq[2], ck[2], cs[2][2], cv[2][2];
#pragma unroll
        for (int q2 = 0; q2 < 2; ++q2) {
            cq[q2] = *(const u32x4*)((const bf16_t*)(p.ws + WS_QD) + (size_t)item[q2] * 4096 + r8 * 64 + ch);
            ck[q2] = *(const u32x4*)((const bf16_t*)(p.ws + WS_KD) + (size_t)item[q2] * 4096 + r8 * 64 + ch);
#pragma unroll
            for (int i = 0; i < 2; ++i) {
                cs[q2][i] = *(const u32x4*)((const bf16_t*)(p.ws + WS_ST) + (size_t)item[q2] * 8192 + (r8 + 64 * i) * 64 + ch);
                cv[q2][i] = *(const u32x4*)((const bf16_t*)(p.ws + WS_VTG) + (size_t)item[q2] * 8192 + (r8 + 64 * i) * 64 + ch);
            }
        }
#pragma unroll
        for (int q2 = 0; q2 < 2; ++q2) {
            bf16_t* im = img + q2 * GO_IMG;
            *(u32x4*)(im + GO_QD + r8 * GO_LD + ch) = cq[q2]; *(u32x4*)(im + GO_KD + r8 * GO_LD + ch) = ck[q2];
#pragma unroll
            for (int i = 0; i < 2; ++i) { *(u32x4*)(im + GO_ST + (r8 + 64 * i) * GO_LD + ch) = cs[q2][i]; *(u32x4*)(im + GO_VT + (r8 + 64 * i) * GO_LD + ch) = cv[q2][i]; }
        }
    }
    u32x4 zf[2][2]; f32x4 gf[4];
#pragma unroll
    for (int mp = 0; mp < 2; ++mp) {
        const int dv = 64 * dh + 32 * mp + 8 * fq;
        gf[2 * mp] = *(const f32x4*)(p.gla_ng + l * 128 + dv); gf[2 * mp + 1] = *(const f32x4*)(p.gla_ng + l * 128 + dv + 4);
#pragma unroll
        for (int q2 = 0; q2 < 2; ++q2) zf[q2][mp] = *(const u32x4*)(proj + (size_t)tok[q2] * NPROJ + C_Z + 1536 + h * 128 + dv);
    }
    __syncthreads();
    f32x4 acc[2][4];
#pragma unroll
    for (int q2 = 0; q2 < 2; ++q2) {
        const bf16_t* im = img + q2 * GO_IMG;
        bf16x8 bq[2];
#pragma unroll
        for (int kk = 0; kk < 2; ++kk) bq[kk] = *(const bf16x8*)(im + GO_QD + t * GO_LD + 32 * kk + 8 * fq);
        f32x4 sc[4];
#pragma unroll
        for (int mb = 0; mb < 4; ++mb) {
            sc[mb] = (f32x4){0.f, 0.f, 0.f, 0.f};
            if (mb <= tb) {
#pragma unroll
                for (int kk = 0; kk < 2; ++kk) { const bf16x8 a = *(const bf16x8*)(im + GO_KD + (16 * mb + fr) * GO_LD + 32 * kk + 8 * fq); sc[mb] = MFMA16(a, bq[kk], sc[mb]); }
#pragma unroll
                for (int j = 0; j < 4; ++j) if (16 * mb + 4 * fq + j > t) sc[mb][j] = 0.f;
            }
        }
        bf16x8 bp[2];
#pragma unroll
        for (int k2 = 0; k2 < 2; ++k2)
            bp[k2] = __builtin_bit_cast(bf16x8, (u32x4){cvt_pk_bf16(sc[2 * k2][0], sc[2 * k2][1]), cvt_pk_bf16(sc[2 * k2][2], sc[2 * k2][3]),
                                                        cvt_pk_bf16(sc[2 * k2 + 1][0], sc[2 * k2 + 1][1]), cvt_pk_bf16(sc[2 * k2 + 1][2], sc[2 * k2 + 1][3])});
        float ssq = 0.f;
#pragma unroll
        for (int mb = 0; mb < 4; ++mb) {
            const int dvrow = 64 * dh + 32 * (mb >> 1) + 8 * (fr >> 2) + 4 * (mb & 1) + (fr & 3);
            acc[q2][mb] = (f32x4){0.f, 0.f, 0.f, 0.f};
#pragma unroll
            for (int k2 = 0; k2 < 2; ++k2) {
                const bf16_t* vp = im + GO_VT + dvrow * GO_LD + 32 * k2 + 4 * fq;
                const u32x2 a0 = *(const u32x2*)vp, a1 = *(const u32x2*)(vp + 16);
                acc[q2][mb] = MFMA16(__builtin_bit_cast(bf16x8, (u32x4){a0.x, a0.y, a1.x, a1.y}), bp[k2], acc[q2][mb]);
            }
#pragma unroll
            for (int kk = 0; kk < 2; ++kk) { const bf16x8 a = *(const bf16x8*)(im + GO_ST + dvrow * GO_LD + 32 * kk + 8 * fq); acc[q2][mb] = MFMA16(a, bq[kk], acc[q2][mb]); }
            ssq += (acc[q2][mb][0] * acc[q2][mb][0] + acc[q2][mb][1] * acc[q2][mb][1]) + (acc[q2][mb][2] * acc[q2][mb][2] + acc[q2][mb][3] * acc[q2][mb][3]);
        }
        ssq += __shfl_xor(ssq, 16); ssq += __shfl_xor(ssq, 32);
        if (fq == 0) red[(q2 * 2 + dh) * 64 + t] = ssq;
    }
    __syncthreads();
#pragma unroll
    for (int q2 = 0; q2 < 2; ++q2) {
        const float rstd = rsqrtf((red[(q2 * 2) * 64 + t] + red[(q2 * 2 + 1) * 64 + t]) * (1.f / 128.f) + EPS);
#pragma unroll
        for (int mp = 0; mp < 2; ++mp) {
            const int col = 1536 + h * 128 + 64 * dh + 32 * mp + 8 * fq;
            const u32x4 z = zf[q2][mp];
            const f32x4 a = acc[q2][2 * mp] * rstd * gf[2 * mp], b3 = acc[q2][2 * mp + 1] * rstd * gf[2 * mp + 1];
            u32x4 y; y.x = cvt_pk_bf16(a[0] * bf_lo(z.x), a[1] * bf_hi(z.x)); y.y = cvt_pk_bf16(a[2] * bf_lo(z.y), a[3] * bf_hi(z.y));
            y.z = cvt_pk_bf16(b3[0] * bf_lo(z.z), b3[1] * bf_hi(z.z)); y.w = cvt_pk_bf16(b3[2] * bf_lo(z.w), b3[3] * bf_hi(z.w));
            *(u32x4*)(Y + (size_t)tok[q2] * D + col) = y;
        }
    }
    __syncthreads();
}

#define XB_TMO      128
#define XB_XCNT(j)  (256  + 64 * (j))
#define XB_XSUB(j)  (1280 + 64 * (j))
#define XB_XGEN(j)  (2304 + 64 * (j))
#define XB_TOP      3328
#define XB_TOPGEN   3392
#define XCD_BAR_WORDS 3456
#define XB_SPIN_CAP (1u << 18)
__device__ __forceinline__ unsigned xb_ld(unsigned* p)              { return __hip_atomic_load(p, __ATOMIC_RELAXED, __HIP_MEMORY_SCOPE_AGENT); }
__device__ __forceinline__ unsigned xb_add(unsigned* p, unsigned v) { return __hip_atomic_fetch_add(p, v, __ATOMIC_RELAXED, __HIP_MEMORY_SCOPE_AGENT); }
__device__ __forceinline__ unsigned xb_xcc_id() { return (unsigned)__builtin_amdgcn_s_getreg((3 << 11) | 20) & 0xFu; }
#define XB_SPIN(cond, bar) do { unsigned _sp = 0; while (cond) { __builtin_amdgcn_s_sleep(1); \
    if ((++_sp & 255u) == 0u) { if (xb_ld(&(bar)[XB_TMO])) break; if (_sp > XB_SPIN_CAP) { atomicAdd(&(bar)[XB_TMO], 1u); break; } } } } while (0)
__device__ __forceinline__ void xcd_barrier_complete(unsigned* bar, unsigned x, unsigned& nloc, unsigned& nx) {
    const unsigned G = gridDim.x * gridDim.y * gridDim.z;
    unsigned sum, cnt, mine, sp = 0u;
    for (;;) {
        sum = 0u; cnt = 0u; mine = 0u;
#pragma unroll
        for (unsigned j = 0; j < 16; ++j) { const unsigned c = xb_ld(&bar[XB_XCNT(j)]); sum += c; cnt += (c > 0u) ? 1u : 0u; mine = (j == x) ? c : mine; }
        if (sum == G) break;
        __builtin_amdgcn_s_sleep(1);
        if ((++sp & 255u) == 0u) { if (xb_ld(&bar[XB_TMO])) break; if (sp > XB_SPIN_CAP) { atomicAdd(&bar[XB_TMO], 1u); break; } }
    }
    nloc = mine > 0u ? mine : 1u; nx = cnt > 0u ? cnt : 1u;
}
__device__ __forceinline__ void xcd_barrier(unsigned* bar, volatile LAS unsigned* st) {
    asm volatile("s_waitcnt vmcnt(0)" ::: "memory");
    __syncthreads();
    if (threadIdx.x == 0) {
        __builtin_amdgcn_s_waitcnt(0);
        const unsigned x = xb_xcc_id();
        unsigned nloc = st[0], nx = st[1];
        if (nloc == 0u) { xcd_barrier_complete(bar, x, nloc, nx); st[0] = nloc; st[1] = nx; }
        const unsigned old = xb_add(&bar[XB_XSUB(x)], 1u);
        const unsigned gen = old / nloc;
        if (old + 1u == (gen + 1u) * nloc) {
            __builtin_amdgcn_fence(__ATOMIC_RELEASE, "agent");
            asm volatile("s_waitcnt vmcnt(0)" ::: "memory");
            const unsigned og = xb_add(&bar[XB_TOP], 1u);
            const unsigned tg = og / nx;
            if (og + 1u == (tg + 1u) * nx) xb_add(&bar[XB_TOPGEN], 1u);
            else XB_SPIN(xb_ld(&bar[XB_TOPGEN]) == tg, bar);
            __builtin_amdgcn_fence(__ATOMIC_ACQUIRE, "agent");
            xb_add(&bar[XB_XGEN(x)], 1u);
            asm volatile("s_waitcnt vmcnt(0)" ::: "memory");
        } else {
            XB_SPIN(xb_ld(&bar[XB_XGEN(x)]) == gen, bar);
            __builtin_amdgcn_fence(__ATOMIC_ACQUIRE, "agent");
            asm volatile("s_waitcnt vmcnt(0)" ::: "memory");
        }
    }
    __syncthreads();
}

constexpr int N_PHASES = 14;
__global__ void __launch_bounds__(512, 2) fwd_kernel(Params p) {
    extern __shared__ __attribute__((aligned(16))) unsigned char lds[];
    const int G = gridDim.x;
    const int lo = p.ph_lo, hi = p.ph_hi;
    unsigned* const xbar = (unsigned*)(p.ws + WS_BAR);
    volatile LAS unsigned* const xst = (volatile LAS unsigned*)((LAS unsigned char*)lds + 131072 + 64);
    if (threadIdx.x < 2) xst[threadIdx.x] = 0u;
    __syncthreads();
    if (lo < 0) cg::this_grid().sync();
    if (hi - lo > 1 && threadIdx.x == 0) (void)xb_add(&xbar[XB_XCNT(xb_xcc_id())], 1u);
#ifndef PHMASK
#define PHMASK 0xffff
#endif
#define IN(k) (((PHMASK >> ((k) < 2 ? (k) : 2 + ((k) - 2) % 6)) & 1) && lo <= (k) && (k) < hi)
#define SEAM(k) do { STAMP(2 * (k)); if (IN(k) && IN((k) + 1)) { xcd_barrier(xbar, xst); } STAMP(2 * (k) + 1); } while (0)
#define FRESH() int tid = threadIdx.x; asm volatile("" : "+v"(tid)); int bx = blockIdx.x; asm volatile("" : "+s"(bx)); \
    const int lane = tid & 63, wave = __builtin_amdgcn_readfirstlane(tid >> 6); \
    const Params q = fresh_params(p); (void)lane; (void)wave; (void)bx;
    unsigned long long tacc = 0ull, tprev = (PMASK != 0ull) ? __builtin_amdgcn_s_memrealtime() : 0ull;
#define STAMP(idx) do { if (PMASK != 0ull) { const unsigned long long now_ = __builtin_amdgcn_s_memrealtime(); if ((PMASK >> (idx)) & 1ull) tacc += now_ - tprev; tprev = now_; } } while (0)
    if (IN(0)) for (int rep = 0; rep < REPN(0); ++rep) { FRESH(); mod_items(q, 0, lds, tid, wave, lane, bx); __syncthreads(); }
    SEAM(0);
    if (IN(1)) for (int rep = 0; rep < REPN(1); ++rep) { FRESH(); mod_items(q, 1, lds, tid, wave, lane, bx); __syncthreads(); STAMP(32); p0_convert(q, lds, tid, wave, lane, bx); STAMP(33); row_pass(q, 0, wave, lane, bx); }
    SEAM(1);
#pragma unroll 1
    for (int l = 0; l < 2; ++l) {
        const int pb = 2 + 6 * l;
        if (IN(pb)) for (int rep = 0; rep < REPN(2); ++rep) {
            FRESH();
            pg8::Gemm g{(const bf16_t*)(q.ws + WS_H), (const bf16_t*)(q.ws + WS_WIN + (size_t)l * WIN_BYTES), M, NPAD, D};
            pg8::StaticOrder S; S.init(M, NPAD, G, bx);
            pg8::EpiProj E{(bf16_t*)(q.ws + WS_PROJ), (float*)(q.ws + WS_CG), (float*)(q.ws + WS_SGST)};
            pg8::gemm_phase<pg8::EpiProj, pg8::StaticOrder, true, true>((LAS unsigned char*)lds, g, S, E, tid);
        }
        SEAM(pb);
        if (IN(pb + 1)) for (int rep = 0; rep < REPN(3); ++rep) {
#ifndef MIXMASK
#define MIXMASK 7
#endif
            for (int rr = 0; rr < ((MIXR >> 0) & 15); ++rr) { FRESH(); for (int it = bx; it < 256; it += G) attn_item(q, l, it, lds, tid, wave, lane); }
            STAMP(36 + 4 * l); for (int rr = 0; rr < ((MIXR >> 4) & 15); ++rr) { FRESH(); for (int it = bx; it < 256; it += G) sg_pair_item(q, l, it, lds, tid, wave, lane); } STAMP(37 + 4 * l);
            for (int rr = 0; rr < ((MIXR >> 8) & 15); ++rr) { FRESH(); for (int it = bx; it < 512; it += G) gla_local_item(q, l, it, lds, tid, wave, lane); }
        }
        SEAM(pb + 1);
        if (IN(pb + 2)) for (int rep = 0; rep < REPN(4); ++rep) { FRESH(); gla_scan(q, tid, bx); }
        SEAM(pb + 2);
        if (IN(pb + 3)) for (int rep = 0; rep < REPN(5); ++rep) { FRESH(); for (int it = bx; it < 256; it += G) gla_out_pair(q, l, it, lds, tid, wave, lane); }
        SEAM(pb + 3);
        if (IN(pb + 4)) for (int rep = 0; rep < REPN(6); ++rep) {
            FRESH();
            pg8::Gemm g{(const bf16_t*)(q.ws + WS_Y), (const bf16_t*)(q.ws + WS_WOUT + (size_t)l * WOUT_BYTES), M, D, D};
            pg8::StaticOrder S; S.init(M, D, G, bx);
            pg8::EpiOut E{(bf16_t*)(q.ws + WS_OUT)};
            pg8::gemm_phase<pg8::EpiOut, pg8::StaticOrder, true, true>((LAS unsigned char*)lds, g, S, E, tid);
        }
        SEAM(pb + 4);
        if (IN(pb + 5)) { FRESH(); row_pass(q, l + 1, wave, lane, bx); }
        if (l == 0) SEAM(pb + 5);
    }
    STAMP(26);
    if (PMASK != 0ull) { if (blockIdx.x == 0 && threadIdx.x == 0) { const unsigned long long t0 = __builtin_amdgcn_s_memrealtime(); while (__builtin_amdgcn_s_memrealtime() - t0 < tacc) __builtin_amdgcn_s_sleep(8); } }
#undef IN
#undef SEAM
#undef FRESH
}

extern "C" void kernel_launch(void* const* d_in, const int* in_sizes, int n_in, void* d_out, int out_size, void* d_ws, size_t ws_size, hipStream_t stream) {
    static int grid = 0;
    if (grid == 0) {
        if (n_in != 17 || in_sizes[0] != M * D || out_size != M * D || ws_size < WS_END) { fprintf(stderr, "kernel_launch: unexpected shapes (n_in %d, in0 %d, out %d, ws %zu)\n", n_in, n_in > 0 ? in_sizes[0] : -1, out_size, ws_size); grid = -1; return; }
        int dev = 0, cus = 0, per_cu = 0;
        if (hipGetDevice(&dev) != hipSuccess || hipDeviceGetAttribute(&cus, hipDeviceAttributeMultiprocessorCount, dev) != hipSuccess) { grid = -1; return; }
        if (hipFuncSetAttribute((const void*)fwd_kernel, hipFuncAttributeMaxDynamicSharedMemorySize, LDS_BYTES) != hipSuccess) { fprintf(stderr, "kernel_launch: hipFuncSetAttribute failed\n"); grid = -1; return; }
        if (hipOccupancyMaxActiveBlocksPerMultiprocessor(&per_cu, (const void*)fwd_kernel, 512, LDS_BYTES) != hipSuccess || per_cu < 1) { fprintf(stderr, "kernel_launch: occupancy query says %d blocks per CU\n", per_cu); per_cu = 1; }
        (void)hipGetLastError();
        grid = cus;
    }
    if (grid < 0) return;
    Params p{};
    p.x = (const float*)d_in[0]; p.c = (const float*)d_in[1]; p.pos = (const int*)d_in[2]; p.w_mod = (const float*)d_in[3]; p.b_mod = (const float*)d_in[4];
    p.g_pre = (const float*)d_in[5]; p.g_post = (const float*)d_in[6]; p.w_in = (const float*)d_in[7]; p.w_out = (const float*)d_in[8]; p.sinks = (const float*)d_in[9];
    p.sg_w = (const float*)d_in[10]; p.sg_b = (const float*)d_in[11]; p.sg_ln_g = (const float*)d_in[12]; p.sg_ln_b = (const float*)d_in[13];
    p.gla_wup = (const float*)d_in[14]; p.gla_bg = (const float*)d_in[15]; p.gla_ng = (const float*)d_in[16];
    p.out = (float*)d_out; p.ws = (unsigned char*)d_ws;
#if MK_SINGLE
    if (hipMemsetAsync((char*)d_ws + WS_BAR, 0, XCD_BAR_WORDS * 4, stream) != hipSuccess) { fprintf(stderr, "kernel_launch: memset failed\n"); return; }
    p.ph_lo = 0; p.ph_hi = N_PHASES;
    void* args[] = {&p};
    hipError_t e = hipLaunchCooperativeKernel((const void*)fwd_kernel, dim3(grid), dim3(512), args, LDS_BYTES, stream);
    if (e != hipSuccess) fprintf(stderr, "kernel_launch: cooperative launch failed: %s (grid %d)\n", hipGetErrorString(e), grid);
#else
    for (int ph = 0; ph < N_PHASES; ++ph) {
        p.ph_lo = ph; p.ph_hi = ph + 1;
        hipLaunchKernelGGL(fwd_kernel, dim3(grid), dim3(512), LDS_BYTES, stream, p);
    }
#endif
}
```

```cpp
#include <hip/hip_runtime.h>
#include <hip/hip_cooperative_groups.h>
#include <cstdio>
#include <cstdint>
namespace cg = cooperative_groups;

#ifndef REPS
#define REPS 0x11111111
#endif
#define REPN(k) ((REPS >> (4 * (k))) & 15)
#ifndef PMASK
#define PMASK 0ull
#endif
#ifndef MIXR
#define MIXR 0x111
#endif
#ifndef MK_SINGLE
#define MK_SINGLE 1
#endif

#define LAS __attribute__((address_space(3)))
typedef unsigned short bf16_t;
typedef short bf16x8 __attribute__((ext_vector_type(8)));
typedef float f32x4 __attribute__((ext_vector_type(4)));
typedef float f32x2 __attribute__((ext_vector_type(2)));
typedef unsigned u32x4 __attribute__((ext_vector_type(4)));
typedef unsigned u32x2 __attribute__((ext_vector_type(2)));

constexpr int D = 2048, NB = 4, SEQ = 2048, M = NB * SEQ;
constexpr int NPROJ = 5632;
constexpr int NPAD = 5888;
constexpr int WIN_LD = 5648;
constexpr float EPS = 1e-6f;
constexpr int C_AQ = 0, C_AK = 1024, C_AV = 1280, C_SU = 1536, C_SV = 2048, C_CQ = 2560, C_CK = 2816, C_CV = 3072, C_Z = 3584;
constexpr float LOG2E = 1.4426950408889634f;

constexpr size_t MiB = 1u << 20;
constexpr size_t WS_WIN = 0, WIN_BYTES = (size_t)NPAD * D * 2;
constexpr size_t WS_WOUT = 46 * MiB, WOUT_BYTES = (size_t)D * D * 2;
constexpr size_t WS_H = 62 * MiB, WS_PROJ = 94 * MiB, WS_CG = 182 * MiB, WS_MOD = 183 * MiB, WS_Y = 184 * MiB, WS_OUT = 216 * MiB;
constexpr size_t WS_LOCT = 248 * MiB, WS_ST = 264 * MiB, WS_DEC = 272 * MiB, WS_BAR = 273 * MiB, WS_QD = 274 * MiB, WS_KD = 278 * MiB, WS_VTG = 282 * MiB, WS_X1B = 290 * MiB, WS_SGST = 322 * MiB, WS_SGW = 323 * MiB, WS_END = 324 * MiB;

constexpr int LDS_BYTES = 135168;

struct Params {
    const float* x; const float* c; const int* pos; const float* w_mod; const float* b_mod; const float* g_pre; const float* g_post;
    const float* w_in; const float* w_out; const float* sinks; const float* sg_w; const float* sg_b; const float* sg_ln_g; const float* sg_ln_b;
    const float* gla_wup; const float* gla_bg; const float* gla_ng;
    float* out; unsigned char* ws; int ph_lo, ph_hi;
};

__device__ __forceinline__ Params fresh_params(const Params& p) {
#if defined(__HIP_DEVICE_COMPILE__)
    typedef unsigned long long u64;
    const __attribute__((address_space(4))) u64* pp = (const __attribute__((address_space(4))) u64*)__builtin_amdgcn_kernarg_segment_ptr();
    asm volatile("" : "+s"(pp));
    Params q; u64* dst = (u64*)&q;
#pragma unroll
    for (int i = 0; i < (int)(sizeof(Params) / 8); ++i) dst[i] = pp[i];
    return q;
#else
    return p;
#endif
}
static_assert(sizeof(Params) % 8 == 0, "Params is copied in 8-byte words");

typedef __bf16 bf16x2_t __attribute__((ext_vector_type(2)));
__device__ __forceinline__ unsigned cvt_pk_bf16(float lo, float hi) { const f32x2 v = {lo, hi}; const bf16x2_t b = __builtin_convertvector(v, bf16x2_t); return __builtin_bit_cast(unsigned, b); }
__device__ __forceinline__ float bf_lo(unsigned u) { return __builtin_bit_cast(float, u << 16); }
__device__ __forceinline__ float bf_hi(unsigned u) { return __builtin_bit_cast(float, u & 0xffff0000u); }
__device__ __forceinline__ float bf1(bf16_t v) { return __builtin_bit_cast(float, (unsigned)v << 16); }
__device__ __forceinline__ bf16_t f2bf(float f) { return (bf16_t)(cvt_pk_bf16(f, 0.f) & 0xffffu); }
__device__ __forceinline__ float fast_exp2(float x) { return __builtin_amdgcn_exp2f(x); }
__device__ __forceinline__ float fast_rcp(float x) { return __builtin_amdgcn_rcpf(x); }
__device__ __forceinline__ float silu_f(float x) { return x * fast_rcp(1.f + fast_exp2(-x * LOG2E)); }
__device__ __forceinline__ float gelu_tanh_f(float x) { const float u = 0.7978845608028654f * (x + 0.044715f * x * x * x); return x * fast_rcp(1.f + fast_exp2(-2.f * LOG2E * u)); }
__device__ __forceinline__ float wave_sum(float v) {
#pragma unroll
    for (int o = 1; o < 64; o <<= 1) v += __shfl_xor(v, o);
    return v;
}

typedef short v4i16_t __attribute__((ext_vector_type(4)));
__device__ __forceinline__ bf16x8 tr_operand(const void* p0, const void* p1) {
    const v4i16_t a = __builtin_amdgcn_ds_read_tr16_b64_v4i16((__attribute__((address_space(3))) v4i16_t*)p0);
    const v4i16_t b = __builtin_amdgcn_ds_read_tr16_b64_v4i16((__attribute__((address_space(3))) v4i16_t*)p1);
    return __builtin_shufflevector(a, b, 0, 1, 2, 3, 4, 5, 6, 7);
}
#define MFMA16(a, b, c) __builtin_amdgcn_mfma_f32_16x16x32_bf16((a), (b), (c), 0, 0, 0)

namespace pg8 {
#define PG8_LAS __attribute__((address_space(3)))
constexpr int BM = 256, BK = 64, HALF = 128, HTB = HALF * BK * 2, STAGE_BYTES = 8 * HTB, NXCD = 8, WGM = 8;
__host__ __device__ __forceinline__ int lds_byte(int r, int c) { const int st = (r >> 4) * 2 + (c >> 5), rr = r & 15, cc = c & 31, ob = rr * 64 + cc * 2; return st * 1024 + (ob ^ (((ob >> 9) & 1) << 5)); }
__host__ __device__ __forceinline__ void stage_rc(int b, int& R, int& C) { const int st = b / 1024, sb = b % 1024, swz = sb ^ (((sb >> 9) & 1) << 5); R = (st >> 1) * 16 + swz / 64; C = (st & 1) * 32 + (swz % 64) / 2; }
__host__ __device__ __forceinline__ int perm32(int rho) { const int n = rho >> 4, i = rho & 15; return 8 * (i >> 2) + 4 * n + (i & 3); }
struct Unit { int pm, pn; };
struct Gemm { const bf16_t* A; const bf16_t* Bt; int M, N, K; };
struct StaticOrder {
    int nM, nN, nwg, G, c;
    __host__ __device__ void init(int M_, int N_, int G_, int c_) { nM = M_ / BM; nN = N_ / BM; nwg = nM * nN; G = G_; c = c_; }
    __host__ __device__ bool next(int i, Unit& u) const {
        const long L = (long)i * G + c; if (L >= nwg) return false;
        int wgid = (int)L; { const int q = nwg / NXCD, r = nwg % NXCD, xcd = wgid % NXCD, off = wgid / NXCD; wgid = (xcd < r ? xcd * (q + 1) : r * (q + 1) + (xcd - r) * q) + off; }
        const int nig = WGM * nN, gid = wgid / nig, fm = gid * WGM, gsz = (nM - fm) < WGM ? (nM - fm) : WGM;
        u.pm = fm + ((wgid % nig) % gsz); u.pn = (wgid % nig) / gsz; return true;
    }
    __device__ __forceinline__ void a_ready(const Unit&) const {}
    __device__ __forceinline__ void done(const Unit&) const {}
};

template <class Epi, class Sched, bool ALIGN_EPI = false, bool SP2 = false>
__device__ __forceinline__ void gemm_phase(PG8_LAS unsigned char* lds, const Gemm g, const Sched& S, const Epi& E, const int tid) {
    const int wid = __builtin_amdgcn_readfirstlane(tid >> 6), lane = tid & 63, wr = wid >> 2, wc = wid & 3, fr = lane & 15, fq = lane >> 4;
    const int K = g.K, nt = K / BK;
    unsigned voffA[2], voffB[2];
#pragma unroll
    for (int i = 0; i < 2; ++i) { int R, C; stage_rc(tid * 16 + i * 8192, R, C); const int Rb = Epi::PERM ? ((R & ~31) + perm32(R & 31)) : R;
        voffA[i] = (unsigned)(R * K + C) * 2u; voffB[i] = (unsigned)(Rb * K + C) * 2u; }
    const size_t kstep = (size_t)(BK * 2);
    const size_t hstep = (size_t)HALF * K * 2;
    const size_t tstep = 2 * hstep;
    const unsigned ldsw = (unsigned)wid * 1024u;
    const int aoff = lds_byte(wr * 64 + fr, fq * 8), boff = lds_byte(wc * 32 + fr, fq * 8);
#define PG8_SA(b, h) (((b) * 2 + (h)) * HTB)
#define PG8_SB(b, h) ((4 + (b) * 2 + (h)) * HTB)
#define PG8_STAGE(bufoff, gbase, voff) do { _Pragma("unroll") for (int _i = 0; _i < 2; ++_i) \
        __builtin_amdgcn_global_load_lds((const unsigned*)((const char*)(gbase) + (voff)[_i]), (PG8_LAS unsigned*)(lds + (bufoff) + ldsw + _i * 8192), 16, 0, 0); } while (0)
#define PG8_LDA(dst, b, h) do { _Pragma("unroll") for (int m = 0; m < 4; ++m) _Pragma("unroll") for (int k = 0; k < 2; ++k) dst[m][k] = *(const PG8_LAS bf16x8*)(lds + PG8_SA(b, h) + aoff + m * 2048 + k * 1024); } while (0)
#define PG8_LDB(dst, b, h) do { _Pragma("unroll") for (int n = 0; n < 2; ++n) _Pragma("unroll") for (int k = 0; k < 2; ++k) dst[n][k] = *(const PG8_LAS bf16x8*)(lds + PG8_SB(b, h) + boff + n * 2048 + k * 1024); } while (0)
#define PG8_MMA(ai, bj, At, Bt) do { __builtin_amdgcn_s_setprio(1); _Pragma("unroll") for (int m = 0; m < 4; ++m) _Pragma("unroll") for (int n = 0; n < 2; ++n) _Pragma("unroll") for (int k = 0; k < 2; ++k) \
        acc[ai][bj][m][n] = __builtin_amdgcn_mfma_f32_16x16x32_bf16(Bt[n][k], At[m][k], acc[ai][bj][m][n], 0, 0, 0); __builtin_amdgcn_s_setprio(0); } while (0)
#define PG8_WAIT_V(n) asm volatile("s_waitcnt vmcnt(" #n ")" ::: "memory")
#define PG8_WAIT_L(n) asm volatile("s_waitcnt lgkmcnt(" #n ")" ::: "memory")
#define PG8_BAR __builtin_amdgcn_s_barrier()
#define PG8_SCHED __builtin_amdgcn_sched_barrier(0)
    Unit cur, nxt; int ui = 0;
    if (!S.next(0, cur)) return;
    f32x4 acc[2][2][4][2];
#pragma unroll
    for (int a = 0; a < 2; ++a)
#pragma unroll
        for (int b = 0; b < 2; ++b)
#pragma unroll
            for (int m = 0; m < 4; ++m)
#pragma unroll
                for (int n = 0; n < 2; ++n) acc[a][b][m][n] = (f32x4){0.f, 0.f, 0.f, 0.f};
    bf16x8 At[4][2], B0[2][2], B1[2][2];
    const char* cA = (const char*)g.A + (size_t)cur.pm * tstep; const char* cB = (const char*)g.Bt + (size_t)cur.pn * tstep;
    S.a_ready(cur);
    if constexpr (SP2) {
        PG8_STAGE(PG8_SB(0, 0), cB, voffB); PG8_STAGE(PG8_SB(0, 1), cB + hstep, voffB); PG8_STAGE(PG8_SA(0, 0), cA, voffA); PG8_STAGE(PG8_SA(0, 1), cA + hstep, voffA);
        if (wr == 1) PG8_BAR;
        PG8_WAIT_V(2); PG8_BAR;
        PG8_STAGE(PG8_SB(1, 0), cB + kstep, voffB); PG8_STAGE(PG8_SA(1, 0), cA + kstep, voffA); PG8_STAGE(PG8_SB(1, 1), cB + hstep + kstep, voffB);
        PG8_WAIT_V(6); PG8_BAR;
    } else {
        PG8_STAGE(PG8_SB(0, 0), cB, voffB); PG8_STAGE(PG8_SA(0, 0), cA, voffA); PG8_STAGE(PG8_SB(0, 1), cB + hstep, voffB); PG8_STAGE(PG8_SA(0, 1), cA + hstep, voffA);
        if (wr == 1) PG8_BAR;
        PG8_WAIT_V(4); PG8_BAR;
        PG8_STAGE(PG8_SB(1, 0), cB + kstep, voffB); PG8_STAGE(PG8_SA(1, 0), cA + kstep, voffA); PG8_STAGE(PG8_SB(1, 1), cB + hstep + kstep, voffB);
        PG8_WAIT_V(6); PG8_BAR;
    }
    for (;;) {
        const bool has_next = S.next(ui + 1, nxt);
        const char* nA = has_next ? (const char*)g.A + (size_t)nxt.pm * tstep : cA; const char* nB = has_next ? (const char*)g.Bt + (size_t)nxt.pn * tstep : cB;
        for (int t = 0; t < nt; t += 2) {
            const bool last = (t == nt - 2);
            const char* a1 = cA + (size_t)(t + 1) * kstep;
            const char* a2 = last ? nA : cA + (size_t)(t + 2) * kstep; const char* b2 = last ? nB : cB + (size_t)(t + 2) * kstep;
            const char* a3 = a2 + kstep; const char* b3 = b2 + kstep;
            if (last && has_next) S.a_ready(nxt);
            if constexpr (SP2) {
            PG8_LDB(B0, 0, 0); PG8_LDB(B1, 0, 1); PG8_SCHED; PG8_LDA(At, 0, 0); PG8_STAGE(PG8_SA(1, 1), a1 + hstep, voffA);
            PG8_WAIT_V(8); PG8_WAIT_L(0); PG8_BAR; PG8_MMA(0, 0, At, B0); PG8_MMA(0, 1, At, B1); PG8_BAR; PG8_SCHED;
            PG8_LDA(At, 0, 1); PG8_STAGE(PG8_SB(0, 0), b2, voffB); PG8_STAGE(PG8_SB(0, 1), b2 + hstep, voffB); PG8_STAGE(PG8_SA(0, 0), a2, voffA);
            PG8_WAIT_V(8); PG8_WAIT_L(0); PG8_BAR; PG8_MMA(1, 0, At, B0); PG8_MMA(1, 1, At, B1); PG8_BAR; PG8_SCHED;
            PG8_LDB(B0, 1, 0); PG8_LDB(B1, 1, 1); PG8_SCHED; PG8_LDA(At, 1, 0); PG8_STAGE(PG8_SA(0, 1), a2 + hstep, voffA);
            PG8_WAIT_V(8); PG8_WAIT_L(0); PG8_BAR; PG8_MMA(0, 0, At, B0); PG8_MMA(0, 1, At, B1); PG8_BAR; PG8_SCHED;
            PG8_LDA(At, 1, 1); PG8_STAGE(PG8_SB(1, 0), b3, voffB); PG8_STAGE(PG8_SB(1, 1), b3 + hstep, voffB); PG8_STAGE(PG8_SA(1, 0), a3, voffA);
            PG8_WAIT_V(8); PG8_WAIT_L(0); PG8_BAR; PG8_MMA(1, 0, At, B0); PG8_MMA(1, 1, At, B1); PG8_BAR; PG8_SCHED;
            } else {
            PG8_LDB(B0, 0, 0); PG8_SCHED; PG8_LDA(At, 0, 0); PG8_STAGE(PG8_SA(1, 1), a1 + hstep, voffA);
            PG8_WAIT_L(8); PG8_BAR; PG8_WAIT_L(0); PG8_MMA(0, 0, At, B0); PG8_BAR; PG8_SCHED;
            PG8_LDB(B1, 0, 1); PG8_STAGE(PG8_SB(0, 0), b2, voffB);
            PG8_BAR; PG8_WAIT_L(0); PG8_MMA(0, 1, At, B1); PG8_BAR;
            PG8_LDA(At, 0, 1); PG8_STAGE(PG8_SA(0, 0), a2, voffA);
            PG8_BAR; PG8_WAIT_L(0); PG8_MMA(1, 0, At, B0); PG8_BAR; PG8_SCHED;
            PG8_STAGE(PG8_SB(0, 1), b2 + hstep, voffB);
            PG8_WAIT_V(6); PG8_BAR; PG8_MMA(1, 1, At, B1); PG8_BAR;
            PG8_LDB(B0, 1, 0); PG8_SCHED; PG8_LDA(At, 1, 0); PG8_STAGE(PG8_SA(0, 1), a2 + hstep, voffA);
            PG8_WAIT_L(8); PG8_BAR; PG8_WAIT_L(0); PG8_MMA(0, 0, At, B0); PG8_BAR; PG8_SCHED;
            PG8_LDB(B1, 1, 1); PG8_STAGE(PG8_SB(1, 0), b3, voffB);
            PG8_BAR; PG8_WAIT_L(0); PG8_MMA(0, 1, At, B1); PG8_BAR;
            PG8_LDA(At, 1, 1); PG8_STAGE(PG8_SA(1, 0), a3, voffA);
            PG8_BAR; PG8_WAIT_L(0); PG8_MMA(1, 0, At, B0); PG8_BAR; PG8_SCHED;
            PG8_STAGE(PG8_SB(1, 1), b3 + hstep, voffB);
            PG8_WAIT_V(6); PG8_BAR; PG8_MMA(1, 1, At, B1); PG8_BAR;
            }
        }
        if constexpr (ALIGN_EPI) { if (wr == 0) PG8_BAR; }
        E(acc, cur, wr, wc, fr, fq); S.done(cur);
        if (!has_next) break;
#pragma unroll
        for (int a = 0; a < 2; ++a)
#pragma unroll
            for (int b = 0; b < 2; ++b)
#pragma unroll
                for (int m = 0; m < 4; ++m)
#pragma unroll
                    for (int n = 0; n < 2; ++n) acc[a][b][m][n] = (f32x4){0.f, 0.f, 0.f, 0.f};
        cur = nxt; cA = nA; cB = nB; ++ui;
        if constexpr (ALIGN_EPI) { if (wr == 1) PG8_BAR; }
    }
    PG8_WAIT_V(0);
    if constexpr (!ALIGN_EPI) { if (wr == 0) PG8_BAR; }
    PG8_BAR;
#undef PG8_SA
#undef PG8_SB
#undef PG8_STAGE
#undef PG8_LDA
#undef PG8_LDB
#undef PG8_MMA
#undef PG8_WAIT_V
#undef PG8_WAIT_L
#undef PG8_BAR
#undef PG8_SCHED
}

struct EpiProj {
    static constexpr bool PERM = true;
    bf16_t* P; float* CG; float* SGST;
    template <int ACT> __device__ __forceinline__ void store_tile(const f32x4 (&acc)[2][2][4][2], bf16_t* base, float* stp, int fq) const {
#pragma unroll
        for (int ai = 0; ai < 2; ++ai)
#pragma unroll
            for (int m = 0; m < 4; ++m) { bf16_t* rowp = base + (size_t)(ai * HALF + m * 16) * NPROJ;
                float rs = 0.f, rq = 0.f;
#pragma unroll
                for (int bj = 0; bj < 2; ++bj) { f32x4 v0 = acc[ai][bj][m][0], v1 = acc[ai][bj][m][1];
                    if (ACT == 1) { for (int e = 0; e < 4; ++e) { v0[e] = gelu_tanh_f(v0[e]); v1[e] = gelu_tanh_f(v1[e]); } }
                    if (ACT == 2) { for (int e = 0; e < 4; ++e) { v0[e] = silu_f(v0[e]); v1[e] = silu_f(v1[e]); } }
                    if (ACT == 1) { rs += ((v0[0] + v0[1]) + (v0[2] + v0[3])) + ((v1[0] + v1[1]) + (v1[2] + v1[3]));
                        rq += ((v0[0] * v0[0] + v0[1] * v0[1]) + (v0[2] * v0[2] + v0[3] * v0[3])) + ((v1[0] * v1[0] + v1[1] * v1[1]) + (v1[2] * v1[2] + v1[3] * v1[3])); }
                    u32x4 w; w.x = cvt_pk_bf16(v0[0], v0[1]); w.y = cvt_pk_bf16(v0[2], v0[3]); w.z = cvt_pk_bf16(v1[0], v1[1]); w.w = cvt_pk_bf16(v1[2], v1[3]);
                    *(u32x4*)(rowp + bj * HALF) = w; }
                if (ACT == 1) { if (stp) { rs += __shfl_xor(rs, 16); rs += __shfl_xor(rs, 32); rq += __shfl_xor(rq, 16); rq += __shfl_xor(rq, 32);
                    if (fq == 0) *(f32x2*)(stp + (size_t)(ai * HALF + m * 16) * 16) = (f32x2){rs, rq}; } } }
    }
    __device__ __forceinline__ void operator()(const f32x4 (&acc)[2][2][4][2], const Unit& u, int wr, int wc, int fr, int fq) const {
        const int row0 = u.pm * BM + wr * 64 + fr;
        if (u.pn < 22) {
            bf16_t* base = P + (size_t)row0 * NPROJ + u.pn * BM + wc * 32 + 8 * fq;
            if (u.pn >= 6 && u.pn < 10) store_tile<1>(acc, base, (u.pn >= 8) ? SGST + (size_t)row0 * 16 + ((u.pn - 8) * 4 + wc) * 2 : nullptr, fq);
            else if (u.pn >= 14) store_tile<2>(acc, base, nullptr, fq);
            else store_tile<0>(acc, base, nullptr, fq);
        } else if (wc == 0 && fq < 2) {
#pragma unroll
            for (int ai = 0; ai < 2; ++ai)
#pragma unroll
                for (int m = 0; m < 4; ++m) { float* p = CG + (size_t)(row0 + ai * HALF + m * 16) * 16 + 8 * fq;
                    *(f32x4*)p = acc[ai][0][m][0]; *(f32x4*)(p + 4) = acc[ai][0][m][1]; }
        }
    }
};
struct EpiOut {
    static constexpr bool PERM = true;
    bf16_t* O;
    __device__ __forceinline__ void operator()(const f32x4 (&acc)[2][2][4][2], const Unit& u, int wr, int wc, int fr, int fq) const {
        bf16_t* base = O + (size_t)(u.pm * BM + wr * 64 + fr) * D + u.pn * BM + wc * 32 + 8 * fq;
#pragma unroll
        for (int ai = 0; ai < 2; ++ai)
#pragma unroll
            for (int m = 0; m < 4; ++m) { bf16_t* rowp = base + (size_t)(ai * HALF + m * 16) * D;
#pragma unroll
                for (int bj = 0; bj < 2; ++bj) { const f32x4 v0 = acc[ai][bj][m][0], v1 = acc[ai][bj][m][1];
                    u32x4 w; w.x = cvt_pk_bf16(v0[0], v0[1]); w.y = cvt_pk_bf16(v0[2], v0[3]); w.z = cvt_pk_bf16(v1[0], v1[1]); w.w = cvt_pk_bf16(v1[2], v1[3]);
                    *(u32x4*)(rowp + bj * HALF) = w; } }
    }
};
}

__device__ __forceinline__ void p0_transpose_item(const float* W, int ldw, int n_src0, bf16_t* WT, int row_dst0, int kb, float* scr, int lane) {
    const int k0 = 64 * kb;
    {   const int kr = lane >> 3, c4 = 4 * (lane & 7);
        const float* src = W + (size_t)(k0 + kr) * ldw + n_src0 + c4;
        f32x4 v[8];
#pragma unroll
        for (int i = 0; i < 8; ++i) v[i] = __builtin_nontemporal_load((const f32x4*)(src + (size_t)(8 * i) * ldw));
#pragma unroll
        for (int i = 0; i < 8; ++i) { float* d = scr + (8 * i + kr) * 33 + c4; d[0] = v[i][0]; d[1] = v[i][1]; d[2] = v[i][2]; d[3] = v[i][3]; }
    }
    asm volatile("s_waitcnt lgkmcnt(0)" ::: "memory");
    const int c = lane & 7;
#pragma unroll
    for (int j = 0; j < 4; ++j) { const int n = (lane >> 3) + 8 * j; const float* s = scr + (8 * c) * 33 + n;
        u32x4 o; o.x = cvt_pk_bf16(s[0 * 33], s[1 * 33]); o.y = cvt_pk_bf16(s[2 * 33], s[3 * 33]); o.z = cvt_pk_bf16(s[4 * 33], s[5 * 33]); o.w = cvt_pk_bf16(s[6 * 33], s[7 * 33]);
        *(u32x4*)(WT + (size_t)(row_dst0 + n) * D + k0 + 8 * c) = o; }
    asm volatile("s_waitcnt lgkmcnt(0)" ::: "memory");
}

__device__ __forceinline__ void mod_items(const Params& p, int l, unsigned char* lds, int tid, int wave, int lane, int bx) {
    const int G = gridDim.x;
    if (bx >= 192) return;
    float* sc = (float*)lds;
    float* red = (float*)(lds + 32768);
    for (int i = tid; i < 4 * D; i += 512) { const int b = i >> 11, k = i & (D - 1); sc[k * 4 + b] = silu_f(p.c[i]); }
    __syncthreads();
    for (int it = bx; it < 192; it += G) {
        const int n0 = 32 * it;
        const int r8 = lane >> 3, c4 = lane & 7;
        const float* wp = p.w_mod + ((size_t)l * D + wave * 256 + r8) * 6144 + n0 + 4 * c4;
        f32x4 a0 = {0, 0, 0, 0}, a1 = a0, a2 = a0, a3 = a0;
#pragma unroll 8
        for (int i = 0; i < 32; ++i) {
            const f32x4 w = __builtin_nontemporal_load((const f32x4*)(wp + (size_t)(8 * i) * 6144));
            const f32x4 s = *(const f32x4*)(sc + (wave * 256 + 8 * i + r8) * 4);
            a0 += w * s[0]; a1 += w * s[1]; a2 += w * s[2]; a3 += w * s[3];
        }
#pragma unroll
        for (int e = 0; e < 4; ++e) {
#pragma unroll
            for (int o = 8; o < 64; o <<= 1) { a0[e] += __shfl_xor(a0[e], o); a1[e] += __shfl_xor(a1[e], o); a2[e] += __shfl_xor(a2[e], o); a3[e] += __shfl_xor(a3[e], o); }
        }
        if (r8 == 0) {
            *(f32x4*)(red + (wave * 4 + 0) * 32 + 4 * c4) = a0; *(f32x4*)(red + (wave * 4 + 1) * 32 + 4 * c4) = a1;
            *(f32x4*)(red + (wave * 4 + 2) * 32 + 4 * c4) = a2; *(f32x4*)(red + (wave * 4 + 3) * 32 + 4 * c4) = a3;
        }
        __syncthreads();
        if (tid < 128) { const int b = tid >> 5, col = tid & 31; float s = p.b_mod[l * 6144 + n0 + col];
#pragma unroll
            for (int w = 0; w < 8; ++w) s += red[(w * 4 + b) * 32 + col];
            ((float*)(p.ws + WS_MOD))[(l * 4 + b) * 6144 + n0 + col] = s; }
        __syncthreads();
    }
}

__device__ __forceinline__ void p0_convert(const Params& p, unsigned char* lds, int tid, int wave, int lane, int bx) {
    const int G = gridDim.x;
    unsigned char* ws = p.ws;
    {
        const int gt = bx * 512 + tid, NT = G * 512;
        for (int i = gt; i < 2 * 256 * (D / 8); i += NT) {
            const int l = i / (256 * (D / 8)), r = i % (256 * (D / 8)), j = r / (D / 8), k8 = (r % (D / 8)) * 8;
            u32x4 o = {0u, 0u, 0u, 0u};
            if (j < 16) { const float* s = p.w_in + ((size_t)l * D + k8) * WIN_LD + 3584 + j;
                o.x = cvt_pk_bf16(s[0], s[WIN_LD]); o.y = cvt_pk_bf16(s[2 * WIN_LD], s[3 * WIN_LD]); o.z = cvt_pk_bf16(s[4 * WIN_LD], s[5 * WIN_LD]); o.w = cvt_pk_bf16(s[6 * WIN_LD], s[7 * WIN_LD]); }
            *(u32x4*)((bf16_t*)(ws + WS_WIN + (size_t)l * WIN_BYTES) + (size_t)(5632 + j) * D + k8) = o;
        }
    }
    {
        const int gt = bx * 512 + tid;
        if (gt < 2 * 8 * 128 * 16) {
            const int t = (gt >> 4) & 127, s0 = (gt & 15) * 8;
            const float* src = p.sg_w + (size_t)gt * 8;
            const f32x4 f0 = *(const f32x4*)src, f1 = *(const f32x4*)(src + 4);
            float w[8] = {f0[0], f0[1], f0[2], f0[3], f1[0], f1[1], f1[2], f1[3]};
#pragma unroll
            for (int e = 0; e < 8; ++e) w[e] = (s0 + e <= t) ? w[e] : 0.f;
            *(u32x4*)((bf16_t*)(ws + WS_SGW) + (size_t)gt * 8) = (u32x4){cvt_pk_bf16(w[0], w[1]), cvt_pk_bf16(w[2], w[3]), cvt_pk_bf16(w[4], w[5]), cvt_pk_bf16(w[6], w[7])};
        }
    }
    {
        float* scr = (float*)(lds + wave * 16384);
        constexpr int PER_L = 32 * 240, NIT = 2 * PER_L;
        int base, end, stride;
        if (G == 256) { if (bx < 192) { base = 55 * bx; end = base + 55; } else { base = 10560 + (bx - 192) * 75; end = base + 75; } base += wave; stride = 8; }
        else { base = bx * 8 + wave; end = NIT; stride = G * 8; }
        for (int it = base; it < end; it += stride) {
            const int l = it / PER_L, r = it % PER_L, kb = r / 240, j = r % 240;
            bf16_t* WinT = (bf16_t*)(ws + WS_WIN + (size_t)l * WIN_BYTES);
            bf16_t* WoT = (bf16_t*)(ws + WS_WOUT + (size_t)l * WOUT_BYTES);
            if (j < 112) p0_transpose_item(p.w_in + (size_t)l * D * WIN_LD, WIN_LD, 32 * j, WinT, 32 * j, kb, scr, lane);
            else if (j < 176) p0_transpose_item(p.w_in + (size_t)l * D * WIN_LD, WIN_LD, 3600 + 32 * (j - 112), WinT, 3584 + 32 * (j - 112), kb, scr, lane);
            else p0_transpose_item(p.w_out + (size_t)l * D * D, D, 32 * (j - 176), WoT, 32 * (j - 176), kb, scr, lane);
        }
    }
}

__device__ __forceinline__ void row_pass(const Params& p, int mode, int wave, int lane, int bx) {
    const int gw = bx * 8 + wave, NGW = gridDim.x * 8;
    unsigned char* ws = p.ws;
    const float* mod = (const float*)(ws + WS_MOD);
    const bf16_t* OUTB = (const bf16_t*)(ws + WS_OUT);
    bf16_t* H = (bf16_t*)(ws + WS_H);
    const int lpost = (mode == 2) ? 1 : 0, lpre = (mode == 0) ? 0 : 1;
    for (int gi = gw; gi < M / 4; gi += NGW) {
        const int r0 = 4 * gi, b = r0 >> 11;
        f32x4 gg[4][2], aa[4][2], tt[4][2];
        if (mode >= 1) {
            const float* gate = mod + (size_t)(lpost * 4 + b) * 6144 + 4096; const float* gp = p.g_post + lpost * D;
#pragma unroll
            for (int j = 0; j < 4; ++j)
#pragma unroll
                for (int h = 0; h < 2; ++h) { const int col = 8 * lane + 512 * j + 4 * h; gg[j][h] = *(const f32x4*)(gate + col) * *(const f32x4*)(gp + col); }
        }
        if (mode <= 1) {
            const float* shift = mod + (size_t)(lpre * 4 + b) * 6144; const float* scale = shift + 2048; const float* gp = p.g_pre + lpre * D;
#pragma unroll
            for (int j = 0; j < 4; ++j)
#pragma unroll
                for (int h = 0; h < 2; ++h) { const int col = 8 * lane + 512 * j + 4 * h;
                    aa[j][h] = *(const f32x4*)(gp + col) * (*(const f32x4*)(scale + col) + 1.f); tt[j][h] = *(const f32x4*)(shift + col); }
        }
#pragma unroll 1
        for (int k = 0; k < 4; ++k) {
            const int r = r0 + k;
            f32x4 v[4][2];
            if (mode == 2) {
                const bf16_t* x1b = (const bf16_t*)(ws + WS_X1B) + (size_t)r * D;
#pragma unroll
                for (int j = 0; j < 4; ++j) { const u32x4 w = *(const u32x4*)(x1b + 8 * lane + 512 * j);
                    v[j][0] = (f32x4){bf_lo(w.x), bf_hi(w.x), bf_lo(w.y), bf_hi(w.y)}; v[j][1] = (f32x4){bf_lo(w.z), bf_hi(w.z), bf_lo(w.w), bf_hi(w.w)}; }
            } else {
                const float* xin = p.x + (size_t)r * D;
#pragma unroll
                for (int j = 0; j < 4; ++j) { v[j][0] = *(const f32x4*)(xin + 8 * lane + 512 * j); v[j][1] = *(const f32x4*)(xin + 8 * lane + 512 * j + 4); }
            }
            if (mode >= 1) {
                f32x4 o[4][2]; float ss = 0.f;
#pragma unroll
                for (int j = 0; j < 4; ++j) { const u32x4 w = *(const u32x4*)(OUTB + (size_t)r * D + 8 * lane + 512 * j);
                    o[j][0] = (f32x4){bf_lo(w.x), bf_hi(w.x), bf_lo(w.y), bf_hi(w.y)}; o[j][1] = (f32x4){bf_lo(w.z), bf_hi(w.z), bf_lo(w.w), bf_hi(w.w)};
#pragma unroll
                    for (int h = 0; h < 2; ++h) ss += (o[j][h][0] * o[j][h][0] + o[j][h][1] * o[j][h][1]) + (o[j][h][2] * o[j][h][2] + o[j][h][3] * o[j][h][3]); }
                const float rstd = rsqrtf(wave_sum(ss) * (1.f / D) + EPS);
                float* xo = p.out + (size_t)r * D;
#pragma unroll
                for (int j = 0; j < 4; ++j)
#pragma unroll
                    for (int h = 0; h < 2; ++h) { const int col = 8 * lane + 512 * j + 4 * h;
                        v[j][h] = v[j][h] + gg[j][h] * (o[j][h] * rstd);
                        if (mode == 2) *(f32x4*)(xo + col) = v[j][h]; }
                if (mode == 1) {
                    bf16_t* x1b = (bf16_t*)(ws + WS_X1B) + (size_t)r * D;
#pragma unroll
                    for (int j = 0; j < 4; ++j) { u32x4 w; w.x = cvt_pk_bf16(v[j][0][0], v[j][0][1]); w.y = cvt_pk_bf16(v[j][0][2], v[j][0][3]); w.z = cvt_pk_bf16(v[j][1][0], v[j][1][1]); w.w = cvt_pk_bf16(v[j][1][2], v[j][1][3]);
                        *(u32x4*)(x1b + 8 * lane + 512 * j) = w;
                        v[j][0] = (f32x4){bf_lo(w.x), bf_hi(w.x), bf_lo(w.y), bf_hi(w.y)}; v[j][1] = (f32x4){bf_lo(w.z), bf_hi(w.z), bf_lo(w.w), bf_hi(w.w)}; }
                }
            }
            if (mode <= 1) {
                float ss = 0.f;
#pragma unroll
                for (int j = 0; j < 4; ++j)
#pragma unroll
                    for (int h = 0; h < 2; ++h) ss += (v[j][h][0] * v[j][h][0] + v[j][h][1] * v[j][h][1]) + (v[j][h][2] * v[j][h][2] + v[j][h][3] * v[j][h][3]);
                const float rstd = rsqrtf(wave_sum(ss) * (1.f / D) + EPS);
#pragma unroll
                for (int j = 0; j < 4; ++j) { f32x4 hh[2];
#pragma unroll
                    for (int h = 0; h < 2; ++h) hh[h] = (v[j][h] * rstd) * aa[j][h] + tt[j][h];
                    u32x4 w; w.x = cvt_pk_bf16(hh[0][0], hh[0][1]); w.y = cvt_pk_bf16(hh[0][2], hh[0][3]); w.z = cvt_pk_bf16(hh[1][0], hh[1][1]); w.w = cvt_pk_bf16(hh[1][2], hh[1][3]);
                    *(u32x4*)(H + (size_t)r * D + 8 * lane + 512 * j) = w; }
            }
        }
    }
}

__device__ __forceinline__ void rope_cs(int pos, int i, float& cs, float& sn) {
    constexpr float F[8] = {0.15915494309189535f, 0.03086376340470123f, 0.005985185712713705f, 0.001160663641240061f,
                            0.00022507907903927653f, 4.364795279280289e-05f, 8.464330808241401e-06f, 1.6414262627950345e-06f};
    const float rev = (float)pos * F[i];
    const float r = __builtin_amdgcn_fractf(rev);
    sn = __builtin_amdgcn_sinf(r); cs = __builtin_amdgcn_cosf(r);
}
constexpr int KS_LD = 72, VS_LD = 72;
__device__ __forceinline__ void attn_item(const Params& p, int l, int item, unsigned char* lds, int tid, int wave, int lane) {
    const int b = item >> 6, n = (item >> 2) & 15, g = item & 3;
    const int fr = lane & 15, fq = lane >> 4;
    bf16_t* Ks = (bf16_t*)lds;
    bf16_t* Vs = (bf16_t*)(lds + 256 * KS_LD * 2);
    const bf16_t* proj = (const bf16_t*)(p.ws + WS_PROJ);
    bf16_t* Y = (bf16_t*)(p.ws + WS_Y);
    const int r = wave >> 1, qh = wave & 1, hq = g * 4 + r;
    const int tokq0 = b * SEQ + n * 128 + 64 * qh;
    u32x4 qraw[4][2]; int qpos[4];
#pragma unroll
    for (int nb = 0; nb < 4; ++nb) {
        const int tok = tokq0 + 16 * nb + fr;
        const bf16_t* qp = proj + (size_t)tok * NPROJ + C_AQ + hq * 64 + 8 * fq;
        qraw[nb][0] = *(const u32x4*)qp; qraw[nb][1] = *(const u32x4*)(qp + 32); qpos[nb] = p.pos[tok];
    }
    {
        const int key = tid >> 1, half = tid & 1;
        const int s = n * 128 - 128 + key;
        u32x4 kv[4], vv[4];
#pragma unroll
        for (int c = 0; c < 4; ++c) { kv[c] = (u32x4){0u, 0u, 0u, 0u}; vv[c] = kv[c]; }
        if (s >= 0) {
            const bf16_t* kp = proj + (size_t)(b * SEQ + s) * NPROJ + C_AK + g * 64 + half * 32;
#pragma unroll
            for (int c = 0; c < 4; ++c) { kv[c] = *(const u32x4*)(kp + 8 * c); vv[c] = *(const u32x4*)(kp + 256 + 8 * c); }
            if (half == 0) {
                const int pos = p.pos[b * SEQ + s];
                unsigned a[4] = {kv[0].x, kv[0].y, kv[0].z, kv[0].w}, bb[4] = {kv[1].x, kv[1].y, kv[1].z, kv[1].w};
#pragma unroll
                for (int e = 0; e < 4; ++e) {
                    float c0, s0, c1, s1; rope_cs(pos, 2 * e, c0, s0); rope_cs(pos, 2 * e + 1, c1, s1);
                    const float t1a = bf_lo(a[e]), t1b = bf_hi(a[e]), t2a = bf_lo(bb[e]), t2b = bf_hi(bb[e]);
                    a[e] = cvt_pk_bf16(t1a * c0 - t2a * s0, t1b * c1 - t2b * s1);
                    bb[e] = cvt_pk_bf16(t2a * c0 + t1a * s0, t2b * c1 + t1b * s1);
                }
                kv[0] = (u32x4){a[0], a[1], a[2], a[3]}; kv[1] = (u32x4){bb[0], bb[1], bb[2], bb[3]};
            }
        }
#pragma unroll
        for (int c = 0; c < 4; ++c) *(u32x4*)(Ks + key * KS_LD + half * 32 + 8 * c) = kv[c];
#pragma unroll
        for (int c = 0; c < 4; ++c) *(u32x4*)(Vs + key * VS_LD + half * 32 + 8 * c) = vv[c];
    }
    __syncthreads();
    bf16x8 qf[4][2];
#pragma unroll
    for (int nb = 0; nb < 4; ++nb) {
        const u32x4 q0 = qraw[nb][0], q1 = qraw[nb][1];
        unsigned own[4] = {q0.x, q0.y, q0.z, q0.w}, par[4];
#pragma unroll
        for (int e = 0; e < 4; ++e) par[e] = __shfl_xor(own[e], 16);
        if (fq < 2) {
            const int pos = qpos[nb];
            const float sg = (fq == 0) ? -1.f : 1.f;
#pragma unroll
            for (int e = 0; e < 4; ++e) {
                float c0, s0, c1, s1; rope_cs(pos, 2 * e, c0, s0); rope_cs(pos, 2 * e + 1, c1, s1);
                const float oa = bf_lo(own[e]), ob = bf_hi(own[e]), pa = bf_lo(par[e]), pb = bf_hi(par[e]);
                own[e] = cvt_pk_bf16((oa * c0 + sg * pa * s0) * 0.125f, (ob * c1 + sg * pb * s1) * 0.125f);
            }
        } else {
#pragma unroll
            for (int e = 0; e < 4; ++e) own[e] = cvt_pk_bf16(bf_lo(own[e]) * 0.125f, bf_hi(own[e]) * 0.125f);
        }
        unsigned o1[4] = {q1.x, q1.y, q1.z, q1.w};
#pragma unroll
        for (int e = 0; e < 4; ++e) o1[e] = cvt_pk_bf16(bf_lo(o1[e]) * 0.125f, bf_hi(o1[e]) * 0.125f);
        qf[nb][0] = __builtin_bit_cast(bf16x8, (u32x4){own[0], own[1], own[2], own[3]});
        qf[nb][1] = __builtin_bit_cast(bf16x8, (u32x4){o1[0], o1[1], o1[2], o1[3]});
    }
    const float sink2 = p.sinks[l * 16 + hq] * LOG2E;
    float m_[4], l_[4];
    f32x4 o[4][4];
#pragma unroll
    for (int nb = 0; nb < 4; ++nb) { m_[nb] = sink2; l_[nb] = 1.f;
#pragma unroll
        for (int hb = 0; hb < 4; ++hb) o[hb][nb] = (f32x4){0.f, 0.f, 0.f, 0.f}; }
    for (int step = 0; step < 6; ++step) {
        const int kj0 = 64 * qh + 32 * step;
        if (n == 0 && kj0 + 32 <= 128) continue;
        f32x4 s[2][4];
#pragma unroll
        for (int mb = 0; mb < 2; ++mb)
#pragma unroll
            for (int nb = 0; nb < 4; ++nb) s[mb][nb] = (f32x4){0.f, 0.f, 0.f, 0.f};
#pragma unroll
        for (int mb = 0; mb < 2; ++mb)
#pragma unroll
            for (int kk = 0; kk < 2; ++kk) {
                const bf16x8 a = *(const bf16x8*)(Ks + (kj0 + 16 * mb + fr) * KS_LD + 32 * kk + 8 * fq);
#pragma unroll
                for (int nb = 0; nb < 4; ++nb) s[mb][nb] = MFMA16(a, qf[nb][kk], s[mb][nb]);
            }
        bf16x8 pb[4];
#pragma unroll
        for (int nb = 0; nb < 4; ++nb) {
            const int qi = 64 * qh + 16 * nb + fr;
            float tmax = -1e30f;
#pragma unroll
            for (int mb = 0; mb < 2; ++mb)
#pragma unroll
                for (int j = 0; j < 4; ++j) {
                    const int kj = kj0 + 16 * mb + 4 * fq + j, dist = qi + 128 - kj;
                    const bool valid = (dist >= 0) && (dist < 128) && (n > 0 || kj >= 128);
                    const float v = valid ? s[mb][nb][j] * LOG2E : -1e30f;
                    s[mb][nb][j] = v; tmax = fmaxf(tmax, v);
                }
            tmax = fmaxf(tmax, __shfl_xor(tmax, 16)); tmax = fmaxf(tmax, __shfl_xor(tmax, 32));
            const float mnew = fmaxf(m_[nb], tmax), alpha = fast_exp2(m_[nb] - mnew);
            m_[nb] = mnew;
            float rs = 0.f;
#pragma unroll
            for (int mb = 0; mb < 2; ++mb)
#pragma unroll
                for (int j = 0; j < 4; ++j) { const float pv = fast_exp2(s[mb][nb][j] - mnew); s[mb][nb][j] = pv; rs += pv; }
            rs += __shfl_xor(rs, 16); rs += __shfl_xor(rs, 32);
            l_[nb] = l_[nb] * alpha + rs;
#pragma unroll
            for (int hb = 0; hb < 4; ++hb) o[hb][nb] = o[hb][nb] * alpha;
            pb[nb] = __builtin_bit_cast(bf16x8, (u32x4){cvt_pk_bf16(s[0][nb][0], s[0][nb][1]), cvt_pk_bf16(s[0][nb][2], s[0][nb][3]),
                                                        cvt_pk_bf16(s[1][nb][0], s[1][nb][1]), cvt_pk_bf16(s[1][nb][2], s[1][nb][3])});
        }
#pragma unroll
        for (int hb = 0; hb < 4; ++hb) {
            const bf16_t* vp = Vs + (kj0 + 4 * fq + (fr >> 2)) * VS_LD + 32 * (hb >> 1) + 8 * (fr & 3) + 4 * (hb & 1);
            const bf16x8 a = tr_operand(vp, vp + 16 * VS_LD);
#pragma unroll
            for (int nb = 0; nb < 4; ++nb) o[hb][nb] = MFMA16(a, pb[nb], o[hb][nb]);
        }
    }
#pragma unroll
    for (int nb = 0; nb < 4; ++nb) {
        const int tok = tokq0 + 16 * nb + fr;
        const float inv = 1.f / l_[nb];
#pragma unroll
        for (int hp = 0; hp < 2; ++hp) {
            const int col = hq * 64 + 32 * hp + 8 * fq;
            const u32x4 z = *(const u32x4*)(proj + (size_t)tok * NPROJ + C_Z + col);
            const f32x4 a = o[2 * hp][nb] * inv, b2 = o[2 * hp + 1][nb] * inv;
            u32x4 y; y.x = cvt_pk_bf16(a[0] * bf_lo(z.x), a[1] * bf_hi(z.x)); y.y = cvt_pk_bf16(a[2] * bf_lo(z.y), a[3] * bf_hi(z.y));
            y.z = cvt_pk_bf16(b2[0] * bf_lo(z.z), b2[1] * bf_hi(z.z)); y.w = cvt_pk_bf16(b2[2] * bf_lo(z.w), b2[3] * bf_hi(z.w));
            *(u32x4*)(Y + (size_t)tok * D + col) = y;
        }
    }
    __syncthreads();
}

constexpr int VN_LD = 72;
__device__ __forceinline__ void sg_pair_item(const Params& p, int l, int pitem, unsigned char* lds, int tid, int wave, int lane) {
    const int b2 = pitem >> 7, c = (pitem >> 3) & 15, g = pitem & 7;
    const int fr = lane & 15, fq = lane >> 4;
    bf16_t* vnT = (bf16_t*)lds;
    const bf16_t* proj = (const bf16_t*)(p.ws + WS_PROJ);
    bf16_t* Y = (bf16_t*)(p.ws + WS_Y);
    const int s = tid >> 2, qd = tid & 3;
    const int t = 16 * wave + fr;
    int tok0[2];
    tok0[0] = b2 * SEQ + c * 128; tok0[1] = (b2 + 2) * SEQ + c * 128;
    u32x4 vw[2][2]; f32x4 stq[2]; u32x4 uf[2][2], zf[2][2];
#pragma unroll
    for (int q2 = 0; q2 < 2; ++q2) {
        const bf16_t* vp = proj + (size_t)(tok0[q2] + s) * NPROJ + C_SV;
        vw[q2][0] = *(const u32x4*)(vp + 64 * g + 16 * qd); vw[q2][1] = *(const u32x4*)(vp + 64 * g + 16 * qd + 8);
        stq[q2] = *(const f32x4*)((const float*)(p.ws + WS_SGST) + (size_t)(tok0[q2] + s) * 16 + 4 * qd);
#pragma unroll
        for (int mp = 0; mp < 2; ++mp) { const int col = 64 * g + 32 * mp + 8 * fq; const size_t ro = (size_t)(tok0[q2] + t) * NPROJ;
            uf[q2][mp] = *(const u32x4*)(proj + ro + C_SU + col); zf[q2][mp] = *(const u32x4*)(proj + ro + C_Z + 1024 + col); }
    }
    bf16x8 wf[4];
    {   const bf16_t* wrow = (const bf16_t*)(p.ws + WS_SGW) + ((size_t)(l * 8 + g) * 128 + t) * 128;
#pragma unroll
        for (int kk = 0; kk < 4; ++kk) if (32 * kk <= 16 * wave + 15) wf[kk] = *(const bf16x8*)(wrow + 32 * kk + 8 * fq); }
    const float bias = p.sg_b[(l * 8 + g) * 128 + t];
    float lgv[16], lbv[16];
    {   const float* lg = p.sg_ln_g + l * 512 + 64 * g + 16 * qd; const float* lb = p.sg_ln_b + l * 512 + 64 * g + 16 * qd;
#pragma unroll
        for (int i = 0; i < 4; ++i) { const f32x4 a = *(const f32x4*)(lg + 4 * i), bb = *(const f32x4*)(lb + 4 * i);
#pragma unroll
            for (int e = 0; e < 4; ++e) { lgv[4 * i + e] = a[e]; lbv[4 * i + e] = bb[e]; } } }
#pragma unroll
    for (int q2 = 0; q2 < 2; ++q2) {
        float sum = stq[q2][0] + stq[q2][2], sq = stq[q2][1] + stq[q2][3];
        sum += __shfl_xor(sum, 1); sum += __shfl_xor(sum, 2); sq += __shfl_xor(sq, 1); sq += __shfl_xor(sq, 2);
        const float mu = sum * (1.f / 512.f), var = fmaxf(sq * (1.f / 512.f) - mu * mu, 0.f), rstd = rsqrtf(var + EPS);
        bf16_t* vq = vnT + q2 * 128 * VN_LD + s * VN_LD + 16 * qd;
#pragma unroll
        for (int i = 0; i < 2; ++i) { const unsigned ww[4] = {vw[q2][i].x, vw[q2][i].y, vw[q2][i].z, vw[q2][i].w}; unsigned o4[4];
#pragma unroll
            for (int e = 0; e < 4; ++e) { const int ch = 8 * i + 2 * e;
                o4[e] = cvt_pk_bf16((bf_lo(ww[e]) - mu) * rstd * lgv[ch] + lbv[ch], (bf_hi(ww[e]) - mu) * rstd * lgv[ch + 1] + lbv[ch + 1]); }
            *(u32x4*)(vq + 8 * i) = (u32x4){o4[0], o4[1], o4[2], o4[3]}; }
    }
    __syncthreads();
    {
        f32x4 acc[2][4];
#pragma unroll
        for (int q2 = 0; q2 < 2; ++q2)
#pragma unroll
            for (int mb = 0; mb < 4; ++mb) acc[q2][mb] = (f32x4){0.f, 0.f, 0.f, 0.f};
#pragma unroll
        for (int kk = 0; kk < 4; ++kk) {
            if (32 * kk <= 16 * wave + 15) {
                const int s0 = 32 * kk + 8 * fq;
                const bf16x8 bfr = wf[kk];
#pragma unroll
                for (int q2 = 0; q2 < 2; ++q2)
#pragma unroll
                    for (int mb = 0; mb < 4; ++mb) {
                        const bf16_t* ap = vnT + (q2 * 128 + s0 + (fr >> 2)) * VN_LD + 32 * (mb >> 1) + 8 * (fr & 3) + 4 * (mb & 1);
                        acc[q2][mb] = MFMA16(tr_operand(ap, ap + 4 * VN_LD), bfr, acc[q2][mb]); }
            }
        }
#pragma unroll
        for (int q2 = 0; q2 < 2; ++q2)
#pragma unroll
            for (int mp = 0; mp < 2; ++mp) {
                const int col = 64 * g + 32 * mp + 8 * fq;
                const u32x4 u = uf[q2][mp], z = zf[q2][mp];
                const f32x4 a = acc[q2][2 * mp] + bias, b3 = acc[q2][2 * mp + 1] + bias;
                u32x4 y; y.x = cvt_pk_bf16(bf_lo(u.x) * a[0] * bf_lo(z.x), bf_hi(u.x) * a[1] * bf_hi(z.x)); y.y = cvt_pk_bf16(bf_lo(u.y) * a[2] * bf_lo(z.y), bf_hi(u.y) * a[3] * bf_hi(z.y));
                y.z = cvt_pk_bf16(bf_lo(u.z) * b3[0] * bf_lo(z.z), bf_hi(u.z) * b3[1] * bf_hi(z.z)); y.w = cvt_pk_bf16(bf_lo(u.w) * b3[2] * bf_lo(z.w), bf_hi(u.w) * b3[3] * bf_hi(z.w));
                *(u32x4*)(Y + (size_t)(tok0[q2] + t) * D + 1024 + col) = y;
            }
    }
    __syncthreads();
}

constexpr int GL_LD = 72;
struct CgRow { f32x4 c0, c1, c2, c3; };
__device__ __forceinline__ CgRow gla_load_cg(const Params& p, int tok) {
    const float* cgp = (const float*)(p.ws + WS_CG) + (size_t)tok * 16;
    CgRow r; r.c0 = *(const f32x4*)cgp; r.c1 = *(const f32x4*)(cgp + 4); r.c2 = *(const f32x4*)(cgp + 8); r.c3 = *(const f32x4*)(cgp + 12); return r;
}
__device__ __forceinline__ float wave_scan_incl(float v) {
#define SCAN_STEP(ctrl, rmask) v += __builtin_bit_cast(float, __builtin_amdgcn_update_dpp(0, __builtin_bit_cast(int, v), (ctrl), (rmask), 0xf, false))
    SCAN_STEP(0x111, 0xf); SCAN_STEP(0x112, 0xf); SCAN_STEP(0x114, 0xf); SCAN_STEP(0x118, 0xf);
    SCAN_STEP(0x142, 0xa); SCAN_STEP(0x143, 0xc);
#undef SCAN_STEP
    return v;
}
__device__ __forceinline__ void gla_b(const float* wl, const CgRow& cr, int wave, int lane, float (&bc)[8], float (&bl)[8]) {
    const f32x4 c0 = cr.c0, c1 = cr.c1, c2 = cr.c2, c3 = cr.c3;
    const float cgv[16] = {c0[0], c0[1], c0[2], c0[3], c1[0], c1[1], c1[2], c1[3], c2[0], c2[1], c2[2], c2[3], c3[0], c3[1], c3[2], c3[3]};
    float x[8];
    {   const f32x4 b0 = *(const f32x4*)(wl + 1024 + 8 * wave), b1 = *(const f32x4*)(wl + 1024 + 8 * wave + 4);
#pragma unroll
        for (int e = 0; e < 4; ++e) { x[e] = b0[e]; x[4 + e] = b1[e]; } }
#pragma unroll
    for (int r = 0; r < 16; ++r) {
        const f32x4 w0 = *(const f32x4*)(wl + r * 64 + 8 * wave), w1 = *(const f32x4*)(wl + r * 64 + 8 * wave + 4);
#pragma unroll
        for (int e = 0; e < 4; ++e) { x[e] += cgv[r] * w0[e]; x[4 + e] += cgv[r] * w1[e]; }
    }
#pragma unroll
    for (int i = 0; i < 8; ++i) {
        float la = (fminf(x[i], 0.f) - __logf(1.f + __expf(-fabsf(x[i])))) * (1.f / 16.f);
        la = wave_scan_incl(la);
        bc[i] = la; bl[i] = __builtin_bit_cast(float, __builtin_amdgcn_readlane(__builtin_bit_cast(int, la), 63));
    }
}
struct VPair { u32x4 a, b; };
__device__ __forceinline__ VPair gla_load_v(const bf16_t* proj, int tok0, int h, int tid) {
    const int t = tid >> 3, c8 = tid & 7;
    const bf16_t* vp = proj + (size_t)(tok0 + t) * NPROJ + C_CV + h * 128 + 16 * c8;
    VPair r; r.a = *(const u32x4*)vp; r.b = *(const u32x4*)(vp + 8); return r;
}
__device__ __forceinline__ void gla_store_vT(const VPair& v, bf16_t* vT, int tid) {
    const int t = tid >> 3, c8 = tid & 7;
#pragma unroll
    for (int i = 0; i < 2; ++i) { const u32x4 w = i ? v.b : v.a; const unsigned ww[4] = {w.x, w.y, w.z, w.w};
#pragma unroll
        for (int e = 0; e < 4; ++e) { const int dv = 16 * c8 + 8 * i + 2 * e;
            vT[dv * GL_LD + t] = (bf16_t)(ww[e] & 0xffffu); vT[(dv + 1) * GL_LD + t] = (bf16_t)(ww[e] >> 16); } }
}
constexpr int GLK_LD = 72, GLV_LD = 136;
__device__ __forceinline__ void gla_local_item(const Params& p, int l, int item, unsigned char* lds, int tid, int wave, int lane) {
    const int bh = item >> 5, c = item & 31, b = bh >> 2, h = bh & 3;
    const int fr = lane & 15, fq = lane >> 4;
    const int tok0 = b * SEQ + c * 64;
    bf16_t* Kr = (bf16_t*)lds;
    bf16_t* Vr = (bf16_t*)(lds + 64 * GLK_LD * 2);
    float* wl = (float*)(lds + 64 * GLK_LD * 2 + 64 * GLV_LD * 2);
    const bf16_t* proj = (const bf16_t*)(p.ws + WS_PROJ);
    const CgRow cr = gla_load_cg(p, tok0 + lane);
    const bf16_t* rowp = proj + (size_t)(tok0 + lane) * NPROJ + h * 64 + 8 * wave;
    const u32x4 qw = *(const u32x4*)(rowp + C_CQ), kw = *(const u32x4*)(rowp + C_CK);
    const VPair vpre = gla_load_v(proj, tok0, h, tid);
    if (tid < 256) *(f32x4*)(wl + (tid >> 4) * 64 + 4 * (tid & 15)) = *(const f32x4*)(p.gla_wup + (size_t)(l * 16 + (tid >> 4)) * 256 + h * 64 + 4 * (tid & 15));
    else if (tid < 272) *(f32x4*)(wl + 1024 + 4 * (tid - 256)) = *(const f32x4*)(p.gla_bg + l * 256 + h * 64 + 4 * (tid - 256));
    __syncthreads();
    float bc[8], bl[8];
    gla_b(wl, cr, wave, lane, bc, bl);
    {
        const unsigned qq[4] = {qw.x, qw.y, qw.z, qw.w}, ww[4] = {kw.x, kw.y, kw.z, kw.w};
        unsigned qo[4], ko[4], lo4[4];
#pragma unroll
        for (int e = 0; e < 4; ++e) {
            lo4[e] = cvt_pk_bf16(bf_lo(ww[e]) * __expf(bl[2 * e] - bc[2 * e]), bf_hi(ww[e]) * __expf(bl[2 * e + 1] - bc[2 * e + 1]));
            const float e0 = __expf(bc[2 * e]), e1 = __expf(bc[2 * e + 1]);
            qo[e] = cvt_pk_bf16(bf_lo(qq[e]) * 0.125f * e0, bf_hi(qq[e]) * 0.125f * e1);
            ko[e] = cvt_pk_bf16(bf_lo(ww[e]) * fast_rcp(e0), bf_hi(ww[e]) * fast_rcp(e1));
        }
        *(u32x4*)(Kr + lane * GLK_LD + 8 * wave) = (u32x4){lo4[0], lo4[1], lo4[2], lo4[3]};
        *(u32x4*)((bf16_t*)(p.ws + WS_QD) + (size_t)item * 4096 + lane * 64 + 8 * wave) = (u32x4){qo[0], qo[1], qo[2], qo[3]};
        *(u32x4*)((bf16_t*)(p.ws + WS_KD) + (size_t)item * 4096 + lane * 64 + 8 * wave) = (u32x4){ko[0], ko[1], ko[2], ko[3]};
        if (lane == 63) { float* dec = (float*)(p.ws + WS_DEC) + (size_t)item * 64 + 8 * wave;
#pragma unroll
            for (int i = 0; i < 8; ++i) dec[i] = __expf(bl[i]); }
        bf16_t* vd = Vr + (tid >> 3) * GLV_LD + 16 * (tid & 7);
        *(u32x4*)vd = vpre.a; *(u32x4*)(vd + 8) = vpre.b;
    }
    __syncthreads();
    {
        f32x4 acc[4];
#pragma unroll
        for (int mb = 0; mb < 4; ++mb) acc[mb] = (f32x4){0.f, 0.f, 0.f, 0.f};
#pragma unroll
        for (int kk = 0; kk < 2; ++kk) {
            const int srow = 32 * kk + 8 * fq + (fr >> 2);
            const bf16_t* bp_ = Vr + srow * GLV_LD + 16 * wave + 4 * (fr & 3);
            const bf16x8 bfr = tr_operand(bp_, bp_ + 4 * GLV_LD);
#pragma unroll
            for (int mb = 0; mb < 4; ++mb) { const bf16_t* ap = Kr + srow * GLK_LD + 16 * mb + 4 * (fr & 3); acc[mb] = MFMA16(tr_operand(ap, ap + 4 * GLK_LD), bfr, acc[mb]); }
        }
        float* loct = (float*)(p.ws + WS_LOCT) + (size_t)item * 8192 + (16 * wave + fr) * 64 + 4 * fq;
#pragma unroll
        for (int mb = 0; mb < 4; ++mb) *(f32x4*)(loct + 16 * mb) = acc[mb];
    }
    __syncthreads();
}
__device__ __forceinline__ void gla_scan(const Params& p, int tid, int bx) {
    const float* loct = (const float*)(p.ws + WS_LOCT); const float* dec = (const float*)(p.ws + WS_DEC);
    bf16_t* ST = (bf16_t*)(p.ws + WS_ST);
    for (int e = bx * 512 + tid; e < 16 * 8192; e += gridDim.x * 512) {
        const int bh = e >> 13, r = e & 8191, dk = r & 63;
        float lo[32], de[32];
#pragma unroll
        for (int c = 0; c < 32; ++c) { const size_t it = (size_t)bh * 32 + c; lo[c] = loct[it * 8192 + r]; de[c] = dec[it * 64 + dk]; }
        float s = 0.f;
#pragma unroll
        for (int c = 0; c < 32; ++c) { const size_t it = (size_t)bh * 32 + c;
            ST[it * 8192 + r] = f2bf(s);
            s = s * de[c] + lo[c]; }
    }
}
constexpr int GO_LD = 72, GOV_LD = 136;
constexpr int GO_QD = 0, GO_KD = 64 * GO_LD, GO_ST = 2 * 64 * GO_LD, GO_VT = GO_ST + 128 * GO_LD, GO_IMG = GO_VT + 128 * GO_LD;
__device__ __forceinline__ void gla_out_pair(const Params& p, int l, int pit, unsigned char* lds, int tid, int wave, int lane) {
    const int bh2 = pit >> 5, c = pit & 31, h = bh2 & 3;
    const int fr = lane & 15, fq = lane >> 4;
    bf16_t* img = (bf16_t*)lds;
    float* red = (float*)(lds + 2 * GO_IMG * 2);
    const bf16_t* proj = (const bf16_t*)(p.ws + WS_PROJ);
    bf16_t* Y = (bf16_t*)(p.ws + WS_Y);
    const int tb = wave & 3, dh = wave >> 2, t = 16 * tb + fr;
    int item[2], tok[2];
    item[0] = bh2 * 32 + c; item[1] = (bh2 + 8) * 32 + c;
    tok[0] = (bh2 >> 2) * SEQ + c * 64 + t; tok[1] = ((bh2 >> 2) + 2) * SEQ + c * 64 + t;
    {
        const int r8 = tid >> 3, ch = (tid & 7) * 8;
        u32x4 cq[2], ck[2], cs[2][2], cv[2][2];
        const int tokb[2] = {(bh2 >> 2) * SEQ + c * 64, ((bh2 >> 2) + 2) * SEQ + c * 64};
#pragma unroll
        for (int q2 = 0; q2 < 2; ++q2) {
            cq[q2] = *(const u32x4*)((const bf16_t*)(p.ws + WS_QD) + (size_t)item[q2] * 4096 + r8 * 64 + ch);
            ck[q2] = *(const u32x4*)((const bf16_t*)(p.ws + WS_KD) + (size_t)item[q2] * 4096 + r8 * 64 + ch);
#pragma unroll
            for (int i = 0; i < 2; ++i) {
                cs[q2][i] = *(const u32x4*)((const bf16_t*)(p.ws + WS_ST) + (size_t)item[q2] * 8192 + (r8 + 64 * i) * 64 + ch);
                cv[q2][i] = *(const u32x4*)(proj + (size_t)(tokb[q2] + r8) * NPROJ + C_CV + h * 128 + ch + 64 * i);
            }
        }
#pragma unroll
        for (int q2 = 0; q2 < 2; ++q2) {
            bf16_t* im = img + q2 * GO_IMG;
            *(u32x4*)(im + GO_QD + r8 * GO_LD + ch) = cq[q2]; *(u32x4*)(im + GO_KD + r8 * GO_LD + ch) = ck[q2];
#pragma unroll
            for (int i = 0; i < 2; ++i) { *(u32x4*)(im + GO_ST + (r8 + 64 * i) * GO_LD + ch) = cs[q2][i]; *(u32x4*)(im + GO_VT + r8 * GOV_LD + ch + 64 * i) = cv[q2][i]; }
        }
    }
    u32x4 zf[2][2]; f32x4 gf[4];
#pragma unroll
    for (int mp = 0; mp < 2; ++mp) {
        const int dv = 64 * dh + 32 * mp + 8 * fq;
        gf[2 * mp] = *(const f32x4*)(p.gla_ng + l * 128 + dv); gf[2 * mp + 1] = *(const f32x4*)(p.gla_ng + l * 128 + dv + 4);
#pragma unroll
        for (int q2 = 0; q2 < 2; ++q2) zf[q2][mp] = *(const u32x4*)(proj + (size_t)tok[q2] * NPROJ + C_Z + 1536 + h * 128 + dv);
    }
    __syncthreads();
    f32x4 acc[2][4];
#pragma unroll
    for (int q2 = 0; q2 < 2; ++q2) {
        const bf16_t* im = img + q2 * GO_IMG;
        bf16x8 bq[2];
#pragma unroll
        for (int kk = 0; kk < 2; ++kk) bq[kk] = *(const bf16x8*)(im + GO_QD + t * GO_LD + 32 * kk + 8 * fq);
        f32x4 sc[4];
#pragma unroll
        for (int mb = 0; mb < 4; ++mb) {
            sc[mb] = (f32x4){0.f, 0.f, 0.f, 0.f};
            if (mb <= tb) {
#pragma unroll
                for (int kk = 0; kk < 2; ++kk) { const bf16x8 a = *(const bf16x8*)(im + GO_KD + (16 * mb + fr) * GO_LD + 32 * kk + 8 * fq); sc[mb] = MFMA16(a, bq[kk], sc[mb]); }
#pragma unroll
                for (int j = 0; j < 4; ++j) if (16 * mb + 4 * fq + j > t) sc[mb][j] = 0.f;
            }
        }
        bf16x8 bp[2];
#pragma unroll
        for (int k2 = 0; k2 < 2; ++k2)
            bp[k2] = __builtin_bit_cast(bf16x8, (u32x4){cvt_pk_bf16(sc[2 * k2][0], sc[2 * k2][1]), cvt_pk_bf16(sc[2 * k2][2], sc[2 * k2][3]),
                                                        cvt_pk_bf16(sc[2 * k2 + 1][0], sc[2 * k2 + 1][1]), cvt_pk_bf16(sc[2 * k2 + 1][2], sc[2 * k2 + 1][3])});
        float ssq = 0.f;
#pragma unroll
        for (int mb = 0; mb < 4; ++mb) {
            const int dvrow = 64 * dh + 32 * (mb >> 1) + 8 * (fr >> 2) + 4 * (mb & 1) + (fr & 3);
            acc[q2][mb] = (f32x4){0.f, 0.f, 0.f, 0.f};
#pragma unroll
            for (int k2 = 0; k2 < 2; ++k2) {
                const bf16_t* vp = im + GO_VT + (32 * k2 + 4 * fq + (fr >> 2)) * GOV_LD + 64 * dh + 32 * (mb >> 1) + 8 * (fr & 3) + 4 * (mb & 1);
                acc[q2][mb] = MFMA16(tr_operand(vp, vp + 16 * GOV_LD), bp[k2], acc[q2][mb]);
            }
#pragma unroll
            for (int kk = 0; kk < 2; ++kk) { const bf16x8 a = *(const bf16x8*)(im + GO_ST + dvrow * GO_LD + 32 * kk + 8 * fq); acc[q2][mb] = MFMA16(a, bq[kk], acc[q2][mb]); }
            ssq += (acc[q2][mb][0] * acc[q2][mb][0] + acc[q2][mb][1] * acc[q2][mb][1]) + (acc[q2][mb][2] * acc[q2][mb][2] + acc[q2][mb][3] * acc[q2][mb][3]);
        }
        ssq += __shfl_xor(ssq, 16); ssq += __shfl_xor(ssq, 32);
        if (fq == 0) red[(q2 * 2 + dh) * 64 + t] = ssq;
    }
    __syncthreads();
#pragma unroll
    for (int q2 = 0; q2 < 2; ++q2) {
        const float rstd = rsqrtf((red[(q2 * 2) * 64 + t] + red[(q2 * 2 + 1) * 64 + t]) * (1.f / 128.f) + EPS);
#pragma unroll
        for (int mp = 0; mp < 2; ++mp) {
            const int col = 1536 + h * 128 + 64 * dh + 32 * mp + 8 * fq;
            const u32x4 z = zf[q2][mp];
            const f32x4 a = acc[q2][2 * mp] * rstd * gf[2 * mp], b3 = acc[q2][2 * mp + 1] * rstd * gf[2 * mp + 1];
            u32x4 y; y.x = cvt_pk_bf16(a[0] * bf_lo(z.x), a[1] * bf_hi(z.x)); y.y = cvt_pk_bf16(a[2] * bf_lo(z.y), a[3] * bf_hi(z.y));
            y.z = cvt_pk_bf16(b3[0] * bf_lo(z.z), b3[1] * bf_hi(z.z)); y.w = cvt_pk_bf16(b3[2] * bf_lo(z.w), b3[3] * bf_hi(z.w));
            *(u32x4*)(Y + (size_t)tok[q2] * D + col) = y;
        }
    }
    __syncthreads();
}

#define XB_TMO      128
#define XB_XCNT(j)  (256  + 64 * (j))
#define XB_XSUB(j)  (1280 + 64 * (j))
#define XB_XGEN(j)  (2304 + 64 * (j))
#define XB_TOP      3328
#define XB_TOPGEN   3392
#define XCD_BAR_WORDS 3456
#define XB_SPIN_CAP (1u << 18)
__device__ __forceinline__ unsigned xb_ld(unsigned* p)              { return __hip_atomic_load(p, __ATOMIC_RELAXED, __HIP_MEMORY_SCOPE_AGENT); }
__device__ __forceinline__ unsigned xb_add(unsigned* p, unsigned v) { return __hip_atomic_fetch_add(p, v, __ATOMIC_RELAXED, __HIP_MEMORY_SCOPE_AGENT); }
__device__ __forceinline__ unsigned xb_xcc_id() { return (unsigned)__builtin_amdgcn_s_getreg((3 << 11) | 20) & 0xFu; }
#define XB_SPIN(cond, bar) do { unsigned _sp = 0; while (cond) { __builtin_amdgcn_s_sleep(1); \
    if ((++_sp & 255u) == 0u) { if (xb_ld(&(bar)[XB_TMO])) break; if (_sp > XB_SPIN_CAP) { atomicAdd(&(bar)[XB_TMO], 1u); break; } } } } while (0)
__device__ __forceinline__ void xcd_barrier_complete(unsigned* bar, unsigned x, unsigned& nloc, unsigned& nx) {
    const unsigned G = gridDim.x * gridDim.y * gridDim.z;
    unsigned sum, cnt, mine, sp = 0u;
    for (;;) {
        sum = 0u; cnt = 0u; mine = 0u;
#pragma unroll
        for (unsigned j = 0; j < 16; ++j) { const unsigned c = xb_ld(&bar[XB_XCNT(j)]); sum += c; cnt += (c > 0u) ? 1u : 0u; mine = (j == x) ? c : mine; }
        if (sum == G) break;
        __builtin_amdgcn_s_sleep(1);
        if ((++sp & 255u) == 0u) { if (xb_ld(&bar[XB_TMO])) break; if (sp > XB_SPIN_CAP) { atomicAdd(&bar[XB_TMO], 1u); break; } }
    }
    nloc = mine > 0u ? mine : 1u; nx = cnt > 0u ? cnt : 1u;
}
__device__ __forceinline__ void xcd_barrier(unsigned* bar, volatile LAS unsigned* st) {
    asm volatile("s_waitcnt vmcnt(0)" ::: "memory");
    __syncthreads();
    if (threadIdx.x == 0) {
        __builtin_amdgcn_s_waitcnt(0);
        const unsigned x = xb_xcc_id();
        unsigned nloc = st[0], nx = st[1];
        if (nloc == 0u) { xcd_barrier_complete(bar, x, nloc, nx); st[0] = nloc; st[1] = nx; }
        const unsigned old = xb_add(&bar[XB_XSUB(x)], 1u);
        const unsigned gen = old / nloc;
        if (old + 1u == (gen + 1u) * nloc) {
            __builtin_amdgcn_fence(__ATOMIC_RELEASE, "agent");
            asm volatile("s_waitcnt vmcnt(0)" ::: "memory");
            const unsigned og = xb_add(&bar[XB_TOP], 1u);
            const unsigned tg = og / nx;
            if (og + 1u == (tg + 1u) * nx) xb_add(&bar[XB_TOPGEN], 1u);
            else XB_SPIN(xb_ld(&bar[XB_TOPGEN]) == tg, bar);
            __builtin_amdgcn_fence(__ATOMIC_ACQUIRE, "agent");
            xb_add(&bar[XB_XGEN(x)], 1u);
            asm volatile("s_waitcnt vmcnt(0)" ::: "memory");
        } else {
            XB_SPIN(xb_ld(&bar[XB_XGEN(x)]) == gen, bar);
            __builtin_amdgcn_fence(__ATOMIC_ACQUIRE, "agent");
            asm volatile("s_waitcnt vmcnt(0)" ::: "memory");
        }
    }
    __syncthreads();
}

constexpr int N_PHASES = 14;
__global__ void __launch_bounds__(512, 2) fwd_kernel(Params p) {
    extern __shared__ __attribute__((aligned(16))) unsigned char lds[];
    const int G = gridDim.x;
    const int lo = p.ph_lo, hi = p.ph_hi;
    unsigned* const xbar = (unsigned*)(p.ws + WS_BAR);
    volatile LAS unsigned* const xst = (volatile LAS unsigned*)((LAS unsigned char*)lds + 131072 + 64);
    if (threadIdx.x < 2) xst[threadIdx.x] = 0u;
    __syncthreads();
    if (lo < 0) cg::this_grid().sync();
    if (hi - lo > 1 && threadIdx.x == 0) (void)xb_add(&xbar[XB_XCNT(xb_xcc_id())], 1u);
#ifndef PHMASK
#define PHMASK 0xffff
#endif
#define IN(k) (((PHMASK >> ((k) < 2 ? (k) : 2 + ((k) - 2) % 6)) & 1) && lo <= (k) && (k) < hi)
#define SEAM(k) do { STAMP(2 * (k)); if (IN(k) && IN((k) + 1)) { xcd_barrier(xbar, xst); } STAMP(2 * (k) + 1); } while (0)
#define FRESH() int tid = threadIdx.x; asm volatile("" : "+v"(tid)); int bx = blockIdx.x; asm volatile("" : "+s"(bx)); \
    const int lane = tid & 63, wave = __builtin_amdgcn_readfirstlane(tid >> 6); \
    const Params q = fresh_params(p); (void)lane; (void)wave; (void)bx;
    unsigned long long tacc = 0ull, tprev = (PMASK != 0ull) ? __builtin_amdgcn_s_memrealtime() : 0ull;
#define STAMP(idx) do { if (PMASK != 0ull) { const unsigned long long now_ = __builtin_amdgcn_s_memrealtime(); if ((PMASK >> (idx)) & 1ull) tacc += now_ - tprev; tprev = now_; } } while (0)
    if (IN(0)) for (int rep = 0; rep < REPN(0); ++rep) { FRESH(); mod_items(q, 0, lds, tid, wave, lane, bx); __syncthreads(); }
    SEAM(0);
    if (IN(1)) for (int rep = 0; rep < REPN(1); ++rep) { FRESH(); mod_items(q, 1, lds, tid, wave, lane, bx); __syncthreads(); STAMP(32); p0_convert(q, lds, tid, wave, lane, bx); STAMP(33); row_pass(q, 0, wave, lane, bx); }
    SEAM(1);
#pragma unroll 1
    for (int l = 0; l < 2; ++l) {
        const int pb = 2 + 6 * l;
        if (IN(pb)) for (int rep = 0; rep < REPN(2); ++rep) {
            FRESH();
            pg8::Gemm g{(const bf16_t*)(q.ws + WS_H), (const bf16_t*)(q.ws + WS_WIN + (size_t)l * WIN_BYTES), M, NPAD, D};
            pg8::StaticOrder S; S.init(M, NPAD, G, bx);
            pg8::EpiProj E{(bf16_t*)(q.ws + WS_PROJ), (float*)(q.ws + WS_CG), (float*)(q.ws + WS_SGST)};
            pg8::gemm_phase<pg8::EpiProj, pg8::StaticOrder, true, true>((LAS unsigned char*)lds, g, S, E, tid);
        }
        SEAM(pb);
        if (IN(pb + 1)) for (int rep = 0; rep < REPN(3); ++rep) {
#ifndef MIXMASK
#define MIXMASK 7
#endif
            for (int rr = 0; rr < ((MIXR >> 0) & 15); ++rr) { FRESH(); for (int it = bx; it < 256; it += G) attn_item(q, l, it, lds, tid, wave, lane); }
            STAMP(36 + 4 * l); for (int rr = 0; rr < ((MIXR >> 4) & 15); ++rr) { FRESH(); for (int it = bx; it < 256; it += G) sg_pair_item(q, l, it, lds, tid, wave, lane); } STAMP(37 + 4 * l);
            for (int rr = 0; rr < ((MIXR >> 8) & 15); ++rr) { FRESH(); for (int it = bx; it < 512; it += G) gla_local_item(q, l, it, lds, tid, wave, lane); }
        }
        SEAM(pb + 1);
        if (IN(pb + 2)) for (int rep = 0; rep < REPN(4); ++rep) { FRESH(); gla_scan(q, tid, bx); }
        SEAM(pb + 2);
        if (IN(pb + 3)) for (int rep = 0; rep < REPN(5); ++rep) { FRESH(); for (int it = bx; it < 256; it += G) gla_out_pair(q, l, it, lds, tid, wave, lane); }
        SEAM(pb + 3);
        if (IN(pb + 4)) for (int rep = 0; rep < REPN(6); ++rep) {
            FRESH();
            pg8::Gemm g{(const bf16_t*)(q.ws + WS_Y), (const bf16_t*)(q.ws + WS_WOUT + (size_t)l * WOUT_BYTES), M, D, D};
            pg8::StaticOrder S; S.init(M, D, G, bx);
            pg8::EpiOut E{(bf16_t*)(q.ws + WS_OUT)};
            pg8::gemm_phase<pg8::EpiOut, pg8::StaticOrder, true, true>((LAS unsigned char*)lds, g, S, E, tid);
        }
        SEAM(pb + 4);
        if (IN(pb + 5)) { FRESH(); row_pass(q, l + 1, wave, lane, bx); }
        if (l == 0) SEAM(pb + 5);
    }
    STAMP(26);
    if (PMASK != 0ull) { if (blockIdx.x == 0 && threadIdx.x == 0) { const unsigned long long t0 = __builtin_amdgcn_s_memrealtime(); while (__builtin_amdgcn_s_memrealtime() - t0 < tacc) __builtin_amdgcn_s_sleep(8); } }
#undef IN
#undef SEAM
#undef FRESH
}

extern "C" void kernel_launch(void* const* d_in, const int* in_sizes, int n_in, void* d_out, int out_size, void* d_ws, size_t ws_size, hipStream_t stream) {
    static int grid = 0;
    if (grid == 0) {
        if (n_in != 17 || in_sizes[0] != M * D || out_size != M * D || ws_size < WS_END) { fprintf(stderr, "kernel_launch: unexpected shapes (n_in %d, in0 %d, out %d, ws %zu)\n", n_in, n_in > 0 ? in_sizes[0] : -1, out_size, ws_size); grid = -1; return; }
        int dev = 0, cus = 0, per_cu = 0;
        if (hipGetDevice(&dev) != hipSuccess || hipDeviceGetAttribute(&cus, hipDeviceAttributeMultiprocessorCount, dev) != hipSuccess) { grid = -1; return; }
        if (hipFuncSetAttribute((const void*)fwd_kernel, hipFuncAttributeMaxDynamicSharedMemorySize, LDS_BYTES) != hipSuccess) { fprintf(stderr, "kernel_launch: hipFuncSetAttribute failed\n"); grid = -1; return; }
        if (hipOccupancyMaxActiveBlocksPerMultiprocessor(&per_cu, (const void*)fwd_kernel, 512, LDS_BYTES) != hipSuccess || per_cu < 1) { fprintf(stderr, "kernel_launch: occupancy query says %d blocks per CU\n", per_cu); per_cu = 1; }
        (void)hipGetLastError();
        grid = cus;
    }
    if (grid < 0) return;
    Params p{};
    p.x = (const float*)d_in[0]; p.c = (const float*)d_in[1]; p.pos = (const int*)d_in[2]; p.w_mod = (const float*)d_in[3]; p.b_mod = (const float*)d_in[4];
    p.g_pre = (const float*)d_in[5]; p.g_post = (const float*)d_in[6]; p.w_in = (const float*)d_in[7]; p.w_out = (const float*)d_in[8]; p.sinks = (const float*)d_in[9];
    p.sg_w = (const float*)d_in[10]; p.sg_b = (const float*)d_in[11]; p.sg_ln_g = (const float*)d_in[12]; p.sg_ln_b = (const float*)d_in[13];
    p.gla_wup = (const float*)d_in[14]; p.gla_bg = (const float*)d_in[15]; p.gla_ng = (const float*)d_in[16];
    p.out = (float*)d_out; p.ws = (unsigned char*)d_ws;
#if MK_SINGLE
    if (hipMemsetAsync((char*)d_ws + WS_BAR, 0, XCD_BAR_WORDS * 4, stream) != hipSuccess) { fprintf(stderr, "kernel_launch: memset failed\n"); return; }
    p.ph_lo = 0; p.ph_hi = N_PHASES;
    void* args[] = {&p};
    hipError_t e = hipLaunchCooperativeKernel((const void*)fwd_kernel, dim3(grid), dim3(512), args, LDS_BYTES, stream);
    if (e != hipSuccess) fprintf(stderr, "kernel_launch: cooperative launch failed: %s (grid %d)\n", hipGetErrorString(e), grid);
#else
    for (int ph = 0; ph < N_PHASES; ++ph) {
        p.ph_lo = ph; p.ph_hi = ph + 1;
        hipLaunchKernelGGL(fwd_kernel, dim3(grid), dim3(512), LDS_BYTES, stream, p);
    }
#endif
}
```

```cpp
#include <hip/hip_runtime.h>
#include <hip/hip_cooperative_groups.h>
#include <cstdio>
#include <cstdint>
namespace cg = cooperative_groups;

#ifndef REPS
#define REPS 0x11111111
#endif
#define REPN(k) ((REPS >> (4 * (k))) & 15)
#ifndef PMASK
#define PMASK 0ull
#endif
#ifndef MIXR
#define MIXR 0x111
#endif
#ifndef MK_SINGLE
#define MK_SINGLE 1
#endif

#define LAS __attribute__((address_space(3)))
typedef unsigned short bf16_t;
typedef short bf16x8 __attribute__((ext_vector_type(8)));
typedef float f32x4 __attribute__((ext_vector_type(4)));
typedef float f32x2 __attribute__((ext_vector_type(2)));
typedef unsigned u32x4 __attribute__((ext_vector_type(4)));
typedef unsigned u32x2 __attribute__((ext_vector_type(2)));

constexpr int D = 2048, NB = 4, SEQ = 2048, M = NB * SEQ;
constexpr int NPROJ = 5632;
constexpr int NPAD = 5888;
constexpr int WIN_LD = 5648;
constexpr float EPS = 1e-6f;
constexpr int C_AQ = 0, C_AK = 1024, C_AV = 1280, C_SU = 1536, C_SV = 2048, C_CQ = 2560, C_CK = 2816, C_CV = 3072, C_Z = 3584;
constexpr float LOG2E = 1.4426950408889634f;

constexpr size_t MiB = 1u << 20;
constexpr size_t WS_WIN = 0, WIN_BYTES = (size_t)NPAD * D * 2;
constexpr size_t WS_WOUT = 46 * MiB, WOUT_BYTES = (size_t)D * D * 2;
constexpr size_t WS_H = 62 * MiB, WS_PROJ = 94 * MiB, WS_CG = 182 * MiB, WS_MOD = 183 * MiB, WS_Y = 184 * MiB, WS_OUT = 216 * MiB;
constexpr size_t WS_LOCT = 248 * MiB, WS_ST = 264 * MiB, WS_DEC = 272 * MiB, WS_BAR = 273 * MiB, WS_QD = 274 * MiB, WS_KD = 278 * MiB, WS_VTG = 282 * MiB, WS_X1B = 290 * MiB, WS_SGST = 322 * MiB, WS_SGW = 323 * MiB, WS_END = 324 * MiB;

constexpr int LDS_BYTES = 135168;

struct Params {
    const float* x; const float* c; const int* pos; const float* w_mod; const float* b_mod; const float* g_pre; const float* g_post;
    const float* w_in; const float* w_out; const float* sinks; const float* sg_w; const float* sg_b; const float* sg_ln_g; const float* sg_ln_b;
    const float* gla_wup; const float* gla_bg; const float* gla_ng;
    float* out; unsigned char* ws; int ph_lo, ph_hi;
};

__device__ __forceinline__ Params fresh_params(const Params& p) {
#if defined(__HIP_DEVICE_COMPILE__)
    typedef unsigned long long u64;
    const __attribute__((address_space(4))) u64* pp = (const __attribute__((address_space(4))) u64*)__builtin_amdgcn_kernarg_segment_ptr();
    asm volatile("" : "+s"(pp));
    Params q; u64* dst = (u64*)&q;
#pragma unroll
    for (int i = 0; i < (int)(sizeof(Params) / 8); ++i) dst[i] = pp[i];
    return q;
#else
    return p;
#endif
}
static_assert(sizeof(Params) % 8 == 0, "Params is copied in 8-byte words");

typedef __bf16 bf16x2_t __attribute__((ext_vector_type(2)));
__device__ __forceinline__ unsigned cvt_pk_bf16(float lo, float hi) { const f32x2 v = {lo, hi}; const bf16x2_t b = __builtin_convertvector(v, bf16x2_t); return __builtin_bit_cast(unsigned, b); }
__device__ __forceinline__ float bf_lo(unsigned u) { return __builtin_bit_cast(float, u << 16); }
__device__ __forceinline__ float bf_hi(unsigned u) { return __builtin_bit_cast(float, u & 0xffff0000u); }
__device__ __forceinline__ float bf1(bf16_t v) { return __builtin_bit_cast(float, (unsigned)v << 16); }
__device__ __forceinline__ bf16_t f2bf(float f) { return (bf16_t)(cvt_pk_bf16(f, 0.f) & 0xffffu); }
__device__ __forceinline__ float fast_exp2(float x) { return __builtin_amdgcn_exp2f(x); }
__device__ __forceinline__ float fast_rcp(float x) { return __builtin_amdgcn_rcpf(x); }
__device__ __forceinline__ float silu_f(float x) { return x * fast_rcp(1.f + fast_exp2(-x * LOG2E)); }
__device__ __forceinline__ float gelu_tanh_f(float x) { const float u = 0.7978845608028654f * (x + 0.044715f * x * x * x); return x * fast_rcp(1.f + fast_exp2(-2.f * LOG2E * u)); }
__device__ __forceinline__ float wave_sum(float v) {
#pragma unroll
    for (int o = 1; o < 64; o <<= 1) v += __shfl_xor(v, o);
    return v;
}

typedef short v4i16_t __attribute__((ext_vector_type(4)));
__device__ __forceinline__ bf16x8 tr_operand(const void* p0, const void* p1) {
    const v4i16_t a = __builtin_amdgcn_ds_read_tr16_b64_v4i16((__attribute__((address_space(3))) v4i16_t*)p0);
    const v4i16_t b = __builtin_amdgcn_ds_read_tr16_b64_v4i16((__attribute__((address_space(3))) v4i16_t*)p1);
    return __builtin_shufflevector(a, b, 0, 1, 2, 3, 4, 5, 6, 7);
}
#define MFMA16(a, b, c) __builtin_amdgcn_mfma_f32_16x16x32_bf16((a), (b), (c), 0, 0, 0)

namespace pg8 {
#define PG8_LAS __attribute__((address_space(3)))
constexpr int BM = 256, BK = 64, HALF = 128, HTB = HALF * BK * 2, STAGE_BYTES = 8 * HTB, NXCD = 8, WGM = 8;
__host__ __device__ __forceinline__ int lds_byte(int r, int c) { const int st = (r >> 4) * 2 + (c >> 5), rr = r & 15, cc = c & 31, ob = rr * 64 + cc * 2; return st * 1024 + (ob ^ (((ob >> 9) & 1) << 5)); }
__host__ __device__ __forceinline__ void stage_rc(int b, int& R, int& C) { const int st = b / 1024, sb = b % 1024, swz = sb ^ (((sb >> 9) & 1) << 5); R = (st >> 1) * 16 + swz / 64; C = (st & 1) * 32 + (swz % 64) / 2; }
__host__ __device__ __forceinline__ int perm32(int rho) { const int n = rho >> 4, i = rho & 15; return 8 * (i >> 2) + 4 * n + (i & 3); }
struct Unit { int pm, pn; };
struct Gemm { const bf16_t* A; const bf16_t* Bt; int M, N, K; };
struct StaticOrder {
    int nM, nN, nwg, G, c;
    __host__ __device__ void init(int M_, int N_, int G_, int c_) { nM = M_ / BM; nN = N_ / BM; nwg = nM * nN; G = G_; c = c_; }
    __host__ __device__ bool next(int i, Unit& u) const {
        const long L = (long)i * G + c; if (L >= nwg) return false;
        int wgid = (int)L; { const int q = nwg / NXCD, r = nwg % NXCD, xcd = wgid % NXCD, off = wgid / NXCD; wgid = (xcd < r ? xcd * (q + 1) : r * (q + 1) + (xcd - r) * q) + off; }
        const int nig = WGM * nN, gid = wgid / nig, fm = gid * WGM, gsz = (nM - fm) < WGM ? (nM - fm) : WGM;
        u.pm = fm + ((wgid % nig) % gsz); u.pn = (wgid % nig) / gsz; return true;
    }
    __device__ __forceinline__ void a_ready(const Unit&) const {}
    __device__ __forceinline__ void done(const Unit&) const {}
};

template <class Epi, class Sched, bool ALIGN_EPI = false, bool SP2 = false>
__device__ __forceinline__ void gemm_phase(PG8_LAS unsigned char* lds, const Gemm g, const Sched& S, const Epi& E, const int tid) {
    const int wid = __builtin_amdgcn_readfirstlane(tid >> 6), lane = tid & 63, wr = wid >> 2, wc = wid & 3, fr = lane & 15, fq = lane >> 4;
    const int K = g.K, nt = K / BK;
    unsigned voffA[2], voffB[2];
#pragma unroll
    for (int i = 0; i < 2; ++i) { int R, C; stage_rc(tid * 16 + i * 8192, R, C); const int Rb = Epi::PERM ? ((R & ~31) + perm32(R & 31)) : R;
        voffA[i] = (unsigned)(R * K + C) * 2u; voffB[i] = (unsigned)(Rb * K + C) * 2u; }
    const size_t kstep = (size_t)(BK * 2);
    const size_t hstep = (size_t)HALF * K * 2;
    const size_t tstep = 2 * hstep;
    const unsigned ldsw = (unsigned)wid * 1024u;
    const int aoff = lds_byte(wr * 64 + fr, fq * 8), boff = lds_byte(wc * 32 + fr, fq * 8);
#define PG8_SA(b, h) (((b) * 2 + (h)) * HTB)
#define PG8_SB(b, h) ((4 + (b) * 2 + (h)) * HTB)
#define PG8_STAGE(bufoff, gbase, voff) do { _Pragma("unroll") for (int _i = 0; _i < 2; ++_i) \
        __builtin_amdgcn_global_load_lds((const unsigned*)((const char*)(gbase) + (voff)[_i]), (PG8_LAS unsigned*)(lds + (bufoff) + ldsw + _i * 8192), 16, 0, 0); } while (0)
#define PG8_LDA(dst, b, h) do { _Pragma("unroll") for (int m = 0; m < 4; ++m) _Pragma("unroll") for (int k = 0; k < 2; ++k) dst[m][k] = *(const PG8_LAS bf16x8*)(lds + PG8_SA(b, h) + aoff + m * 2048 + k * 1024); } while (0)
#define PG8_LDB(dst, b, h) do { _Pragma("unroll") for (int n = 0; n < 2; ++n) _Pragma("unroll") for (int k = 0; k < 2; ++k) dst[n][k] = *(const PG8_LAS bf16x8*)(lds + PG8_SB(b, h) + boff + n * 2048 + k * 1024); } while (0)
#define PG8_MMA(ai, bj, At, Bt) do { __builtin_amdgcn_s_setprio(1); _Pragma("unroll") for (int m = 0; m < 4; ++m) _Pragma("unroll") for (int n = 0; n < 2; ++n) _Pragma("unroll") for (int k = 0; k < 2; ++k) \
        acc[ai][bj][m][n] = __builtin_amdgcn_mfma_f32_16x16x32_bf16(Bt[n][k], At[m][k], acc[ai][bj][m][n], 0, 0, 0); __builtin_amdgcn_s_setprio(0); } while (0)
#define PG8_WAIT_V(n) asm volatile("s_waitcnt vmcnt(" #n ")" ::: "memory")
#define PG8_WAIT_L(n) asm volatile("s_waitcnt lgkmcnt(" #n ")" ::: "memory")
#define PG8_BAR __builtin_amdgcn_s_barrier()
#define PG8_SCHED __builtin_amdgcn_sched_barrier(0)
    Unit cur, nxt; int ui = 0;
    if (!S.next(0, cur)) return;
    f32x4 acc[2][2][4][2];
#pragma unroll
    for (int a = 0; a < 2; ++a)
#pragma unroll
        for (int b = 0; b < 2; ++b)
#pragma unroll
            for (int m = 0; m < 4; ++m)
#pragma unroll
                for (int n = 0; n < 2; ++n) acc[a][b][m][n] = (f32x4){0.f, 0.f, 0.f, 0.f};
    bf16x8 At[4][2], B0[2][2], B1[2][2];
    const char* cA = (const char*)g.A + (size_t)cur.pm * tstep; const char* cB = (const char*)g.Bt + (size_t)cur.pn * tstep;
    S.a_ready(cur);
    if constexpr (SP2) {
        PG8_STAGE(PG8_SB(0, 0), cB, voffB); PG8_STAGE(PG8_SB(0, 1), cB + hstep, voffB); PG8_STAGE(PG8_SA(0, 0), cA, voffA); PG8_STAGE(PG8_SA(0, 1), cA + hstep, voffA);
        if (wr == 1) PG8_BAR;
        PG8_WAIT_V(2); PG8_BAR;
        PG8_STAGE(PG8_SB(1, 0), cB + kstep, voffB); PG8_STAGE(PG8_SA(1, 0), cA + kstep, voffA); PG8_STAGE(PG8_SB(1, 1), cB + hstep + kstep, voffB);
        PG8_WAIT_V(6); PG8_BAR;
    } else {
        PG8_STAGE(PG8_SB(0, 0), cB, voffB); PG8_STAGE(PG8_SA(0, 0), cA, voffA); PG8_STAGE(PG8_SB(0, 1), cB + hstep, voffB); PG8_STAGE(PG8_SA(0, 1), cA + hstep, voffA);
        if (wr == 1) PG8_BAR;
        PG8_WAIT_V(4); PG8_BAR;
        PG8_STAGE(PG8_SB(1, 0), cB + kstep, voffB); PG8_STAGE(PG8_SA(1, 0), cA + kstep, voffA); PG8_STAGE(PG8_SB(1, 1), cB + hstep + kstep, voffB);
        PG8_WAIT_V(6); PG8_BAR;
    }
    for (;;) {
        const bool has_next = S.next(ui + 1, nxt);
        const char* nA = has_next ? (const char*)g.A + (size_t)nxt.pm * tstep : cA; const char* nB = has_next ? (const char*)g.Bt + (size_t)nxt.pn * tstep : cB;
        for (int t = 0; t < nt; t += 2) {
            const bool last = (t == nt - 2);
            const char* a1 = cA + (size_t)(t + 1) * kstep;
            const char* a2 = last ? nA : cA + (size_t)(t + 2) * kstep; const char* b2 = last ? nB : cB + (size_t)(t + 2) * kstep;
            const char* a3 = a2 + kstep; const char* b3 = b2 + kstep;
            if (last && has_next) S.a_ready(nxt);
            if constexpr (SP2) {
            PG8_LDB(B0, 0, 0); PG8_LDB(B1, 0, 1); PG8_SCHED; PG8_LDA(At, 0, 0); PG8_STAGE(PG8_SA(1, 1), a1 + hstep, voffA);
            PG8_WAIT_V(8); PG8_WAIT_L(0); PG8_BAR; PG8_MMA(0, 0, At, B0); PG8_MMA(0, 1, At, B1); PG8_BAR; PG8_SCHED;
            PG8_LDA(At, 0, 1); PG8_STAGE(PG8_SB(0, 0), b2, voffB); PG8_STAGE(PG8_SB(0, 1), b2 + hstep, voffB); PG8_STAGE(PG8_SA(0, 0), a2, voffA);
            PG8_WAIT_V(8); PG8_WAIT_L(0); PG8_BAR; PG8_MMA(1, 0, At, B0); PG8_MMA(1, 1, At, B1); PG8_BAR; PG8_SCHED;
            PG8_LDB(B0, 1, 0); PG8_LDB(B1, 1, 1); PG8_SCHED; PG8_LDA(At, 1, 0); PG8_STAGE(PG8_SA(0, 1), a2 + hstep, voffA);
            PG8_WAIT_V(8); PG8_WAIT_L(0); PG8_BAR; PG8_MMA(0, 0, At, B0); PG8_MMA(0, 1, At, B1); PG8_BAR; PG8_SCHED;
            PG8_LDA(At, 1, 1); PG8_STAGE(PG8_SB(1, 0), b3, voffB); PG8_STAGE(PG8_SB(1, 1), b3 + hstep, voffB); PG8_STAGE(PG8_SA(1, 0), a3, voffA);
            PG8_WAIT_V(8); PG8_WAIT_L(0); PG8_BAR; PG8_MMA(1, 0, At, B0); PG8_MMA(1, 1, At, B1); PG8_BAR; PG8_SCHED;
            } else {
            PG8_LDB(B0, 0, 0); PG8_SCHED; PG8_LDA(At, 0, 0); PG8_STAGE(PG8_SA(1, 1), a1 + hstep, voffA);
            PG8_WAIT_L(8); PG8_BAR; PG8_WAIT_L(0); PG8_MMA(0, 0, At, B0); PG8_BAR; PG8_SCHED;
            PG8_LDB(B1, 0, 1); PG8_STAGE(PG8_SB(0, 0), b2, voffB);
            PG8_BAR; PG8_WAIT_L(0); PG8_MMA(0, 1, At, B1); PG8_BAR;
            PG8_LDA(At, 0, 1); PG8_STAGE(PG8_SA(0, 0), a2, voffA);
            PG8_BAR; PG8_WAIT_L(0); PG8_MMA(1, 0, At, B0); PG8_BAR; PG8_SCHED;
            PG8_STAGE(PG8_SB(0, 1), b2 + hstep, voffB);
            PG8_WAIT_V(6); PG8_BAR; PG8_MMA(1, 1, At, B1); PG8_BAR;
            PG8_LDB(B0, 1, 0); PG8_SCHED; PG8_LDA(At, 1, 0); PG8_STAGE(PG8_SA(0, 1), a2 + hstep, voffA);
            PG8_WAIT_L(8); PG8_BAR; PG8_WAIT_L(0); PG8_MMA(0, 0, At, B0); PG8_BAR; PG8_SCHED;
            PG8_LDB(B1, 1, 1); PG8_STAGE(PG8_SB(1, 0), b3, voffB);
            PG8_BAR; PG8_WAIT_L(0); PG8_MMA(0, 1, At, B1); PG8_BAR;
            PG8_LDA(At, 1, 1); PG8_STAGE(PG8_SA(1, 0), a3, voffA);
            PG8_BAR; PG8_WAIT_L(0); PG8_MMA(1, 0, At, B0); PG8_BAR; PG8_SCHED;
            PG8_STAGE(PG8_SB(1, 1), b3 + hstep, voffB);
            PG8_WAIT_V(6); PG8_BAR; PG8_MMA(1, 1, At, B1); PG8_BAR;
            }
        }
        if constexpr (ALIGN_EPI) { if (wr == 0) PG8_BAR; }
        E(acc, cur, wr, wc, fr, fq); S.done(cur);
        if (!has_next) break;
#pragma unroll
        for (int a = 0; a < 2; ++a)
#pragma unroll
            for (int b = 0; b < 2; ++b)
#pragma unroll
                for (int m = 0; m < 4; ++m)
#pragma unroll
                    for (int n = 0; n < 2; ++n) acc[a][b][m][n] = (f32x4){0.f, 0.f, 0.f, 0.f};
        cur = nxt; cA = nA; cB = nB; ++ui;
        if constexpr (ALIGN_EPI) { if (wr == 1) PG8_BAR; }
    }
    PG8_WAIT_V(0);
    if constexpr (!ALIGN_EPI) { if (wr == 0) PG8_BAR; }
    PG8_BAR;
#undef PG8_SA
#undef PG8_SB
#undef PG8_STAGE
#undef PG8_LDA
#undef PG8_LDB
#undef PG8_MMA
#undef PG8_WAIT_V
#undef PG8_WAIT_L
#undef PG8_BAR
#undef PG8_SCHED
}

struct EpiProj {
    static constexpr bool PERM = true;
    bf16_t* P; float* CG; float* SGST;
    template <int ACT> __device__ __forceinline__ void store_tile(const f32x4 (&acc)[2][2][4][2], bf16_t* base, float* stp, int fq) const {
#pragma unroll
        for (int ai = 0; ai < 2; ++ai)
#pragma unroll
            for (int m = 0; m < 4; ++m) { bf16_t* rowp = base + (size_t)(ai * HALF + m * 16) * NPROJ;
                float rs = 0.f, rq = 0.f;
#pragma unroll
                for (int bj = 0; bj < 2; ++bj) { f32x4 v0 = acc[ai][bj][m][0], v1 = acc[ai][bj][m][1];
                    if (ACT == 1) { for (int e = 0; e < 4; ++e) { v0[e] = gelu_tanh_f(v0[e]); v1[e] = gelu_tanh_f(v1[e]); } }
                    if (ACT == 2) { for (int e = 0; e < 4; ++e) { v0[e] = silu_f(v0[e]); v1[e] = silu_f(v1[e]); } }
                    if (ACT == 1) { rs += ((v0[0] + v0[1]) + (v0[2] + v0[3])) + ((v1[0] + v1[1]) + (v1[2] + v1[3]));
                        rq += ((v0[0] * v0[0] + v0[1] * v0[1]) + (v0[2] * v0[2] + v0[3] * v0[3])) + ((v1[0] * v1[0] + v1[1] * v1[1]) + (v1[2] * v1[2] + v1[3] * v1[3])); }
                    u32x4 w; w.x = cvt_pk_bf16(v0[0], v0[1]); w.y = cvt_pk_bf16(v0[2], v0[3]); w.z = cvt_pk_bf16(v1[0], v1[1]); w.w = cvt_pk_bf16(v1[2], v1[3]);
                    *(u32x4*)(rowp + bj * HALF) = w; }
                if (ACT == 1) { if (stp) { rs += __shfl_xor(rs, 16); rs += __shfl_xor(rs, 32); rq += __shfl_xor(rq, 16); rq += __shfl_xor(rq, 32);
                    if (fq == 0) *(f32x2*)(stp + (size_t)(ai * HALF + m * 16) * 16) = (f32x2){rs, rq}; } } }
    }
    __device__ __forceinline__ void operator()(const f32x4 (&acc)[2][2][4][2], const Unit& u, int wr, int wc, int fr, int fq) const {
        const int row0 = u.pm * BM + wr * 64 + fr;
        if (u.pn < 22) {
            bf16_t* base = P + (size_t)row0 * NPROJ + u.pn * BM + wc * 32 + 8 * fq;
            if (u.pn >= 6 && u.pn < 10) store_tile<1>(acc, base, (u.pn >= 8) ? SGST + (size_t)row0 * 16 + ((u.pn - 8) * 4 + wc) * 2 : nullptr, fq);
            else if (u.pn >= 14) store_tile<2>(acc, base, nullptr, fq);
            else store_tile<0>(acc, base, nullptr, fq);
        } else if (wc == 0 && fq < 2) {
#pragma unroll
            for (int ai = 0; ai < 2; ++ai)
#pragma unroll
                for (int m = 0; m < 4; ++m) { float* p = CG + (size_t)(row0 + ai * HALF + m * 16) * 16 + 8 * fq;
                    *(f32x4*)p = acc[ai][0][m][0]; *(f32x4*)(p + 4) = acc[ai][0][m][1]; }
        }
    }
};
struct EpiOut {
    static constexpr bool PERM = true;
    bf16_t* O;
    __device__ __forceinline__ void operator()(const f32x4 (&acc)[2][2][4][2], const Unit& u, int wr, int wc, int fr, int fq) const {
        bf16_t* base = O + (size_t)(u.pm * BM + wr * 64 + fr) * D + u.pn * BM + wc * 32 + 8 * fq;
#pragma unroll
        for (int ai = 0; ai < 2; ++ai)
#pragma unroll
            for (int m = 0; m < 4; ++m) { bf16_t* rowp = base + (size_t)(ai * HALF + m * 16) * D;
#pragma unroll
                for (int bj = 0; bj < 2; ++bj) { const f32x4 v0 = acc[ai][bj][m][0], v1 = acc[ai][bj][m][1];
                    u32x4 w; w.x = cvt_pk_bf16(v0[0], v0[1]); w.y = cvt_pk_bf16(v0[2], v0[3]); w.z = cvt_pk_bf16(v1[0], v1[1]); w.w = cvt_pk_bf16(v1[2], v1[3]);
                    *(u32x4*)(rowp + bj * HALF) = w; } }
    }
};
}

__device__ __forceinline__ void p0_transpose_item(const float* W, int ldw, int n_src0, bf16_t* WT, int row_dst0, int kb, float* scr, int lane) {
    const int k0 = 64 * kb;
    {   const int kr = lane >> 3, c4 = 4 * (lane & 7);
        const float* src = W + (size_t)(k0 + kr) * ldw + n_src0 + c4;
        f32x4 v[8];
#pragma unroll
        for (int i = 0; i < 8; ++i) v[i] = __builtin_nontemporal_load((const f32x4*)(src + (size_t)(8 * i) * ldw));
#pragma unroll
        for (int i = 0; i < 8; ++i) { float* d = scr + (8 * i + kr) * 33 + c4; d[0] = v[i][0]; d[1] = v[i][1]; d[2] = v[i][2]; d[3] = v[i][3]; }
    }
    asm volatile("s_waitcnt lgkmcnt(0)" ::: "memory");
    const int c = lane & 7;
#pragma unroll
    for (int j = 0; j < 4; ++j) { const int n = (lane >> 3) + 8 * j; const float* s = scr + (8 * c) * 33 + n;
        u32x4 o; o.x = cvt_pk_bf16(s[0 * 33], s[1 * 33]); o.y = cvt_pk_bf16(s[2 * 33], s[3 * 33]); o.z = cvt_pk_bf16(s[4 * 33], s[5 * 33]); o.w = cvt_pk_bf16(s[6 * 33], s[7 * 33]);
        *(u32x4*)(WT + (size_t)(row_dst0 + n) * D + k0 + 8 * c) = o; }
    asm volatile("s_waitcnt lgkmcnt(0)" ::: "memory");
}

__device__ __forceinline__ void mod_items(const Params& p, int l, unsigned char* lds, int tid, int wave, int lane, int bx) {
    const int G = gridDim.x;
    if (bx >= 192) return;
    float* sc = (float*)lds;
    float* red = (float*)(lds + 32768);
    for (int i = tid; i < 4 * D; i += 512) { const int b = i >> 11, k = i & (D - 1); sc[k * 4 + b] = silu_f(p.c[i]); }
    __syncthreads();
    for (int it = bx; it < 192; it += G) {
        const int n0 = 32 * it;
        const int r8 = lane >> 3, c4 = lane & 7;
        const float* wp = p.w_mod + ((size_t)l * D + wave * 256 + r8) * 6144 + n0 + 4 * c4;
        f32x4 a0 = {0, 0, 0, 0}, a1 = a0, a2 = a0, a3 = a0;
#pragma unroll 8
        for (int i = 0; i < 32; ++i) {
            const f32x4 w = __builtin_nontemporal_load((const f32x4*)(wp + (size_t)(8 * i) * 6144));
            const f32x4 s = *(const f32x4*)(sc + (wave * 256 + 8 * i + r8) * 4);
            a0 += w * s[0]; a1 += w * s[1]; a2 += w * s[2]; a3 += w * s[3];
        }
#pragma unroll
        for (int e = 0; e < 4; ++e) {
#pragma unroll
            for (int o = 8; o < 64; o <<= 1) { a0[e] += __shfl_xor(a0[e], o); a1[e] += __shfl_xor(a1[e], o); a2[e] += __shfl_xor(a2[e], o); a3[e] += __shfl_xor(a3[e], o); }
        }
        if (r8 == 0) {
            *(f32x4*)(red + (wave * 4 + 0) * 32 + 4 * c4) = a0; *(f32x4*)(red + (wave * 4 + 1) * 32 + 4 * c4) = a1;
            *(f32x4*)(red + (wave * 4 + 2) * 32 + 4 * c4) = a2; *(f32x4*)(red + (wave * 4 + 3) * 32 + 4 * c4) = a3;
        }
        __syncthreads();
        if (tid < 128) { const int b = tid >> 5, col = tid & 31; float s = p.b_mod[l * 6144 + n0 + col];
#pragma unroll
            for (int w = 0; w < 8; ++w) s += red[(w * 4 + b) * 32 + col];
            ((float*)(p.ws + WS_MOD))[(l * 4 + b) * 6144 + n0 + col] = s; }
        __syncthreads();
    }
}

__device__ __forceinline__ void p0_transposes(const Params& p, unsigned char* lds, int wave, int lane, int bx, int part) {
    const int G = gridDim.x;
    unsigned char* ws = p.ws;
    float* scr = (float*)(lds + wave * 16384);
    constexpr int PER_L = 32 * 240, NIT = 2 * PER_L;
    int base, end, stride;
    if (G == 256) {
        if (part == 0) { if (bx < 192) return; base = 13824 + (bx - 192) * 24; end = base + 24; }
        else if (bx < 192) { base = 49 * bx; end = base + 49; } else { base = 9408 + (bx - 192) * 69; end = base + 69; }
        base += wave; stride = 8;
    } else { if (part == 0) return; base = bx * 8 + wave; end = NIT; stride = G * 8; }
    for (int it = base; it < end; it += stride) {
        const int l = it / PER_L, r = it % PER_L, kb = r / 240, j = r % 240;
        bf16_t* WinT = (bf16_t*)(ws + WS_WIN + (size_t)l * WIN_BYTES);
        bf16_t* WoT = (bf16_t*)(ws + WS_WOUT + (size_t)l * WOUT_BYTES);
        if (j < 112) p0_transpose_item(p.w_in + (size_t)l * D * WIN_LD, WIN_LD, 32 * j, WinT, 32 * j, kb, scr, lane);
        else if (j < 176) p0_transpose_item(p.w_in + (size_t)l * D * WIN_LD, WIN_LD, 3600 + 32 * (j - 112), WinT, 3584 + 32 * (j - 112), kb, scr, lane);
        else p0_transpose_item(p.w_out + (size_t)l * D * D, D, 32 * (j - 176), WoT, 32 * (j - 176), kb, scr, lane);
    }
}

__device__ __forceinline__ void p0_convert(const Params& p, unsigned char* lds, int tid, int wave, int lane, int bx) {
    const int G = gridDim.x;
    unsigned char* ws = p.ws;
    {
        const int gt = bx * 512 + tid, NT = G * 512;
        for (int i = gt; i < 2 * 256 * (D / 8); i += NT) {
            const int l = i / (256 * (D / 8)), r = i % (256 * (D / 8)), j = r / (D / 8), k8 = (r % (D / 8)) * 8;
            u32x4 o = {0u, 0u, 0u, 0u};
            if (j < 16) { const float* s = p.w_in + ((size_t)l * D + k8) * WIN_LD + 3584 + j;
                o.x = cvt_pk_bf16(s[0], s[WIN_LD]); o.y = cvt_pk_bf16(s[2 * WIN_LD], s[3 * WIN_LD]); o.z = cvt_pk_bf16(s[4 * WIN_LD], s[5 * WIN_LD]); o.w = cvt_pk_bf16(s[6 * WIN_LD], s[7 * WIN_LD]); }
            *(u32x4*)((bf16_t*)(ws + WS_WIN + (size_t)l * WIN_BYTES) + (size_t)(5632 + j) * D + k8) = o;
        }
    }
    {
        const int gt = bx * 512 + tid;
        if (gt < 2 * 8 * 128 * 16) {
            const int t = (gt >> 4) & 127, s0 = (gt & 15) * 8;
            const float* src = p.sg_w + (size_t)gt * 8;
            const f32x4 f0 = *(const f32x4*)src, f1 = *(const f32x4*)(src + 4);
            float w[8] = {f0[0], f0[1], f0[2], f0[3], f1[0], f1[1], f1[2], f1[3]};
#pragma unroll
            for (int e = 0; e < 8; ++e) w[e] = (s0 + e <= t) ? w[e] : 0.f;
            *(u32x4*)((bf16_t*)(ws + WS_SGW) + (size_t)gt * 8) = (u32x4){cvt_pk_bf16(w[0], w[1]), cvt_pk_bf16(w[2], w[3]), cvt_pk_bf16(w[4], w[5]), cvt_pk_bf16(w[6], w[7])};
        }
    }
    p0_transposes(p, lds, wave, lane, bx, 1);
}

__device__ __forceinline__ void row_pass(const Params& p, int mode, int wave, int lane, int bx) {
    const int gw = bx * 8 + wave, NGW = gridDim.x * 8;
    unsigned char* ws = p.ws;
    const float* mod = (const float*)(ws + WS_MOD);
    const bf16_t* OUTB = (const bf16_t*)(ws + WS_OUT);
    bf16_t* H = (bf16_t*)(ws + WS_H);
    const int lpost = (mode == 2) ? 1 : 0, lpre = (mode == 0) ? 0 : 1;
    for (int gi = gw; gi < M / 4; gi += NGW) {
        const int r0 = 4 * gi, b = r0 >> 11;
        f32x4 gg[4][2], aa[4][2], tt[4][2];
        if (mode >= 1) {
            const float* gate = mod + (size_t)(lpost * 4 + b) * 6144 + 4096; const float* gp = p.g_post + lpost * D;
#pragma unroll
            for (int j = 0; j < 4; ++j)
#pragma unroll
                for (int h = 0; h < 2; ++h) { const int col = 8 * lane + 512 * j + 4 * h; gg[j][h] = *(const f32x4*)(gate + col) * *(const f32x4*)(gp + col); }
        }
        if (mode <= 1) {
            const float* shift = mod + (size_t)(lpre * 4 + b) * 6144; const float* scale = shift + 2048; const float* gp = p.g_pre + lpre * D;
#pragma unroll
            for (int j = 0; j < 4; ++j)
#pragma unroll
                for (int h = 0; h < 2; ++h) { const int col = 8 * lane + 512 * j + 4 * h;
                    aa[j][h] = *(const f32x4*)(gp + col) * (*(const f32x4*)(scale + col) + 1.f); tt[j][h] = *(const f32x4*)(shift + col); }
        }
#pragma unroll 1
        for (int k = 0; k < 4; ++k) {
            const int r = r0 + k;
            f32x4 v[4][2];
            if (mode == 2) {
                const bf16_t* x1b = (const bf16_t*)(ws + WS_X1B) + (size_t)r * D;
#pragma unroll
                for (int j = 0; j < 4; ++j) { const u32x4 w = *(const u32x4*)(x1b + 8 * lane + 512 * j);
                    v[j][0] = (f32x4){bf_lo(w.x), bf_hi(w.x), bf_lo(w.y), bf_hi(w.y)}; v[j][1] = (f32x4){bf_lo(w.z), bf_hi(w.z), bf_lo(w.w), bf_hi(w.w)}; }
            } else {
                const float* xin = p.x + (size_t)r * D;
#pragma unroll
                for (int j = 0; j < 4; ++j) { v[j][0] = *(const f32x4*)(xin + 8 * lane + 512 * j); v[j][1] = *(const f32x4*)(xin + 8 * lane + 512 * j + 4); }
            }
            if (mode >= 1) {
                f32x4 o[4][2]; float ss = 0.f;
#pragma unroll
                for (int j = 0; j < 4; ++j) { const u32x4 w = *(const u32x4*)(OUTB + (size_t)r * D + 8 * lane + 512 * j);
                    o[j][0] = (f32x4){bf_lo(w.x), bf_hi(w.x), bf_lo(w.y), bf_hi(w.y)}; o[j][1] = (f32x4){bf_lo(w.z), bf_hi(w.z), bf_lo(w.w), bf_hi(w.w)};
#pragma unroll
                    for (int h = 0; h < 2; ++h) ss += (o[j][h][0] * o[j][h][0] + o[j][h][1] * o[j][h][1]) + (o[j][h][2] * o[j][h][2] + o[j][h][3] * o[j][h][3]); }
                const float rstd = rsqrtf(wave_sum(ss) * (1.f / D) + EPS);
                float* xo = p.out + (size_t)r * D;
#pragma unroll
                for (int j = 0; j < 4; ++j)
#pragma unroll
                    for (int h = 0; h < 2; ++h) { const int col = 8 * lane + 512 * j + 4 * h;
                        v[j][h] = v[j][h] + gg[j][h] * (o[j][h] * rstd);
                        if (mode == 2) *(f32x4*)(xo + col) = v[j][h]; }
                if (mode == 1) {
                    bf16_t* x1b = (bf16_t*)(ws + WS_X1B) + (size_t)r * D;
#pragma unroll
                    for (int j = 0; j < 4; ++j) { u32x4 w; w.x = cvt_pk_bf16(v[j][0][0], v[j][0][1]); w.y = cvt_pk_bf16(v[j][0][2], v[j][0][3]); w.z = cvt_pk_bf16(v[j][1][0], v[j][1][1]); w.w = cvt_pk_bf16(v[j][1][2], v[j][1][3]);
                        *(u32x4*)(x1b + 8 * lane + 512 * j) = w;
                        v[j][0] = (f32x4){bf_lo(w.x), bf_hi(w.x), bf_lo(w.y), bf_hi(w.y)}; v[j][1] = (f32x4){bf_lo(w.z), bf_hi(w.z), bf_lo(w.w), bf_hi(w.w)}; }
                }
            }
            if (mode <= 1) {
                float ss = 0.f;
#pragma unroll
                for (int j = 0; j < 4; ++j)
#pragma unroll
                    for (int h = 0; h < 2; ++h) ss += (v[j][h][0] * v[j][h][0] + v[j][h][1] * v[j][h][1]) + (v[j][h][2] * v[j][h][2] + v[j][h][3] * v[j][h][3]);
                const float rstd = rsqrtf(wave_sum(ss) * (1.f / D) + EPS);
#pragma unroll
                for (int j = 0; j < 4; ++j) { f32x4 hh[2];
#pragma unroll
                    for (int h = 0; h < 2; ++h) hh[h] = (v[j][h] * rstd) * aa[j][h] + tt[j][h];
                    u32x4 w; w.x = cvt_pk_bf16(hh[0][0], hh[0][1]); w.y = cvt_pk_bf16(hh[0][2], hh[0][3]); w.z = cvt_pk_bf16(hh[1][0], hh[1][1]); w.w = cvt_pk_bf16(hh[1][2], hh[1][3]);
                    *(u32x4*)(H + (size_t)r * D + 8 * lane + 512 * j) = w; }
            }
        }
    }
}

__device__ __forceinline__ void rope_cs(int pos, int i, float& cs, float& sn) {
    constexpr float F[8] = {0.15915494309189535f, 0.03086376340470123f, 0.005985185712713705f, 0.001160663641240061f,
                            0.00022507907903927653f, 4.364795279280289e-05f, 8.464330808241401e-06f, 1.6414262627950345e-06f};
    const float rev = (float)pos * F[i];
    const float r = __builtin_amdgcn_fractf(rev);
    sn = __builtin_amdgcn_sinf(r); cs = __builtin_amdgcn_cosf(r);
}
constexpr int KS_LD = 72, VS_LD = 72;
__device__ __forceinline__ void attn_item(const Params& p, int l, int item, unsigned char* lds, int tid, int wave, int lane) {
    const int b = item >> 6, n = (item >> 2) & 15, g = item & 3;
    const int fr = lane & 15, fq = lane >> 4;
    bf16_t* Ks = (bf16_t*)lds;
    bf16_t* Vs = (bf16_t*)(lds + 256 * KS_LD * 2);
    const bf16_t* proj = (const bf16_t*)(p.ws + WS_PROJ);
    bf16_t* Y = (bf16_t*)(p.ws + WS_Y);
    const int r = wave >> 1, qh = wave & 1, hq = g * 4 + r;
    const int tokq0 = b * SEQ + n * 128 + 64 * qh;
    u32x4 qraw[4][2]; int qpos[4];
#pragma unroll
    for (int nb = 0; nb < 4; ++nb) {
        const int tok = tokq0 + 16 * nb + fr;
        const bf16_t* qp = proj + (size_t)tok * NPROJ + C_AQ + hq * 64 + 8 * fq;
        qraw[nb][0] = *(const u32x4*)qp; qraw[nb][1] = *(const u32x4*)(qp + 32); qpos[nb] = p.pos[tok];
    }
    {
        const int key = tid >> 1, half = tid & 1;
        const int s = n * 128 - 128 + key;
        u32x4 kv[4], vv[4];
#pragma unroll
        for (int c = 0; c < 4; ++c) { kv[c] = (u32x4){0u, 0u, 0u, 0u}; vv[c] = kv[c]; }
        if (s >= 0) {
            const bf16_t* kp = proj + (size_t)(b * SEQ + s) * NPROJ + C_AK + g * 64 + half * 32;
#pragma unroll
            for (int c = 0; c < 4; ++c) { kv[c] = *(const u32x4*)(kp + 8 * c); vv[c] = *(const u32x4*)(kp + 256 + 8 * c); }
            if (half == 0) {
                const int pos = p.pos[b * SEQ + s];
                unsigned a[4] = {kv[0].x, kv[0].y, kv[0].z, kv[0].w}, bb[4] = {kv[1].x, kv[1].y, kv[1].z, kv[1].w};
#pragma unroll
                for (int e = 0; e < 4; ++e) {
                    float c0, s0, c1, s1; rope_cs(pos, 2 * e, c0, s0); rope_cs(pos, 2 * e + 1, c1, s1);
                    const float t1a = bf_lo(a[e]), t1b = bf_hi(a[e]), t2a = bf_lo(bb[e]), t2b = bf_hi(bb[e]);
                    a[e] = cvt_pk_bf16(t1a * c0 - t2a * s0, t1b * c1 - t2b * s1);
                    bb[e] = cvt_pk_bf16(t2a * c0 + t1a * s0, t2b * c1 + t1b * s1);
                }
                kv[0] = (u32x4){a[0], a[1], a[2], a[3]}; kv[1] = (u32x4){bb[0], bb[1], bb[2], bb[3]};
            }
        }
#pragma unroll
        for (int c = 0; c < 4; ++c) *(u32x4*)(Ks + key * KS_LD + half * 32 + 8 * c) = kv[c];
#pragma unroll
        for (int c = 0; c < 4; ++c) *(u32x4*)(Vs + key * VS_LD + half * 32 + 8 * c) = vv[c];
    }
    __syncthreads();
    bf16x8 qf[4][2];
#pragma unroll
    for (int nb = 0; nb < 4; ++nb) {
        const u32x4 q0 = qraw[nb][0], q1 = qraw[nb][1];
        unsigned own[4] = {q0.x, q0.y, q0.z, q0.w}, par[4];
#pragma unroll
        for (int e = 0; e < 4; ++e) par[e] = __shfl_xor(own[e], 16);
        if (fq < 2) {
            const int pos = qpos[nb];
            const float sg = (fq == 0) ? -1.f : 1.f;
#pragma unroll
            for (int e = 0; e < 4; ++e) {
                float c0, s0, c1, s1; rope_cs(pos, 2 * e, c0, s0); rope_cs(pos, 2 * e + 1, c1, s1);
                const float oa = bf_lo(own[e]), ob = bf_hi(own[e]), pa = bf_lo(par[e]), pb = bf_hi(par[e]);
                own[e] = cvt_pk_bf16((oa * c0 + sg * pa * s0) * 0.125f, (ob * c1 + sg * pb * s1) * 0.125f);
            }
        } else {
#pragma unroll
            for (int e = 0; e < 4; ++e) own[e] = cvt_pk_bf16(bf_lo(own[e]) * 0.125f, bf_hi(own[e]) * 0.125f);
        }
        unsigned o1[4] = {q1.x, q1.y, q1.z, q1.w};
#pragma unroll
        for (int e = 0; e < 4; ++e) o1[e] = cvt_pk_bf16(bf_lo(o1[e]) * 0.125f, bf_hi(o1[e]) * 0.125f);
        qf[nb][0] = __builtin_bit_cast(bf16x8, (u32x4){own[0], own[1], own[2], own[3]});
        qf[nb][1] = __builtin_bit_cast(bf16x8, (u32x4){o1[0], o1[1], o1[2], o1[3]});
    }
    const float sink2 = p.sinks[l * 16 + hq] * LOG2E;
    float m_[4], l_[4];
    f32x4 o[4][4];
#pragma unroll
    for (int nb = 0; nb < 4; ++nb) { m_[nb] = sink2; l_[nb] = 1.f;
#pragma unroll
        for (int hb = 0; hb < 4; ++hb) o[hb][nb] = (f32x4){0.f, 0.f, 0.f, 0.f}; }
    for (int step = 0; step < 6; ++step) {
        const int kj0 = 64 * qh + 32 * step;
        if (n == 0 && kj0 + 32 <= 128) continue;
        f32x4 s[2][4];
#pragma unroll
        for (int mb = 0; mb < 2; ++mb)
#pragma unroll
            for (int nb = 0; nb < 4; ++nb) s[mb][nb] = (f32x4){0.f, 0.f, 0.f, 0.f};
#pragma unroll
        for (int mb = 0; mb < 2; ++mb)
#pragma unroll
            for (int kk = 0; kk < 2; ++kk) {
                const bf16x8 a = *(const bf16x8*)(Ks + (kj0 + 16 * mb + fr) * KS_LD + 32 * kk + 8 * fq);
#pragma unroll
                for (int nb = 0; nb < 4; ++nb) s[mb][nb] = MFMA16(a, qf[nb][kk], s[mb][nb]);
            }
        bf16x8 pb[4];
#pragma unroll
        for (int nb = 0; nb < 4; ++nb) {
            const int qi = 64 * qh + 16 * nb + fr;
            float tmax = -1e30f;
#pragma unroll
            for (int mb = 0; mb < 2; ++mb)
#pragma unroll
                for (int j = 0; j < 4; ++j) {
                    const int kj = kj0 + 16 * mb + 4 * fq + j, dist = qi + 128 - kj;
                    const bool valid = (dist >= 0) && (dist < 128) && (n > 0 || kj >= 128);
                    const float v = valid ? s[mb][nb][j] * LOG2E : -1e30f;
                    s[mb][nb][j] = v; tmax = fmaxf(tmax, v);
                }
            tmax = fmaxf(tmax, __shfl_xor(tmax, 16)); tmax = fmaxf(tmax, __shfl_xor(tmax, 32));
            const float mnew = fmaxf(m_[nb], tmax), alpha = fast_exp2(m_[nb] - mnew);
            m_[nb] = mnew;
            float rs = 0.f;
#pragma unroll
            for (int mb = 0; mb < 2; ++mb)
#pragma unroll
                for (int j = 0; j < 4; ++j) { const float pv = fast_exp2(s[mb][nb][j] - mnew); s[mb][nb][j] = pv; rs += pv; }
            rs += __shfl_xor(rs, 16); rs += __shfl_xor(rs, 32);
            l_[nb] = l_[nb] * alpha + rs;
#pragma unroll
            for (int hb = 0; hb < 4; ++hb) o[hb][nb] = o[hb][nb] * alpha;
            pb[nb] = __builtin_bit_cast(bf16x8, (u32x4){cvt_pk_bf16(s[0][nb][0], s[0][nb][1]), cvt_pk_bf16(s[0][nb][2], s[0][nb][3]),
                                                        cvt_pk_bf16(s[1][nb][0], s[1][nb][1]), cvt_pk_bf16(s[1][nb][2], s[1][nb][3])});
        }
#pragma unroll
        for (int hb = 0; hb < 4; ++hb) {
            const bf16_t* vp = Vs + (kj0 + 4 * fq + (fr >> 2)) * VS_LD + 32 * (hb >> 1) + 8 * (fr & 3) + 4 * (hb & 1);
            const bf16x8 a = tr_operand(vp, vp + 16 * VS_LD);
#pragma unroll
            for (int nb = 0; nb < 4; ++nb) o[hb][nb] = MFMA16(a, pb[nb], o[hb][nb]);
        }
    }
#pragma unroll
    for (int nb = 0; nb < 4; ++nb) {
        const int tok = tokq0 + 16 * nb + fr;
        const float inv = 1.f / l_[nb];
#pragma unroll
        for (int hp = 0; hp < 2; ++hp) {
            const int col = hq * 64 + 32 * hp + 8 * fq;
            const u32x4 z = *(const u32x4*)(proj + (size_t)tok * NPROJ + C_Z + col);
            const f32x4 a = o[2 * hp][nb] * inv, b2 = o[2 * hp + 1][nb] * inv;
            u32x4 y; y.x = cvt_pk_bf16(a[0] * bf_lo(z.x), a[1] * bf_hi(z.x)); y.y = cvt_pk_bf16(a[2] * bf_lo(z.y), a[3] * bf_hi(z.y));
            y.z = cvt_pk_bf16(b2[0] * bf_lo(z.z), b2[1] * bf_hi(z.z)); y.w = cvt_pk_bf16(b2[2] * bf_lo(z.w), b2[3] * bf_hi(z.w));
            *(u32x4*)(Y + (size_t)tok * D + col) = y;
        }
    }
    __syncthreads();
}

constexpr int VN_LD = 72;
__device__ __forceinline__ void sg_pair_item(const Params& p, int l, int pitem, unsigned char* lds, int tid, int wave, int lane) {
    const int b2 = pitem >> 7, c = (pitem >> 3) & 15, g = pitem & 7;
    const int fr = lane & 15, fq = lane >> 4;
    bf16_t* vnT = (bf16_t*)lds;
    const bf16_t* proj = (const bf16_t*)(p.ws + WS_PROJ);
    bf16_t* Y = (bf16_t*)(p.ws + WS_Y);
    const int s = tid >> 2, qd = tid & 3;
    const int t = 16 * wave + fr;
    int tok0[2];
    tok0[0] = b2 * SEQ + c * 128; tok0[1] = (b2 + 2) * SEQ + c * 128;
    u32x4 vw[2][2]; f32x4 stq[2]; u32x4 uf[2][2], zf[2][2];
#pragma unroll
    for (int q2 = 0; q2 < 2; ++q2) {
        const bf16_t* vp = proj + (size_t)(tok0[q2] + s) * NPROJ + C_SV;
        vw[q2][0] = *(const u32x4*)(vp + 64 * g + 16 * qd); vw[q2][1] = *(const u32x4*)(vp + 64 * g + 16 * qd + 8);
        stq[q2] = *(const f32x4*)((const float*)(p.ws + WS_SGST) + (size_t)(tok0[q2] + s) * 16 + 4 * qd);
#pragma unroll
        for (int mp = 0; mp < 2; ++mp) { const int col = 64 * g + 32 * mp + 8 * fq; const size_t ro = (size_t)(tok0[q2] + t) * NPROJ;
            uf[q2][mp] = *(const u32x4*)(proj + ro + C_SU + col); zf[q2][mp] = *(const u32x4*)(proj + ro + C_Z + 1024 + col); }
    }
    bf16x8 wf[4];
    {   const bf16_t* wrow = (const bf16_t*)(p.ws + WS_SGW) + ((size_t)(l * 8 + g) * 128 + t) * 128;
#pragma unroll
        for (int kk = 0; kk < 4; ++kk) if (32 * kk <= 16 * wave + 15) wf[kk] = *(const bf16x8*)(wrow + 32 * kk + 8 * fq); }
    const float bias = p.sg_b[(l * 8 + g) * 128 + t];
    float lgv[16], lbv[16];
    {   const float* lg = p.sg_ln_g + l * 512 + 64 * g + 16 * qd; const float* lb = p.sg_ln_b + l * 512 + 64 * g + 16 * qd;
#pragma unroll
        for (int i = 0; i < 4; ++i) { const f32x4 a = *(const f32x4*)(lg + 4 * i), bb = *(const f32x4*)(lb + 4 * i);
#pragma unroll
            for (int e = 0; e < 4; ++e) { lgv[4 * i + e] = a[e]; lbv[4 * i + e] = bb[e]; } } }
#pragma unroll
    for (int q2 = 0; q2 < 2; ++q2) {
        float sum = stq[q2][0] + stq[q2][2], sq = stq[q2][1] + stq[q2][3];
        sum += __shfl_xor(sum, 1); sum += __shfl_xor(sum, 2); sq += __shfl_xor(sq, 1); sq += __shfl_xor(sq, 2);
        const float mu = sum * (1.f / 512.f), var = fmaxf(sq * (1.f / 512.f) - mu * mu, 0.f), rstd = rsqrtf(var + EPS);
        bf16_t* vq = vnT + q2 * 128 * VN_LD + s * VN_LD + 16 * qd;
#pragma unroll
        for (int i = 0; i < 2; ++i) { const unsigned ww[4] = {vw[q2][i].x, vw[q2][i].y, vw[q2][i].z, vw[q2][i].w}; unsigned o4[4];
#pragma unroll
            for (int e = 0; e < 4; ++e) { const int ch = 8 * i + 2 * e;
                o4[e] = cvt_pk_bf16((bf_lo(ww[e]) - mu) * rstd * lgv[ch] + lbv[ch], (bf_hi(ww[e]) - mu) * rstd * lgv[ch + 1] + lbv[ch + 1]); }
            *(u32x4*)(vq + 8 * i) = (u32x4){o4[0], o4[1], o4[2], o4[3]}; }
    }
    __syncthreads();
    {
        f32x4 acc[2][4];
#pragma unroll
        for (int q2 = 0; q2 < 2; ++q2)
#pragma unroll
            for (int mb = 0; mb < 4; ++mb) acc[q2][mb] = (f32x4){0.f, 0.f, 0.f, 0.f};
#pragma unroll
        for (int kk = 0; kk < 4; ++kk) {
            if (32 * kk <= 16 * wave + 15) {
                const int s0 = 32 * kk + 8 * fq;
                const bf16x8 bfr = wf[kk];
#pragma unroll
                for (int q2 = 0; q2 < 2; ++q2)
#pragma unroll
                    for (int mb = 0; mb < 4; ++mb) {
                        const bf16_t* ap = vnT + (q2 * 128 + s0 + (fr >> 2)) * VN_LD + 32 * (mb >> 1) + 8 * (fr & 3) + 4 * (mb & 1);
                        acc[q2][mb] = MFMA16(tr_operand(ap, ap + 4 * VN_LD), bfr, acc[q2][mb]); }
            }
        }
#pragma unroll
        for (int q2 = 0; q2 < 2; ++q2)
#pragma unroll
            for (int mp = 0; mp < 2; ++mp) {
                const int col = 64 * g + 32 * mp + 8 * fq;
                const u32x4 u = uf[q2][mp], z = zf[q2][mp];
                const f32x4 a = acc[q2][2 * mp] + bias, b3 = acc[q2][2 * mp + 1] + bias;
                u32x4 y; y.x = cvt_pk_bf16(bf_lo(u.x) * a[0] * bf_lo(z.x), bf_hi(u.x) * a[1] * bf_hi(z.x)); y.y = cvt_pk_bf16(bf_lo(u.y) * a[2] * bf_lo(z.y), bf_hi(u.y) * a[3] * bf_hi(z.y));
                y.z = cvt_pk_bf16(bf_lo(u.z) * b3[0] * bf_lo(z.z), bf_hi(u.z) * b3[1] * bf_hi(z.z)); y.w = cvt_pk_bf16(bf_lo(u.w) * b3[2] * bf_lo(z.w), bf_hi(u.w) * b3[3] * bf_hi(z.w));
                *(u32x4*)(Y + (size_t)(tok0[q2] + t) * D + 1024 + col) = y;
            }
    }
    __syncthreads();
}

constexpr int GL_LD = 72;
struct CgRow { f32x4 c0, c1, c2, c3; };
__device__ __forceinline__ CgRow gla_load_cg(const Params& p, int tok) {
    const float* cgp = (const float*)(p.ws + WS_CG) + (size_t)tok * 16;
    CgRow r; r.c0 = *(const f32x4*)cgp; r.c1 = *(const f32x4*)(cgp + 4); r.c2 = *(const f32x4*)(cgp + 8); r.c3 = *(const f32x4*)(cgp + 12); return r;
}
__device__ __forceinline__ float wave_scan_incl(float v) {
#define SCAN_STEP(ctrl, rmask) v += __builtin_bit_cast(float, __builtin_amdgcn_update_dpp(0, __builtin_bit_cast(int, v), (ctrl), (rmask), 0xf, false))
    SCAN_STEP(0x111, 0xf); SCAN_STEP(0x112, 0xf); SCAN_STEP(0x114, 0xf); SCAN_STEP(0x118, 0xf);
    SCAN_STEP(0x142, 0xa); SCAN_STEP(0x143, 0xc);
#undef SCAN_STEP
    return v;
}
__device__ __forceinline__ void gla_b(const float* wl, const CgRow& cr, int wave, int lane, float (&bc)[8], float (&bl)[8]) {
    const f32x4 c0 = cr.c0, c1 = cr.c1, c2 = cr.c2, c3 = cr.c3;
    const float cgv[16] = {c0[0], c0[1], c0[2], c0[3], c1[0], c1[1], c1[2], c1[3], c2[0], c2[1], c2[2], c2[3], c3[0], c3[1], c3[2], c3[3]};
    float x[8];
    {   const f32x4 b0 = *(const f32x4*)(wl + 1024 + 8 * wave), b1 = *(const f32x4*)(wl + 1024 + 8 * wave + 4);
#pragma unroll
        for (int e = 0; e < 4; ++e) { x[e] = b0[e]; x[4 + e] = b1[e]; } }
#pragma unroll
    for (int r = 0; r < 16; ++r) {
        const f32x4 w0 = *(const f32x4*)(wl + r * 64 + 8 * wave), w1 = *(const f32x4*)(wl + r * 64 + 8 * wave + 4);
#pragma unroll
        for (int e = 0; e < 4; ++e) { x[e] += cgv[r] * w0[e]; x[4 + e] += cgv[r] * w1[e]; }
    }
#pragma unroll
    for (int i = 0; i < 8; ++i) {
        float la = (fminf(x[i], 0.f) - __logf(1.f + __expf(-fabsf(x[i])))) * (1.f / 16.f);
        la = wave_scan_incl(la);
        bc[i] = la; bl[i] = __builtin_bit_cast(float, __builtin_amdgcn_readlane(__builtin_bit_cast(int, la), 63));
    }
}
struct VPair { u32x4 a, b; };
__device__ __forceinline__ VPair gla_load_v(const bf16_t* proj, int tok0, int h, int tid) {
    const int t = tid >> 3, c8 = tid & 7;
    const bf16_t* vp = proj + (size_t)(tok0 + t) * NPROJ + C_CV + h * 128 + 16 * c8;
    VPair r; r.a = *(const u32x4*)vp; r.b = *(const u32x4*)(vp + 8); return r;
}
__device__ __forceinline__ void gla_store_vT(const VPair& v, bf16_t* vT, int tid) {
    const int t = tid >> 3, c8 = tid & 7;
#pragma unroll
    for (int i = 0; i < 2; ++i) { const u32x4 w = i ? v.b : v.a; const unsigned ww[4] = {w.x, w.y, w.z, w.w};
#pragma unroll
        for (int e = 0; e < 4; ++e) { const int dv = 16 * c8 + 8 * i + 2 * e;
            vT[dv * GL_LD + t] = (bf16_t)(ww[e] & 0xffffu); vT[(dv + 1) * GL_LD + t] = (bf16_t)(ww[e] >> 16); } }
}
constexpr int GLK_LD = 72, GLV_LD = 136;
__device__ __forceinline__ void gla_local_item(const Params& p, int l, int item, unsigned char* lds, int tid, int wave, int lane) {
    const int bh = item >> 5, c = item & 31, b = bh >> 2, h = bh & 3;
    const int fr = lane & 15, fq = lane >> 4;
    const int tok0 = b * SEQ + c * 64;
    bf16_t* Kr = (bf16_t*)lds;
    bf16_t* Vr = (bf16_t*)(lds + 64 * GLK_LD * 2);
    float* wl = (float*)(lds + 64 * GLK_LD * 2 + 64 * GLV_LD * 2);
    const bf16_t* proj = (const bf16_t*)(p.ws + WS_PROJ);
    const CgRow cr = gla_load_cg(p, tok0 + lane);
    const bf16_t* rowp = proj + (size_t)(tok0 + lane) * NPROJ + h * 64 + 8 * wave;
    const u32x4 qw = *(const u32x4*)(rowp + C_CQ), kw = *(const u32x4*)(rowp + C_CK);
    const VPair vpre = gla_load_v(proj, tok0, h, tid);
    if (tid < 256) *(f32x4*)(wl + (tid >> 4) * 64 + 4 * (tid & 15)) = *(const f32x4*)(p.gla_wup + (size_t)(l * 16 + (tid >> 4)) * 256 + h * 64 + 4 * (tid & 15));
    else if (tid < 272) *(f32x4*)(wl + 1024 + 4 * (tid - 256)) = *(const f32x4*)(p.gla_bg + l * 256 + h * 64 + 4 * (tid - 256));
    __syncthreads();
    float bc[8], bl[8];
    gla_b(wl, cr, wave, lane, bc, bl);
    {
        const unsigned qq[4] = {qw.x, qw.y, qw.z, qw.w}, ww[4] = {kw.x, kw.y, kw.z, kw.w};
        unsigned qo[4], ko[4], lo4[4];
#pragma unroll
        for (int e = 0; e < 4; ++e) {
            lo4[e] = cvt_pk_bf16(bf_lo(ww[e]) * __expf(bl[2 * e] - bc[2 * e]), bf_hi(ww[e]) * __expf(bl[2 * e + 1] - bc[2 * e + 1]));
            const float e0 = __expf(bc[2 * e]), e1 = __expf(bc[2 * e + 1]);
            qo[e] = cvt_pk_bf16(bf_lo(qq[e]) * 0.125f * e0, bf_hi(qq[e]) * 0.125f * e1);
            ko[e] = cvt_pk_bf16(bf_lo(ww[e]) * fast_rcp(e0), bf_hi(ww[e]) * fast_rcp(e1));
        }
        *(u32x4*)(Kr + lane * GLK_LD + 8 * wave) = (u32x4){lo4[0], lo4[1], lo4[2], lo4[3]};
        *(u32x4*)((bf16_t*)(p.ws + WS_QD) + (size_t)item * 4096 + lane * 64 + 8 * wave) = (u32x4){qo[0], qo[1], qo[2], qo[3]};
        *(u32x4*)((bf16_t*)(p.ws + WS_KD) + (size_t)item * 4096 + lane * 64 + 8 * wave) = (u32x4){ko[0], ko[1], ko[2], ko[3]};
        if (lane == 63) { float* dec = (float*)(p.ws + WS_DEC) + (size_t)item * 64 + 8 * wave;
#pragma unroll
            for (int i = 0; i < 8; ++i) dec[i] = __expf(bl[i]); }
        bf16_t* vd = Vr + (tid >> 3) * GLV_LD + 16 * (tid & 7);
        *(u32x4*)vd = vpre.a; *(u32x4*)(vd + 8) = vpre.b;
    }
    __syncthreads();
    {
        f32x4 acc[4];
#pragma unroll
        for (int mb = 0; mb < 4; ++mb) acc[mb] = (f32x4){0.f, 0.f, 0.f, 0.f};
#pragma unroll
        for (int kk = 0; kk < 2; ++kk) {
            const int srow = 32 * kk + 8 * fq + (fr >> 2);
            const bf16_t* bp_ = Vr + srow * GLV_LD + 16 * wave + 4 * (fr & 3);
            const bf16x8 bfr = tr_operand(bp_, bp_ + 4 * GLV_LD);
#pragma unroll
            for (int mb = 0; mb < 4; ++mb) { const bf16_t* ap = Kr + srow * GLK_LD + 16 * mb + 4 * (fr & 3); acc[mb] = MFMA16(tr_operand(ap, ap + 4 * GLK_LD), bfr, acc[mb]); }
        }
        float* loct = (float*)(p.ws + WS_LOCT) + (size_t)item * 8192 + (16 * wave + fr) * 64 + 4 * fq;
#pragma unroll
        for (int mb = 0; mb < 4; ++mb) *(f32x4*)(loct + 16 * mb) = acc[mb];
    }
    __syncthreads();
}
__device__ __forceinline__ void gla_scan(const Params& p, int tid, int bx) {
    const float* loct = (const float*)(p.ws + WS_LOCT); const float* dec = (const float*)(p.ws + WS_DEC);
    bf16_t* ST = (bf16_t*)(p.ws + WS_ST);
    for (int e = bx * 512 + tid; e < 16 * 8192; e += gridDim.x * 512) {
        const int bh = e >> 13, r = e & 8191, dk = r & 63;
        float lo[32], de[32];
#pragma unroll
        for (int c = 0; c < 32; ++c) { const size_t it = (size_t)bh * 32 + c; lo[c] = loct[it * 8192 + r]; de[c] = dec[it * 64 + dk]; }
        float s = 0.f;
#pragma unroll
        for (int c = 0; c < 32; ++c) { const size_t it = (size_t)bh * 32 + c;
            ST[it * 8192 + r] = f2bf(s);
            s = s * de[c] + lo[c]; }
    }
}
constexpr int GO_LD = 72, GOV_LD = 136;
constexpr int GO_QD = 0, GO_KD = 64 * GO_LD, GO_ST = 2 * 64 * GO_LD, GO_VT = GO_ST + 128 * GO_LD, GO_IMG = GO_VT + 128 * GO_LD;
__device__ __forceinline__ void gla_out_pair(const Params& p, int l, int pit, unsigned char* lds, int tid, int wave, int lane) {
    const int bh2 = pit >> 5, c = pit & 31, h = bh2 & 3;
    const int fr = lane & 15, fq = lane >> 4;
    bf16_t* img = (bf16_t*)lds;
    float* red = (float*)(lds + 2 * GO_IMG * 2);
    const bf16_t* proj = (const bf16_t*)(p.ws + WS_PROJ);
    bf16_t* Y = (bf16_t*)(p.ws + WS_Y);
    const int tb = wave & 3, dh = wave >> 2, t = 16 * tb + fr;
    int item[2], tok[2];
    item[0] = bh2 * 32 + c; item[1] = (bh2 + 8) * 32 + c;
    tok[0] = (bh2 >> 2) * SEQ + c * 64 + t; tok[1] = ((bh2 >> 2) + 2) * SEQ + c * 64 + t;
    {
        const int r8 = tid >> 3, ch = (tid & 7) * 8;
        u32x4 cq[2], ck[2], cs[2][2], cv[2][2];
        const int tokb[2] = {(bh2 >> 2) * SEQ + c * 64, ((bh2 >> 2) + 2) * SEQ + c * 64};
#pragma unroll
        for (int q2 = 0; q2 < 2; ++q2) {
            cq[q2] = *(const u32x4*)((const bf16_t*)(p.ws + WS_QD) + (size_t)item[q2] * 4096 + r8 * 64 + ch);
            ck[q2] = *(const u32x4*)((const bf16_t*)(p.ws + WS_KD) + (size_t)item[q2] * 4096 + r8 * 64 + ch);
#pragma unroll
            for (int i = 0; i < 2; ++i) {
                cs[q2][i] = *(const u32x4*)((const bf16_t*)(p.ws + WS_ST) + (size_t)item[q2] * 8192 + (r8 + 64 * i) * 64 + ch);
                cv[q2][i] = *(const u32x4*)(proj + (size_t)(tokb[q2] + r8) * NPROJ + C_CV + h * 128 + ch + 64 * i);
            }
        }
#pragma unroll
        for (int q2 = 0; q2 < 2; ++q2) {
            bf16_t* im = img + q2 * GO_IMG;
            *(u32x4*)(im + GO_QD + r8 * GO_LD + ch) = cq[q2]; *(u32x4*)(im + GO_KD + r8 * GO_LD + ch) = ck[q2];
#pragma unroll
            for (int i = 0; i < 2; ++i) { *(u32x4*)(im + GO_ST + (r8 + 64 * i) * GO_LD + ch) = cs[q2][i]; *(u32x4*)(im + GO_VT + r8 * GOV_LD + ch + 64 * i) = cv[q2][i]; }
        }
    }
    u32x4 zf[2][2]; f32x4 gf[4];
#pragma unroll
    for (int mp = 0; mp < 2; ++mp) {
        const int dv = 64 * dh + 32 * mp + 8 * fq;
        gf[2 * mp] = *(const f32x4*)(p.gla_ng + l * 128 + dv); gf[2 * mp + 1] = *(const f32x4*)(p.gla_ng + l * 128 + dv + 4);
#pragma unroll
        for (int q2 = 0; q2 < 2; ++q2) zf[q2][mp] = *(const u32x4*)(proj + (size_t)tok[q2] * NPROJ + C_Z + 1536 + h * 128 + dv);
    }
    __syncthreads();
    f32x4 acc[2][4];
#pragma unroll
    for (int q2 = 0; q2 < 2; ++q2) {
        const bf16_t* im = img + q2 * GO_IMG;
        bf16x8 bq[2];
#pragma unroll
        for (int kk = 0; kk < 2; ++kk) bq[kk] = *(const bf16x8*)(im + GO_QD + t * GO_LD + 32 * kk + 8 * fq);
        f32x4 sc[4];
#pragma unroll
        for (int mb = 0; mb < 4; ++mb) {
            sc[mb] = (f32x4){0.f, 0.f, 0.f, 0.f};
            if (mb <= tb) {
#pragma unroll
                for (int kk = 0; kk < 2; ++kk) { const bf16x8 a = *(const bf16x8*)(im + GO_KD + (16 * mb + fr) * GO_LD + 32 * kk + 8 * fq); sc[mb] = MFMA16(a, bq[kk], sc[mb]); }
#pragma unroll
                for (int j = 0; j < 4; ++j) if (16 * mb + 4 * fq + j > t) sc[mb][j] = 0.f;
            }
        }
        bf16x8 bp[2];
#pragma unroll
        for (int k2 = 0; k2 < 2; ++k2)
            bp[k2] = __builtin_bit_cast(bf16x8, (u32x4){cvt_pk_bf16(sc[2 * k2][0], sc[2 * k2][1]), cvt_pk_bf16(sc[2 * k2][2], sc[2 * k2][3]),
                                                        cvt_pk_bf16(sc[2 * k2 + 1][0], sc[2 * k2 + 1][1]), cvt_pk_bf16(sc[2 * k2 + 1][2], sc[2 * k2 + 1][3])});
        float ssq = 0.f;
#pragma unroll
        for (int mb = 0; mb < 4; ++mb) {
            const int dvrow = 64 * dh + 32 * (mb >> 1) + 8 * (fr >> 2) + 4 * (mb & 1) + (fr & 3);
            acc[q2][mb] = (f32x4){0.f, 0.f, 0.f, 0.f};
#pragma unroll
            for (int k2 = 0; k2 < 2; ++k2) {
                const bf16_t* vp = im + GO_VT + (32 * k2 + 4 * fq + (fr >> 2)) * GOV_LD + 64 * dh + 32 * (mb >> 1) + 8 * (fr & 3) + 4 * (mb & 1);
                acc[q2][mb] = MFMA16(tr_operand(vp, vp + 16 * GOV_LD), bp[k2], acc[q2][mb]);
            }
#pragma unroll
            for (int kk = 0; kk < 2; ++kk) { const bf16x8 a = *(const bf16x8*)(im + GO_ST + dvrow * GO_LD + 32 * kk + 8 * fq); acc[q2][mb] = MFMA16(a, bq[kk], acc[q2][mb]); }
            ssq += (acc[q2][mb][0] * acc[q2][mb][0] + acc[q2][mb][1] * acc[q2][mb][1]) + (acc[q2][mb][2] * acc[q2][mb][2] + acc[q2][mb][3] * acc[q2][mb][3]);
        }
        ssq += __shfl_xor(ssq, 16); ssq += __shfl_xor(ssq, 32);
        if (fq == 0) red[(q2 * 2 + dh) * 64 + t] = ssq;
    }
    __syncthreads();
#pragma unroll
    for (int q2 = 0; q2 < 2; ++q2) {
        const float rstd = rsqrtf((red[(q2 * 2) * 64 + t] + red[(q2 * 2 + 1) * 64 + t]) * (1.f / 128.f) + EPS);
#pragma unroll
        for (int mp = 0; mp < 2; ++mp) {
            const int col = 1536 + h * 128 + 64 * dh + 32 * mp + 8 * fq;
            const u32x4 z = zf[q2][mp];
            const f32x4 a = acc[q2][2 * mp] * rstd * gf[2 * mp], b3 = acc[q2][2 * mp + 1] * rstd * gf[2 * mp + 1];
            u32x4 y; y.x = cvt_pk_bf16(a[0] * bf_lo(z.x), a[1] * bf_hi(z.x)); y.y = cvt_pk_bf16(a[2] * bf_lo(z.y), a[3] * bf_hi(z.y));
            y.z = cvt_pk_bf16(b3[0] * bf_lo(z.z), b3[1] * bf_hi(z.z)); y.w = cvt_pk_bf16(b3[2] * bf_lo(z.w), b3[3] * bf_hi(z.w));
            *(u32x4*)(Y + (size_t)tok[q2] * D + col) = y;
        }
    }
    __syncthreads();
}

#define XB_TMO      128
#define XB_XCNT(j)  (256  + 64 * (j))
#define XB_XSUB(j)  (1280 + 64 * (j))
#define XB_XGEN(j)  (2304 + 64 * (j))
#define XB_TOP      3328
#define XB_TOPGEN   3392
#define XCD_BAR_WORDS 3456
#define XB_SPIN_CAP (1u << 18)
__device__ __forceinline__ unsigned xb_ld(unsigned* p)              { return __hip_atomic_load(p, __ATOMIC_RELAXED, __HIP_MEMORY_SCOPE_AGENT); }
__device__ __forceinline__ unsigned xb_add(unsigned* p, unsigned v) { return __hip_atomic_fetch_add(p, v, __ATOMIC_RELAXED, __HIP_MEMORY_SCOPE_AGENT); }
__device__ __forceinline__ unsigned xb_xcc_id() { return (unsigned)__builtin_amdgcn_s_getreg((3 << 11) | 20) & 0xFu; }
#define XB_SPIN(cond, bar) do { unsigned _sp = 0; while (cond) { __builtin_amdgcn_s_sleep(1); \
    if ((++_sp & 255u) == 0u) { if (xb_ld(&(bar)[XB_TMO])) break; if (_sp > XB_SPIN_CAP) { atomicAdd(&(bar)[XB_TMO], 1u); break; } } } } while (0)
__device__ __forceinline__ void xcd_barrier_complete(unsigned* bar, unsigned x, unsigned& nloc, unsigned& nx) {
    const unsigned G = gridDim.x * gridDim.y * gridDim.z;
    unsigned sum, cnt, mine, sp = 0u;
    for (;;) {
        sum = 0u; cnt = 0u; mine = 0u;
#pragma unroll
        for (unsigned j = 0; j < 16; ++j) { const unsigned c = xb_ld(&bar[XB_XCNT(j)]); sum += c; cnt += (c > 0u) ? 1u : 0u; mine = (j == x) ? c : mine; }
        if (sum == G) break;
        __builtin_amdgcn_s_sleep(1);
        if ((++sp & 255u) == 0u) { if (xb_ld(&bar[XB_TMO])) break; if (sp > XB_SPIN_CAP) { atomicAdd(&bar[XB_TMO], 1u); break; } }
    }
    nloc = mine > 0u ? mine : 1u; nx = cnt > 0u ? cnt : 1u;
}
__device__ __forceinline__ void xcd_barrier(unsigned* bar, volatile LAS unsigned* st) {
    asm volatile("s_waitcnt vmcnt(0)" ::: "memory");
    __syncthreads();
    if (threadIdx.x == 0) {
        __builtin_amdgcn_s_waitcnt(0);
        const unsigned x = xb_xcc_id();
        unsigned nloc = st[0], nx = st[1];
        if (nloc == 0u) { xcd_barrier_complete(bar, x, nloc, nx); st[0] = nloc; st[1] = nx; }
        const unsigned old = xb_add(&bar[XB_XSUB(x)], 1u);
        const unsigned gen = old / nloc;
        if (old + 1u == (gen + 1u) * nloc) {
            __builtin_amdgcn_fence(__ATOMIC_RELEASE, "agent");
            asm volatile("s_waitcnt vmcnt(0)" ::: "memory");
            const unsigned og = xb_add(&bar[XB_TOP], 1u);
            const unsigned tg = og / nx;
            if (og + 1u == (tg + 1u) * nx) xb_add(&bar[XB_TOPGEN], 1u);
            else XB_SPIN(xb_ld(&bar[XB_TOPGEN]) == tg, bar);
            __builtin_amdgcn_fence(__ATOMIC_ACQUIRE, "agent");
            xb_add(&bar[XB_XGEN(x)], 1u);
            asm volatile("s_waitcnt vmcnt(0)" ::: "memory");
        } else {
            XB_SPIN(xb_ld(&bar[XB_XGEN(x)]) == gen, bar);
            __builtin_amdgcn_fence(__ATOMIC_ACQUIRE, "agent");
            asm volatile("s_waitcnt vmcnt(0)" ::: "memory");
        }
    }
    __syncthreads();
}

constexpr int N_PHASES = 14;
__global__ void __launch_bounds__(512, 2) fwd_kernel(Params p) {
    extern __shared__ __attribute__((aligned(16))) unsigned char lds[];
    const int G = gridDim.x;
    const int lo = p.ph_lo, hi = p.ph_hi;
    unsigned* const xbar = (unsigned*)(p.ws + WS_BAR);
    volatile LAS unsigned* const xst = (volatile LAS unsigned*)((LAS unsigned char*)lds + 131072 + 64);
    if (threadIdx.x < 2) xst[threadIdx.x] = 0u;
    __syncthreads();
    if (lo < 0) cg::this_grid().sync();
    if (hi - lo > 1 && threadIdx.x == 0) (void)xb_add(&xbar[XB_XCNT(xb_xcc_id())], 1u);
#ifndef PHMASK
#define PHMASK 0xffff
#endif
#define IN(k) (((PHMASK >> ((k) < 2 ? (k) : 2 + ((k) - 2) % 6)) & 1) && lo <= (k) && (k) < hi)
#define SEAM(k) do { STAMP(2 * (k)); if (IN(k) && IN((k) + 1)) { xcd_barrier(xbar, xst); } STAMP(2 * (k) + 1); } while (0)
#define FRESH() int tid = threadIdx.x; asm volatile("" : "+v"(tid)); int bx = blockIdx.x; asm volatile("" : "+s"(bx)); \
    const int lane = tid & 63, wave = __builtin_amdgcn_readfirstlane(tid >> 6); \
    const Params q = fresh_params(p); (void)lane; (void)wave; (void)bx;
    unsigned long long tacc = 0ull, tprev = (PMASK != 0ull) ? __builtin_amdgcn_s_memrealtime() : 0ull;
#define STAMP(idx) do { if (PMASK != 0ull) { const unsigned long long now_ = __builtin_amdgcn_s_memrealtime(); if ((PMASK >> (idx)) & 1ull) tacc += now_ - tprev; tprev = now_; } } while (0)
    if (IN(0)) for (int rep = 0; rep < REPN(0); ++rep) { FRESH(); mod_items(q, 0, lds, tid, wave, lane, bx); __syncthreads(); p0_transposes(q, lds, wave, lane, bx, 0); }
    SEAM(0);
    if (IN(1)) for (int rep = 0; rep < REPN(1); ++rep) { FRESH(); mod_items(q, 1, lds, tid, wave, lane, bx); __syncthreads(); STAMP(32); p0_convert(q, lds, tid, wave, lane, bx); STAMP(33); row_pass(q, 0, wave, lane, bx); }
    SEAM(1);
#pragma unroll 1
    for (int l = 0; l < 2; ++l) {
        const int pb = 2 + 6 * l;
        if (IN(pb)) for (int rep = 0; rep < REPN(2); ++rep) {
            FRESH();
            pg8::Gemm g{(const bf16_t*)(q.ws + WS_H), (const bf16_t*)(q.ws + WS_WIN + (size_t)l * WIN_BYTES), M, NPAD, D};
            pg8::StaticOrder S; S.init(M, NPAD, G, bx);
            pg8::EpiProj E{(bf16_t*)(q.ws + WS_PROJ), (float*)(q.ws + WS_CG), (float*)(q.ws + WS_SGST)};
            pg8::gemm_phase<pg8::EpiProj, pg8::StaticOrder, true, true>((LAS unsigned char*)lds, g, S, E, tid);
        }
        SEAM(pb);
        if (IN(pb + 1)) for (int rep = 0; rep < REPN(3); ++rep) {
#ifndef MIXMASK
#define MIXMASK 7
#endif
            for (int rr = 0; rr < ((MIXR >> 0) & 15); ++rr) { FRESH(); for (int it = bx; it < 256; it += G) attn_item(q, l, it, lds, tid, wave, lane); }
            STAMP(36 + 4 * l); for (int rr = 0; rr < ((MIXR >> 4) & 15); ++rr) { FRESH(); for (int it = bx; it < 256; it += G) sg_pair_item(q, l, it, lds, tid, wave, lane); } STAMP(37 + 4 * l);
            for (int rr = 0; rr < ((MIXR >> 8) & 15); ++rr) { FRESH(); for (int it = bx; it < 512; it += G) gla_local_item(q, l, it, lds, tid, wave, lane); }
        }
        SEAM(pb + 1);
        if (IN(pb + 2)) for (int rep = 0; rep < REPN(4); ++rep) { FRESH(); gla_scan(q, tid, bx); }
        SEAM(pb + 2);
        if (IN(pb + 3)) for (int rep = 0; rep < REPN(5); ++rep) { FRESH(); for (int it = bx; it < 256; it += G) gla_out_pair(q, l, it, lds, tid, wave, lane); }
        SEAM(pb + 3);
        if (IN(pb + 4)) for (int rep = 0; rep < REPN(6); ++rep) {
            FRESH();
            pg8::Gemm g{(const bf16_t*)(q.ws + WS_Y), (const bf16_t*)(q.ws + WS_WOUT + (size_t)l * WOUT_BYTES), M, D, D};
            pg8::StaticOrder S; S.init(M, D, G, bx);
            pg8::EpiOut E{(bf16_t*)(q.ws + WS_OUT)};
            pg8::gemm_phase<pg8::EpiOut, pg8::StaticOrder, true, true>((LAS unsigned char*)lds, g, S, E, tid);
        }
        SEAM(pb + 4);
        if (IN(pb + 5)) { FRESH(); row_pass(q, l + 1, wave, lane, bx); }
        if (l == 0) SEAM(pb + 5);
    }
    STAMP(26);
    if (PMASK != 0ull) { if (blockIdx.x == 0 && threadIdx.x == 0) { const unsigned long long t0 = __builtin_amdgcn_s_memrealtime(); while (__builtin_amdgcn_s_memrealtime() - t0 < tacc) __builtin_amdgcn_s_sleep(8); } }
#undef IN
#undef SEAM
#undef FRESH
}

extern "C" void kernel_launch(void* const* d_in, const int* in_sizes, int n_in, void* d_out, int out_size, void* d_ws, size_t ws_size, hipStream_t stream) {
    static int grid = 0;
    if (grid == 0) {
        if (n_in != 17 || in_sizes[0] != M * D || out_size != M * D || ws_size < WS_END) { fprintf(stderr, "kernel_launch: unexpected shapes (n_in %d, in0 %d, out %d, ws %zu)\n", n_in, n_in > 0 ? in_sizes[0] : -1, out_size, ws_size); grid = -1; return; }
        int dev = 0, cus = 0, per_cu = 0;
        if (hipGetDevice(&dev) != hipSuccess || hipDeviceGetAttribute(&cus, hipDeviceAttributeMultiprocessorCount, dev) != hipSuccess) { grid = -1; return; }
        if (hipFuncSetAttribute((const void*)fwd_kernel, hipFuncAttributeMaxDynamicSharedMemorySize, LDS_BYTES) != hipSuccess) { fprintf(stderr, "kernel_launch: hipFuncSetAttribute failed\n"); grid = -1; return; }
        if (hipOccupancyMaxActiveBlocksPerMultiprocessor(&per_cu, (const void*)fwd_kernel, 512, LDS_BYTES) != hipSuccess || per_cu < 1) { fprintf(stderr, "kernel_launch: occupancy query says %d blocks per CU\n", per_cu); per_cu = 1; }
        (void)hipGetLastError();
        grid = cus;
    }
    if (grid < 0) return;
    Params p{};
    p.x = (const float*)d_in[0]; p.c = (const float*)d_in[1]; p.pos = (const int*)d_in[2]; p.w_mod = (const float*)d_in[3]; p.b_mod = (const float*)d_in[4];
    p.g_pre = (const float*)d_in[5]; p.g_post = (const float*)d_in[6]; p.w_in = (const float*)d_in[7]; p.w_out = (const float*)d_in[8]; p.sinks = (const float*)d_in[9];
    p.sg_w = (const float*)d_in[10]; p.sg_b = (const float*)d_in[11]; p.sg_ln_g = (const float*)d_in[12]; p.sg_ln_b = (const float*)d_in[13];
    p.gla_wup = (const float*)d_in[14]; p.gla_bg = (const float*)d_in[15]; p.gla_ng = (const float*)d_in[16];
    p.out = (float*)d_out; p.ws = (unsigned char*)d_ws;
#if MK_SINGLE
    if (hipMemsetAsync((char*)d_ws + WS_BAR, 0, XCD_BAR_WORDS * 4, stream) != hipSuccess) { fprintf(stderr, "kernel_launch: memset failed\n"); return; }
    p.ph_lo = 0; p.ph_hi = N_PHASES;
    void* args[] = {&p};
    hipError_t e = hipLaunchCooperativeKernel((const void*)fwd_kernel, dim3(grid), dim3(512), args, LDS_BYTES, stream);
    if (e != hipSuccess) fprintf(stderr, "kernel_launch: cooperative launch failed: %s (grid %d)\n", hipGetErrorString(e), grid);
#else
    for (int ph = 0; ph < N_PHASES; ++ph) {
        p.ph_lo = ph; p.ph_hi = ph + 1;
        hipLaunchKernelGGL(fwd_kernel, dim3(grid), dim3(512), LDS_BYTES, stream, p);
    }
#endif
}
```

```cpp
#include <hip/hip_runtime.h>
#include <hip/hip_cooperative_groups.h>
#include <cstdio>
#include <cstdint>
namespace cg = cooperative_groups;

#ifndef REPS
#define REPS 0x11111111
#endif
#define REPN(k) ((REPS >> (4 * (k))) & 15)
#ifndef PMASK
#define PMASK 0ull
#endif
#ifndef MIXR
#define MIXR 0x111
#endif
#ifndef MK_SINGLE
#define MK_SINGLE 1
#endif

#define LAS __attribute__((address_space(3)))
typedef unsigned short bf16_t;
typedef short bf16x8 __attribute__((ext_vector_type(8)));
typedef float f32x4 __attribute__((ext_vector_type(4)));
typedef float f32x2 __attribute__((ext_vector_type(2)));
typedef unsigned u32x4 __attribute__((ext_vector_type(4)));
typedef unsigned u32x2 __attribute__((ext_vector_type(2)));

constexpr int D = 2048, NB = 4, SEQ = 2048, M = NB * SEQ;
constexpr int NPROJ = 5632;
constexpr int NPAD = 5888;
constexpr int WIN_LD = 5648;
constexpr float EPS = 1e-6f;
constexpr int C_AQ = 0, C_AK = 1024, C_AV = 1280, C_SU = 1536, C_SV = 2048, C_CQ = 2560, C_CK = 2816, C_CV = 3072, C_Z = 3584;
constexpr float LOG2E = 1.4426950408889634f;

constexpr size_t MiB = 1u << 20;
constexpr size_t WS_WIN = 0, WIN_BYTES = (size_t)NPAD * D * 2;
constexpr size_t WS_WOUT = 46 * MiB, WOUT_BYTES = (size_t)D * D * 2;
constexpr size_t WS_H = 62 * MiB, WS_PROJ = 94 * MiB, WS_CG = 182 * MiB, WS_MOD = 183 * MiB, WS_Y = 184 * MiB, WS_OUT = 216 * MiB;
constexpr size_t WS_LOCT = 248 * MiB, WS_ST = 264 * MiB, WS_DEC = 272 * MiB, WS_BAR = 273 * MiB, WS_QD = 274 * MiB, WS_KD = 278 * MiB, WS_VTG = 282 * MiB, WS_X1B = 290 * MiB, WS_SGST = 322 * MiB, WS_SGW = 323 * MiB, WS_END = 324 * MiB;

constexpr int LDS_BYTES = 135168;

struct Params {
    const float* x; const float* c; const int* pos; const float* w_mod; const float* b_mod; const float* g_pre; const float* g_post;
    const float* w_in; const float* w_out; const float* sinks; const float* sg_w; const float* sg_b; const float* sg_ln_g; const float* sg_ln_b;
    const float* gla_wup; const float* gla_bg; const float* gla_ng;
    float* out; unsigned char* ws; int ph_lo, ph_hi;
};

__device__ __forceinline__ Params fresh_params(const Params& p) {
#if defined(__HIP_DEVICE_COMPILE__)
    typedef unsigned long long u64;
    const __attribute__((address_space(4))) u64* pp = (const __attribute__((address_space(4))) u64*)__builtin_amdgcn_kernarg_segment_ptr();
    asm volatile("" : "+s"(pp));
    Params q; u64* dst = (u64*)&q;
#pragma unroll
    for (int i = 0; i < (int)(sizeof(Params) / 8); ++i) dst[i] = pp[i];
    return q;
#else
    return p;
#endif
}
static_assert(sizeof(Params) % 8 == 0, "Params is copied in 8-byte words");

typedef __bf16 bf16x2_t __attribute__((ext_vector_type(2)));
__device__ __forceinline__ unsigned cvt_pk_bf16(float lo, float hi) { const f32x2 v = {lo, hi}; const bf16x2_t b = __builtin_convertvector(v, bf16x2_t); return __builtin_bit_cast(unsigned, b); }
__device__ __forceinline__ float bf_lo(unsigned u) { return __builtin_bit_cast(float, u << 16); }
__device__ __forceinline__ float bf_hi(unsigned u) { return __builtin_bit_cast(float, u & 0xffff0000u); }
__device__ __forceinline__ float bf1(bf16_t v) { return __builtin_bit_cast(float, (unsigned)v << 16); }
__device__ __forceinline__ bf16_t f2bf(float f) { return (bf16_t)(cvt_pk_bf16(f, 0.f) & 0xffffu); }
__device__ __forceinline__ float fast_exp2(float x) { return __builtin_amdgcn_exp2f(x); }
__device__ __forceinline__ float fast_rcp(float x) { return __builtin_amdgcn_rcpf(x); }
__device__ __forceinline__ float silu_f(float x) { return x * fast_rcp(1.f + fast_exp2(-x * LOG2E)); }
__device__ __forceinline__ float gelu_tanh_f(float x) { const float u = 0.7978845608028654f * (x + 0.044715f * x * x * x); return x * fast_rcp(1.f + fast_exp2(-2.f * LOG2E * u)); }
__device__ __forceinline__ float wave_sum(float v) {
#pragma unroll
    for (int o = 1; o < 64; o <<= 1) v += __shfl_xor(v, o);
    return v;
}

typedef short v4i16_t __attribute__((ext_vector_type(4)));
__device__ __forceinline__ bf16x8 tr_operand(const void* p0, const void* p1) {
    const v4i16_t a = __builtin_amdgcn_ds_read_tr16_b64_v4i16((__attribute__((address_space(3))) v4i16_t*)p0);
    const v4i16_t b = __builtin_amdgcn_ds_read_tr16_b64_v4i16((__attribute__((address_space(3))) v4i16_t*)p1);
    return __builtin_shufflevector(a, b, 0, 1, 2, 3, 4, 5, 6, 7);
}
#define MFMA16(a, b, c) __builtin_amdgcn_mfma_f32_16x16x32_bf16((a), (b), (c), 0, 0, 0)

namespace pg8 {
#define PG8_LAS __attribute__((address_space(3)))
constexpr int BM = 256, BK = 64, HALF = 128, HTB = HALF * BK * 2, STAGE_BYTES = 8 * HTB, NXCD = 8, WGM = 8;
__host__ __device__ __forceinline__ int lds_byte(int r, int c) { const int st = (r >> 4) * 2 + (c >> 5), rr = r & 15, cc = c & 31, ob = rr * 64 + cc * 2; return st * 1024 + (ob ^ (((ob >> 9) & 1) << 5)); }
__host__ __device__ __forceinline__ void stage_rc(int b, int& R, int& C) { const int st = b / 1024, sb = b % 1024, swz = sb ^ (((sb >> 9) & 1) << 5); R = (st >> 1) * 16 + swz / 64; C = (st & 1) * 32 + (swz % 64) / 2; }
__host__ __device__ __forceinline__ int perm32(int rho) { const int n = rho >> 4, i = rho & 15; return 8 * (i >> 2) + 4 * n + (i & 3); }
struct Unit { int pm, pn; };
struct Gemm { const bf16_t* A; const bf16_t* Bt; int M, N, K; };
struct StaticOrder {
    int nM, nN, nwg, G, c;
    __host__ __device__ void init(int M_, int N_, int G_, int c_) { nM = M_ / BM; nN = N_ / BM; nwg = nM * nN; G = G_; c = c_; }
    __host__ __device__ bool next(int i, Unit& u) const {
        const long L = (long)i * G + c; if (L >= nwg) return false;
        int wgid = (int)L; { const int q = nwg / NXCD, r = nwg % NXCD, xcd = wgid % NXCD, off = wgid / NXCD; wgid = (xcd < r ? xcd * (q + 1) : r * (q + 1) + (xcd - r) * q) + off; }
        const int nig = WGM * nN, gid = wgid / nig, fm = gid * WGM, gsz = (nM - fm) < WGM ? (nM - fm) : WGM;
        u.pm = fm + ((wgid % nig) % gsz); u.pn = (wgid % nig) / gsz; return true;
    }
    __device__ __forceinline__ void a_ready(const Unit&) const {}
    __device__ __forceinline__ void done(const Unit&) const {}
};

template <class Epi, class Sched, bool ALIGN_EPI = false, bool SP2 = false>
__device__ __forceinline__ void gemm_phase(PG8_LAS unsigned char* lds, const Gemm g, const Sched& S, const Epi& E, const int tid) {
    const int wid = __builtin_amdgcn_readfirstlane(tid >> 6), lane = tid & 63, wr = wid >> 2, wc = wid & 3, fr = lane & 15, fq = lane >> 4;
    const int K = g.K, nt = K / BK;
    unsigned voffA[2], voffB[2];
#pragma unroll
    for (int i = 0; i < 2; ++i) { int R, C; stage_rc(tid * 16 + i * 8192, R, C); const int Rb = Epi::PERM ? ((R & ~31) + perm32(R & 31)) : R;
        voffA[i] = (unsigned)(R * K + C) * 2u; voffB[i] = (unsigned)(Rb * K + C) * 2u; }
    const size_t kstep = (size_t)(BK * 2);
    const size_t hstep = (size_t)HALF * K * 2;
    const size_t tstep = 2 * hstep;
    const unsigned ldsw = (unsigned)wid * 1024u;
    const int aoff = lds_byte(wr * 64 + fr, fq * 8), boff = lds_byte(wc * 32 + fr, fq * 8);
#define PG8_SA(b, h) (((b) * 2 + (h)) * HTB)
#define PG8_SB(b, h) ((4 + (b) * 2 + (h)) * HTB)
#define PG8_STAGE(bufoff, gbase, voff) do { _Pragma("unroll") for (int _i = 0; _i < 2; ++_i) \
        __builtin_amdgcn_global_load_lds((const unsigned*)((const char*)(gbase) + (voff)[_i]), (PG8_LAS unsigned*)(lds + (bufoff) + ldsw + _i * 8192), 16, 0, 0); } while (0)
#define PG8_LDA(dst, b, h) do { _Pragma("unroll") for (int m = 0; m < 4; ++m) _Pragma("unroll") for (int k = 0; k < 2; ++k) dst[m][k] = *(const PG8_LAS bf16x8*)(lds + PG8_SA(b, h) + aoff + m * 2048 + k * 1024); } while (0)
#define PG8_LDB(dst, b, h) do { _Pragma("unroll") for (int n = 0; n < 2; ++n) _Pragma("unroll") for (int k = 0; k < 2; ++k) dst[n][k] = *(const PG8_LAS bf16x8*)(lds + PG8_SB(b, h) + boff + n * 2048 + k * 1024); } while (0)
#define PG8_MMA(ai, bj, At, Bt) do { __builtin_amdgcn_s_setprio(1); _Pragma("unroll") for (int m = 0; m < 4; ++m) _Pragma("unroll") for (int n = 0; n < 2; ++n) _Pragma("unroll") for (int k = 0; k < 2; ++k) \
        acc[ai][bj][m][n] = __builtin_amdgcn_mfma_f32_16x16x32_bf16(Bt[n][k], At[m][k], acc[ai][bj][m][n], 0, 0, 0); __builtin_amdgcn_s_setprio(0); } while (0)
#define PG8_WAIT_V(n) asm volatile("s_waitcnt vmcnt(" #n ")" ::: "memory")
#define PG8_WAIT_L(n) asm volatile("s_waitcnt lgkmcnt(" #n ")" ::: "memory")
#define PG8_BAR __builtin_amdgcn_s_barrier()
#define PG8_SCHED __builtin_amdgcn_sched_barrier(0)
    Unit cur, nxt; int ui = 0;
    if (!S.next(0, cur)) return;
    f32x4 acc[2][2][4][2];
#pragma unroll
    for (int a = 0; a < 2; ++a)
#pragma unroll
        for (int b = 0; b < 2; ++b)
#pragma unroll
            for (int m = 0; m < 4; ++m)
#pragma unroll
                for (int n = 0; n < 2; ++n) acc[a][b][m][n] = (f32x4){0.f, 0.f, 0.f, 0.f};
    bf16x8 At[4][2], B0[2][2], B1[2][2];
    const char* cA = (const char*)g.A + (size_t)cur.pm * tstep; const char* cB = (const char*)g.Bt + (size_t)cur.pn * tstep;
    S.a_ready(cur);
    if constexpr (SP2) {
        PG8_STAGE(PG8_SB(0, 0), cB, voffB); PG8_STAGE(PG8_SB(0, 1), cB + hstep, voffB); PG8_STAGE(PG8_SA(0, 0), cA, voffA); PG8_STAGE(PG8_SA(0, 1), cA + hstep, voffA);
        if (wr == 1) PG8_BAR;
        PG8_WAIT_V(2); PG8_BAR;
        PG8_STAGE(PG8_SB(1, 0), cB + kstep, voffB); PG8_STAGE(PG8_SA(1, 0), cA + kstep, voffA); PG8_STAGE(PG8_SB(1, 1), cB + hstep + kstep, voffB);
        PG8_WAIT_V(6); PG8_BAR;
    } else {
        PG8_STAGE(PG8_SB(0, 0), cB, voffB); PG8_STAGE(PG8_SA(0, 0), cA, voffA); PG8_STAGE(PG8_SB(0, 1), cB + hstep, voffB); PG8_STAGE(PG8_SA(0, 1), cA + hstep, voffA);
        if (wr == 1) PG8_BAR;
        PG8_WAIT_V(4); PG8_BAR;
        PG8_STAGE(PG8_SB(1, 0), cB + kstep, voffB); PG8_STAGE(PG8_SA(1, 0), cA + kstep, voffA); PG8_STAGE(PG8_SB(1, 1), cB + hstep + kstep, voffB);
        PG8_WAIT_V(6); PG8_BAR;
    }
    for (;;) {
        const bool has_next = S.next(ui + 1, nxt);
        const char* nA = has_next ? (const char*)g.A + (size_t)nxt.pm * tstep : cA; const char* nB = has_next ? (const char*)g.Bt + (size_t)nxt.pn * tstep : cB;
        for (int t = 0; t < nt; t += 2) {
            const bool last = (t == nt - 2);
            const char* a1 = cA + (size_t)(t + 1) * kstep;
            const char* a2 = last ? nA : cA + (size_t)(t + 2) * kstep; const char* b2 = last ? nB : cB + (size_t)(t + 2) * kstep;
            const char* a3 = a2 + kstep; const char* b3 = b2 + kstep;
            if (last && has_next) S.a_ready(nxt);
            if constexpr (SP2) {
            PG8_LDB(B0, 0, 0); PG8_LDB(B1, 0, 1); PG8_SCHED; PG8_LDA(At, 0, 0); PG8_STAGE(PG8_SA(1, 1), a1 + hstep, voffA);
            PG8_WAIT_V(8); PG8_WAIT_L(0); PG8_BAR; PG8_MMA(0, 0, At, B0); PG8_MMA(0, 1, At, B1); PG8_BAR; PG8_SCHED;
            PG8_LDA(At, 0, 1); PG8_STAGE(PG8_SB(0, 0), b2, voffB); PG8_STAGE(PG8_SB(0, 1), b2 + hstep, voffB); PG8_STAGE(PG8_SA(0, 0), a2, voffA);
            PG8_WAIT_V(8); PG8_WAIT_L(0); PG8_BAR; PG8_MMA(1, 0, At, B0); PG8_MMA(1, 1, At, B1); PG8_BAR; PG8_SCHED;
            PG8_LDB(B0, 1, 0); PG8_LDB(B1, 1, 1); PG8_SCHED; PG8_LDA(At, 1, 0); PG8_STAGE(PG8_SA(0, 1), a2 + hstep, voffA);
            PG8_WAIT_V(8); PG8_WAIT_L(0); PG8_BAR; PG8_MMA(0, 0, At, B0); PG8_MMA(0, 1, At, B1); PG8_BAR; PG8_SCHED;
            PG8_LDA(At, 1, 1); PG8_STAGE(PG8_SB(1, 0), b3, voffB); PG8_STAGE(PG8_SB(1, 1), b3 + hstep, voffB); PG8_STAGE(PG8_SA(1, 0), a3, voffA);
            PG8_WAIT_V(8); PG8_WAIT_L(0); PG8_BAR; PG8_MMA(1, 0, At, B0); PG8_MMA(1, 1, At, B1); PG8_BAR; PG8_SCHED;
            } else {
            PG8_LDB(B0, 0, 0); PG8_SCHED; PG8_LDA(At, 0, 0); PG8_STAGE(PG8_SA(1, 1), a1 + hstep, voffA);
            PG8_WAIT_L(8); PG8_BAR; PG8_WAIT_L(0); PG8_MMA(0, 0, At, B0); PG8_BAR; PG8_SCHED;
            PG8_LDB(B1, 0, 1); PG8_STAGE(PG8_SB(0, 0), b2, voffB);
            PG8_BAR; PG8_WAIT_L(0); PG8_MMA(0, 1, At, B1); PG8_BAR;
            PG8_LDA(At, 0, 1); PG8_STAGE(PG8_SA(0, 0), a2, voffA);
            PG8_BAR; PG8_WAIT_L(0); PG8_MMA(1, 0, At, B0); PG8_BAR; PG8_SCHED;
            PG8_STAGE(PG8_SB(0, 1), b2 + hstep, voffB);
            PG8_WAIT_V(6); PG8_BAR; PG8_MMA(1, 1, At, B1); PG8_BAR;
            PG8_LDB(B0, 1, 0); PG8_SCHED; PG8_LDA(At, 1, 0); PG8_STAGE(PG8_SA(0, 1), a2 + hstep, voffA);
            PG8_WAIT_L(8); PG8_BAR; PG8_WAIT_L(0); PG8_MMA(0, 0, At, B0); PG8_BAR; PG8_SCHED;
            PG8_LDB(B1, 1, 1); PG8_STAGE(PG8_SB(1, 0), b3, voffB);
            PG8_BAR; PG8_WAIT_L(0); PG8_MMA(0, 1, At, B1); PG8_BAR;
            PG8_LDA(At, 1, 1); PG8_STAGE(PG8_SA(1, 0), a3, voffA);
            PG8_BAR; PG8_WAIT_L(0); PG8_MMA(1, 0, At, B0); PG8_BAR; PG8_SCHED;
            PG8_STAGE(PG8_SB(1, 1), b3 + hstep, voffB);
            PG8_WAIT_V(6); PG8_BAR; PG8_MMA(1, 1, At, B1); PG8_BAR;
            }
        }
        if constexpr (ALIGN_EPI) { if (wr == 0) PG8_BAR; }
        E(acc, cur, wr, wc, fr, fq); S.done(cur);
        if (!has_next) break;
#pragma unroll
        for (int a = 0; a < 2; ++a)
#pragma unroll
            for (int b = 0; b < 2; ++b)
#pragma unroll
                for (int m = 0; m < 4; ++m)
#pragma unroll
                    for (int n = 0; n < 2; ++n) acc[a][b][m][n] = (f32x4){0.f, 0.f, 0.f, 0.f};
        cur = nxt; cA = nA; cB = nB; ++ui;
        if constexpr (ALIGN_EPI) { if (wr == 1) PG8_BAR; }
    }
    PG8_WAIT_V(0);
    if constexpr (!ALIGN_EPI) { if (wr == 0) PG8_BAR; }
    PG8_BAR;
#undef PG8_SA
#undef PG8_SB
#undef PG8_STAGE
#undef PG8_LDA
#undef PG8_LDB
#undef PG8_MMA
#undef PG8_WAIT_V
#undef PG8_WAIT_L
#undef PG8_BAR
#undef PG8_SCHED
}

struct EpiProj {
    static constexpr bool PERM = true;
    bf16_t* P; float* CG; float* SGST;
    template <int ACT> __device__ __forceinline__ void store_tile(const f32x4 (&acc)[2][2][4][2], bf16_t* base, float* stp, int fq) const {
#pragma unroll
        for (int ai = 0; ai < 2; ++ai)
#pragma unroll
            for (int m = 0; m < 4; ++m) { bf16_t* rowp = base + (size_t)(ai * HALF + m * 16) * NPROJ;
                float rs = 0.f, rq = 0.f;
#pragma unroll
                for (int bj = 0; bj < 2; ++bj) { f32x4 v0 = acc[ai][bj][m][0], v1 = acc[ai][bj][m][1];
                    if (ACT == 1) { for (int e = 0; e < 4; ++e) { v0[e] = gelu_tanh_f(v0[e]); v1[e] = gelu_tanh_f(v1[e]); } }
                    if (ACT == 2) { for (int e = 0; e < 4; ++e) { v0[e] = silu_f(v0[e]); v1[e] = silu_f(v1[e]); } }
                    if (ACT == 1) { rs += ((v0[0] + v0[1]) + (v0[2] + v0[3])) + ((v1[0] + v1[1]) + (v1[2] + v1[3]));
                        rq += ((v0[0] * v0[0] + v0[1] * v0[1]) + (v0[2] * v0[2] + v0[3] * v0[3])) + ((v1[0] * v1[0] + v1[1] * v1[1]) + (v1[2] * v1[2] + v1[3] * v1[3])); }
                    u32x4 w; w.x = cvt_pk_bf16(v0[0], v0[1]); w.y = cvt_pk_bf16(v0[2], v0[3]); w.z = cvt_pk_bf16(v1[0], v1[1]); w.w = cvt_pk_bf16(v1[2], v1[3]);
                    *(u32x4*)(rowp + bj * HALF) = w; }
                if (ACT == 1) { if (stp) { rs += __shfl_xor(rs, 16); rs += __shfl_xor(rs, 32); rq += __shfl_xor(rq, 16); rq += __shfl_xor(rq, 32);
                    if (fq == 0) *(f32x2*)(stp + (size_t)(ai * HALF + m * 16) * 16) = (f32x2){rs, rq}; } } }
    }
    __device__ __forceinline__ void operator()(const f32x4 (&acc)[2][2][4][2], const Unit& u, int wr, int wc, int fr, int fq) const {
        const int row0 = u.pm * BM + wr * 64 + fr;
        if (u.pn < 22) {
            bf16_t* base = P + (size_t)row0 * NPROJ + u.pn * BM + wc * 32 + 8 * fq;
            if (u.pn >= 6 && u.pn < 10) store_tile<1>(acc, base, (u.pn >= 8) ? SGST + (size_t)row0 * 16 + ((u.pn - 8) * 4 + wc) * 2 : nullptr, fq);
            else if (u.pn >= 14) store_tile<2>(acc, base, nullptr, fq);
            else store_tile<0>(acc, base, nullptr, fq);
        } else if (wc == 0 && fq < 2) {
#pragma unroll
            for (int ai = 0; ai < 2; ++ai)
#pragma unroll
                for (int m = 0; m < 4; ++m) { float* p = CG + (size_t)(row0 + ai * HALF + m * 16) * 16 + 8 * fq;
                    *(f32x4*)p = acc[ai][0][m][0]; *(f32x4*)(p + 4) = acc[ai][0][m][1]; }
        }
    }
};
struct EpiOut {
    static constexpr bool PERM = true;
    bf16_t* O;
    __device__ __forceinline__ void operator()(const f32x4 (&acc)[2][2][4][2], const Unit& u, int wr, int wc, int fr, int fq) const {
        bf16_t* base = O + (size_t)(u.pm * BM + wr * 64 + fr) * D + u.pn * BM + wc * 32 + 8 * fq;
#pragma unroll
        for (int ai = 0; ai < 2; ++ai)
#pragma unroll
            for (int m = 0; m < 4; ++m) { bf16_t* rowp = base + (size_t)(ai * HALF + m * 16) * D;
#pragma unroll
                for (int bj = 0; bj < 2; ++bj) { const f32x4 v0 = acc[ai][bj][m][0], v1 = acc[ai][bj][m][1];
                    u32x4 w; w.x = cvt_pk_bf16(v0[0], v0[1]); w.y = cvt_pk_bf16(v0[2], v0[3]); w.z = cvt_pk_bf16(v1[0], v1[1]); w.w = cvt_pk_bf16(v1[2], v1[3]);
                    *(u32x4*)(rowp + bj * HALF) = w; } }
    }
};
}

__device__ __forceinline__ void p0_transpose_item(const float* W, int ldw, int n_src0, bf16_t* WT, int row_dst0, int kb, float* scr, int lane) {
    const int k0 = 64 * kb;
    {   const int kr = lane >> 3, c4 = 4 * (lane & 7);
        const float* src = W + (size_t)(k0 + kr) * ldw + n_src0 + c4;
        f32x4 v[8];
#pragma unroll
        for (int i = 0; i < 8; ++i) v[i] = __builtin_nontemporal_load((const f32x4*)(src + (size_t)(8 * i) * ldw));
#pragma unroll
        for (int i = 0; i < 8; ++i) { float* d = scr + (8 * i + kr) * 33 + c4; d[0] = v[i][0]; d[1] = v[i][1]; d[2] = v[i][2]; d[3] = v[i][3]; }
    }
    asm volatile("s_waitcnt lgkmcnt(0)" ::: "memory");
    const int c = lane & 7;
#pragma unroll
    for (int j = 0; j < 4; ++j) { const int n = (lane >> 3) + 8 * j; const float* s = scr + (8 * c) * 33 + n;
        u32x4 o; o.x = cvt_pk_bf16(s[0 * 33], s[1 * 33]); o.y = cvt_pk_bf16(s[2 * 33], s[3 * 33]); o.z = cvt_pk_bf16(s[4 * 33], s[5 * 33]); o.w = cvt_pk_bf16(s[6 * 33], s[7 * 33]);
        *(u32x4*)(WT + (size_t)(row_dst0 + n) * D + k0 + 8 * c) = o; }
    asm volatile("s_waitcnt lgkmcnt(0)" ::: "memory");
}

__device__ __forceinline__ void mod_items(const Params& p, int l, unsigned char* lds, int tid, int wave, int lane, int bx) {
    const int G = gridDim.x;
    if (bx >= 192) return;
    float* sc = (float*)lds;
    float* red = (float*)(lds + 32768);
    for (int i = tid; i < 4 * D; i += 512) { const int b = i >> 11, k = i & (D - 1); sc[k * 4 + b] = silu_f(p.c[i]); }
    __syncthreads();
    for (int it = bx; it < 192; it += G) {
        const int n0 = 32 * it;
        const int r8 = lane >> 3, c4 = lane & 7;
        const float* wp = p.w_mod + ((size_t)l * D + wave * 256 + r8) * 6144 + n0 + 4 * c4;
        f32x4 a0 = {0, 0, 0, 0}, a1 = a0, a2 = a0, a3 = a0;
#pragma unroll 8
        for (int i = 0; i < 32; ++i) {
            const f32x4 w = __builtin_nontemporal_load((const f32x4*)(wp + (size_t)(8 * i) * 6144));
            const f32x4 s = *(const f32x4*)(sc + (wave * 256 + 8 * i + r8) * 4);
            a0 += w * s[0]; a1 += w * s[1]; a2 += w * s[2]; a3 += w * s[3];
        }
#pragma unroll
        for (int e = 0; e < 4; ++e) {
#pragma unroll
            for (int o = 8; o < 64; o <<= 1) { a0[e] += __shfl_xor(a0[e], o); a1[e] += __shfl_xor(a1[e], o); a2[e] += __shfl_xor(a2[e], o); a3[e] += __shfl_xor(a3[e], o); }
        }
        if (r8 == 0) {
            *(f32x4*)(red + (wave * 4 + 0) * 32 + 4 * c4) = a0; *(f32x4*)(red + (wave * 4 + 1) * 32 + 4 * c4) = a1;
            *(f32x4*)(red + (wave * 4 + 2) * 32 + 4 * c4) = a2; *(f32x4*)(red + (wave * 4 + 3) * 32 + 4 * c4) = a3;
        }
        __syncthreads();
        if (tid < 128) { const int b = tid >> 5, col = tid & 31; float s = p.b_mod[l * 6144 + n0 + col];
#pragma unroll
            for (int w = 0; w < 8; ++w) s += red[(w * 4 + b) * 32 + col];
            ((float*)(p.ws + WS_MOD))[(l * 4 + b) * 6144 + n0 + col] = s; }
        __syncthreads();
    }
}

__device__ __forceinline__ void p0_transposes(const Params& p, unsigned char* lds, int wave, int lane, int bx, int part) {
    const int G = gridDim.x;
    unsigned char* ws = p.ws;
    float* scr = (float*)(lds + wave * 16384);
    constexpr int PER_L = 32 * 240, NIT = 2 * PER_L;
    int base, end, stride;
    if (G == 256) {
        if (part == 0) { if (bx < 192) return; base = 13824 + (bx - 192) * 24; end = base + 24; }
        else if (bx < 192) { base = 49 * bx; end = base + 49; } else { base = 9408 + (bx - 192) * 69; end = base + 69; }
        base += wave; stride = 8;
    } else { if (part == 0) return; base = bx * 8 + wave; end = NIT; stride = G * 8; }
    for (int it = base; it < end; it += stride) {
        const int l = it / PER_L, r = it % PER_L, kb = r / 240, j = r % 240;
        bf16_t* WinT = (bf16_t*)(ws + WS_WIN + (size_t)l * WIN_BYTES);
        bf16_t* WoT = (bf16_t*)(ws + WS_WOUT + (size_t)l * WOUT_BYTES);
        if (j < 112) p0_transpose_item(p.w_in + (size_t)l * D * WIN_LD, WIN_LD, 32 * j, WinT, 32 * j, kb, scr, lane);
        else if (j < 176) p0_transpose_item(p.w_in + (size_t)l * D * WIN_LD, WIN_LD, 3600 + 32 * (j - 112), WinT, 3584 + 32 * (j - 112), kb, scr, lane);
        else p0_transpose_item(p.w_out + (size_t)l * D * D, D, 32 * (j - 176), WoT, 32 * (j - 176), kb, scr, lane);
    }
}

__device__ __forceinline__ void p0_convert(const Params& p, unsigned char* lds, int tid, int wave, int lane, int bx) {
    const int G = gridDim.x;
    unsigned char* ws = p.ws;
    {
        const int gt = bx * 512 + tid, NT = G * 512;
        for (int i = gt; i < 2 * 256 * (D / 8); i += NT) {
            const int l = i / (256 * (D / 8)), r = i % (256 * (D / 8)), j = r / (D / 8), k8 = (r % (D / 8)) * 8;
            u32x4 o = {0u, 0u, 0u, 0u};
            if (j < 16) { const float* s = p.w_in + ((size_t)l * D + k8) * WIN_LD + 3584 + j;
                o.x = cvt_pk_bf16(s[0], s[WIN_LD]); o.y = cvt_pk_bf16(s[2 * WIN_LD], s[3 * WIN_LD]); o.z = cvt_pk_bf16(s[4 * WIN_LD], s[5 * WIN_LD]); o.w = cvt_pk_bf16(s[6 * WIN_LD], s[7 * WIN_LD]); }
            *(u32x4*)((bf16_t*)(ws + WS_WIN + (size_t)l * WIN_BYTES) + (size_t)(5632 + j) * D + k8) = o;
        }
    }
    {
        const int gt = bx * 512 + tid;
        if (gt < 2 * 8 * 128 * 16) {
            const int t = (gt >> 4) & 127, s0 = (gt & 15) * 8;
            const float* src = p.sg_w + (size_t)gt * 8;
            const f32x4 f0 = *(const f32x4*)src, f1 = *(const f32x4*)(src + 4);
            float w[8] = {f0[0], f0[1], f0[2], f0[3], f1[0], f1[1], f1[2], f1[3]};
#pragma unroll
            for (int e = 0; e < 8; ++e) w[e] = (s0 + e <= t) ? w[e] : 0.f;
            *(u32x4*)((bf16_t*)(ws + WS_SGW) + (size_t)gt * 8) = (u32x4){cvt_pk_bf16(w[0], w[1]), cvt_pk_bf16(w[2], w[3]), cvt_pk_bf16(w[4], w[5]), cvt_pk_bf16(w[6], w[7])};
        }
    }
    p0_transposes(p, lds, wave, lane, bx, 1);
}

__device__ __forceinline__ void row_pass(const Params& p, int mode, int wave, int lane, int bx) {
    const int gw = bx * 8 + wave, NGW = gridDim.x * 8;
    unsigned char* ws = p.ws;
    const float* mod = (const float*)(ws + WS_MOD);
    const bf16_t* OUTB = (const bf16_t*)(ws + WS_OUT);
    bf16_t* H = (bf16_t*)(ws + WS_H);
    const int lpost = (mode == 2) ? 1 : 0, lpre = (mode == 0) ? 0 : 1;
    for (int gi = gw; gi < M / 4; gi += NGW) {
        const int r0 = 4 * gi, b = r0 >> 11;
        f32x4 gg[4][2], aa[4][2], tt[4][2];
        if (mode >= 1) {
            const float* gate = mod + (size_t)(lpost * 4 + b) * 6144 + 4096; const float* gp = p.g_post + lpost * D;
#pragma unroll
            for (int j = 0; j < 4; ++j)
#pragma unroll
                for (int h = 0; h < 2; ++h) { const int col = 8 * lane + 512 * j + 4 * h; gg[j][h] = *(const f32x4*)(gate + col) * *(const f32x4*)(gp + col); }
        }
        if (mode <= 1) {
            const float* shift = mod + (size_t)(lpre * 4 + b) * 6144; const float* scale = shift + 2048; const float* gp = p.g_pre + lpre * D;
#pragma unroll
            for (int j = 0; j < 4; ++j)
#pragma unroll
                for (int h = 0; h < 2; ++h) { const int col = 8 * lane + 512 * j + 4 * h;
                    aa[j][h] = *(const f32x4*)(gp + col) * (*(const f32x4*)(scale + col) + 1.f); tt[j][h] = *(const f32x4*)(shift + col); }
        }
#pragma unroll 1
        for (int k = 0; k < 4; ++k) {
            const int r = r0 + k;
            f32x4 v[4][2];
            if (mode == 2) {
                const bf16_t* x1b = (const bf16_t*)(ws + WS_X1B) + (size_t)r * D;
#pragma unroll
                for (int j = 0; j < 4; ++j) { const u32x4 w = *(const u32x4*)(x1b + 8 * lane + 512 * j);
                    v[j][0] = (f32x4){bf_lo(w.x), bf_hi(w.x), bf_lo(w.y), bf_hi(w.y)}; v[j][1] = (f32x4){bf_lo(w.z), bf_hi(w.z), bf_lo(w.w), bf_hi(w.w)}; }
            } else {
                const float* xin = p.x + (size_t)r * D;
#pragma unroll
                for (int j = 0; j < 4; ++j) { v[j][0] = *(const f32x4*)(xin + 8 * lane + 512 * j); v[j][1] = *(const f32x4*)(xin + 8 * lane + 512 * j + 4); }
            }
            if (mode >= 1) {
                f32x4 o[4][2]; float ss = 0.f;
#pragma unroll
                for (int j = 0; j < 4; ++j) { const u32x4 w = *(const u32x4*)(OUTB + (size_t)r * D + 8 * lane + 512 * j);
                    o[j][0] = (f32x4){bf_lo(w.x), bf_hi(w.x), bf_lo(w.y), bf_hi(w.y)}; o[j][1] = (f32x4){bf_lo(w.z), bf_hi(w.z), bf_lo(w.w), bf_hi(w.w)};
#pragma unroll
                    for (int h = 0; h < 2; ++h) ss += (o[j][h][0] * o[j][h][0] + o[j][h][1] * o[j][h][1]) + (o[j][h][2] * o[j][h][2] + o[j][h][3] * o[j][h][3]); }
                const float rstd = rsqrtf(wave_sum(ss) * (1.f / D) + EPS);
                float* xo = p.out + (size_t)r * D;
#pragma unroll
                for (int j = 0; j < 4; ++j)
#pragma unroll
                    for (int h = 0; h < 2; ++h) { const int col = 8 * lane + 512 * j + 4 * h;
                        v[j][h] = v[j][h] + gg[j][h] * (o[j][h] * rstd);
                        if (mode == 2) *(f32x4*)(xo + col) = v[j][h]; }
                if (mode == 1) {
                    bf16_t* x1b = (bf16_t*)(ws + WS_X1B) + (size_t)r * D;
#pragma unroll
                    for (int j = 0; j < 4; ++j) { u32x4 w; w.x = cvt_pk_bf16(v[j][0][0], v[j][0][1]); w.y = cvt_pk_bf16(v[j][0][2], v[j][0][3]); w.z = cvt_pk_bf16(v[j][1][0], v[j][1][1]); w.w = cvt_pk_bf16(v[j][1][2], v[j][1][3]);
                        *(u32x4*)(x1b + 8 * lane + 512 * j) = w;
                        v[j][0] = (f32x4){bf_lo(w.x), bf_hi(w.x), bf_lo(w.y), bf_hi(w.y)}; v[j][1] = (f32x4){bf_lo(w.z), bf_hi(w.z), bf_lo(w.w), bf_hi(w.w)}; }
                }
            }
            if (mode <= 1) {
                float ss = 0.f;
#pragma unroll
                for (int j = 0; j < 4; ++j)
#pragma unroll
                    for (int h = 0; h < 2; ++h) ss += (v[j][h][0] * v[j][h][0] + v[j][h][1] * v[j][h][1]) + (v[j][h][2] * v[j][h][2] + v[j][h][3] * v[j][h][3]);
                const float rstd = rsqrtf(wave_sum(ss) * (1.f / D) + EPS);
#pragma unroll
                for (int j = 0; j < 4; ++j) { f32x4 hh[2];
#pragma unroll
                    for (int h = 0; h < 2; ++h) hh[h] = (v[j][h] * rstd) * aa[j][h] + tt[j][h];
                    u32x4 w; w.x = cvt_pk_bf16(hh[0][0], hh[0][1]); w.y = cvt_pk_bf16(hh[0][2], hh[0][3]); w.z = cvt_pk_bf16(hh[1][0], hh[1][1]); w.w = cvt_pk_bf16(hh[1][2], hh[1][3]);
                    *(u32x4*)(H + (size_t)r * D + 8 * lane + 512 * j) = w; }
            }
        }
    }
}

__device__ __forceinline__ void rope_cs(int pos, int i, float& cs, float& sn) {
    constexpr float F[8] = {0.15915494309189535f, 0.03086376340470123f, 0.005985185712713705f, 0.001160663641240061f,
                            0.00022507907903927653f, 4.364795279280289e-05f, 8.464330808241401e-06f, 1.6414262627950345e-06f};
    const float rev = (float)pos * F[i];
    const float r = __builtin_amdgcn_fractf(rev);
    sn = __builtin_amdgcn_sinf(r); cs = __builtin_amdgcn_cosf(r);
}
constexpr int KS_LD = 72, VS_LD = 72;
__device__ __forceinline__ void attn_item(const Params& p, int l, int item, unsigned char* lds, int tid, int wave, int lane) {
    const int b = item >> 6, n = (item >> 2) & 15, g = item & 3;
    const int fr = lane & 15, fq = lane >> 4;
    bf16_t* Ks = (bf16_t*)lds;
    bf16_t* Vs = (bf16_t*)(lds + 256 * KS_LD * 2);
    const bf16_t* proj = (const bf16_t*)(p.ws + WS_PROJ);
    bf16_t* Y = (bf16_t*)(p.ws + WS_Y);
    const int r = wave >> 1, qh = wave & 1, hq = g * 4 + r;
    const int tokq0 = b * SEQ + n * 128 + 64 * qh;
    u32x4 qraw[4][2]; int qpos[4];
#pragma unroll
    for (int nb = 0; nb < 4; ++nb) {
        const int tok = tokq0 + 16 * nb + fr;
        const bf16_t* qp = proj + (size_t)tok * NPROJ + C_AQ + hq * 64 + 8 * fq;
        qraw[nb][0] = *(const u32x4*)qp; qraw[nb][1] = *(const u32x4*)(qp + 32); qpos[nb] = p.pos[tok];
    }
    {
        const int key = tid >> 1, half = tid & 1;
        const int s = n * 128 - 128 + key;
        u32x4 kv[4], vv[4];
#pragma unroll
        for (int c = 0; c < 4; ++c) { kv[c] = (u32x4){0u, 0u, 0u, 0u}; vv[c] = kv[c]; }
        if (s >= 0) {
            const bf16_t* kp = proj + (size_t)(b * SEQ + s) * NPROJ + C_AK + g * 64 + half * 32;
#pragma unroll
            for (int c = 0; c < 4; ++c) { kv[c] = *(const u32x4*)(kp + 8 * c); vv[c] = *(const u32x4*)(kp + 256 + 8 * c); }
            if (half == 0) {
                const int pos = p.pos[b * SEQ + s];
                unsigned a[4] = {kv[0].x, kv[0].y, kv[0].z, kv[0].w}, bb[4] = {kv[1].x, kv[1].y, kv[1].z, kv[1].w};
#pragma unroll
                for (int e = 0; e < 4; ++e) {
                    float c0, s0, c1, s1; rope_cs(pos, 2 * e, c0, s0); rope_cs(pos, 2 * e + 1, c1, s1);
                    const float t1a = bf_lo(a[e]), t1b = bf_hi(a[e]), t2a = bf_lo(bb[e]), t2b = bf_hi(bb[e]);
                    a[e] = cvt_pk_bf16(t1a * c0 - t2a * s0, t1b * c1 - t2b * s1);
                    bb[e] = cvt_pk_bf16(t2a * c0 + t1a * s0, t2b * c1 + t1b * s1);
                }
                kv[0] = (u32x4){a[0], a[1], a[2], a[3]}; kv[1] = (u32x4){bb[0], bb[1], bb[2], bb[3]};
            }
        }
#pragma unroll
        for (int c = 0; c < 4; ++c) *(u32x4*)(Ks + key * KS_LD + half * 32 + 8 * c) = kv[c];
#pragma unroll
        for (int c = 0; c < 4; ++c) *(u32x4*)(Vs + key * VS_LD + half * 32 + 8 * c) = vv[c];
    }
    __syncthreads();
    bf16x8 qf[4][2];
#pragma unroll
    for (int nb = 0; nb < 4; ++nb) {
        const u32x4 q0 = qraw[nb][0], q1 = qraw[nb][1];
        unsigned own[4] = {q0.x, q0.y, q0.z, q0.w}, par[4];
#pragma unroll
        for (int e = 0; e < 4; ++e) par[e] = __shfl_xor(own[e], 16);
        if (fq < 2) {
            const int pos = qpos[nb];
            const float sg = (fq == 0) ? -1.f : 1.f;
#pragma unroll
            for (int e = 0; e < 4; ++e) {
                float c0, s0, c1, s1; rope_cs(pos, 2 * e, c0, s0); rope_cs(pos, 2 * e + 1, c1, s1);
                const float oa = bf_lo(own[e]), ob = bf_hi(own[e]), pa = bf_lo(par[e]), pb = bf_hi(par[e]);
                own[e] = cvt_pk_bf16((oa * c0 + sg * pa * s0) * 0.125f, (ob * c1 + sg * pb * s1) * 0.125f);
            }
        } else {
#pragma unroll
            for (int e = 0; e < 4; ++e) own[e] = cvt_pk_bf16(bf_lo(own[e]) * 0.125f, bf_hi(own[e]) * 0.125f);
        }
        unsigned o1[4] = {q1.x, q1.y, q1.z, q1.w};
#pragma unroll
        for (int e = 0; e < 4; ++e) o1[e] = cvt_pk_bf16(bf_lo(o1[e]) * 0.125f, bf_hi(o1[e]) * 0.125f);
        qf[nb][0] = __builtin_bit_cast(bf16x8, (u32x4){own[0], own[1], own[2], own[3]});
        qf[nb][1] = __builtin_bit_cast(bf16x8, (u32x4){o1[0], o1[1], o1[2], o1[3]});
    }
    const float sink2 = p.sinks[l * 16 + hq] * LOG2E;
    float m_[4], l_[4];
    f32x4 o[4][4];
#pragma unroll
    for (int nb = 0; nb < 4; ++nb) { m_[nb] = sink2; l_[nb] = 1.f;
#pragma unroll
        for (int hb = 0; hb < 4; ++hb) o[hb][nb] = (f32x4){0.f, 0.f, 0.f, 0.f}; }
    for (int step = 0; step < 6; ++step) {
        const int kj0 = 64 * qh + 32 * step;
        if (n == 0 && kj0 + 32 <= 128) continue;
        f32x4 s[2][4];
#pragma unroll
        for (int mb = 0; mb < 2; ++mb)
#pragma unroll
            for (int nb = 0; nb < 4; ++nb) s[mb][nb] = (f32x4){0.f, 0.f, 0.f, 0.f};
#pragma unroll
        for (int mb = 0; mb < 2; ++mb)
#pragma unroll
            for (int kk = 0; kk < 2; ++kk) {
                const bf16x8 a = *(const bf16x8*)(Ks + (kj0 + 16 * mb + fr) * KS_LD + 32 * kk + 8 * fq);
#pragma unroll
                for (int nb = 0; nb < 4; ++nb) s[mb][nb] = MFMA16(a, qf[nb][kk], s[mb][nb]);
            }
        bf16x8 pb[4];
#pragma unroll
        for (int nb = 0; nb < 4; ++nb) {
            const int qi = 64 * qh + 16 * nb + fr;
            float tmax = -1e30f;
#pragma unroll
            for (int mb = 0; mb < 2; ++mb)
#pragma unroll
                for (int j = 0; j < 4; ++j) {
                    const int kj = kj0 + 16 * mb + 4 * fq + j, dist = qi + 128 - kj;
                    const bool valid = (dist >= 0) && (dist < 128) && (n > 0 || kj >= 128);
                    const float v = valid ? s[mb][nb][j] * LOG2E : -1e30f;
                    s[mb][nb][j] = v; tmax = fmaxf(tmax, v);
                }
            tmax = fmaxf(tmax, __shfl_xor(tmax, 16)); tmax = fmaxf(tmax, __shfl_xor(tmax, 32));
            if (__builtin_amdgcn_ballot_w64(tmax > m_[nb] + 8.f) != 0ull) {
                const float mnew = fmaxf(m_[nb], tmax), alpha = fast_exp2(m_[nb] - mnew);
                m_[nb] = mnew; l_[nb] = l_[nb] * alpha;
#pragma unroll
                for (int hb = 0; hb < 4; ++hb) o[hb][nb] = o[hb][nb] * alpha;
            }
            const float mref = m_[nb];
            float rs = 0.f;
#pragma unroll
            for (int mb = 0; mb < 2; ++mb)
#pragma unroll
                for (int j = 0; j < 4; ++j) { const float pv = fast_exp2(s[mb][nb][j] - mref); s[mb][nb][j] = pv; rs += pv; }
            rs += __shfl_xor(rs, 16); rs += __shfl_xor(rs, 32);
            l_[nb] = l_[nb] + rs;
            pb[nb] = __builtin_bit_cast(bf16x8, (u32x4){cvt_pk_bf16(s[0][nb][0], s[0][nb][1]), cvt_pk_bf16(s[0][nb][2], s[0][nb][3]),
                                                        cvt_pk_bf16(s[1][nb][0], s[1][nb][1]), cvt_pk_bf16(s[1][nb][2], s[1][nb][3])});
        }
#pragma unroll
        for (int hb = 0; hb < 4; ++hb) {
            const bf16_t* vp = Vs + (kj0 + 4 * fq + (fr >> 2)) * VS_LD + 32 * (hb >> 1) + 8 * (fr & 3) + 4 * (hb & 1);
            const bf16x8 a = tr_operand(vp, vp + 16 * VS_LD);
#pragma unroll
            for (int nb = 0; nb < 4; ++nb) o[hb][nb] = MFMA16(a, pb[nb], o[hb][nb]);
        }
    }
#pragma unroll
    for (int nb = 0; nb < 4; ++nb) {
        const int tok = tokq0 + 16 * nb + fr;
        const float inv = 1.f / l_[nb];
#pragma unroll
        for (int hp = 0; hp < 2; ++hp) {
            const int col = hq * 64 + 32 * hp + 8 * fq;
            const u32x4 z = *(const u32x4*)(proj + (size_t)tok * NPROJ + C_Z + col);
            const f32x4 a = o[2 * hp][nb] * inv, b2 = o[2 * hp + 1][nb] * inv;
            u32x4 y; y.x = cvt_pk_bf16(a[0] * bf_lo(z.x), a[1] * bf_hi(z.x)); y.y = cvt_pk_bf16(a[2] * bf_lo(z.y), a[3] * bf_hi(z.y));
            y.z = cvt_pk_bf16(b2[0] * bf_lo(z.z), b2[1] * bf_hi(z.z)); y.w = cvt_pk_bf16(b2[2] * bf_lo(z.w), b2[3] * bf_hi(z.w));
            *(u32x4*)(Y + (size_t)tok * D + col) = y;
        }
    }
    __syncthreads();
}

constexpr int VN_LD = 72;
__device__ __forceinline__ void sg_pair_item(const Params& p, int l, int pitem, unsigned char* lds, int tid, int wave, int lane) {
    const int b2 = pitem >> 7, c = (pitem >> 3) & 15, g = pitem & 7;
    const int fr = lane & 15, fq = lane >> 4;
    bf16_t* vnT = (bf16_t*)lds;
    const bf16_t* proj = (const bf16_t*)(p.ws + WS_PROJ);
    bf16_t* Y = (bf16_t*)(p.ws + WS_Y);
    const int s = tid >> 2, qd = tid & 3;
    const int t = 16 * wave + fr;
    int tok0[2];
    tok0[0] = b2 * SEQ + c * 128; tok0[1] = (b2 + 2) * SEQ + c * 128;
    u32x4 vw[2][2]; f32x4 stq[2]; u32x4 uf[2][2], zf[2][2];
#pragma unroll
    for (int q2 = 0; q2 < 2; ++q2) {
        const bf16_t* vp = proj + (size_t)(tok0[q2] + s) * NPROJ + C_SV;
        vw[q2][0] = *(const u32x4*)(vp + 64 * g + 16 * qd); vw[q2][1] = *(const u32x4*)(vp + 64 * g + 16 * qd + 8);
        stq[q2] = *(const f32x4*)((const float*)(p.ws + WS_SGST) + (size_t)(tok0[q2] + s) * 16 + 4 * qd);
#pragma unroll
        for (int mp = 0; mp < 2; ++mp) { const int col = 64 * g + 32 * mp + 8 * fq; const size_t ro = (size_t)(tok0[q2] + t) * NPROJ;
            uf[q2][mp] = *(const u32x4*)(proj + ro + C_SU + col); zf[q2][mp] = *(const u32x4*)(proj + ro + C_Z + 1024 + col); }
    }
    bf16x8 wf[4];
    {   const bf16_t* wrow = (const bf16_t*)(p.ws + WS_SGW) + ((size_t)(l * 8 + g) * 128 + t) * 128;
#pragma unroll
        for (int kk = 0; kk < 4; ++kk) if (32 * kk <= 16 * wave + 15) wf[kk] = *(const bf16x8*)(wrow + 32 * kk + 8 * fq); }
    const float bias = p.sg_b[(l * 8 + g) * 128 + t];
    float lgv[16], lbv[16];
    {   const float* lg = p.sg_ln_g + l * 512 + 64 * g + 16 * qd; const float* lb = p.sg_ln_b + l * 512 + 64 * g + 16 * qd;
#pragma unroll
        for (int i = 0; i < 4; ++i) { const f32x4 a = *(const f32x4*)(lg + 4 * i), bb = *(const f32x4*)(lb + 4 * i);
#pragma unroll
            for (int e = 0; e < 4; ++e) { lgv[4 * i + e] = a[e]; lbv[4 * i + e] = bb[e]; } } }
#pragma unroll
    for (int q2 = 0; q2 < 2; ++q2) {
        float sum = stq[q2][0] + stq[q2][2], sq = stq[q2][1] + stq[q2][3];
        sum += __shfl_xor(sum, 1); sum += __shfl_xor(sum, 2); sq += __shfl_xor(sq, 1); sq += __shfl_xor(sq, 2);
        const float mu = sum * (1.f / 512.f), var = fmaxf(sq * (1.f / 512.f) - mu * mu, 0.f), rstd = rsqrtf(var + EPS);
        bf16_t* vq = vnT + q2 * 128 * VN_LD + s * VN_LD + 16 * qd;
#pragma unroll
        for (int i = 0; i < 2; ++i) { const unsigned ww[4] = {vw[q2][i].x, vw[q2][i].y, vw[q2][i].z, vw[q2][i].w}; unsigned o4[4];
#pragma unroll
            for (int e = 0; e < 4; ++e) { const int ch = 8 * i + 2 * e;
                o4[e] = cvt_pk_bf16((bf_lo(ww[e]) - mu) * rstd * lgv[ch] + lbv[ch], (bf_hi(ww[e]) - mu) * rstd * lgv[ch + 1] + lbv[ch + 1]); }
            *(u32x4*)(vq + 8 * i) = (u32x4){o4[0], o4[1], o4[2], o4[3]}; }
    }
    __syncthreads();
    {
        f32x4 acc[2][4];
#pragma unroll
        for (int q2 = 0; q2 < 2; ++q2)
#pragma unroll
            for (int mb = 0; mb < 4; ++mb) acc[q2][mb] = (f32x4){0.f, 0.f, 0.f, 0.f};
#pragma unroll
        for (int kk = 0; kk < 4; ++kk) {
            if (32 * kk <= 16 * wave + 15) {
                const int s0 = 32 * kk + 8 * fq;
                const bf16x8 bfr = wf[kk];
#pragma unroll
                for (int q2 = 0; q2 < 2; ++q2)
#pragma unroll
                    for (int mb = 0; mb < 4; ++mb) {
                        const bf16_t* ap = vnT + (q2 * 128 + s0 + (fr >> 2)) * VN_LD + 32 * (mb >> 1) + 8 * (fr & 3) + 4 * (mb & 1);
                        acc[q2][mb] = MFMA16(tr_operand(ap, ap + 4 * VN_LD), bfr, acc[q2][mb]); }
            }
        }
#pragma unroll
        for (int q2 = 0; q2 < 2; ++q2)
#pragma unroll
            for (int mp = 0; mp < 2; ++mp) {
                const int col = 64 * g + 32 * mp + 8 * fq;
                const u32x4 u = uf[q2][mp], z = zf[q2][mp];
                const f32x4 a = acc[q2][2 * mp] + bias, b3 = acc[q2][2 * mp + 1] + bias;
                u32x4 y; y.x = cvt_pk_bf16(bf_lo(u.x) * a[0] * bf_lo(z.x), bf_hi(u.x) * a[1] * bf_hi(z.x)); y.y = cvt_pk_bf16(bf_lo(u.y) * a[2] * bf_lo(z.y), bf_hi(u.y) * a[3] * bf_hi(z.y));
                y.z = cvt_pk_bf16(bf_lo(u.z) * b3[0] * bf_lo(z.z), bf_hi(u.z) * b3[1] * bf_hi(z.z)); y.w = cvt_pk_bf16(bf_lo(u.w) * b3[2] * bf_lo(z.w), bf_hi(u.w) * b3[3] * bf_hi(z.w));
                *(u32x4*)(Y + (size_t)(tok0[q2] + t) * D + 1024 + col) = y;
            }
    }
    __syncthreads();
}

constexpr int GL_LD = 72;
struct CgRow { f32x4 c0, c1, c2, c3; };
__device__ __forceinline__ CgRow gla_load_cg(const Params& p, int tok) {
    const float* cgp = (const float*)(p.ws + WS_CG) + (size_t)tok * 16;
    CgRow r; r.c0 = *(const f32x4*)cgp; r.c1 = *(const f32x4*)(cgp + 4); r.c2 = *(const f32x4*)(cgp + 8); r.c3 = *(const f32x4*)(cgp + 12); return r;
}
__device__ __forceinline__ float wave_scan_incl(float v) {
#define SCAN_STEP(ctrl, rmask) v += __builtin_bit_cast(float, __builtin_amdgcn_update_dpp(0, __builtin_bit_cast(int, v), (ctrl), (rmask), 0xf, false))
    SCAN_STEP(0x111, 0xf); SCAN_STEP(0x112, 0xf); SCAN_STEP(0x114, 0xf); SCAN_STEP(0x118, 0xf);
    SCAN_STEP(0x142, 0xa); SCAN_STEP(0x143, 0xc);
#undef SCAN_STEP
    return v;
}
__device__ __forceinline__ void gla_b(const float* wl, const CgRow& cr, int wave, int lane, float (&bc)[8], float (&bl)[8]) {
    const f32x4 c0 = cr.c0, c1 = cr.c1, c2 = cr.c2, c3 = cr.c3;
    const float cgv[16] = {c0[0], c0[1], c0[2], c0[3], c1[0], c1[1], c1[2], c1[3], c2[0], c2[1], c2[2], c2[3], c3[0], c3[1], c3[2], c3[3]};
    float x[8];
    {   const f32x4 b0 = *(const f32x4*)(wl + 1024 + 8 * wave), b1 = *(const f32x4*)(wl + 1024 + 8 * wave + 4);
#pragma unroll
        for (int e = 0; e < 4; ++e) { x[e] = b0[e]; x[4 + e] = b1[e]; } }
#pragma unroll
    for (int r = 0; r < 16; ++r) {
        const f32x4 w0 = *(const f32x4*)(wl + r * 64 + 8 * wave), w1 = *(const f32x4*)(wl + r * 64 + 8 * wave + 4);
#pragma unroll
        for (int e = 0; e < 4; ++e) { x[e] += cgv[r] * w0[e]; x[4 + e] += cgv[r] * w1[e]; }
    }
#pragma unroll
    for (int i = 0; i < 8; ++i) {
        float la = (fminf(x[i], 0.f) - __logf(1.f + __expf(-fabsf(x[i])))) * (1.f / 16.f);
        la = wave_scan_incl(la);
        bc[i] = la; bl[i] = __builtin_bit_cast(float, __builtin_amdgcn_readlane(__builtin_bit_cast(int, la), 63));
    }
}
struct VPair { u32x4 a, b; };
__device__ __forceinline__ VPair gla_load_v(const bf16_t* proj, int tok0, int h, int tid) {
    const int t = tid >> 3, c8 = tid & 7;
    const bf16_t* vp = proj + (size_t)(tok0 + t) * NPROJ + C_CV + h * 128 + 16 * c8;
    VPair r; r.a = *(const u32x4*)vp; r.b = *(const u32x4*)(vp + 8); return r;
}
__device__ __forceinline__ void gla_store_vT(const VPair& v, bf16_t* vT, int tid) {
    const int t = tid >> 3, c8 = tid & 7;
#pragma unroll
    for (int i = 0; i < 2; ++i) { const u32x4 w = i ? v.b : v.a; const unsigned ww[4] = {w.x, w.y, w.z, w.w};
#pragma unroll
        for (int e = 0; e < 4; ++e) { const int dv = 16 * c8 + 8 * i + 2 * e;
            vT[dv * GL_LD + t] = (bf16_t)(ww[e] & 0xffffu); vT[(dv + 1) * GL_LD + t] = (bf16_t)(ww[e] >> 16); } }
}
constexpr int GLK_LD = 72, GLV_LD = 136;
__device__ __forceinline__ void gla_local_item(const Params& p, int l, int item, unsigned char* lds, int tid, int wave, int lane) {
    const int bh = item >> 5, c = item & 31, b = bh >> 2, h = bh & 3;
    const int fr = lane & 15, fq = lane >> 4;
    const int tok0 = b * SEQ + c * 64;
    bf16_t* Kr = (bf16_t*)lds;
    bf16_t* Vr = (bf16_t*)(lds + 64 * GLK_LD * 2);
    float* wl = (float*)(lds + 64 * GLK_LD * 2 + 64 * GLV_LD * 2);
    const bf16_t* proj = (const bf16_t*)(p.ws + WS_PROJ);
    const CgRow cr = gla_load_cg(p, tok0 + lane);
    const bf16_t* rowp = proj + (size_t)(tok0 + lane) * NPROJ + h * 64 + 8 * wave;
    const u32x4 qw = *(const u32x4*)(rowp + C_CQ), kw = *(const u32x4*)(rowp + C_CK);
    const VPair vpre = gla_load_v(proj, tok0, h, tid);
    if (tid < 256) *(f32x4*)(wl + (tid >> 4) * 64 + 4 * (tid & 15)) = *(const f32x4*)(p.gla_wup + (size_t)(l * 16 + (tid >> 4)) * 256 + h * 64 + 4 * (tid & 15));
    else if (tid < 272) *(f32x4*)(wl + 1024 + 4 * (tid - 256)) = *(const f32x4*)(p.gla_bg + l * 256 + h * 64 + 4 * (tid - 256));
    __syncthreads();
    float bc[8], bl[8];
    gla_b(wl, cr, wave, lane, bc, bl);
    {
        const unsigned qq[4] = {qw.x, qw.y, qw.z, qw.w}, ww[4] = {kw.x, kw.y, kw.z, kw.w};
        unsigned qo[4], ko[4], lo4[4];
#pragma unroll
        for (int e = 0; e < 4; ++e) {
            lo4[e] = cvt_pk_bf16(bf_lo(ww[e]) * __expf(bl[2 * e] - bc[2 * e]), bf_hi(ww[e]) * __expf(bl[2 * e + 1] - bc[2 * e + 1]));
            const float e0 = __expf(bc[2 * e]), e1 = __expf(bc[2 * e + 1]);
            qo[e] = cvt_pk_bf16(bf_lo(qq[e]) * 0.125f * e0, bf_hi(qq[e]) * 0.125f * e1);
            ko[e] = cvt_pk_bf16(bf_lo(ww[e]) * fast_rcp(e0), bf_hi(ww[e]) * fast_rcp(e1));
        }
        *(u32x4*)(Kr + lane * GLK_LD + 8 * wave) = (u32x4){lo4[0], lo4[1], lo4[2], lo4[3]};
        *(u32x4*)((bf16_t*)(p.ws + WS_QD) + (size_t)item * 4096 + lane * 64 + 8 * wave) = (u32x4){qo[0], qo[1], qo[2], qo[3]};
        *(u32x4*)((bf16_t*)(p.ws + WS_KD) + (size_t)item * 4096 + lane * 64 + 8 * wave) = (u32x4){ko[0], ko[1], ko[2], ko[3]};
        if (lane == 63) { float* dec = (float*)(p.ws + WS_DEC) + (size_t)item * 64 + 8 * wave;
#pragma unroll
            for (int i = 0; i < 8; ++i) dec[i] = __expf(bl[i]); }
        bf16_t* vd = Vr + (tid >> 3) * GLV_LD + 16 * (tid & 7);
        *(u32x4*)vd = vpre.a; *(u32x4*)(vd + 8) = vpre.b;
    }
    __syncthreads();
    {
        f32x4 acc[4];
#pragma unroll
        for (int mb = 0; mb < 4; ++mb) acc[mb] = (f32x4){0.f, 0.f, 0.f, 0.f};
#pragma unroll
        for (int kk = 0; kk < 2; ++kk) {
            const int srow = 32 * kk + 8 * fq + (fr >> 2);
            const bf16_t* bp_ = Vr + srow * GLV_LD + 16 * wave + 4 * (fr & 3);
            const bf16x8 bfr = tr_operand(bp_, bp_ + 4 * GLV_LD);
#pragma unroll
            for (int mb = 0; mb < 4; ++mb) { const bf16_t* ap = Kr + srow * GLK_LD + 16 * mb + 4 * (fr & 3); acc[mb] = MFMA16(tr_operand(ap, ap + 4 * GLK_LD), bfr, acc[mb]); }
        }
        float* loct = (float*)(p.ws + WS_LOCT) + (size_t)item * 8192 + (16 * wave + fr) * 64 + 4 * fq;
#pragma unroll
        for (int mb = 0; mb < 4; ++mb) *(f32x4*)(loct + 16 * mb) = acc[mb];
    }
    __syncthreads();
}
__device__ __forceinline__ void gla_scan(const Params& p, int tid, int bx) {
    const float* loct = (const float*)(p.ws + WS_LOCT); const float* dec = (const float*)(p.ws + WS_DEC);
    bf16_t* ST = (bf16_t*)(p.ws + WS_ST);
    for (int e = bx * 512 + tid; e < 16 * 8192; e += gridDim.x * 512) {
        const int bh = e >> 13, r = e & 8191, dk = r & 63;
        float lo[32], de[32];
#pragma unroll
        for (int c = 0; c < 32; ++c) { const size_t it = (size_t)bh * 32 + c; lo[c] = loct[it * 8192 + r]; de[c] = dec[it * 64 + dk]; }
        float s = 0.f;
#pragma unroll
        for (int c = 0; c < 32; ++c) { const size_t it = (size_t)bh * 32 + c;
            ST[it * 8192 + r] = f2bf(s);
            s = s * de[c] + lo[c]; }
    }
}
constexpr int GO_LD = 72, GOV_LD = 136;
constexpr int GO_QD = 0, GO_KD = 64 * GO_LD, GO_ST = 2 * 64 * GO_LD, GO_VT = GO_ST + 128 * GO_LD, GO_IMG = GO_VT + 128 * GO_LD;
__device__ __forceinline__ void gla_out_pair(const Params& p, int l, int pit, unsigned char* lds, int tid, int wave, int lane) {
    const int bh2 = pit >> 5, c = pit & 31, h = bh2 & 3;
    const int fr = lane & 15, fq = lane >> 4;
    bf16_t* img = (bf16_t*)lds;
    float* red = (float*)(lds + 2 * GO_IMG * 2);
    const bf16_t* proj = (const bf16_t*)(p.ws + WS_PROJ);
    bf16_t* Y = (bf16_t*)(p.ws + WS_Y);
    const int tb = wave & 3, dh = wave >> 2, t = 16 * tb + fr;
    int item[2], tok[2];
    item[0] = bh2 * 32 + c; item[1] = (bh2 + 8) * 32 + c;
    tok[0] = (bh2 >> 2) * SEQ + c * 64 + t; tok[1] = ((bh2 >> 2) + 2) * SEQ + c * 64 + t;
    {
        const int r8 = tid >> 3, ch = (tid & 7) * 8;
        u32x4 cq[2], ck[2], cs[2][2], cv[2][2];
        const int tokb[2] = {(bh2 >> 2) * SEQ + c * 64, ((bh2 >> 2) + 2) * SEQ + c * 64};
#pragma unroll
        for (int q2 = 0; q2 < 2; ++q2) {
            cq[q2] = *(const u32x4*)((const bf16_t*)(p.ws + WS_QD) + (size_t)item[q2] * 4096 + r8 * 64 + ch);
            ck[q2] = *(const u32x4*)((const bf16_t*)(p.ws + WS_KD) + (size_t)item[q2] * 4096 + r8 * 64 + ch);
#pragma unroll
            for (int i = 0; i < 2; ++i) {
                cs[q2][i] = *(const u32x4*)((const bf16_t*)(p.ws + WS_ST) + (size_t)item[q2] * 8192 + (r8 + 64 * i) * 64 + ch);
                cv[q2][i] = *(const u32x4*)(proj + (size_t)(tokb[q2] + r8) * NPROJ + C_CV + h * 128 + ch + 64 * i);
            }
        }
#pragma unroll
        for (int q2 = 0; q2 < 2; ++q2) {
            bf16_t* im = img + q2 * GO_IMG;
            *(u32x4*)(im + GO_QD + r8 * GO_LD + ch) = cq[q2]; *(u32x4*)(im + GO_KD + r8 * GO_LD + ch) = ck[q2];
#pragma unroll
            for (int i = 0; i < 2; ++i) { *(u32x4*)(im + GO_ST + (r8 + 64 * i) * GO_LD + ch) = cs[q2][i]; *(u32x4*)(im + GO_VT + r8 * GOV_LD + ch + 64 * i) = cv[q2][i]; }
        }
    }
    u32x4 zf[2][2]; f32x4 gf[4];
#pragma unroll
    for (int mp = 0; mp < 2; ++mp) {
        const int dv = 64 * dh + 32 * mp + 8 * fq;
        gf[2 * mp] = *(const f32x4*)(p.gla_ng + l * 128 + dv); gf[2 * mp + 1] = *(const f32x4*)(p.gla_ng + l * 128 + dv + 4);
#pragma unroll
        for (int q2 = 0; q2 < 2; ++q2) zf[q2][mp] = *(const u32x4*)(proj + (size_t)tok[q2] * NPROJ + C_Z + 1536 + h * 128 + dv);
    }
    __syncthreads();
    f32x4 acc[2][4];
#pragma unroll
    for (int q2 = 0; q2 < 2; ++q2) {
        const bf16_t* im = img + q2 * GO_IMG;
        bf16x8 bq[2];
#pragma unroll
        for (int kk = 0; kk < 2; ++kk) bq[kk] = *(const bf16x8*)(im + GO_QD + t * GO_LD + 32 * kk + 8 * fq);
        f32x4 sc[4];
#pragma unroll
        for (int mb = 0; mb < 4; ++mb) {
            sc[mb] = (f32x4){0.f, 0.f, 0.f, 0.f};
            if (mb <= tb) {
#pragma unroll
                for (int kk = 0; kk < 2; ++kk) { const bf16x8 a = *(const bf16x8*)(im + GO_KD + (16 * mb + fr) * GO_LD + 32 * kk + 8 * fq); sc[mb] = MFMA16(a, bq[kk], sc[mb]); }
#pragma unroll
                for (int j = 0; j < 4; ++j) if (16 * mb + 4 * fq + j > t) sc[mb][j] = 0.f;
            }
        }
        bf16x8 bp[2];
#pragma unroll
        for (int k2 = 0; k2 < 2; ++k2)
            bp[k2] = __builtin_bit_cast(bf16x8, (u32x4){cvt_pk_bf16(sc[2 * k2][0], sc[2 * k2][1]), cvt_pk_bf16(sc[2 * k2][2], sc[2 * k2][3]),
                                                        cvt_pk_bf16(sc[2 * k2 + 1][0], sc[2 * k2 + 1][1]), cvt_pk_bf16(sc[2 * k2 + 1][2], sc[2 * k2 + 1][3])});
        float ssq = 0.f;
#pragma unroll
        for (int mb = 0; mb < 4; ++mb) {
            const int dvrow = 64 * dh + 32 * (mb >> 1) + 8 * (fr >> 2) + 4 * (mb & 1) + (fr & 3);
            acc[q2][mb] = (f32x4){0.f, 0.f, 0.f, 0.f};
#pragma unroll
            for (int k2 = 0; k2 < 2; ++k2) {
                const bf16_t* vp = im + GO_VT + (32 * k2 + 4 * fq + (fr >> 2)) * GOV_LD + 64 * dh + 32 * (mb >> 1) + 8 * (fr & 3) + 4 * (mb & 1);
                acc[q2][mb] = MFMA16(tr_operand(vp, vp + 16 * GOV_LD), bp[k2], acc[q2][mb]);
            }
#pragma unroll
            for (int kk = 0; kk < 2; ++kk) { const bf16x8 a = *(const bf16x8*)(im + GO_ST + dvrow * GO_LD + 32 * kk + 8 * fq); acc[q2][mb] = MFMA16(a, bq[kk], acc[q2][mb]); }
            ssq += (acc[q2][mb][0] * acc[q2][mb][0] + acc[q2][mb][1] * acc[q2][mb][1]) + (acc[q2][mb][2] * acc[q2][mb][2] + acc[q2][mb][3] * acc[q2][mb][3]);
        }
        ssq += __shfl_xor(ssq, 16); ssq += __shfl_xor(ssq, 32);
        if (fq == 0) red[(q2 * 2 + dh) * 64 + t] = ssq;
    }
    __syncthreads();
#pragma unroll
    for (int q2 = 0; q2 < 2; ++q2) {
        const float rstd = rsqrtf((red[(q2 * 2) * 64 + t] + red[(q2 * 2 + 1) * 64 + t]) * (1.f / 128.f) + EPS);
#pragma unroll
        for (int mp = 0; mp < 2; ++mp) {
            const int col = 1536 + h * 128 + 64 * dh + 32 * mp + 8 * fq;
            const u32x4 z = zf[q2][mp];
            const f32x4 a = acc[q2][2 * mp] * rstd * gf[2 * mp], b3 = acc[q2][2 * mp + 1] * rstd * gf[2 * mp + 1];
            u32x4 y; y.x = cvt_pk_bf16(a[0] * bf_lo(z.x), a[1] * bf_hi(z.x)); y.y = cvt_pk_bf16(a[2] * bf_lo(z.y), a[3] * bf_hi(z.y));
            y.z = cvt_pk_bf16(b3[0] * bf_lo(z.z), b3[1] * bf_hi(z.z)); y.w = cvt_pk_bf16(b3[2] * bf_lo(z.w), b3[3] * bf_hi(z.w));
            *(u32x4*)(Y + (size_t)tok[q2] * D + col) = y;
        }
    }
    __syncthreads();
}

#define XB_TMO      128
#define XB_XCNT(j)  (256  + 64 * (j))
#define XB_XSUB(j)  (1280 + 64 * (j))
#define XB_XGEN(j)  (2304 + 64 * (j))
#define XB_TOP      3328
#define XB_TOPGEN   3392
#define XCD_BAR_WORDS 3456
#define XB_SPIN_CAP (1u << 18)
__device__ __forceinline__ unsigned xb_ld(unsigned* p)              { return __hip_atomic_load(p, __ATOMIC_RELAXED, __HIP_MEMORY_SCOPE_AGENT); }
__device__ __forceinline__ unsigned xb_add(unsigned* p, unsigned v) { return __hip_atomic_fetch_add(p, v, __ATOMIC_RELAXED, __HIP_MEMORY_SCOPE_AGENT); }
__device__ __forceinline__ unsigned xb_xcc_id() { return (unsigned)__builtin_amdgcn_s_getreg((3 << 11) | 20) & 0xFu; }
#define XB_SPIN(cond, bar) do { unsigned _sp = 0; while (cond) { __builtin_amdgcn_s_sleep(1); \
    if ((++_sp & 255u) == 0u) { if (xb_ld(&(bar)[XB_TMO])) break; if (_sp > XB_SPIN_CAP) { atomicAdd(&(bar)[XB_TMO], 1u); break; } } } } while (0)
__device__ __forceinline__ void xcd_barrier_complete(unsigned* bar, unsigned x, unsigned& nloc, unsigned& nx) {
    const unsigned G = gridDim.x * gridDim.y * gridDim.z;
    unsigned sum, cnt, mine, sp = 0u;
    for (;;) {
        sum = 0u; cnt = 0u; mine = 0u;
#pragma unroll
        for (unsigned j = 0; j < 16; ++j) { const unsigned c = xb_ld(&bar[XB_XCNT(j)]); sum += c; cnt += (c > 0u) ? 1u : 0u; mine = (j == x) ? c : mine; }
        if (sum == G) break;
        __builtin_amdgcn_s_sleep(1);
        if ((++sp & 255u) == 0u) { if (xb_ld(&bar[XB_TMO])) break; if (sp > XB_SPIN_CAP) { atomicAdd(&bar[XB_TMO], 1u); break; } }
    }
    nloc = mine > 0u ? mine : 1u; nx = cnt > 0u ? cnt : 1u;
}
__device__ __forceinline__ void xcd_barrier(unsigned* bar, volatile LAS unsigned* st) {
    asm volatile("s_waitcnt vmcnt(0)" ::: "memory");
    __syncthreads();
    if (threadIdx.x == 0) {
        __builtin_amdgcn_s_waitcnt(0);
        const unsigned x = xb_xcc_id();
        unsigned nloc = st[0], nx = st[1];
        if (nloc == 0u) { xcd_barrier_complete(bar, x, nloc, nx); st[0] = nloc; st[1] = nx; }
        const unsigned old = xb_add(&bar[XB_XSUB(x)], 1u);
        const unsigned gen = old / nloc;
        if (old + 1u == (gen + 1u) * nloc) {
            __builtin_amdgcn_fence(__ATOMIC_RELEASE, "agent");
            asm volatile("s_waitcnt vmcnt(0)" ::: "memory");
            const unsigned og = xb_add(&bar[XB_TOP], 1u);
            const unsigned tg = og / nx;
            if (og + 1u == (tg + 1u) * nx) xb_add(&bar[XB_TOPGEN], 1u);
            else XB_SPIN(xb_ld(&bar[XB_TOPGEN]) == tg, bar);
            __builtin_amdgcn_fence(__ATOMIC_ACQUIRE, "agent");
            xb_add(&bar[XB_XGEN(x)], 1u);
            asm volatile("s_waitcnt vmcnt(0)" ::: "memory");
        } else {
            XB_SPIN(xb_ld(&bar[XB_XGEN(x)]) == gen, bar);
            __builtin_amdgcn_fence(__ATOMIC_ACQUIRE, "agent");
            asm volatile("s_waitcnt vmcnt(0)" ::: "memory");
        }
    }
    __syncthreads();
}

constexpr int N_PHASES = 14;
__global__ void __launch_bounds__(512, 2) fwd_kernel(Params p) {
    extern __shared__ __attribute__((aligned(16))) unsigned char lds[];
    const int G = gridDim.x;
    const int lo = p.ph_lo, hi = p.ph_hi;
    unsigned* const xbar = (unsigned*)(p.ws + WS_BAR);
    volatile LAS unsigned* const xst = (volatile LAS unsigned*)((LAS unsigned char*)lds + 131072 + 64);
    if (threadIdx.x < 2) xst[threadIdx.x] = 0u;
    __syncthreads();
    if (lo < 0) cg::this_grid().sync();
    if (hi - lo > 1 && threadIdx.x == 0) (void)xb_add(&xbar[XB_XCNT(xb_xcc_id())], 1u);
#ifndef PHMASK
#define PHMASK 0xffff
#endif
#define IN(k) (((PHMASK >> ((k) < 2 ? (k) : 2 + ((k) - 2) % 6)) & 1) && lo <= (k) && (k) < hi)
#define SEAM(k) do { STAMP(2 * (k)); if (IN(k) && IN((k) + 1)) { xcd_barrier(xbar, xst); } STAMP(2 * (k) + 1); } while (0)
#define FRESH() int tid = threadIdx.x; asm volatile("" : "+v"(tid)); int bx = blockIdx.x; asm volatile("" : "+s"(bx)); \
    const int lane = tid & 63, wave = __builtin_amdgcn_readfirstlane(tid >> 6); \
    const Params q = fresh_params(p); (void)lane; (void)wave; (void)bx;
    unsigned long long tacc = 0ull, tprev = (PMASK != 0ull) ? __builtin_amdgcn_s_memrealtime() : 0ull;
#define STAMP(idx) do { if (PMASK != 0ull) { const unsigned long long now_ = __builtin_amdgcn_s_memrealtime(); if ((PMASK >> (idx)) & 1ull) tacc += now_ - tprev; tprev = now_; } } while (0)
    if (IN(0)) for (int rep = 0; rep < REPN(0); ++rep) { FRESH(); mod_items(q, 0, lds, tid, wave, lane, bx); __syncthreads(); p0_transposes(q, lds, wave, lane, bx, 0); }
    SEAM(0);
    if (IN(1)) for (int rep = 0; rep < REPN(1); ++rep) { FRESH(); mod_items(q, 1, lds, tid, wave, lane, bx); __syncthreads(); STAMP(32); p0_convert(q, lds, tid, wave, lane, bx); STAMP(33); row_pass(q, 0, wave, lane, bx); }
    SEAM(1);
#pragma unroll 1
    for (int l = 0; l < 2; ++l) {
        const int pb = 2 + 6 * l;
        if (IN(pb)) for (int rep = 0; rep < REPN(2); ++rep) {
            FRESH();
            pg8::Gemm g{(const bf16_t*)(q.ws + WS_H), (const bf16_t*)(q.ws + WS_WIN + (size_t)l * WIN_BYTES), M, NPAD, D};
            pg8::StaticOrder S; S.init(M, NPAD, G, bx);
            pg8::EpiProj E{(bf16_t*)(q.ws + WS_PROJ), (float*)(q.ws + WS_CG), (float*)(q.ws + WS_SGST)};
            pg8::gemm_phase<pg8::EpiProj, pg8::StaticOrder, true, true>((LAS unsigned char*)lds, g, S, E, tid);
        }
        SEAM(pb);
        if (IN(pb + 1)) for (int rep = 0; rep < REPN(3); ++rep) {
#ifndef MIXMASK
#define MIXMASK 7
#endif
            for (int rr = 0; rr < ((MIXR >> 0) & 15); ++rr) { FRESH(); for (int it = bx; it < 256; it += G) attn_item(q, l, it, lds, tid, wave, lane); }
            STAMP(36 + 4 * l); for (int rr = 0; rr < ((MIXR >> 4) & 15); ++rr) { FRESH(); for (int it = bx; it < 256; it += G) sg_pair_item(q, l, it, lds, tid, wave, lane); } STAMP(37 + 4 * l);
            for (int rr = 0; rr < ((MIXR >> 8) & 15); ++rr) { FRESH(); for (int it = bx; it < 512; it += G) gla_local_item(q, l, it, lds, tid, wave, lane); }
        }
        SEAM(pb + 1);
        if (IN(pb + 2)) for (int rep = 0; rep < REPN(4); ++rep) { FRESH(); gla_scan(q, tid, bx); }
        SEAM(pb + 2);
        if (IN(pb + 3)) for (int rep = 0; rep < REPN(5); ++rep) { FRESH(); for (int it = bx; it < 256; it += G) gla_out_pair(q, l, it, lds, tid, wave, lane); }
        SEAM(pb + 3);
        if (IN(pb + 4)) for (int rep = 0; rep < REPN(6); ++rep) {
            FRESH();
            pg8::Gemm g{(const bf16_t*)(q.ws + WS_Y), (const bf16_t*)(q.ws + WS_WOUT + (size_t)l * WOUT_BYTES), M, D, D};
            pg8::StaticOrder S; S.init(M, D, G, bx);
            pg8::EpiOut E{(bf16_t*)(q.ws + WS_OUT)};
            pg8::gemm_phase<pg8::EpiOut, pg8::StaticOrder, true, true>((LAS unsigned char*)lds, g, S, E, tid);
        }
        SEAM(pb + 4);
        if (IN(pb + 5)) { FRESH(); row_pass(q, l + 1, wave, lane, bx); }
        if (l == 0) SEAM(pb + 5);
    }
    STAMP(26);
    if (PMASK != 0ull) { if (blockIdx.x == 0 && threadIdx.x == 0) { const unsigned long long t0 = __builtin_amdgcn_s_memrealtime(); while (__builtin_amdgcn_s_memrealtime() - t0 < tacc) __builtin_amdgcn_s_sleep(8); } }
#undef IN
#undef SEAM
#undef FRESH
}

extern "C" void kernel_launch(void* const* d_in, const int* in_sizes, int n_in, void* d_out, int out_size, void* d_ws, size_t ws_size, hipStream_t stream) {
    static int grid = 0;
    if (grid == 0) {
        if (n_in != 17 || in_sizes[0] != M * D || out_size != M * D || ws_size < WS_END) { fprintf(stderr, "kernel_launch: unexpected shapes (n_in %d, in0 %d, out %d, ws %zu)\n", n_in, n_in > 0 ? in_sizes[0] : -1, out_size, ws_size); grid = -1; return; }
        int dev = 0, cus = 0, per_cu = 0;
        if (hipGetDevice(&dev) != hipSuccess || hipDeviceGetAttribute(&cus, hipDeviceAttributeMultiprocessorCount, dev) != hipSuccess) { grid = -1; return; }
        if (hipFuncSetAttribute((const void*)fwd_kernel, hipFuncAttributeMaxDynamicSharedMemorySize, LDS_BYTES) != hipSuccess) { fprintf(stderr, "kernel_launch: hipFuncSetAttribute failed\n"); grid = -1; return; }
        if (hipOccupancyMaxActiveBlocksPerMultiprocessor(&per_cu, (const void*)fwd_kernel, 512, LDS_BYTES) != hipSuccess || per_cu < 1) { fprintf(stderr, "kernel_launch: occupancy query says %d blocks per CU\n", per_cu); per_cu = 1; }
        (void)hipGetLastError();
        grid = cus;
    }
    if (grid < 0) return;
    Params p{};
    p.x = (const float*)d_in[0]; p.c = (const float*)d_in[1]; p.pos = (const int*)d_in[2]; p.w_mod = (const float*)d_in[3]; p.b_mod = (const float*)d_in[4];
    p.g_pre = (const float*)d_in[5]; p.g_post = (const float*)d_in[6]; p.w_in = (const float*)d_in[7]; p.w_out = (const float*)d_in[8]; p.sinks = (const float*)d_in[9];
    p.sg_w = (const float*)d_in[10]; p.sg_b = (const float*)d_in[11]; p.sg_ln_g = (const float*)d_in[12]; p.sg_ln_b = (const float*)d_in[13];
    p.gla_wup = (const float*)d_in[14]; p.gla_bg = (const float*)d_in[15]; p.gla_ng = (const float*)d_in[16];
    p.out = (float*)d_out; p.ws = (unsigned char*)d_ws;
#if MK_SINGLE
    if (hipMemsetAsync((char*)d_ws + WS_BAR, 0, XCD_BAR_WORDS * 4, stream) != hipSuccess) { fprintf(stderr, "kernel_launch: memset failed\n"); return; }
    p.ph_lo = 0; p.ph_hi = N_PHASES;
    void* args[] = {&p};
    hipError_t e = hipLaunchCooperativeKernel((const void*)fwd_kernel, dim3(grid), dim3(512), args, LDS_BYTES, stream);
    if (e != hipSuccess) fprintf(stderr, "kernel_launch: cooperative launch failed: %s (grid %d)\n", hipGetErrorString(e), grid);
#else
    for (int ph = 0; ph < N_PHASES; ++ph) {
        p.ph_lo = ph; p.ph_hi = ph + 1;
        hipLaunchKernelGGL(fwd_kernel, dim3(grid), dim3(512), LDS_BYTES, stream, p);
    }
#endif
}
```

```cpp
#include <hip/hip_runtime.h>
#include <hip/hip_cooperative_groups.h>
#include <cstdio>
#include <cstdint>
namespace cg = cooperative_groups;

#ifndef REPS
#define REPS 0x11111111
#endif
#define REPN(k) ((REPS >> (4 * (k))) & 15)
#ifndef PMASK
#define PMASK 0ull
#endif
#ifndef MIXR
#define MIXR 0x111
#endif
#ifndef MK_SINGLE
#define MK_SINGLE 1
#endif

#define LAS __attribute__((address_space(3)))
typedef unsigned short bf16_t;
typedef short bf16x8 __attribute__((ext_vector_type(8)));
typedef float f32x4 __attribute__((ext_vector_type(4)));
typedef float f32x2 __attribute__((ext_vector_type(2)));
typedef unsigned u32x4 __attribute__((ext_vector_type(4)));
typedef unsigned u32x2 __attribute__((ext_vector_type(2)));

constexpr int D = 2048, NB = 4, SEQ = 2048, M = NB * SEQ;
constexpr int NPROJ = 5632;
constexpr int NPAD = 5888;
constexpr int WIN_LD = 5648;
constexpr float EPS = 1e-6f;
constexpr int C_AQ = 0, C_AK = 1024, C_AV = 1280, C_SU = 1536, C_SV = 2048, C_CQ = 2560, C_CK = 2816, C_CV = 3072, C_Z = 3584;
constexpr float LOG2E = 1.4426950408889634f;

constexpr size_t MiB = 1u << 20;
constexpr size_t WS_WIN = 0, WIN_BYTES = (size_t)NPAD * D * 2;
constexpr size_t WS_WOUT = 46 * MiB, WOUT_BYTES = (size_t)D * D * 2;
constexpr size_t WS_H = 62 * MiB, WS_PROJ = 94 * MiB, WS_CG = 182 * MiB, WS_MOD = 183 * MiB, WS_Y = 184 * MiB, WS_OUT = 216 * MiB;
constexpr size_t WS_LOCT = 248 * MiB, WS_ST = 264 * MiB, WS_DEC = 272 * MiB, WS_BAR = 273 * MiB, WS_QD = 274 * MiB, WS_KD = 278 * MiB, WS_VTG = 282 * MiB, WS_X1B = 290 * MiB, WS_SGST = 322 * MiB, WS_SGW = 323 * MiB, WS_END = 324 * MiB;

constexpr int LDS_BYTES = 135168;

struct Params {
    const float* x; const float* c; const int* pos; const float* w_mod; const float* b_mod; const float* g_pre; const float* g_post;
    const float* w_in; const float* w_out; const float* sinks; const float* sg_w; const float* sg_b; const float* sg_ln_g; const float* sg_ln_b;
    const float* gla_wup; const float* gla_bg; const float* gla_ng;
    float* out; unsigned char* ws; int ph_lo, ph_hi;
};

__device__ __forceinline__ Params fresh_params(const Params& p) {
#if defined(__HIP_DEVICE_COMPILE__)
    typedef unsigned long long u64;
    const __attribute__((address_space(4))) u64* pp = (const __attribute__((address_space(4))) u64*)__builtin_amdgcn_kernarg_segment_ptr();
    asm volatile("" : "+s"(pp));
    Params q; u64* dst = (u64*)&q;
#pragma unroll
    for (int i = 0; i < (int)(sizeof(Params) / 8); ++i) dst[i] = pp[i];
    return q;
#else
    return p;
#endif
}
static_assert(sizeof(Params) % 8 == 0, "Params is copied in 8-byte words");

typedef __bf16 bf16x2_t __attribute__((ext_vector_type(2)));
__device__ __forceinline__ unsigned cvt_pk_bf16(float lo, float hi) { const f32x2 v = {lo, hi}; const bf16x2_t b = __builtin_convertvector(v, bf16x2_t); return __builtin_bit_cast(unsigned, b); }
__device__ __forceinline__ float bf_lo(unsigned u) { return __builtin_bit_cast(float, u << 16); }
__device__ __forceinline__ float bf_hi(unsigned u) { return __builtin_bit_cast(float, u & 0xffff0000u); }
__device__ __forceinline__ float bf1(bf16_t v) { return __builtin_bit_cast(float, (unsigned)v << 16); }
__device__ __forceinline__ bf16_t f2bf(float f) { return (bf16_t)(cvt_pk_bf16(f, 0.f) & 0xffffu); }
__device__ __forceinline__ float fast_exp2(float x) { return __builtin_amdgcn_exp2f(x); }
__device__ __forceinline__ float fast_rcp(float x) { return __builtin_amdgcn_rcpf(x); }
__device__ __forceinline__ float silu_f(float x) { return x * fast_rcp(1.f + fast_exp2(-x * LOG2E)); }
__device__ __forceinline__ float gelu_tanh_f(float x) { const float u = 0.7978845608028654f * (x + 0.044715f * x * x * x); return x * fast_rcp(1.f + fast_exp2(-2.f * LOG2E * u)); }
__device__ __forceinline__ float wave_sum(float v) {
#pragma unroll
    for (int o = 1; o < 64; o <<= 1) v += __shfl_xor(v, o);
    return v;
}

typedef short v4i16_t __attribute__((ext_vector_type(4)));
__device__ __forceinline__ bf16x8 tr_operand(const void* p0, const void* p1) {
    const v4i16_t a = __builtin_amdgcn_ds_read_tr16_b64_v4i16((__attribute__((address_space(3))) v4i16_t*)p0);
    const v4i16_t b = __builtin_amdgcn_ds_read_tr16_b64_v4i16((__attribute__((address_space(3))) v4i16_t*)p1);
    return __builtin_shufflevector(a, b, 0, 1, 2, 3, 4, 5, 6, 7);
}
#define MFMA16(a, b, c) __builtin_amdgcn_mfma_f32_16x16x32_bf16((a), (b), (c), 0, 0, 0)

namespace pg8 {
#define PG8_LAS __attribute__((address_space(3)))
constexpr int BM = 256, BK = 64, HALF = 128, HTB = HALF * BK * 2, STAGE_BYTES = 8 * HTB, NXCD = 8, WGM = 8;
__host__ __device__ __forceinline__ int lds_byte(int r, int c) { const int st = (r >> 4) * 2 + (c >> 5), rr = r & 15, cc = c & 31, ob = rr * 64 + cc * 2; return st * 1024 + (ob ^ (((ob >> 9) & 1) << 5)); }
__host__ __device__ __forceinline__ void stage_rc(int b, int& R, int& C) { const int st = b / 1024, sb = b % 1024, swz = sb ^ (((sb >> 9) & 1) << 5); R = (st >> 1) * 16 + swz / 64; C = (st & 1) * 32 + (swz % 64) / 2; }
__host__ __device__ __forceinline__ int perm32(int rho) { const int n = rho >> 4, i = rho & 15; return 8 * (i >> 2) + 4 * n + (i & 3); }
struct Unit { int pm, pn; };
struct Gemm { const bf16_t* A; const bf16_t* Bt; int M, N, K; };
struct StaticOrder {
    int nM, nN, nwg, G, c;
    __host__ __device__ void init(int M_, int N_, int G_, int c_) { nM = M_ / BM; nN = N_ / BM; nwg = nM * nN; G = G_; c = c_; }
    __host__ __device__ bool next(int i, Unit& u) const {
        const long L = (long)i * G + c; if (L >= nwg) return false;
        int wgid = (int)L; { const int q = nwg / NXCD, r = nwg % NXCD, xcd = wgid % NXCD, off = wgid / NXCD; wgid = (xcd < r ? xcd * (q + 1) : r * (q + 1) + (xcd - r) * q) + off; }
        const int nig = WGM * nN, gid = wgid / nig, fm = gid * WGM, gsz = (nM - fm) < WGM ? (nM - fm) : WGM;
        u.pm = fm + ((wgid % nig) % gsz); u.pn = (wgid % nig) / gsz; return true;
    }
    __device__ __forceinline__ void a_ready(const Unit&) const {}
    __device__ __forceinline__ void done(const Unit&) const {}
};

template <class Epi, class Sched, bool ALIGN_EPI = false, bool SP2 = false>
__device__ __forceinline__ void gemm_phase(PG8_LAS unsigned char* lds, const Gemm g, const Sched& S, const Epi& E, const int tid) {
    const int wid = __builtin_amdgcn_readfirstlane(tid >> 6), lane = tid & 63, wr = wid >> 2, wc = wid & 3, fr = lane & 15, fq = lane >> 4;
    const int K = g.K, nt = K / BK;
    unsigned voffA[2], voffB[2];
#pragma unroll
    for (int i = 0; i < 2; ++i) { int R, C; stage_rc(tid * 16 + i * 8192, R, C); const int Rb = Epi::PERM ? ((R & ~31) + perm32(R & 31)) : R;
        voffA[i] = (unsigned)(R * K + C) * 2u; voffB[i] = (unsigned)(Rb * K + C) * 2u; }
    const size_t kstep = (size_t)(BK * 2);
    const size_t hstep = (size_t)HALF * K * 2;
    const size_t tstep = 2 * hstep;
    const unsigned ldsw = (unsigned)wid * 1024u;
    const int aoff = lds_byte(wr * 64 + fr, fq * 8), boff = lds_byte(wc * 32 + fr, fq * 8);
#define PG8_SA(b, h) (((b) * 2 + (h)) * HTB)
#define PG8_SB(b, h) ((4 + (b) * 2 + (h)) * HTB)
#define PG8_STAGE(bufoff, gbase, voff) do { _Pragma("unroll") for (int _i = 0; _i < 2; ++_i) \
        __builtin_amdgcn_global_load_lds((const unsigned*)((const char*)(gbase) + (voff)[_i]), (PG8_LAS unsigned*)(lds + (bufoff) + ldsw + _i * 8192), 16, 0, 0); } while (0)
#define PG8_LDA(dst, b, h) do { _Pragma("unroll") for (int m = 0; m < 4; ++m) _Pragma("unroll") for (int k = 0; k < 2; ++k) dst[m][k] = *(const PG8_LAS bf16x8*)(lds + PG8_SA(b, h) + aoff + m * 2048 + k * 1024); } while (0)
#define PG8_LDB(dst, b, h) do { _Pragma("unroll") for (int n = 0; n < 2; ++n) _Pragma("unroll") for (int k = 0; k < 2; ++k) dst[n][k] = *(const PG8_LAS bf16x8*)(lds + PG8_SB(b, h) + boff + n * 2048 + k * 1024); } while (0)
#define PG8_MMA(ai, bj, At, Bt) do { __builtin_amdgcn_s_setprio(1); _Pragma("unroll") for (int m = 0; m < 4; ++m) _Pragma("unroll") for (int n = 0; n < 2; ++n) _Pragma("unroll") for (int k = 0; k < 2; ++k) \
        acc[ai][bj][m][n] = __builtin_amdgcn_mfma_f32_16x16x32_bf16(Bt[n][k], At[m][k], acc[ai][bj][m][n], 0, 0, 0); __builtin_amdgcn_s_setprio(0); } while (0)
#define PG8_WAIT_V(n) asm volatile("s_waitcnt vmcnt(" #n ")" ::: "memory")
#define PG8_WAIT_L(n) asm volatile("s_waitcnt lgkmcnt(" #n ")" ::: "memory")
#define PG8_BAR __builtin_amdgcn_s_barrier()
#define PG8_SCHED __builtin_amdgcn_sched_barrier(0)
    Unit cur, nxt; int ui = 0;
    if (!S.next(0, cur)) return;
    f32x4 acc[2][2][4][2];
#pragma unroll
    for (int a = 0; a < 2; ++a)
#pragma unroll
        for (int b = 0; b < 2; ++b)
#pragma unroll
            for (int m = 0; m < 4; ++m)
#pragma unroll
                for (int n = 0; n < 2; ++n) acc[a][b][m][n] = (f32x4){0.f, 0.f, 0.f, 0.f};
    bf16x8 At[4][2], B0[2][2], B1[2][2];
    const char* cA = (const char*)g.A + (size_t)cur.pm * tstep; const char* cB = (const char*)g.Bt + (size_t)cur.pn * tstep;
    S.a_ready(cur);
    if constexpr (SP2) {
        PG8_STAGE(PG8_SB(0, 0), cB, voffB); PG8_STAGE(PG8_SB(0, 1), cB + hstep, voffB); PG8_STAGE(PG8_SA(0, 0), cA, voffA); PG8_STAGE(PG8_SA(0, 1), cA + hstep, voffA);
        if (wr == 1) PG8_BAR;
        PG8_WAIT_V(2); PG8_BAR;
        PG8_STAGE(PG8_SB(1, 0), cB + kstep, voffB); PG8_STAGE(PG8_SA(1, 0), cA + kstep, voffA); PG8_STAGE(PG8_SB(1, 1), cB + hstep + kstep, voffB);
        PG8_WAIT_V(6); PG8_BAR;
    } else {
        PG8_STAGE(PG8_SB(0, 0), cB, voffB); PG8_STAGE(PG8_SA(0, 0), cA, voffA); PG8_STAGE(PG8_SB(0, 1), cB + hstep, voffB); PG8_STAGE(PG8_SA(0, 1), cA + hstep, voffA);
        if (wr == 1) PG8_BAR;
        PG8_WAIT_V(4); PG8_BAR;
        PG8_STAGE(PG8_SB(1, 0), cB + kstep, voffB); PG8_STAGE(PG8_SA(1, 0), cA + kstep, voffA); PG8_STAGE(PG8_SB(1, 1), cB + hstep + kstep, voffB);
        PG8_WAIT_V(6); PG8_BAR;
    }
    for (;;) {
        const bool has_next = S.next(ui + 1, nxt);
        const char* nA = has_next ? (const char*)g.A + (size_t)nxt.pm * tstep : cA; const char* nB = has_next ? (const char*)g.Bt + (size_t)nxt.pn * tstep : cB;
        for (int t = 0; t < nt; t += 2) {
            const bool last = (t == nt - 2);
            const char* a1 = cA + (size_t)(t + 1) * kstep;
            const char* a2 = last ? nA : cA + (size_t)(t + 2) * kstep; const char* b2 = last ? nB : cB + (size_t)(t + 2) * kstep;
            const char* a3 = a2 + kstep; const char* b3 = b2 + kstep;
            if (last && has_next) S.a_ready(nxt);
            if constexpr (SP2) {
            PG8_LDB(B0, 0, 0); PG8_LDB(B1, 0, 1); PG8_SCHED; PG8_LDA(At, 0, 0); PG8_STAGE(PG8_SA(1, 1), a1 + hstep, voffA);
            PG8_WAIT_V(8); PG8_WAIT_L(0); PG8_BAR; PG8_MMA(0, 0, At, B0); PG8_MMA(0, 1, At, B1); PG8_BAR; PG8_SCHED;
            PG8_LDA(At, 0, 1); PG8_STAGE(PG8_SB(0, 0), b2, voffB); PG8_STAGE(PG8_SB(0, 1), b2 + hstep, voffB); PG8_STAGE(PG8_SA(0, 0), a2, voffA);
            PG8_WAIT_V(8); PG8_WAIT_L(0); PG8_BAR; PG8_MMA(1, 0, At, B0); PG8_MMA(1, 1, At, B1); PG8_BAR; PG8_SCHED;
            PG8_LDB(B0, 1, 0); PG8_LDB(B1, 1, 1); PG8_SCHED; PG8_LDA(At, 1, 0); PG8_STAGE(PG8_SA(0, 1), a2 + hstep, voffA);
            PG8_WAIT_V(8); PG8_WAIT_L(0); PG8_BAR; PG8_MMA(0, 0, At, B0); PG8_MMA(0, 1, At, B1); PG8_BAR; PG8_SCHED;
            PG8_LDA(At, 1, 1); PG8_STAGE(PG8_SB(1, 0), b3, voffB); PG8_STAGE(PG8_SB(1, 1), b3 + hstep, voffB); PG8_STAGE(PG8_SA(1, 0), a3, voffA);
            PG8_WAIT_V(8); PG8_WAIT_L(0); PG8_BAR; PG8_MMA(1, 0, At, B0); PG8_MMA(1, 1, At, B1); PG8_BAR; PG8_SCHED;
            } else {
            PG8_LDB(B0, 0, 0); PG8_SCHED; PG8_LDA(At, 0, 0); PG8_STAGE(PG8_SA(1, 1), a1 + hstep, voffA);
            PG8_WAIT_L(8); PG8_BAR; PG8_WAIT_L(0); PG8_MMA(0, 0, At, B0); PG8_BAR; PG8_SCHED;
            PG8_LDB(B1, 0, 1); PG8_STAGE(PG8_SB(0, 0), b2, voffB);
            PG8_BAR; PG8_WAIT_L(0); PG8_MMA(0, 1, At, B1); PG8_BAR;
            PG8_LDA(At, 0, 1); PG8_STAGE(PG8_SA(0, 0), a2, voffA);
            PG8_BAR; PG8_WAIT_L(0); PG8_MMA(1, 0, At, B0); PG8_BAR; PG8_SCHED;
            PG8_STAGE(PG8_SB(0, 1), b2 + hstep, voffB);
            PG8_WAIT_V(6); PG8_BAR; PG8_MMA(1, 1, At, B1); PG8_BAR;
            PG8_LDB(B0, 1, 0); PG8_SCHED; PG8_LDA(At, 1, 0); PG8_STAGE(PG8_SA(0, 1), a2 + hstep, voffA);
            PG8_WAIT_L(8); PG8_BAR; PG8_WAIT_L(0); PG8_MMA(0, 0, At, B0); PG8_BAR; PG8_SCHED;
            PG8_LDB(B1, 1, 1); PG8_STAGE(PG8_SB(1, 0), b3, voffB);
            PG8_BAR; PG8_WAIT_L(0); PG8_MMA(0, 1, At, B1); PG8_BAR;
            PG8_LDA(At, 1, 1); PG8_STAGE(PG8_SA(1, 0), a3, voffA);
            PG8_BAR; PG8_WAIT_L(0); PG8_MMA(1, 0, At, B0); PG8_BAR; PG8_SCHED;
            PG8_STAGE(PG8_SB(1, 1), b3 + hstep, voffB);
            PG8_WAIT_V(6); PG8_BAR; PG8_MMA(1, 1, At, B1); PG8_BAR;
            }
        }
        if constexpr (ALIGN_EPI) { if (wr == 0) PG8_BAR; }
        E(acc, cur, wr, wc, fr, fq); S.done(cur);
        if (!has_next) break;
#pragma unroll
        for (int a = 0; a < 2; ++a)
#pragma unroll
            for (int b = 0; b < 2; ++b)
#pragma unroll
                for (int m = 0; m < 4; ++m)
#pragma unroll
                    for (int n = 0; n < 2; ++n) acc[a][b][m][n] = (f32x4){0.f, 0.f, 0.f, 0.f};
        cur = nxt; cA = nA; cB = nB; ++ui;
        if constexpr (ALIGN_EPI) { if (wr == 1) PG8_BAR; }
    }
    PG8_WAIT_V(0);
    if constexpr (!ALIGN_EPI) { if (wr == 0) PG8_BAR; }
    PG8_BAR;
#undef PG8_SA
#undef PG8_SB
#undef PG8_STAGE
#undef PG8_LDA
#undef PG8_LDB
#undef PG8_MMA
#undef PG8_WAIT_V
#undef PG8_WAIT_L
#undef PG8_BAR
#undef PG8_SCHED
}

struct EpiProj {
    static constexpr bool PERM = true;
    bf16_t* P; float* CG; float* SGST;
    template <int ACT> __device__ __forceinline__ void store_tile(const f32x4 (&acc)[2][2][4][2], bf16_t* base, float* stp, int fq) const {
#pragma unroll
        for (int ai = 0; ai < 2; ++ai)
#pragma unroll
            for (int m = 0; m < 4; ++m) { bf16_t* rowp = base + (size_t)(ai * HALF + m * 16) * NPROJ;
                float rs = 0.f, rq = 0.f;
#pragma unroll
                for (int bj = 0; bj < 2; ++bj) { f32x4 v0 = acc[ai][bj][m][0], v1 = acc[ai][bj][m][1];
                    if (ACT == 1) { for (int e = 0; e < 4; ++e) { v0[e] = gelu_tanh_f(v0[e]); v1[e] = gelu_tanh_f(v1[e]); } }
                    if (ACT == 2) { for (int e = 0; e < 4; ++e) { v0[e] = silu_f(v0[e]); v1[e] = silu_f(v1[e]); } }
                    if (ACT == 1) { rs += ((v0[0] + v0[1]) + (v0[2] + v0[3])) + ((v1[0] + v1[1]) + (v1[2] + v1[3]));
                        rq += ((v0[0] * v0[0] + v0[1] * v0[1]) + (v0[2] * v0[2] + v0[3] * v0[3])) + ((v1[0] * v1[0] + v1[1] * v1[1]) + (v1[2] * v1[2] + v1[3] * v1[3])); }
                    u32x4 w; w.x = cvt_pk_bf16(v0[0], v0[1]); w.y = cvt_pk_bf16(v0[2], v0[3]); w.z = cvt_pk_bf16(v1[0], v1[1]); w.w = cvt_pk_bf16(v1[2], v1[3]);
                    *(u32x4*)(rowp + bj * HALF) = w; }
                if (ACT == 1) { if (stp) { rs += __shfl_xor(rs, 16); rs += __shfl_xor(rs, 32); rq += __shfl_xor(rq, 16); rq += __shfl_xor(rq, 32);
                    if (fq == 0) *(f32x2*)(stp + (size_t)(ai * HALF + m * 16) * 16) = (f32x2){rs, rq}; } } }
    }
    __device__ __forceinline__ void operator()(const f32x4 (&acc)[2][2][4][2], const Unit& u, int wr, int wc, int fr, int fq) const {
        const int row0 = u.pm * BM + wr * 64 + fr;
        if (u.pn < 22) {
            bf16_t* base = P + (size_t)row0 * NPROJ + u.pn * BM + wc * 32 + 8 * fq;
            if (u.pn >= 6 && u.pn < 10) store_tile<1>(acc, base, (u.pn >= 8) ? SGST + (size_t)row0 * 16 + ((u.pn - 8) * 4 + wc) * 2 : nullptr, fq);
            else if (u.pn >= 14) store_tile<2>(acc, base, nullptr, fq);
            else store_tile<0>(acc, base, nullptr, fq);
        } else if (wc == 0 && fq < 2) {
#pragma unroll
            for (int ai = 0; ai < 2; ++ai)
#pragma unroll
                for (int m = 0; m < 4; ++m) { float* p = CG + (size_t)(row0 + ai * HALF + m * 16) * 16 + 8 * fq;
                    *(f32x4*)p = acc[ai][0][m][0]; *(f32x4*)(p + 4) = acc[ai][0][m][1]; }
        }
    }
};
struct EpiOut {
    static constexpr bool PERM = true;
    bf16_t* O;
    __device__ __forceinline__ void operator()(const f32x4 (&acc)[2][2][4][2], const Unit& u, int wr, int wc, int fr, int fq) const {
        bf16_t* base = O + (size_t)(u.pm * BM + wr * 64 + fr) * D + u.pn * BM + wc * 32 + 8 * fq;
#pragma unroll
        for (int ai = 0; ai < 2; ++ai)
#pragma unroll
            for (int m = 0; m < 4; ++m) { bf16_t* rowp = base + (size_t)(ai * HALF + m * 16) * D;
#pragma unroll
                for (int bj = 0; bj < 2; ++bj) { const f32x4 v0 = acc[ai][bj][m][0], v1 = acc[ai][bj][m][1];
                    u32x4 w; w.x = cvt_pk_bf16(v0[0], v0[1]); w.y = cvt_pk_bf16(v0[2], v0[3]); w.z = cvt_pk_bf16(v1[0], v1[1]); w.w = cvt_pk_bf16(v1[2], v1[3]);
                    *(u32x4*)(rowp + bj * HALF) = w; } }
    }
};
}

__device__ __forceinline__ void p0_transpose_item(const float* W, int ldw, int n_src0, bf16_t* WT, int row_dst0, int kb, float* scr, int lane) {
    const int k0 = 64 * kb;
    {   const int kr = lane >> 3, c4 = 4 * (lane & 7);
        const float* src = W + (size_t)(k0 + kr) * ldw + n_src0 + c4;
        f32x4 v[8];
#pragma unroll
        for (int i = 0; i < 8; ++i) v[i] = __builtin_nontemporal_load((const f32x4*)(src + (size_t)(8 * i) * ldw));
#pragma unroll
        for (int i = 0; i < 8; ++i) { float* d = scr + (8 * i + kr) * 33 + c4; d[0] = v[i][0]; d[1] = v[i][1]; d[2] = v[i][2]; d[3] = v[i][3]; }
    }
    asm volatile("s_waitcnt lgkmcnt(0)" ::: "memory");
    const int c = lane & 7;
#pragma unroll
    for (int j = 0; j < 4; ++j) { const int n = (lane >> 3) + 8 * j; const float* s = scr + (8 * c) * 33 + n;
        u32x4 o; o.x = cvt_pk_bf16(s[0 * 33], s[1 * 33]); o.y = cvt_pk_bf16(s[2 * 33], s[3 * 33]); o.z = cvt_pk_bf16(s[4 * 33], s[5 * 33]); o.w = cvt_pk_bf16(s[6 * 33], s[7 * 33]);
        *(u32x4*)(WT + (size_t)(row_dst0 + n) * D + k0 + 8 * c) = o; }
    asm volatile("s_waitcnt lgkmcnt(0)" ::: "memory");
}

__device__ __forceinline__ void mod_items(const Params& p, int l, unsigned char* lds, int tid, int wave, int lane, int bx) {
    const int G = gridDim.x;
    if (bx >= 192) return;
    float* sc = (float*)lds;
    float* red = (float*)(lds + 32768);
    for (int i = tid; i < 4 * D; i += 512) { const int b = i >> 11, k = i & (D - 1); sc[k * 4 + b] = silu_f(p.c[i]); }
    __syncthreads();
    for (int it = bx; it < 192; it += G) {
        const int n0 = 32 * it;
        const int r8 = lane >> 3, c4 = lane & 7;
        const float* wp = p.w_mod + ((size_t)l * D + wave * 256 + r8) * 6144 + n0 + 4 * c4;
        f32x4 a0 = {0, 0, 0, 0}, a1 = a0, a2 = a0, a3 = a0;
#pragma unroll 8
        for (int i = 0; i < 32; ++i) {
            const f32x4 w = __builtin_nontemporal_load((const f32x4*)(wp + (size_t)(8 * i) * 6144));
            const f32x4 s = *(const f32x4*)(sc + (wave * 256 + 8 * i + r8) * 4);
            a0 += w * s[0]; a1 += w * s[1]; a2 += w * s[2]; a3 += w * s[3];
        }
#pragma unroll
        for (int e = 0; e < 4; ++e) {
#pragma unroll
            for (int o = 8; o < 64; o <<= 1) { a0[e] += __shfl_xor(a0[e], o); a1[e] += __shfl_xor(a1[e], o); a2[e] += __shfl_xor(a2[e], o); a3[e] += __shfl_xor(a3[e], o); }
        }
        if (r8 == 0) {
            *(f32x4*)(red + (wave * 4 + 0) * 32 + 4 * c4) = a0; *(f32x4*)(red + (wave * 4 + 1) * 32 + 4 * c4) = a1;
            *(f32x4*)(red + (wave * 4 + 2) * 32 + 4 * c4) = a2; *(f32x4*)(red + (wave * 4 + 3) * 32 + 4 * c4) = a3;
        }
        __syncthreads();
        if (tid < 128) { const int b = tid >> 5, col = tid & 31; float s = p.b_mod[l * 6144 + n0 + col];
#pragma unroll
            for (int w = 0; w < 8; ++w) s += red[(w * 4 + b) * 32 + col];
            ((float*)(p.ws + WS_MOD))[(l * 4 + b) * 6144 + n0 + col] = s; }
        __syncthreads();
    }
}

__device__ __forceinline__ void p0_transposes(const Params& p, unsigned char* lds, int wave, int lane, int bx, int part) {
    const int G = gridDim.x;
    unsigned char* ws = p.ws;
    float* scr = (float*)(lds + wave * 16384);
    constexpr int PER_L = 32 * 240, NIT = 2 * PER_L;
    int base, end, stride;
    if (G == 256) {
        if (part == 0) { if (bx < 192) return; base = 13824 + (bx - 192) * 24; end = base + 24; }
        else if (bx < 192) { base = 49 * bx; end = base + 49; } else { base = 9408 + (bx - 192) * 69; end = base + 69; }
        base += wave; stride = 8;
    } else { if (part == 0) return; base = bx * 8 + wave; end = NIT; stride = G * 8; }
    for (int it = base; it < end; it += stride) {
        const int l = it / PER_L, r = it % PER_L, kb = r / 240, j = r % 240;
        bf16_t* WinT = (bf16_t*)(ws + WS_WIN + (size_t)l * WIN_BYTES);
        bf16_t* WoT = (bf16_t*)(ws + WS_WOUT + (size_t)l * WOUT_BYTES);
        if (j < 112) p0_transpose_item(p.w_in + (size_t)l * D * WIN_LD, WIN_LD, 32 * j, WinT, 32 * j, kb, scr, lane);
        else if (j < 176) p0_transpose_item(p.w_in + (size_t)l * D * WIN_LD, WIN_LD, 3600 + 32 * (j - 112), WinT, 3584 + 32 * (j - 112), kb, scr, lane);
        else p0_transpose_item(p.w_out + (size_t)l * D * D, D, 32 * (j - 176), WoT, 32 * (j - 176), kb, scr, lane);
    }
}

__device__ __forceinline__ void p0_convert(const Params& p, unsigned char* lds, int tid, int wave, int lane, int bx) {
    const int G = gridDim.x;
    unsigned char* ws = p.ws;
    {
        const int gt = bx * 512 + tid, NT = G * 512;
        for (int i = gt; i < 2 * 256 * (D / 8); i += NT) {
            const int l = i / (256 * (D / 8)), r = i % (256 * (D / 8)), j = r / (D / 8), k8 = (r % (D / 8)) * 8;
            u32x4 o = {0u, 0u, 0u, 0u};
            if (j < 16) { const float* s = p.w_in + ((size_t)l * D + k8) * WIN_LD + 3584 + j;
                o.x = cvt_pk_bf16(s[0], s[WIN_LD]); o.y = cvt_pk_bf16(s[2 * WIN_LD], s[3 * WIN_LD]); o.z = cvt_pk_bf16(s[4 * WIN_LD], s[5 * WIN_LD]); o.w = cvt_pk_bf16(s[6 * WIN_LD], s[7 * WIN_LD]); }
            *(u32x4*)((bf16_t*)(ws + WS_WIN + (size_t)l * WIN_BYTES) + (size_t)(5632 + j) * D + k8) = o;
        }
    }
    {
        const int gt = bx * 512 + tid;
        if (gt < 2 * 8 * 128 * 16) {
            const int t = (gt >> 4) & 127, s0 = (gt & 15) * 8;
            const float* src = p.sg_w + (size_t)gt * 8;
            const f32x4 f0 = *(const f32x4*)src, f1 = *(const f32x4*)(src + 4);
            float w[8] = {f0[0], f0[1], f0[2], f0[3], f1[0], f1[1], f1[2], f1[3]};
#pragma unroll
            for (int e = 0; e < 8; ++e) w[e] = (s0 + e <= t) ? w[e] : 0.f;
            *(u32x4*)((bf16_t*)(ws + WS_SGW) + (size_t)gt * 8) = (u32x4){cvt_pk_bf16(w[0], w[1]), cvt_pk_bf16(w[2], w[3]), cvt_pk_bf16(w[4], w[5]), cvt_pk_bf16(w[6], w[7])};
        }
    }
    p0_transposes(p, lds, wave, lane, bx, 1);
}

__device__ __forceinline__ void row_pass(const Params& p, int mode, int wave, int lane, int bx) {
    const int gw = bx * 8 + wave, NGW = gridDim.x * 8;
    unsigned char* ws = p.ws;
    const float* mod = (const float*)(ws + WS_MOD);
    const bf16_t* OUTB = (const bf16_t*)(ws + WS_OUT);
    bf16_t* H = (bf16_t*)(ws + WS_H);
    const int lpost = (mode == 2) ? 1 : 0, lpre = (mode == 0) ? 0 : 1;
    for (int gi = gw; gi < M / 4; gi += NGW) {
        const int r0 = 4 * gi, b = r0 >> 11;
        f32x4 gg[4][2], aa[4][2], tt[4][2];
        if (mode >= 1) {
            const float* gate = mod + (size_t)(lpost * 4 + b) * 6144 + 4096; const float* gp = p.g_post + lpost * D;
#pragma unroll
            for (int j = 0; j < 4; ++j)
#pragma unroll
                for (int h = 0; h < 2; ++h) { const int col = 8 * lane + 512 * j + 4 * h; gg[j][h] = *(const f32x4*)(gate + col) * *(const f32x4*)(gp + col); }
        }
        if (mode <= 1) {
            const float* shift = mod + (size_t)(lpre * 4 + b) * 6144; const float* scale = shift + 2048; const float* gp = p.g_pre + lpre * D;
#pragma unroll
            for (int j = 0; j < 4; ++j)
#pragma unroll
                for (int h = 0; h < 2; ++h) { const int col = 8 * lane + 512 * j + 4 * h;
                    aa[j][h] = *(const f32x4*)(gp + col) * (*(const f32x4*)(scale + col) + 1.f); tt[j][h] = *(const f32x4*)(shift + col); }
        }
#pragma unroll 1
        for (int k = 0; k < 4; ++k) {
            const int r = r0 + k;
            f32x4 v[4][2];
            if (mode == 2) {
                const bf16_t* x1b = (const bf16_t*)(ws + WS_X1B) + (size_t)r * D;
#pragma unroll
                for (int j = 0; j < 4; ++j) { const u32x4 w = *(const u32x4*)(x1b + 8 * lane + 512 * j);
                    v[j][0] = (f32x4){bf_lo(w.x), bf_hi(w.x), bf_lo(w.y), bf_hi(w.y)}; v[j][1] = (f32x4){bf_lo(w.z), bf_hi(w.z), bf_lo(w.w), bf_hi(w.w)}; }
            } else {
                const float* xin = p.x + (size_t)r * D;
#pragma unroll
                for (int j = 0; j < 4; ++j) { v[j][0] = *(const f32x4*)(xin + 8 * lane + 512 * j); v[j][1] = *(const f32x4*)(xin + 8 * lane + 512 * j + 4); }
            }
            if (mode >= 1) {
                f32x4 o[4][2]; float ss = 0.f;
#pragma unroll
                for (int j = 0; j < 4; ++j) { const u32x4 w = *(const u32x4*)(OUTB + (size_t)r * D + 8 * lane + 512 * j);
                    o[j][0] = (f32x4){bf_lo(w.x), bf_hi(w.x), bf_lo(w.y), bf_hi(w.y)}; o[j][1] = (f32x4){bf_lo(w.z), bf_hi(w.z), bf_lo(w.w), bf_hi(w.w)};
#pragma unroll
                    for (int h = 0; h < 2; ++h) ss += (o[j][h][0] * o[j][h][0] + o[j][h][1] * o[j][h][1]) + (o[j][h][2] * o[j][h][2] + o[j][h][3] * o[j][h][3]); }
                const float rstd = rsqrtf(wave_sum(ss) * (1.f / D) + EPS);
                float* xo = p.out + (size_t)r * D;
#pragma unroll
                for (int j = 0; j < 4; ++j)
#pragma unroll
                    for (int h = 0; h < 2; ++h) { const int col = 8 * lane + 512 * j + 4 * h;
                        v[j][h] = v[j][h] + gg[j][h] * (o[j][h] * rstd);
                        if (mode == 2) *(f32x4*)(xo + col) = v[j][h]; }
                if (mode == 1) {
                    bf16_t* x1b = (bf16_t*)(ws + WS_X1B) + (size_t)r * D;
#pragma unroll
                    for (int j = 0; j < 4; ++j) { u32x4 w; w.x = cvt_pk_bf16(v[j][0][0], v[j][0][1]); w.y = cvt_pk_bf16(v[j][0][2], v[j][0][3]); w.z = cvt_pk_bf16(v[j][1][0], v[j][1][1]); w.w = cvt_pk_bf16(v[j][1][2], v[j][1][3]);
                        *(u32x4*)(x1b + 8 * lane + 512 * j) = w;
                        v[j][0] = (f32x4){bf_lo(w.x), bf_hi(w.x), bf_lo(w.y), bf_hi(w.y)}; v[j][1] = (f32x4){bf_lo(w.z), bf_hi(w.z), bf_lo(w.w), bf_hi(w.w)}; }
                }
            }
            if (mode <= 1) {
                float ss = 0.f;
#pragma unroll
                for (int j = 0; j < 4; ++j)
#pragma unroll
                    for (int h = 0; h < 2; ++h) ss += (v[j][h][0] * v[j][h][0] + v[j][h][1] * v[j][h][1]) + (v[j][h][2] * v[j][h][2] + v[j][h][3] * v[j][h][3]);
                const float rstd = rsqrtf(wave_sum(ss) * (1.f / D) + EPS);
#pragma unroll
                for (int j = 0; j < 4; ++j) { f32x4 hh[2];
#pragma unroll
                    for (int h = 0; h < 2; ++h) hh[h] = (v[j][h] * rstd) * aa[j][h] + tt[j][h];
                    u32x4 w; w.x = cvt_pk_bf16(hh[0][0], hh[0][1]); w.y = cvt_pk_bf16(hh[0][2], hh[0][3]); w.z = cvt_pk_bf16(hh[1][0], hh[1][1]); w.w = cvt_pk_bf16(hh[1][2], hh[1][3]);
                    *(u32x4*)(H + (size_t)r * D + 8 * lane + 512 * j) = w; }
            }
        }
    }
}

__device__ __forceinline__ void rope_cs(int pos, int i, float& cs, float& sn) {
    constexpr float F[8] = {0.15915494309189535f, 0.03086376340470123f, 0.005985185712713705f, 0.001160663641240061f,
                            0.00022507907903927653f, 4.364795279280289e-05f, 8.464330808241401e-06f, 1.6414262627950345e-06f};
    const float rev = (float)pos * F[i];
    const float r = __builtin_amdgcn_fractf(rev);
    sn = __builtin_amdgcn_sinf(r); cs = __builtin_amdgcn_cosf(r);
}
constexpr int KS_LD = 72, VS_LD = 72;
__device__ __forceinline__ void attn_item(const Params& p, int l, int item, unsigned char* lds, int tid, int wave, int lane) {
    const int b = item >> 6, n = (item >> 2) & 15, g = item & 3;
    const int fr = lane & 15, fq = lane >> 4;
    bf16_t* Ks = (bf16_t*)lds;
    bf16_t* Vs = (bf16_t*)(lds + 256 * KS_LD * 2);
    const bf16_t* proj = (const bf16_t*)(p.ws + WS_PROJ);
    bf16_t* Y = (bf16_t*)(p.ws + WS_Y);
    const int r = wave >> 1, qh = wave & 1, hq = g * 4 + r;
    const int tokq0 = b * SEQ + n * 128 + 64 * qh;
    u32x4 qraw[4][2]; int qpos[4];
#pragma unroll
    for (int nb = 0; nb < 4; ++nb) {
        const int tok = tokq0 + 16 * nb + fr;
        const bf16_t* qp = proj + (size_t)tok * NPROJ + C_AQ + hq * 64 + 8 * fq;
        qraw[nb][0] = *(const u32x4*)qp; qraw[nb][1] = *(const u32x4*)(qp + 32); qpos[nb] = p.pos[tok];
    }
    {
        const int key = tid >> 1, half = tid & 1;
        const int s = n * 128 - 128 + key;
        u32x4 kv[4], vv[4];
#pragma unroll
        for (int c = 0; c < 4; ++c) { kv[c] = (u32x4){0u, 0u, 0u, 0u}; vv[c] = kv[c]; }
        if (s >= 0) {
            const bf16_t* kp = proj + (size_t)(b * SEQ + s) * NPROJ + C_AK + g * 64 + half * 32;
#pragma unroll
            for (int c = 0; c < 4; ++c) { kv[c] = *(const u32x4*)(kp + 8 * c); vv[c] = *(const u32x4*)(kp + 256 + 8 * c); }
            if (half == 0) {
                const int pos = p.pos[b * SEQ + s];
                unsigned a[4] = {kv[0].x, kv[0].y, kv[0].z, kv[0].w}, bb[4] = {kv[1].x, kv[1].y, kv[1].z, kv[1].w};
#pragma unroll
                for (int e = 0; e < 4; ++e) {
                    float c0, s0, c1, s1; rope_cs(pos, 2 * e, c0, s0); rope_cs(pos, 2 * e + 1, c1, s1);
                    const float t1a = bf_lo(a[e]), t1b = bf_hi(a[e]), t2a = bf_lo(bb[e]), t2b = bf_hi(bb[e]);
                    a[e] = cvt_pk_bf16(t1a * c0 - t2a * s0, t1b * c1 - t2b * s1);
                    bb[e] = cvt_pk_bf16(t2a * c0 + t1a * s0, t2b * c1 + t1b * s1);
                }
                kv[0] = (u32x4){a[0], a[1], a[2], a[3]}; kv[1] = (u32x4){bb[0], bb[1], bb[2], bb[3]};
            }
        }
#pragma unroll
        for (int c = 0; c < 4; ++c) *(u32x4*)(Ks + key * KS_LD + half * 32 + 8 * c) = kv[c];
#pragma unroll
        for (int c = 0; c < 4; ++c) *(u32x4*)(Vs + key * VS_LD + half * 32 + 8 * c) = vv[c];
    }
    __syncthreads();
    bf16x8 qf[4][2];
#pragma unroll
    for (int nb = 0; nb < 4; ++nb) {
        const u32x4 q0 = qraw[nb][0], q1 = qraw[nb][1];
        unsigned own[4] = {q0.x, q0.y, q0.z, q0.w}, par[4];
#pragma unroll
        for (int e = 0; e < 4; ++e) par[e] = __shfl_xor(own[e], 16);
        if (fq < 2) {
            const int pos = qpos[nb];
            const float sg = (fq == 0) ? -1.f : 1.f;
#pragma unroll
            for (int e = 0; e < 4; ++e) {
                float c0, s0, c1, s1; rope_cs(pos, 2 * e, c0, s0); rope_cs(pos, 2 * e + 1, c1, s1);
                const float oa = bf_lo(own[e]), ob = bf_hi(own[e]), pa = bf_lo(par[e]), pb = bf_hi(par[e]);
                own[e] = cvt_pk_bf16((oa * c0 + sg * pa * s0) * 0.125f, (ob * c1 + sg * pb * s1) * 0.125f);
            }
        } else {
#pragma unroll
            for (int e = 0; e < 4; ++e) own[e] = cvt_pk_bf16(bf_lo(own[e]) * 0.125f, bf_hi(own[e]) * 0.125f);
        }
        unsigned o1[4] = {q1.x, q1.y, q1.z, q1.w};
#pragma unroll
        for (int e = 0; e < 4; ++e) o1[e] = cvt_pk_bf16(bf_lo(o1[e]) * 0.125f, bf_hi(o1[e]) * 0.125f);
        qf[nb][0] = __builtin_bit_cast(bf16x8, (u32x4){own[0], own[1], own[2], own[3]});
        qf[nb][1] = __builtin_bit_cast(bf16x8, (u32x4){o1[0], o1[1], o1[2], o1[3]});
    }
    const float sink2 = p.sinks[l * 16 + hq] * LOG2E;
    float m_[4], l_[4];
    f32x4 o[4][4];
#pragma unroll
    for (int nb = 0; nb < 4; ++nb) { m_[nb] = sink2; l_[nb] = (fq == 0) ? 1.f : 0.f;
#pragma unroll
        for (int hb = 0; hb < 4; ++hb) o[hb][nb] = (f32x4){0.f, 0.f, 0.f, 0.f}; }
    for (int step = 0; step < 6; ++step) {
        const int kj0 = 64 * qh + 32 * step;
        if (n == 0 && kj0 + 32 <= 128) continue;
        f32x4 s[2][4];
#pragma unroll
        for (int mb = 0; mb < 2; ++mb)
#pragma unroll
            for (int nb = 0; nb < 4; ++nb) s[mb][nb] = (f32x4){0.f, 0.f, 0.f, 0.f};
#pragma unroll
        for (int mb = 0; mb < 2; ++mb)
#pragma unroll
            for (int kk = 0; kk < 2; ++kk) {
                const bf16x8 a = *(const bf16x8*)(Ks + (kj0 + 16 * mb + fr) * KS_LD + 32 * kk + 8 * fq);
#pragma unroll
                for (int nb = 0; nb < 4; ++nb) s[mb][nb] = MFMA16(a, qf[nb][kk], s[mb][nb]);
            }
        bf16x8 pb[4];
#pragma unroll
        for (int nb = 0; nb < 4; ++nb) {
            const int qi = 64 * qh + 16 * nb + fr;
            float tmax = -1e30f;
#pragma unroll
            for (int mb = 0; mb < 2; ++mb)
#pragma unroll
                for (int j = 0; j < 4; ++j) {
                    const int kj = kj0 + 16 * mb + 4 * fq + j, dist = qi + 128 - kj;
                    const bool valid = (dist >= 0) && (dist < 128) && (n > 0 || kj >= 128);
                    const float v = valid ? s[mb][nb][j] * LOG2E : -1e30f;
                    s[mb][nb][j] = v; tmax = fmaxf(tmax, v);
                }
            if (__builtin_amdgcn_ballot_w64(tmax > m_[nb] + 8.f) != 0ull) {
                tmax = fmaxf(tmax, __shfl_xor(tmax, 16)); tmax = fmaxf(tmax, __shfl_xor(tmax, 32));
                const float mnew = fmaxf(m_[nb], tmax), alpha = fast_exp2(m_[nb] - mnew);
                m_[nb] = mnew; l_[nb] = l_[nb] * alpha;
#pragma unroll
                for (int hb = 0; hb < 4; ++hb) o[hb][nb] = o[hb][nb] * alpha;
            }
            const float mref = m_[nb];
            float rs = 0.f;
#pragma unroll
            for (int mb = 0; mb < 2; ++mb)
#pragma unroll
                for (int j = 0; j < 4; ++j) { const float pv = fast_exp2(s[mb][nb][j] - mref); s[mb][nb][j] = pv; rs += pv; }
            l_[nb] = l_[nb] + rs;
            pb[nb] = __builtin_bit_cast(bf16x8, (u32x4){cvt_pk_bf16(s[0][nb][0], s[0][nb][1]), cvt_pk_bf16(s[0][nb][2], s[0][nb][3]),
                                                        cvt_pk_bf16(s[1][nb][0], s[1][nb][1]), cvt_pk_bf16(s[1][nb][2], s[1][nb][3])});
        }
#pragma unroll
        for (int hb = 0; hb < 4; ++hb) {
            const bf16_t* vp = Vs + (kj0 + 4 * fq + (fr >> 2)) * VS_LD + 32 * (hb >> 1) + 8 * (fr & 3) + 4 * (hb & 1);
            const bf16x8 a = tr_operand(vp, vp + 16 * VS_LD);
#pragma unroll
            for (int nb = 0; nb < 4; ++nb) o[hb][nb] = MFMA16(a, pb[nb], o[hb][nb]);
        }
    }
#pragma unroll
    for (int nb = 0; nb < 4; ++nb) {
        const int tok = tokq0 + 16 * nb + fr;
        float lt = l_[nb]; lt += __shfl_xor(lt, 16); lt += __shfl_xor(lt, 32);
        const float inv = 1.f / lt;
#pragma unroll
        for (int hp = 0; hp < 2; ++hp) {
            const int col = hq * 64 + 32 * hp + 8 * fq;
            const u32x4 z = *(const u32x4*)(proj + (size_t)tok * NPROJ + C_Z + col);
            const f32x4 a = o[2 * hp][nb] * inv, b2 = o[2 * hp + 1][nb] * inv;
            u32x4 y; y.x = cvt_pk_bf16(a[0] * bf_lo(z.x), a[1] * bf_hi(z.x)); y.y = cvt_pk_bf16(a[2] * bf_lo(z.y), a[3] * bf_hi(z.y));
            y.z = cvt_pk_bf16(b2[0] * bf_lo(z.z), b2[1] * bf_hi(z.z)); y.w = cvt_pk_bf16(b2[2] * bf_lo(z.w), b2[3] * bf_hi(z.w));
            *(u32x4*)(Y + (size_t)tok * D + col) = y;
        }
    }
    __syncthreads();
}

constexpr int VN_LD = 72;
__device__ __forceinline__ void sg_pair_item(const Params& p, int l, int pitem, unsigned char* lds, int tid, int wave, int lane) {
    const int b2 = pitem >> 7, c = (pitem >> 3) & 15, g = pitem & 7;
    const int fr = lane & 15, fq = lane >> 4;
    bf16_t* vnT = (bf16_t*)lds;
    const bf16_t* proj = (const bf16_t*)(p.ws + WS_PROJ);
    bf16_t* Y = (bf16_t*)(p.ws + WS_Y);
    const int s = tid >> 2, qd = tid & 3;
    const int t = 16 * wave + fr;
    int tok0[2];
    tok0[0] = b2 * SEQ + c * 128; tok0[1] = (b2 + 2) * SEQ + c * 128;
    u32x4 vw[2][2]; f32x4 stq[2]; u32x4 uf[2][2], zf[2][2];
#pragma unroll
    for (int q2 = 0; q2 < 2; ++q2) {
        const bf16_t* vp = proj + (size_t)(tok0[q2] + s) * NPROJ + C_SV;
        vw[q2][0] = *(const u32x4*)(vp + 64 * g + 16 * qd); vw[q2][1] = *(const u32x4*)(vp + 64 * g + 16 * qd + 8);
        stq[q2] = *(const f32x4*)((const float*)(p.ws + WS_SGST) + (size_t)(tok0[q2] + s) * 16 + 4 * qd);
#pragma unroll
        for (int mp = 0; mp < 2; ++mp) { const int col = 64 * g + 32 * mp + 8 * fq; const size_t ro = (size_t)(tok0[q2] + t) * NPROJ;
            uf[q2][mp] = *(const u32x4*)(proj + ro + C_SU + col); zf[q2][mp] = *(const u32x4*)(proj + ro + C_Z + 1024 + col); }
    }
    bf16x8 wf[4];
    {   const bf16_t* wrow = (const bf16_t*)(p.ws + WS_SGW) + ((size_t)(l * 8 + g) * 128 + t) * 128;
#pragma unroll
        for (int kk = 0; kk < 4; ++kk) if (32 * kk <= 16 * wave + 15) wf[kk] = *(const bf16x8*)(wrow + 32 * kk + 8 * fq); }
    const float bias = p.sg_b[(l * 8 + g) * 128 + t];
    float lgv[16], lbv[16];
    {   const float* lg = p.sg_ln_g + l * 512 + 64 * g + 16 * qd; const float* lb = p.sg_ln_b + l * 512 + 64 * g + 16 * qd;
#pragma unroll
        for (int i = 0; i < 4; ++i) { const f32x4 a = *(const f32x4*)(lg + 4 * i), bb = *(const f32x4*)(lb + 4 * i);
#pragma unroll
            for (int e = 0; e < 4; ++e) { lgv[4 * i + e] = a[e]; lbv[4 * i + e] = bb[e]; } } }
#pragma unroll
    for (int q2 = 0; q2 < 2; ++q2) {
        float sum = stq[q2][0] + stq[q2][2], sq = stq[q2][1] + stq[q2][3];
        sum += __shfl_xor(sum, 1); sum += __shfl_xor(sum, 2); sq += __shfl_xor(sq, 1); sq += __shfl_xor(sq, 2);
        const float mu = sum * (1.f / 512.f), var = fmaxf(sq * (1.f / 512.f) - mu * mu, 0.f), rstd = rsqrtf(var + EPS);
        bf16_t* vq = vnT + q2 * 128 * VN_LD + s * VN_LD + 16 * qd;
#pragma unroll
        for (int i = 0; i < 2; ++i) { const unsigned ww[4] = {vw[q2][i].x, vw[q2][i].y, vw[q2][i].z, vw[q2][i].w}; unsigned o4[4];
#pragma unroll
            for (int e = 0; e < 4; ++e) { const int ch = 8 * i + 2 * e;
                o4[e] = cvt_pk_bf16((bf_lo(ww[e]) - mu) * rstd * lgv[ch] + lbv[ch], (bf_hi(ww[e]) - mu) * rstd * lgv[ch + 1] + lbv[ch + 1]); }
            *(u32x4*)(vq + 8 * i) = (u32x4){o4[0], o4[1], o4[2], o4[3]}; }
    }
    __syncthreads();
    {
        f32x4 acc[2][4];
#pragma unroll
        for (int q2 = 0; q2 < 2; ++q2)
#pragma unroll
            for (int mb = 0; mb < 4; ++mb) acc[q2][mb] = (f32x4){0.f, 0.f, 0.f, 0.f};
#pragma unroll
        for (int kk = 0; kk < 4; ++kk) {
            if (32 * kk <= 16 * wave + 15) {
                const int s0 = 32 * kk + 8 * fq;
                const bf16x8 bfr = wf[kk];
#pragma unroll
                for (int q2 = 0; q2 < 2; ++q2)
#pragma unroll
                    for (int mb = 0; mb < 4; ++mb) {
                        const bf16_t* ap = vnT + (q2 * 128 + s0 + (fr >> 2)) * VN_LD + 32 * (mb >> 1) + 8 * (fr & 3) + 4 * (mb & 1);
                        acc[q2][mb] = MFMA16(tr_operand(ap, ap + 4 * VN_LD), bfr, acc[q2][mb]); }
            }
        }
#pragma unroll
        for (int q2 = 0; q2 < 2; ++q2)
#pragma unroll
            for (int mp = 0; mp < 2; ++mp) {
                const int col = 64 * g + 32 * mp + 8 * fq;
                const u32x4 u = uf[q2][mp], z = zf[q2][mp];
                const f32x4 a = acc[q2][2 * mp] + bias, b3 = acc[q2][2 * mp + 1] + bias;
                u32x4 y; y.x = cvt_pk_bf16(bf_lo(u.x) * a[0] * bf_lo(z.x), bf_hi(u.x) * a[1] * bf_hi(z.x)); y.y = cvt_pk_bf16(bf_lo(u.y) * a[2] * bf_lo(z.y), bf_hi(u.y) * a[3] * bf_hi(z.y));
                y.z = cvt_pk_bf16(bf_lo(u.z) * b3[0] * bf_lo(z.z), bf_hi(u.z) * b3[1] * bf_hi(z.z)); y.w = cvt_pk_bf16(bf_lo(u.w) * b3[2] * bf_lo(z.w), bf_hi(u.w) * b3[3] * bf_hi(z.w));
                *(u32x4*)(Y + (size_t)(tok0[q2] + t) * D + 1024 + col) = y;
            }
    }
    __syncthreads();
}

constexpr int GL_LD = 72;
struct CgRow { f32x4 c0, c1, c2, c3; };
__device__ __forceinline__ CgRow gla_load_cg(const Params& p, int tok) {
    const float* cgp = (const float*)(p.ws + WS_CG) + (size_t)tok * 16;
    CgRow r; r.c0 = *(const f32x4*)cgp; r.c1 = *(const f32x4*)(cgp + 4); r.c2 = *(const f32x4*)(cgp + 8); r.c3 = *(const f32x4*)(cgp + 12); return r;
}
__device__ __forceinline__ float wave_scan_incl(float v) {
#define SCAN_STEP(ctrl, rmask) v += __builtin_bit_cast(float, __builtin_amdgcn_update_dpp(0, __builtin_bit_cast(int, v), (ctrl), (rmask), 0xf, false))
    SCAN_STEP(0x111, 0xf); SCAN_STEP(0x112, 0xf); SCAN_STEP(0x114, 0xf); SCAN_STEP(0x118, 0xf);
    SCAN_STEP(0x142, 0xa); SCAN_STEP(0x143, 0xc);
#undef SCAN_STEP
    return v;
}
__device__ __forceinline__ void gla_b(const float* wl, const CgRow& cr, int wave, int lane, float (&bc)[8], float (&bl)[8]) {
    const f32x4 c0 = cr.c0, c1 = cr.c1, c2 = cr.c2, c3 = cr.c3;
    const float cgv[16] = {c0[0], c0[1], c0[2], c0[3], c1[0], c1[1], c1[2], c1[3], c2[0], c2[1], c2[2], c2[3], c3[0], c3[1], c3[2], c3[3]};
    float x[8];
    {   const f32x4 b0 = *(const f32x4*)(wl + 1024 + 8 * wave), b1 = *(const f32x4*)(wl + 1024 + 8 * wave + 4);
#pragma unroll
        for (int e = 0; e < 4; ++e) { x[e] = b0[e]; x[4 + e] = b1[e]; } }
#pragma unroll
    for (int r = 0; r < 16; ++r) {
        const f32x4 w0 = *(const f32x4*)(wl + r * 64 + 8 * wave), w1 = *(const f32x4*)(wl + r * 64 + 8 * wave + 4);
#pragma unroll
        for (int e = 0; e < 4; ++e) { x[e] += cgv[r] * w0[e]; x[4 + e] += cgv[r] * w1[e]; }
    }
#pragma unroll
    for (int i = 0; i < 8; ++i) {
        float la = (fminf(x[i], 0.f) - __logf(1.f + __expf(-fabsf(x[i])))) * (1.f / 16.f);
        la = wave_scan_incl(la);
        bc[i] = la; bl[i] = __builtin_bit_cast(float, __builtin_amdgcn_readlane(__builtin_bit_cast(int, la), 63));
    }
}
struct VPair { u32x4 a, b; };
__device__ __forceinline__ VPair gla_load_v(const bf16_t* proj, int tok0, int h, int tid) {
    const int t = tid >> 3, c8 = tid & 7;
    const bf16_t* vp = proj + (size_t)(tok0 + t) * NPROJ + C_CV + h * 128 + 16 * c8;
    VPair r; r.a = *(const u32x4*)vp; r.b = *(const u32x4*)(vp + 8); return r;
}
__device__ __forceinline__ void gla_store_vT(const VPair& v, bf16_t* vT, int tid) {
    const int t = tid >> 3, c8 = tid & 7;
#pragma unroll
    for (int i = 0; i < 2; ++i) { const u32x4 w = i ? v.b : v.a; const unsigned ww[4] = {w.x, w.y, w.z, w.w};
#pragma unroll
        for (int e = 0; e < 4; ++e) { const int dv = 16 * c8 + 8 * i + 2 * e;
            vT[dv * GL_LD + t] = (bf16_t)(ww[e] & 0xffffu); vT[(dv + 1) * GL_LD + t] = (bf16_t)(ww[e] >> 16); } }
}
constexpr int GLK_LD = 72, GLV_LD = 136;
__device__ __forceinline__ void gla_local_item(const Params& p, int l, int item, unsigned char* lds, int tid, int wave, int lane) {
    const int bh = item >> 5, c = item & 31, b = bh >> 2, h = bh & 3;
    const int fr = lane & 15, fq = lane >> 4;
    const int tok0 = b * SEQ + c * 64;
    bf16_t* Kr = (bf16_t*)lds;
    bf16_t* Vr = (bf16_t*)(lds + 64 * GLK_LD * 2);
    float* wl = (float*)(lds + 64 * GLK_LD * 2 + 64 * GLV_LD * 2);
    const bf16_t* proj = (const bf16_t*)(p.ws + WS_PROJ);
    const CgRow cr = gla_load_cg(p, tok0 + lane);
    const bf16_t* rowp = proj + (size_t)(tok0 + lane) * NPROJ + h * 64 + 8 * wave;
    const u32x4 qw = *(const u32x4*)(rowp + C_CQ), kw = *(const u32x4*)(rowp + C_CK);
    const VPair vpre = gla_load_v(proj, tok0, h, tid);
    if (tid < 256) *(f32x4*)(wl + (tid >> 4) * 64 + 4 * (tid & 15)) = *(const f32x4*)(p.gla_wup + (size_t)(l * 16 + (tid >> 4)) * 256 + h * 64 + 4 * (tid & 15));
    else if (tid < 272) *(f32x4*)(wl + 1024 + 4 * (tid - 256)) = *(const f32x4*)(p.gla_bg + l * 256 + h * 64 + 4 * (tid - 256));
    __syncthreads();
    float bc[8], bl[8];
    gla_b(wl, cr, wave, lane, bc, bl);
    {
        const unsigned qq[4] = {qw.x, qw.y, qw.z, qw.w}, ww[4] = {kw.x, kw.y, kw.z, kw.w};
        unsigned qo[4], ko[4], lo4[4];
#pragma unroll
        for (int e = 0; e < 4; ++e) {
            lo4[e] = cvt_pk_bf16(bf_lo(ww[e]) * __expf(bl[2 * e] - bc[2 * e]), bf_hi(ww[e]) * __expf(bl[2 * e + 1] - bc[2 * e + 1]));
            const float e0 = __expf(bc[2 * e]), e1 = __expf(bc[2 * e + 1]);
            qo[e] = cvt_pk_bf16(bf_lo(qq[e]) * 0.125f * e0, bf_hi(qq[e]) * 0.125f * e1);
            ko[e] = cvt_pk_bf16(bf_lo(ww[e]) * fast_rcp(e0), bf_hi(ww[e]) * fast_rcp(e1));
        }
        *(u32x4*)(Kr + lane * GLK_LD + 8 * wave) = (u32x4){lo4[0], lo4[1], lo4[2], lo4[3]};
        *(u32x4*)((bf16_t*)(p.ws + WS_QD) + (size_t)item * 4096 + lane * 64 + 8 * wave) = (u32x4){qo[0], qo[1], qo[2], qo[3]};
        *(u32x4*)((bf16_t*)(p.ws + WS_KD) + (size_t)item * 4096 + lane * 64 + 8 * wave) = (u32x4){ko[0], ko[1], ko[2], ko[3]};
        if (lane == 63) { float* dec = (float*)(p.ws + WS_DEC) + (size_t)item * 64 + 8 * wave;
#pragma unroll
            for (int i = 0; i < 8; ++i) dec[i] = __expf(bl[i]); }
        bf16_t* vd = Vr + (tid >> 3) * GLV_LD + 16 * (tid & 7);
        *(u32x4*)vd = vpre.a; *(u32x4*)(vd + 8) = vpre.b;
    }
    __syncthreads();
    {
        f32x4 acc[4];
#pragma unroll
        for (int mb = 0; mb < 4; ++mb) acc[mb] = (f32x4){0.f, 0.f, 0.f, 0.f};
#pragma unroll
        for (int kk = 0; kk < 2; ++kk) {
            const int srow = 32 * kk + 8 * fq + (fr >> 2);
            const bf16_t* bp_ = Vr + srow * GLV_LD + 16 * wave + 4 * (fr & 3);
            const bf16x8 bfr = tr_operand(bp_, bp_ + 4 * GLV_LD);
#pragma unroll
            for (int mb = 0; mb < 4; ++mb) { const bf16_t* ap = Kr + srow * GLK_LD + 16 * mb + 4 * (fr & 3); acc[mb] = MFMA16(tr_operand(ap, ap + 4 * GLK_LD), bfr, acc[mb]); }
        }
        float* loct = (float*)(p.ws + WS_LOCT) + (size_t)item * 8192 + (16 * wave + fr) * 64 + 4 * fq;
#pragma unroll
        for (int mb = 0; mb < 4; ++mb) *(f32x4*)(loct + 16 * mb) = acc[mb];
    }
    __syncthreads();
}
__device__ __forceinline__ void gla_scan(const Params& p, int tid, int bx) {
    const float* loct = (const float*)(p.ws + WS_LOCT); const float* dec = (const float*)(p.ws + WS_DEC);
    bf16_t* ST = (bf16_t*)(p.ws + WS_ST);
    for (int e = bx * 512 + tid; e < 16 * 8192; e += gridDim.x * 512) {
        const int bh = e >> 13, r = e & 8191, dk = r & 63;
        float lo[32], de[32];
#pragma unroll
        for (int c = 0; c < 32; ++c) { const size_t it = (size_t)bh * 32 + c; lo[c] = loct[it * 8192 + r]; de[c] = dec[it * 64 + dk]; }
        float s = 0.f;
#pragma unroll
        for (int c = 0; c < 32; ++c) { const size_t it = (size_t)bh * 32 + c;
            ST[it * 8192 + r] = f2bf(s);
            s = s * de[c] + lo[c]; }
    }
}
constexpr int GO_LD = 72, GOV_LD = 136;
constexpr int GO_QD = 0, GO_KD = 64 * GO_LD, GO_ST = 2 * 64 * GO_LD, GO_VT = GO_ST + 128 * GO_LD, GO_IMG = GO_VT + 128 * GO_LD;
__device__ __forceinline__ void gla_out_pair(const Params& p, int l, int pit, unsigned char* lds, int tid, int wave, int lane) {
    const int bh2 = pit >> 5, c = pit & 31, h = bh2 & 3;
    const int fr = lane & 15, fq = lane >> 4;
    bf16_t* img = (bf16_t*)lds;
    float* red = (float*)(lds + 2 * GO_IMG * 2);
    const bf16_t* proj = (const bf16_t*)(p.ws + WS_PROJ);
    bf16_t* Y = (bf16_t*)(p.ws + WS_Y);
    const int tb = wave & 3, dh = wave >> 2, t = 16 * tb + fr;
    int item[2], tok[2];
    item[0] = bh2 * 32 + c; item[1] = (bh2 + 8) * 32 + c;
    tok[0] = (bh2 >> 2) * SEQ + c * 64 + t; tok[1] = ((bh2 >> 2) + 2) * SEQ + c * 64 + t;
    {
        const int r8 = tid >> 3, ch = (tid & 7) * 8;
        u32x4 cq[2], ck[2], cs[2][2], cv[2][2];
        const int tokb[2] = {(bh2 >> 2) * SEQ + c * 64, ((bh2 >> 2) + 2) * SEQ + c * 64};
#pragma unroll
        for (int q2 = 0; q2 < 2; ++q2) {
            cq[q2] = *(const u32x4*)((const bf16_t*)(p.ws + WS_QD) + (size_t)item[q2] * 4096 + r8 * 64 + ch);
            ck[q2] = *(const u32x4*)((const bf16_t*)(p.ws + WS_KD) + (size_t)item[q2] * 4096 + r8 * 64 + ch);
#pragma unroll
            for (int i = 0; i < 2; ++i) {
                cs[q2][i] = *(const u32x4*)((const bf16_t*)(p.ws + WS_ST) + (size_t)item[q2] * 8192 + (r8 + 64 * i) * 64 + ch);
                cv[q2][i] = *(const u32x4*)(proj + (size_t)(tokb[q2] + r8) * NPROJ + C_CV + h * 128 + ch + 64 * i);
            }
        }
#pragma unroll
        for (int q2 = 0; q2 < 2; ++q2) {
            bf16_t* im = img + q2 * GO_IMG;
            *(u32x4*)(im + GO_QD + r8 * GO_LD + ch) = cq[q2]; *(u32x4*)(im + GO_KD + r8 * GO_LD + ch) = ck[q2];
#pragma unroll
            for (int i = 0; i < 2; ++i) { *(u32x4*)(im + GO_ST + (r8 + 64 * i) * GO_LD + ch) = cs[q2][i]; *(u32x4*)(im + GO_VT + r8 * GOV_LD + ch + 64 * i) = cv[q2][i]; }
        }
    }
    u32x4 zf[2][2]; f32x4 gf[4];
#pragma unroll
    for (int mp = 0; mp < 2; ++mp) {
        const int dv = 64 * dh + 32 * mp + 8 * fq;
        gf[2 * mp] = *(const f32x4*)(p.gla_ng + l * 128 + dv); gf[2 * mp + 1] = *(const f32x4*)(p.gla_ng + l * 128 + dv + 4);
#pragma unroll
        for (int q2 = 0; q2 < 2; ++q2) zf[q2][mp] = *(const u32x4*)(proj + (size_t)tok[q2] * NPROJ + C_Z + 1536 + h * 128 + dv);
    }
    __syncthreads();
    f32x4 acc[2][4];
#pragma unroll
    for (int q2 = 0; q2 < 2; ++q2) {
        const bf16_t* im = img + q2 * GO_IMG;
        bf16x8 bq[2];
#pragma unroll
        for (int kk = 0; kk < 2; ++kk) bq[kk] = *(const bf16x8*)(im + GO_QD + t * GO_LD + 32 * kk + 8 * fq);
        f32x4 sc[4];
#pragma unroll
        for (int mb = 0; mb < 4; ++mb) {
            sc[mb] = (f32x4){0.f, 0.f, 0.f, 0.f};
            if (mb <= tb) {
#pragma unroll
                for (int kk = 0; kk < 2; ++kk) { const bf16x8 a = *(const bf16x8*)(im + GO_KD + (16 * mb + fr) * GO_LD + 32 * kk + 8 * fq); sc[mb] = MFMA16(a, bq[kk], sc[mb]); }
#pragma unroll
                for (int j = 0; j < 4; ++j) if (16 * mb + 4 * fq + j > t) sc[mb][j] = 0.f;
            }
        }
        bf16x8 bp[2];
#pragma unroll
        for (int k2 = 0; k2 < 2; ++k2)
            bp[k2] = __builtin_bit_cast(bf16x8, (u32x4){cvt_pk_bf16(sc[2 * k2][0], sc[2 * k2][1]), cvt_pk_bf16(sc[2 * k2][2], sc[2 * k2][3]),
                                                        cvt_pk_bf16(sc[2 * k2 + 1][0], sc[2 * k2 + 1][1]), cvt_pk_bf16(sc[2 * k2 + 1][2], sc[2 * k2 + 1][3])});
        float ssq = 0.f;
#pragma unroll
        for (int mb = 0; mb < 4; ++mb) {
            const int dvrow = 64 * dh + 32 * (mb >> 1) + 8 * (fr >> 2) + 4 * (mb & 1) + (fr & 3);
            acc[q2][mb] = (f32x4){0.f, 0.f, 0.f, 0.f};
#pragma unroll
            for (int k2 = 0; k2 < 2; ++k2) {
                const bf16_t* vp = im + GO_VT + (32 * k2 + 4 * fq + (fr >> 2)) * GOV_LD + 64 * dh + 32 * (mb >> 1) + 8 * (fr & 3) + 4 * (mb & 1);
                acc[q2][mb] = MFMA16(tr_operand(vp, vp + 16 * GOV_LD), bp[k2], acc[q2][mb]);
            }
#pragma unroll
            for (int kk = 0; kk < 2; ++kk) { const bf16x8 a = *(const bf16x8*)(im + GO_ST + dvrow * GO_LD + 32 * kk + 8 * fq); acc[q2][mb] = MFMA16(a, bq[kk], acc[q2][mb]); }
            ssq += (acc[q2][mb][0] * acc[q2][mb][0] + acc[q2][mb][1] * acc[q2][mb][1]) + (acc[q2][mb][2] * acc[q2][mb][2] + acc[q2][mb][3] * acc[q2][mb][3]);
        }
        ssq += __shfl_xor(ssq, 16); ssq += __shfl_xor(ssq, 32);
        if (fq == 0) red[(q2 * 2 + dh) * 64 + t] = ssq;
    }
    __syncthreads();
#pragma unroll
    for (int q2 = 0; q2 < 2; ++q2) {
        const float rstd = rsqrtf((red[(q2 * 2) * 64 + t] + red[(q2 * 2 + 1) * 64 + t]) * (1.f / 128.f) + EPS);
#pragma unroll
        for (int mp = 0; mp < 2; ++mp) {
            const int col = 1536 + h * 128 + 64 * dh + 32 * mp + 8 * fq;
            const u32x4 z = zf[q2][mp];
            const f32x4 a = acc[q2][2 * mp] * rstd * gf[2 * mp], b3 = acc[q2][2 * mp + 1] * rstd * gf[2 * mp + 1];
            u32x4 y; y.x = cvt_pk_bf16(a[0] * bf_lo(z.x), a[1] * bf_hi(z.x)); y.y = cvt_pk_bf16(a[2] * bf_lo(z.y), a[3] * bf_hi(z.y));
            y.z = cvt_pk_bf16(b3[0] * bf_lo(z.z), b3[1] * bf_hi(z.z)); y.w = cvt_pk_bf16(b3[2] * bf_lo(z.w), b3[3] * bf_hi(z.w));
            *(u32x4*)(Y + (size_t)tok[q2] * D + col) = y;
        }
    }
    __syncthreads();
}

#define XB_TMO      128
#define XB_XCNT(j)  (256  + 64 * (j))
#define XB_XSUB(j)  (1280 + 64 * (j))
#define XB_XGEN(j)  (2304 + 64 * (j))
#define XB_TOP      3328
#define XB_TOPGEN   3392
#define XCD_BAR_WORDS 3456
#define XB_SPIN_CAP (1u << 18)
__device__ __forceinline__ unsigned xb_ld(unsigned* p)              { return __hip_atomic_load(p, __ATOMIC_RELAXED, __HIP_MEMORY_SCOPE_AGENT); }
__device__ __forceinline__ unsigned xb_add(unsigned* p, unsigned v) { return __hip_atomic_fetch_add(p, v, __ATOMIC_RELAXED, __HIP_MEMORY_SCOPE_AGENT); }
__device__ __forceinline__ unsigned xb_xcc_id() { return (unsigned)__builtin_amdgcn_s_getreg((3 << 11) | 20) & 0xFu; }
#define XB_SPIN(cond, bar) do { unsigned _sp = 0; while (cond) { __builtin_amdgcn_s_sleep(1); \
    if ((++_sp & 255u) == 0u) { if (xb_ld(&(bar)[XB_TMO])) break; if (_sp > XB_SPIN_CAP) { atomicAdd(&(bar)[XB_TMO], 1u); break; } } } } while (0)
__device__ __forceinline__ void xcd_barrier_complete(unsigned* bar, unsigned x, unsigned& nloc, unsigned& nx) {
    const unsigned G = gridDim.x * gridDim.y * gridDim.z;
    unsigned sum, cnt, mine, sp = 0u;
    for (;;) {
        sum = 0u; cnt = 0u; mine = 0u;
#pragma unroll
        for (unsigned j = 0; j < 16; ++j) { const unsigned c = xb_ld(&bar[XB_XCNT(j)]); sum += c; cnt += (c > 0u) ? 1u : 0u; mine = (j == x) ? c : mine; }
        if (sum == G) break;
        __builtin_amdgcn_s_sleep(1);
        if ((++sp & 255u) == 0u) { if (xb_ld(&bar[XB_TMO])) break; if (sp > XB_SPIN_CAP) { atomicAdd(&bar[XB_TMO], 1u); break; } }
    }
    nloc = mine > 0u ? mine : 1u; nx = cnt > 0u ? cnt : 1u;
}
__device__ __forceinline__ void xcd_barrier(unsigned* bar, volatile LAS unsigned* st) {
    asm volatile("s_waitcnt vmcnt(0)" ::: "memory");
    __syncthreads();
    if (threadIdx.x == 0) {
        __builtin_amdgcn_s_waitcnt(0);
        const unsigned x = xb_xcc_id();
        unsigned nloc = st[0], nx = st[1];
        if (nloc == 0u) { xcd_barrier_complete(bar, x, nloc, nx); st[0] = nloc; st[1] = nx; }
        const unsigned old = xb_add(&bar[XB_XSUB(x)], 1u);
        const unsigned gen = old / nloc;
        if (old + 1u == (gen + 1u) * nloc) {
            __builtin_amdgcn_fence(__ATOMIC_RELEASE, "agent");
            asm volatile("s_waitcnt vmcnt(0)" ::: "memory");
            const unsigned og = xb_add(&bar[XB_TOP], 1u);
            const unsigned tg = og / nx;
            if (og + 1u == (tg + 1u) * nx) xb_add(&bar[XB_TOPGEN], 1u);
            else XB_SPIN(xb_ld(&bar[XB_TOPGEN]) == tg, bar);
            __builtin_amdgcn_fence(__ATOMIC_ACQUIRE, "agent");
            xb_add(&bar[XB_XGEN(x)], 1u);
            asm volatile("s_waitcnt vmcnt(0)" ::: "memory");
        } else {
            XB_SPIN(xb_ld(&bar[XB_XGEN(x)]) == gen, bar);
            __builtin_amdgcn_fence(__ATOMIC_ACQUIRE, "agent");
            asm volatile("s_waitcnt vmcnt(0)" ::: "memory");
        }
    }
    __syncthreads();
}

constexpr int N_PHASES = 14;
__global__ void __launch_bounds__(512, 2) fwd_kernel(Params p) {
    extern __shared__ __attribute__((aligned(16))) unsigned char lds[];
    const int G = gridDim.x;
    const int lo = p.ph_lo, hi = p.ph_hi;
    unsigned* const xbar = (unsigned*)(p.ws + WS_BAR);
    volatile LAS unsigned* const xst = (volatile LAS unsigned*)((LAS unsigned char*)lds + 131072 + 64);
    if (threadIdx.x < 2) xst[threadIdx.x] = 0u;
    __syncthreads();
    if (lo < 0) cg::this_grid().sync();
    if (hi - lo > 1 && threadIdx.x == 0) (void)xb_add(&xbar[XB_XCNT(xb_xcc_id())], 1u);
#ifndef PHMASK
#define PHMASK 0xffff
#endif
#define IN(k) (((PHMASK >> ((k) < 2 ? (k) : 2 + ((k) - 2) % 6)) & 1) && lo <= (k) && (k) < hi)
#define SEAM(k) do { STAMP(2 * (k)); if (IN(k) && IN((k) + 1)) { xcd_barrier(xbar, xst); } STAMP(2 * (k) + 1); } while (0)
#define FRESH() int tid = threadIdx.x; asm volatile("" : "+v"(tid)); int bx = blockIdx.x; asm volatile("" : "+s"(bx)); \
    const int lane = tid & 63, wave = __builtin_amdgcn_readfirstlane(tid >> 6); \
    const Params q = fresh_params(p); (void)lane; (void)wave; (void)bx;
    unsigned long long tacc = 0ull, tprev = (PMASK != 0ull) ? __builtin_amdgcn_s_memrealtime() : 0ull;
#define STAMP(idx) do { if (PMASK != 0ull) { const unsigned long long now_ = __builtin_amdgcn_s_memrealtime(); if ((PMASK >> (idx)) & 1ull) tacc += now_ - tprev; tprev = now_; } } while (0)
    if (IN(0)) for (int rep = 0; rep < REPN(0); ++rep) { FRESH(); mod_items(q, 0, lds, tid, wave, lane, bx); __syncthreads(); p0_transposes(q, lds, wave, lane, bx, 0); }
    SEAM(0);
    if (IN(1)) for (int rep = 0; rep < REPN(1); ++rep) { FRESH(); mod_items(q, 1, lds, tid, wave, lane, bx); __syncthreads(); STAMP(32); p0_convert(q, lds, tid, wave, lane, bx); STAMP(33); row_pass(q, 0, wave, lane, bx); }
    SEAM(1);
#pragma unroll 1
    for (int l = 0; l < 2; ++l) {
        const int pb = 2 + 6 * l;
        if (IN(pb)) for (int rep = 0; rep < REPN(2); ++rep) {
            FRESH();
            pg8::Gemm g{(const bf16_t*)(q.ws + WS_H), (const bf16_t*)(q.ws + WS_WIN + (size_t)l * WIN_BYTES), M, NPAD, D};
            pg8::StaticOrder S; S.init(M, NPAD, G, bx);
            pg8::EpiProj E{(bf16_t*)(q.ws + WS_PROJ), (float*)(q.ws + WS_CG), (float*)(q.ws + WS_SGST)};
            pg8::gemm_phase<pg8::EpiProj, pg8::StaticOrder, true, true>((LAS unsigned char*)lds, g, S, E, tid);
        }
        SEAM(pb);
        if (IN(pb + 1)) for (int rep = 0; rep < REPN(3); ++rep) {
#ifndef MIXMASK
#define MIXMASK 7
#endif
            for (int rr = 0; rr < ((MIXR >> 0) & 15); ++rr) { FRESH(); for (int it = bx; it < 256; it += G) attn_item(q, l, it, lds, tid, wave, lane); }
            STAMP(36 + 4 * l); for (int rr = 0; rr < ((MIXR >> 4) & 15); ++rr) { FRESH(); for (int it = bx; it < 256; it += G) sg_pair_item(q, l, it, lds, tid, wave, lane); } STAMP(37 + 4 * l);
            for (int rr = 0; rr < ((MIXR >> 8) & 15); ++rr) { FRESH(); for (int it = bx; it < 512; it += G) gla_local_item(q, l, it, lds, tid, wave, lane); }
        }
        SEAM(pb + 1);
        if (IN(pb + 2)) for (int rep = 0; rep < REPN(4); ++rep) { FRESH(); gla_scan(q, tid, bx); }
        SEAM(pb + 2);
        if (IN(pb + 3)) for (int rep = 0; rep < REPN(5); ++rep) { FRESH(); for (int it = bx; it < 256; it += G) gla_out_pair(q, l, it, lds, tid, wave, lane); }
        SEAM(pb + 3);
        if (IN(pb + 4)) for (int rep = 0; rep < REPN(6); ++rep) {
            FRESH();
            pg8::Gemm g{(const bf16_t*)(q.ws + WS_Y), (const bf16_t*)(q.ws + WS_WOUT + (size_t)l * WOUT_BYTES), M, D, D};
            pg8::StaticOrder S; S.init(M, D, G, bx);
            pg8::EpiOut E{(bf16_t*)(q.ws + WS_OUT)};
            pg8::gemm_phase<pg8::EpiOut, pg8::StaticOrder, true, true>((LAS unsigned char*)lds, g, S, E, tid);
        }
        SEAM(pb + 4);
        if (IN(pb + 5)) { FRESH(); row_pass(q, l + 1, wave, lane, bx); }
        if (l == 0) SEAM(pb + 5);
    }
    STAMP(26);
    if (PMASK != 0ull) { if (blockIdx.x == 0 && threadIdx.x == 0) { const unsigned long long t0 = __builtin_amdgcn_s_memrealtime(); while (__builtin_amdgcn_s_memrealtime() - t0 < tacc) __builtin_amdgcn_s_sleep(8); } }
#undef IN
#undef SEAM
#undef FRESH
}

extern "C" void kernel_launch(void* const* d_in, const int* in_sizes, int n_in, void* d_out, int out_size, void* d_ws, size_t ws_size, hipStream_t stream) {
    static int grid = 0;
    if (grid == 0) {
        if (n_in != 17 || in_sizes[0] != M * D || out_size != M * D || ws_size < WS_END) { fprintf(stderr, "kernel_launch: unexpected shapes (n_in %d, in0 %d, out %d, ws %zu)\n", n_in, n_in > 0 ? in_sizes[0] : -1, out_size, ws_size); grid = -1; return; }
        int dev = 0, cus = 0, per_cu = 0;
        if (hipGetDevice(&dev) != hipSuccess || hipDeviceGetAttribute(&cus, hipDeviceAttributeMultiprocessorCount, dev) != hipSuccess) { grid = -1; return; }
        if (hipFuncSetAttribute((const void*)fwd_kernel, hipFuncAttributeMaxDynamicSharedMemorySize, LDS_BYTES) != hipSuccess) { fprintf(stderr, "kernel_launch: hipFuncSetAttribute failed\n"); grid = -1; return; }
        if (hipOccupancyMaxActiveBlocksPerMultiprocessor(&per_cu, (const void*)fwd_kernel, 512, LDS_BYTES) != hipSuccess || per_cu < 1) { fprintf(stderr, "kernel_launch: occupancy query says %d blocks per CU\n", per_cu); per_cu = 1; }
        (void)hipGetLastError();
        grid = cus;
    }
    if (grid < 0) return;
    Params p{};
    p.x = (const float*)d_in[0]; p.c = (const float*)d_in[1]; p.pos = (const int*)d_in[2]; p.w_mod = (const float*)d_in[3]; p.b_mod = (const float*)d_in[4];
    p.g_pre = (const float*)d_in[5]; p.g_post = (const float*)d_in[6]; p.w_in = (const float*)d_in[7]; p.w_out = (const float*)d_in[8]; p.sinks = (const float*)d_in[9];
    p.sg_w = (const float*)d_in[10]; p.sg_b = (const float*)d_in[11]; p.sg_ln_g = (const float*)d_in[12]; p.sg_ln_b = (const float*)d_in[13];
    p.gla_wup = (const float*)d_in[14]; p.gla_bg = (const float*)d_in[15]; p.gla_ng = (const float*)d_in[16];
    p.out = (float*)d_out; p.ws = (unsigned char*)d_ws;
#if MK_SINGLE
    if (hipMemsetAsync((char*)d_ws + WS_BAR, 0, XCD_BAR_WORDS * 4, stream) != hipSuccess) { fprintf(stderr, "kernel_launch: memset failed\n"); return; }
    p.ph_lo = 0; p.ph_hi = N_PHASES;
    void* args[] = {&p};
    hipError_t e = hipLaunchCooperativeKernel((const void*)fwd_kernel, dim3(grid), dim3(512), args, LDS_BYTES, stream);
    if (e != hipSuccess) fprintf(stderr, "kernel_launch: cooperative launch failed: %s (grid %d)\n", hipGetErrorString(e), grid);
#else
    for (int ph = 0; ph < N_PHASES; ++ph) {
        p.ph_lo = ph; p.ph_hi = ph + 1;
        hipLaunchKernelGGL(fwd_kernel, dim3(grid), dim3(512), LDS_BYTES, stream, p);
    }
#endif
}
```

```cpp
#include <hip/hip_runtime.h>
#include <hip/hip_cooperative_groups.h>
#include <cstdio>
#include <cstdint>
namespace cg = cooperative_groups;

#ifndef REPS
#define REPS 0x11111111
#endif
#define REPN(k) ((REPS >> (4 * (k))) & 15)
#ifndef PMASK
#define PMASK 0ull
#endif
#ifndef MIXR
#define MIXR 0x111
#endif
#ifndef MK_SINGLE
#define MK_SINGLE 1
#endif

#define LAS __attribute__((address_space(3)))
typedef unsigned short bf16_t;
typedef short bf16x8 __attribute__((ext_vector_type(8)));
typedef float f32x4 __attribute__((ext_vector_type(4)));
typedef float f32x2 __attribute__((ext_vector_type(2)));
typedef unsigned u32x4 __attribute__((ext_vector_type(4)));
typedef unsigned u32x2 __attribute__((ext_vector_type(2)));

constexpr int D = 2048, NB = 4, SEQ = 2048, M = NB * SEQ;
constexpr int NPROJ = 5632;
constexpr int NPAD = 5888;
constexpr int WIN_LD = 5648;
constexpr float EPS = 1e-6f;
constexpr int C_AQ = 0, C_AK = 1024, C_AV = 1280, C_SU = 1536, C_SV = 2048, C_CQ = 2560, C_CK = 2816, C_CV = 3072, C_Z = 3584;
constexpr float LOG2E = 1.4426950408889634f;

constexpr size_t MiB = 1u << 20;
constexpr size_t WS_WIN = 0, WIN_BYTES = (size_t)NPAD * D * 2;
constexpr size_t WS_WOUT = 46 * MiB, WOUT_BYTES = (size_t)D * D * 2;
constexpr size_t WS_H = 62 * MiB, WS_PROJ = 94 * MiB, WS_CG = 182 * MiB, WS_MOD = 183 * MiB, WS_Y = 184 * MiB, WS_OUT = 216 * MiB;
constexpr size_t WS_LOCT = 248 * MiB, WS_ST = 264 * MiB, WS_DEC = 272 * MiB, WS_BAR = 273 * MiB, WS_QD = 274 * MiB, WS_KD = 278 * MiB, WS_VTG = 282 * MiB, WS_X1B = 290 * MiB, WS_SGST = 322 * MiB, WS_SGW = 323 * MiB, WS_END = 324 * MiB;

constexpr int LDS_BYTES = 135168;

struct Params {
    const float* x; const float* c; const int* pos; const float* w_mod; const float* b_mod; const float* g_pre; const float* g_post;
    const float* w_in; const float* w_out; const float* sinks; const float* sg_w; const float* sg_b; const float* sg_ln_g; const float* sg_ln_b;
    const float* gla_wup; const float* gla_bg; const float* gla_ng;
    float* out; unsigned char* ws; int ph_lo, ph_hi;
};

__device__ __forceinline__ Params fresh_params(const Params& p) {
#if defined(__HIP_DEVICE_COMPILE__)
    typedef unsigned long long u64;
    const __attribute__((address_space(4))) u64* pp = (const __attribute__((address_space(4))) u64*)__builtin_amdgcn_kernarg_segment_ptr();
    asm volatile("" : "+s"(pp));
    Params q; u64* dst = (u64*)&q;
#pragma unroll
    for (int i = 0; i < (int)(sizeof(Params) / 8); ++i) dst[i] = pp[i];
    return q;
#else
    return p;
#endif
}
static_assert(sizeof(Params) % 8 == 0, "Params is copied in 8-byte words");

typedef __bf16 bf16x2_t __attribute__((ext_vector_type(2)));
__device__ __forceinline__ unsigned cvt_pk_bf16(float lo, float hi) { const f32x2 v = {lo, hi}; const bf16x2_t b = __builtin_convertvector(v, bf16x2_t); return __builtin_bit_cast(unsigned, b); }
__device__ __forceinline__ float bf_lo(unsigned u) { return __builtin_bit_cast(float, u << 16); }
__device__ __forceinline__ float bf_hi(unsigned u) { return __builtin_bit_cast(float, u & 0xffff0000u); }
__device__ __forceinline__ float bf1(bf16_t v) { return __builtin_bit_cast(float, (unsigned)v << 16); }
__device__ __forceinline__ bf16_t f2bf(float f) { return (bf16_t)(cvt_pk_bf16(f, 0.f) & 0xffffu); }
__device__ __forceinline__ float fast_exp2(float x) { return __builtin_amdgcn_exp2f(x); }
__device__ __forceinline__ float fast_rcp(float x) { return __builtin_amdgcn_rcpf(x); }
__device__ __forceinline__ float silu_f(float x) { return x * fast_rcp(1.f + fast_exp2(-x * LOG2E)); }
__device__ __forceinline__ float gelu_tanh_f(float x) { const float u = 0.7978845608028654f * (x + 0.044715f * x * x * x); return x * fast_rcp(1.f + fast_exp2(-2.f * LOG2E * u)); }
__device__ __forceinline__ float wave_sum(float v) {
#pragma unroll
    for (int o = 1; o < 64; o <<= 1) v += __shfl_xor(v, o);
    return v;
}

typedef short v4i16_t __attribute__((ext_vector_type(4)));
__device__ __forceinline__ bf16x8 tr_operand(const void* p0, const void* p1) {
    const v4i16_t a = __builtin_amdgcn_ds_read_tr16_b64_v4i16((__attribute__((address_space(3))) v4i16_t*)p0);
    const v4i16_t b = __builtin_amdgcn_ds_read_tr16_b64_v4i16((__attribute__((address_space(3))) v4i16_t*)p1);
    return __builtin_shufflevector(a, b, 0, 1, 2, 3, 4, 5, 6, 7);
}
#define MFMA16(a, b, c) __builtin_amdgcn_mfma_f32_16x16x32_bf16((a), (b), (c), 0, 0, 0)

namespace pg8 {
#define PG8_LAS __attribute__((address_space(3)))
constexpr int BM = 256, BK = 64, HALF = 128, HTB = HALF * BK * 2, STAGE_BYTES = 8 * HTB, NXCD = 8, WGM = 8;
__host__ __device__ __forceinline__ int lds_byte(int r, int c) { const int st = (r >> 4) * 2 + (c >> 5), rr = r & 15, cc = c & 31, ob = rr * 64 + cc * 2; return st * 1024 + (ob ^ (((ob >> 9) & 1) << 5)); }
__host__ __device__ __forceinline__ void stage_rc(int b, int& R, int& C) { const int st = b / 1024, sb = b % 1024, swz = sb ^ (((sb >> 9) & 1) << 5); R = (st >> 1) * 16 + swz / 64; C = (st & 1) * 32 + (swz % 64) / 2; }
__host__ __device__ __forceinline__ int perm32(int rho) { const int n = rho >> 4, i = rho & 15; return 8 * (i >> 2) + 4 * n + (i & 3); }
struct Unit { int pm, pn; };
struct Gemm { const bf16_t* A; const bf16_t* Bt; int M, N, K; };
struct StaticOrder {
    int nM, nN, nwg, G, c;
    __host__ __device__ void init(int M_, int N_, int G_, int c_) { nM = M_ / BM; nN = N_ / BM; nwg = nM * nN; G = G_; c = c_; }
    __host__ __device__ bool next(int i, Unit& u) const {
        const long L = (long)i * G + c; if (L >= nwg) return false;
        int wgid = (int)L; { const int q = nwg / NXCD, r = nwg % NXCD, xcd = wgid % NXCD, off = wgid / NXCD; wgid = (xcd < r ? xcd * (q + 1) : r * (q + 1) + (xcd - r) * q) + off; }
        const int nig = WGM * nN, gid = wgid / nig, fm = gid * WGM, gsz = (nM - fm) < WGM ? (nM - fm) : WGM;
        u.pm = fm + ((wgid % nig) % gsz); u.pn = (wgid % nig) / gsz; return true;
    }
    __device__ __forceinline__ void a_ready(const Unit&) const {}
    __device__ __forceinline__ void done(const Unit&) const {}
};

template <class Epi, class Sched, bool ALIGN_EPI = false, bool SP2 = false>
__device__ __forceinline__ void gemm_phase(PG8_LAS unsigned char* lds, const Gemm g, const Sched& S, const Epi& E, const int tid) {
    const int wid = __builtin_amdgcn_readfirstlane(tid >> 6), lane = tid & 63, wr = wid >> 2, wc = wid & 3, fr = lane & 15, fq = lane >> 4;
    const int K = g.K, nt = K / BK;
    unsigned voffA[2], voffB[2];
#pragma unroll
    for (int i = 0; i < 2; ++i) { int R, C; stage_rc(tid * 16 + i * 8192, R, C); const int Rb = Epi::PERM ? ((R & ~31) + perm32(R & 31)) : R;
        voffA[i] = (unsigned)(R * K + C) * 2u; voffB[i] = (unsigned)(Rb * K + C) * 2u; }
    const size_t kstep = (size_t)(BK * 2);
    const size_t hstep = (size_t)HALF * K * 2;
    const size_t tstep = 2 * hstep;
    const unsigned ldsw = (unsigned)wid * 1024u;
    const int aoff = lds_byte(wr * 64 + fr, fq * 8), boff = lds_byte(wc * 32 + fr, fq * 8);
#define PG8_SA(b, h) (((b) * 2 + (h)) * HTB)
#define PG8_SB(b, h) ((4 + (b) * 2 + (h)) * HTB)
#define PG8_STAGE(bufoff, gbase, voff) do { _Pragma("unroll") for (int _i = 0; _i < 2; ++_i) \
        __builtin_amdgcn_global_load_lds((const unsigned*)((const char*)(gbase) + (voff)[_i]), (PG8_LAS unsigned*)(lds + (bufoff) + ldsw + _i * 8192), 16, 0, 0); } while (0)
#define PG8_LDA(dst, b, h) do { _Pragma("unroll") for (int m = 0; m < 4; ++m) _Pragma("unroll") for (int k = 0; k < 2; ++k) dst[m][k] = *(const PG8_LAS bf16x8*)(lds + PG8_SA(b, h) + aoff + m * 2048 + k * 1024); } while (0)
#define PG8_LDB(dst, b, h) do { _Pragma("unroll") for (int n = 0; n < 2; ++n) _Pragma("unroll") for (int k = 0; k < 2; ++k) dst[n][k] = *(const PG8_LAS bf16x8*)(lds + PG8_SB(b, h) + boff + n * 2048 + k * 1024); } while (0)
#define PG8_MMA(ai, bj, At, Bt) do { __builtin_amdgcn_s_setprio(1); _Pragma("unroll") for (int m = 0; m < 4; ++m) _Pragma("unroll") for (int n = 0; n < 2; ++n) _Pragma("unroll") for (int k = 0; k < 2; ++k) \
        acc[ai][bj][m][n] = __builtin_amdgcn_mfma_f32_16x16x32_bf16(Bt[n][k], At[m][k], acc[ai][bj][m][n], 0, 0, 0); __builtin_amdgcn_s_setprio(0); } while (0)
#define PG8_WAIT_V(n) asm volatile("s_waitcnt vmcnt(" #n ")" ::: "memory")
#define PG8_WAIT_L(n) asm volatile("s_waitcnt lgkmcnt(" #n ")" ::: "memory")
#define PG8_BAR __builtin_amdgcn_s_barrier()
#define PG8_SCHED __builtin_amdgcn_sched_barrier(0)
    Unit cur, nxt; int ui = 0;
    if (!S.next(0, cur)) return;
    f32x4 acc[2][2][4][2];
#pragma unroll
    for (int a = 0; a < 2; ++a)
#pragma unroll
        for (int b = 0; b < 2; ++b)
#pragma unroll
            for (int m = 0; m < 4; ++m)
#pragma unroll
                for (int n = 0; n < 2; ++n) acc[a][b][m][n] = (f32x4){0.f, 0.f, 0.f, 0.f};
    bf16x8 At[4][2], B0[2][2], B1[2][2];
    const char* cA = (const char*)g.A + (size_t)cur.pm * tstep; const char* cB = (const char*)g.Bt + (size_t)cur.pn * tstep;
    S.a_ready(cur);
    if constexpr (SP2) {
        PG8_STAGE(PG8_SB(0, 0), cB, voffB); PG8_STAGE(PG8_SB(0, 1), cB + hstep, voffB); PG8_STAGE(PG8_SA(0, 0), cA, voffA); PG8_STAGE(PG8_SA(0, 1), cA + hstep, voffA);
        if (wr == 1) PG8_BAR;
        PG8_WAIT_V(2); PG8_BAR;
        PG8_STAGE(PG8_SB(1, 0), cB + kstep, voffB); PG8_STAGE(PG8_SA(1, 0), cA + kstep, voffA); PG8_STAGE(PG8_SB(1, 1), cB + hstep + kstep, voffB);
        PG8_WAIT_V(6); PG8_BAR;
    } else {
        PG8_STAGE(PG8_SB(0, 0), cB, voffB); PG8_STAGE(PG8_SA(0, 0), cA, voffA); PG8_STAGE(PG8_SB(0, 1), cB + hstep, voffB); PG8_STAGE(PG8_SA(0, 1), cA + hstep, voffA);
        if (wr == 1) PG8_BAR;
        PG8_WAIT_V(4); PG8_BAR;
        PG8_STAGE(PG8_SB(1, 0), cB + kstep, voffB); PG8_STAGE(PG8_SA(1, 0), cA + kstep, voffA); PG8_STAGE(PG8_SB(1, 1), cB + hstep + kstep, voffB);
        PG8_WAIT_V(6); PG8_BAR;
    }
    for (;;) {
        const bool has_next = S.next(ui + 1, nxt);
        const char* nA = has_next ? (const char*)g.A + (size_t)nxt.pm * tstep : cA; const char* nB = has_next ? (const char*)g.Bt + (size_t)nxt.pn * tstep : cB;
        for (int t = 0; t < nt; t += 2) {
            const bool last = (t == nt - 2);
            const char* a1 = cA + (size_t)(t + 1) * kstep;
            const char* a2 = last ? nA : cA + (size_t)(t + 2) * kstep; const char* b2 = last ? nB : cB + (size_t)(t + 2) * kstep;
            const char* a3 = a2 + kstep; const char* b3 = b2 + kstep;
            if (last && has_next) S.a_ready(nxt);
            if constexpr (SP2) {
            PG8_LDB(B0, 0, 0); PG8_LDB(B1, 0, 1); PG8_SCHED; PG8_LDA(At, 0, 0); PG8_STAGE(PG8_SA(1, 1), a1 + hstep, voffA);
            PG8_WAIT_V(8); PG8_WAIT_L(0); PG8_BAR; PG8_MMA(0, 0, At, B0); PG8_MMA(0, 1, At, B1); PG8_BAR; PG8_SCHED;
            PG8_LDA(At, 0, 1); PG8_STAGE(PG8_SB(0, 0), b2, voffB); PG8_STAGE(PG8_SB(0, 1), b2 + hstep, voffB); PG8_STAGE(PG8_SA(0, 0), a2, voffA);
            PG8_WAIT_V(8); PG8_WAIT_L(0); PG8_BAR; PG8_MMA(1, 0, At, B0); PG8_MMA(1, 1, At, B1); PG8_BAR; PG8_SCHED;
            PG8_LDB(B0, 1, 0); PG8_LDB(B1, 1, 1); PG8_SCHED; PG8_LDA(At, 1, 0); PG8_STAGE(PG8_SA(0, 1), a2 + hstep, voffA);
            PG8_WAIT_V(8); PG8_WAIT_L(0); PG8_BAR; PG8_MMA(0, 0, At, B0); PG8_MMA(0, 1, At, B1); PG8_BAR; PG8_SCHED;
            PG8_LDA(At, 1, 1); PG8_STAGE(PG8_SB(1, 0), b3, voffB); PG8_STAGE(PG8_SB(1, 1), b3 + hstep, voffB); PG8_STAGE(PG8_SA(1, 0), a3, voffA);
            PG8_WAIT_V(8); PG8_WAIT_L(0); PG8_BAR; PG8_MMA(1, 0, At, B0); PG8_MMA(1, 1, At, B1); PG8_BAR; PG8_SCHED;
            } else {
            PG8_LDB(B0, 0, 0); PG8_SCHED; PG8_LDA(At, 0, 0); PG8_STAGE(PG8_SA(1, 1), a1 + hstep, voffA);
            PG8_WAIT_L(8); PG8_BAR; PG8_WAIT_L(0); PG8_MMA(0, 0, At, B0); PG8_BAR; PG8_SCHED;
            PG8_LDB(B1, 0, 1); PG8_STAGE(PG8_SB(0, 0), b2, voffB);
            PG8_BAR; PG8_WAIT_L(0); PG8_MMA(0, 1, At, B1); PG8_BAR;
            PG8_LDA(At, 0, 1); PG8_STAGE(PG8_SA(0, 0), a2, voffA);
            PG8_BAR; PG8_WAIT_L(0); PG8_MMA(1, 0, At, B0); PG8_BAR; PG8_SCHED;
            PG8_STAGE(PG8_SB(0, 1), b2 + hstep, voffB);
            PG8_WAIT_V(6); PG8_BAR; PG8_MMA(1, 1, At, B1); PG8_BAR;
            PG8_LDB(B0, 1, 0); PG8_SCHED; PG8_LDA(At, 1, 0); PG8_STAGE(PG8_SA(0, 1), a2 + hstep, voffA);
            PG8_WAIT_L(8); PG8_BAR; PG8_WAIT_L(0); PG8_MMA(0, 0, At, B0); PG8_BAR; PG8_SCHED;
            PG8_LDB(B1, 1, 1); PG8_STAGE(PG8_SB(1, 0), b3, voffB);
            PG8_BAR; PG8_WAIT_L(0); PG8_MMA(0, 1, At, B1); PG8_BAR;
            PG8_LDA(At, 1, 1); PG8_STAGE(PG8_SA(1, 0), a3, voffA);
            PG8_BAR; PG8_WAIT_L(0); PG8_MMA(1, 0, At, B0); PG8_BAR; PG8_SCHED;
            PG8_STAGE(PG8_SB(1, 1), b3 + hstep, voffB);
            PG8_WAIT_V(6); PG8_BAR; PG8_MMA(1, 1, At, B1); PG8_BAR;
            }
        }
        if constexpr (ALIGN_EPI) { if (wr == 0) PG8_BAR; }
        E(acc, cur, wr, wc, fr, fq); S.done(cur);
        if (!has_next) break;
#pragma unroll
        for (int a = 0; a < 2; ++a)
#pragma unroll
            for (int b = 0; b < 2; ++b)
#pragma unroll
                for (int m = 0; m < 4; ++m)
#pragma unroll
                    for (int n = 0; n < 2; ++n) acc[a][b][m][n] = (f32x4){0.f, 0.f, 0.f, 0.f};
        cur = nxt; cA = nA; cB = nB; ++ui;
        if constexpr (ALIGN_EPI) { if (wr == 1) PG8_BAR; }
    }
    PG8_WAIT_V(0);
    if constexpr (!ALIGN_EPI) { if (wr == 0) PG8_BAR; }
    PG8_BAR;
#undef PG8_SA
#undef PG8_SB
#undef PG8_STAGE
#undef PG8_LDA
#undef PG8_LDB
#undef PG8_MMA
#undef PG8_WAIT_V
#undef PG8_WAIT_L
#undef PG8_BAR
#undef PG8_SCHED
}

struct EpiProj {
    static constexpr bool PERM = true;
    bf16_t* P; float* CG; float* SGST;
    template <int ACT> __device__ __forceinline__ void store_tile(const f32x4 (&acc)[2][2][4][2], bf16_t* base, float* stp, int fq) const {
#pragma unroll
        for (int ai = 0; ai < 2; ++ai)
#pragma unroll
            for (int m = 0; m < 4; ++m) { bf16_t* rowp = base + (size_t)(ai * HALF + m * 16) * NPROJ;
                float rs = 0.f, rq = 0.f;
#pragma unroll
                for (int bj = 0; bj < 2; ++bj) { f32x4 v0 = acc[ai][bj][m][0], v1 = acc[ai][bj][m][1];
                    if (ACT == 1) { for (int e = 0; e < 4; ++e) { v0[e] = gelu_tanh_f(v0[e]); v1[e] = gelu_tanh_f(v1[e]); } }
                    if (ACT == 2) { for (int e = 0; e < 4; ++e) { v0[e] = silu_f(v0[e]); v1[e] = silu_f(v1[e]); } }
                    if (ACT == 1) { rs += ((v0[0] + v0[1]) + (v0[2] + v0[3])) + ((v1[0] + v1[1]) + (v1[2] + v1[3]));
                        rq += ((v0[0] * v0[0] + v0[1] * v0[1]) + (v0[2] * v0[2] + v0[3] * v0[3])) + ((v1[0] * v1[0] + v1[1] * v1[1]) + (v1[2] * v1[2] + v1[3] * v1[3])); }
                    u32x4 w; w.x = cvt_pk_bf16(v0[0], v0[1]); w.y = cvt_pk_bf16(v0[2], v0[3]); w.z = cvt_pk_bf16(v1[0], v1[1]); w.w = cvt_pk_bf16(v1[2], v1[3]);
                    *(u32x4*)(rowp + bj * HALF) = w; }
                if (ACT == 1) { if (stp) { rs += __shfl_xor(rs, 16); rs += __shfl_xor(rs, 32); rq += __shfl_xor(rq, 16); rq += __shfl_xor(rq, 32);
                    if (fq == 0) *(f32x2*)(stp + (size_t)(ai * HALF + m * 16) * 16) = (f32x2){rs, rq}; } } }
    }
    __device__ __forceinline__ void operator()(const f32x4 (&acc)[2][2][4][2], const Unit& u, int wr, int wc, int fr, int fq) const {
        const int row0 = u.pm * BM + wr * 64 + fr;
        if (u.pn < 22) {
            bf16_t* base = P + (size_t)row0 * NPROJ + u.pn * BM + wc * 32 + 8 * fq;
            if (u.pn >= 6 && u.pn < 10) store_tile<1>(acc, base, (u.pn >= 8) ? SGST + (size_t)row0 * 16 + ((u.pn - 8) * 4 + wc) * 2 : nullptr, fq);
            else if (u.pn >= 14) store_tile<2>(acc, base, nullptr, fq);
            else store_tile<0>(acc, base, nullptr, fq);
        } else if (wc == 0 && fq < 2) {
#pragma unroll
            for (int ai = 0; ai < 2; ++ai)
#pragma unroll
                for (int m = 0; m < 4; ++m) { float* p = CG + (size_t)(row0 + ai * HALF + m * 16) * 16 + 8 * fq;
                    *(f32x4*)p = acc[ai][0][m][0]; *(f32x4*)(p + 4) = acc[ai][0][m][1]; }
        }
    }
};
struct EpiOut {
    static constexpr bool PERM = true;
    bf16_t* O;
    __device__ __forceinline__ void operator()(const f32x4 (&acc)[2][2][4][2], const Unit& u, int wr, int wc, int fr, int fq) const {
        bf16_t* base = O + (size_t)(u.pm * BM + wr * 64 + fr) * D + u.pn * BM + wc * 32 + 8 * fq;
#pragma unroll
        for (int ai = 0; ai < 2; ++ai)
#pragma unroll
            for (int m = 0; m < 4; ++m) { bf16_t* rowp = base + (size_t)(ai * HALF + m * 16) * D;
#pragma unroll
                for (int bj = 0; bj < 2; ++bj) { const f32x4 v0 = acc[ai][bj][m][0], v1 = acc[ai][bj][m][1];
                    u32x4 w; w.x = cvt_pk_bf16(v0[0], v0[1]); w.y = cvt_pk_bf16(v0[2], v0[3]); w.z = cvt_pk_bf16(v1[0], v1[1]); w.w = cvt_pk_bf16(v1[2], v1[3]);
                    *(u32x4*)(rowp + bj * HALF) = w; } }
    }
};
}

__device__ __forceinline__ void p0_transpose_item(const float* W, int ldw, int n_src0, bf16_t* WT, int row_dst0, int kb, float* scr, int lane) {
    const int k0 = 64 * kb;
    {   const int kr = lane >> 3, c4 = 4 * (lane & 7);
        const float* src = W + (size_t)(k0 + kr) * ldw + n_src0 + c4;
        f32x4 v[8];
#pragma unroll
        for (int i = 0; i < 8; ++i) v[i] = __builtin_nontemporal_load((const f32x4*)(src + (size_t)(8 * i) * ldw));
#pragma unroll
        for (int i = 0; i < 8; ++i) { float* d = scr + (8 * i + kr) * 33 + c4; d[0] = v[i][0]; d[1] = v[i][1]; d[2] = v[i][2]; d[3] = v[i][3]; }
    }
    asm volatile("s_waitcnt lgkmcnt(0)" ::: "memory");
    const int c = lane & 7;
#pragma unroll
    for (int j = 0; j < 4; ++j) { const int n = (lane >> 3) + 8 * j; const float* s = scr + (8 * c) * 33 + n;
        u32x4 o; o.x = cvt_pk_bf16(s[0 * 33], s[1 * 33]); o.y = cvt_pk_bf16(s[2 * 33], s[3 * 33]); o.z = cvt_pk_bf16(s[4 * 33], s[5 * 33]); o.w = cvt_pk_bf16(s[6 * 33], s[7 * 33]);
        *(u32x4*)(WT + (size_t)(row_dst0 + n) * D + k0 + 8 * c) = o; }
    asm volatile("s_waitcnt lgkmcnt(0)" ::: "memory");
}

__device__ __forceinline__ void mod_items(const Params& p, int l, unsigned char* lds, int tid, int wave, int lane, int bx) {
    const int G = gridDim.x;
    if (bx >= 192) return;
    float* sc = (float*)lds;
    float* red = (float*)(lds + 32768);
    for (int i = tid; i < 4 * D; i += 512) { const int b = i >> 11, k = i & (D - 1); sc[k * 4 + b] = silu_f(p.c[i]); }
    __syncthreads();
    for (int it = bx; it < 192; it += G) {
        const int n0 = 32 * it;
        const int r8 = lane >> 3, c4 = lane & 7;
        const float* wp = p.w_mod + ((size_t)l * D + wave * 256 + r8) * 6144 + n0 + 4 * c4;
        f32x4 a0 = {0, 0, 0, 0}, a1 = a0, a2 = a0, a3 = a0;
#pragma unroll 8
        for (int i = 0; i < 32; ++i) {
            const f32x4 w = __builtin_nontemporal_load((const f32x4*)(wp + (size_t)(8 * i) * 6144));
            const f32x4 s = *(const f32x4*)(sc + (wave * 256 + 8 * i + r8) * 4);
            a0 += w * s[0]; a1 += w * s[1]; a2 += w * s[2]; a3 += w * s[3];
        }
#pragma unroll
        for (int e = 0; e < 4; ++e) {
#pragma unroll
            for (int o = 8; o < 64; o <<= 1) { a0[e] += __shfl_xor(a0[e], o); a1[e] += __shfl_xor(a1[e], o); a2[e] += __shfl_xor(a2[e], o); a3[e] += __shfl_xor(a3[e], o); }
        }
        if (r8 == 0) {
            *(f32x4*)(red + (wave * 4 + 0) * 32 + 4 * c4) = a0; *(f32x4*)(red + (wave * 4 + 1) * 32 + 4 * c4) = a1;
            *(f32x4*)(red + (wave * 4 + 2) * 32 + 4 * c4) = a2; *(f32x4*)(red + (wave * 4 + 3) * 32 + 4 * c4) = a3;
        }
        __syncthreads();
        if (tid < 128) { const int b = tid >> 5, col = tid & 31; float s = p.b_mod[l * 6144 + n0 + col];
#pragma unroll
            for (int w = 0; w < 8; ++w) s += red[(w * 4 + b) * 32 + col];
            ((float*)(p.ws + WS_MOD))[(l * 4 + b) * 6144 + n0 + col] = s; }
        __syncthreads();
    }
}

__device__ __forceinline__ void p0_transposes(const Params& p, unsigned char* lds, int wave, int lane, int bx, int part) {
    const int G = gridDim.x;
    unsigned char* ws = p.ws;
    float* scr = (float*)(lds + wave * 16384);
    constexpr int PER_L = 32 * 240, NIT = 2 * PER_L;
    int base, end, stride;
    if (G == 256) {
        if (part == 0) { if (bx < 192) return; base = 13824 + (bx - 192) * 24; end = base + 24; }
        else if (bx < 192) { base = 49 * bx; end = base + 49; } else { base = 9408 + (bx - 192) * 69; end = base + 69; }
        base += wave; stride = 8;
    } else { if (part == 0) return; base = bx * 8 + wave; end = NIT; stride = G * 8; }
    for (int it = base; it < end; it += stride) {
        const int l = it / PER_L, r = it % PER_L, kb = r / 240, j = r % 240;
        bf16_t* WinT = (bf16_t*)(ws + WS_WIN + (size_t)l * WIN_BYTES);
        bf16_t* WoT = (bf16_t*)(ws + WS_WOUT + (size_t)l * WOUT_BYTES);
        if (j < 112) p0_transpose_item(p.w_in + (size_t)l * D * WIN_LD, WIN_LD, 32 * j, WinT, 32 * j, kb, scr, lane);
        else if (j < 176) p0_transpose_item(p.w_in + (size_t)l * D * WIN_LD, WIN_LD, 3600 + 32 * (j - 112), WinT, 3584 + 32 * (j - 112), kb, scr, lane);
        else p0_transpose_item(p.w_out + (size_t)l * D * D, D, 32 * (j - 176), WoT, 32 * (j - 176), kb, scr, lane);
    }
}

__device__ __forceinline__ void p0_convert(const Params& p, unsigned char* lds, int tid, int wave, int lane, int bx) {
    const int G = gridDim.x;
    unsigned char* ws = p.ws;
    {
        const int gt = bx * 512 + tid, NT = G * 512;
        for (int i = gt; i < 2 * 256 * (D / 8); i += NT) {
            const int l = i / (256 * (D / 8)), r = i % (256 * (D / 8)), j = r / (D / 8), k8 = (r % (D / 8)) * 8;
            u32x4 o = {0u, 0u, 0u, 0u};
            if (j < 16) { const float* s = p.w_in + ((size_t)l * D + k8) * WIN_LD + 3584 + j;
                o.x = cvt_pk_bf16(s[0], s[WIN_LD]); o.y = cvt_pk_bf16(s[2 * WIN_LD], s[3 * WIN_LD]); o.z = cvt_pk_bf16(s[4 * WIN_LD], s[5 * WIN_LD]); o.w = cvt_pk_bf16(s[6 * WIN_LD], s[7 * WIN_LD]); }
            *(u32x4*)((bf16_t*)(ws + WS_WIN + (size_t)l * WIN_BYTES) + (size_t)(5632 + j) * D + k8) = o;
        }
    }
    {
        const int gt = bx * 512 + tid;
        if (gt < 2 * 8 * 128 * 16) {
            const int t = (gt >> 4) & 127, s0 = (gt & 15) * 8;
            const float* src = p.sg_w + (size_t)gt * 8;
            const f32x4 f0 = *(const f32x4*)src, f1 = *(const f32x4*)(src + 4);
            float w[8] = {f0[0], f0[1], f0[2], f0[3], f1[0], f1[1], f1[2], f1[3]};
#pragma unroll
            for (int e = 0; e < 8; ++e) w[e] = (s0 + e <= t) ? w[e] : 0.f;
            *(u32x4*)((bf16_t*)(ws + WS_SGW) + (size_t)gt * 8) = (u32x4){cvt_pk_bf16(w[0], w[1]), cvt_pk_bf16(w[2], w[3]), cvt_pk_bf16(w[4], w[5]), cvt_pk_bf16(w[6], w[7])};
        }
    }
    p0_transposes(p, lds, wave, lane, bx, 1);
}

__device__ __forceinline__ void row_pass(const Params& p, int mode, int wave, int lane, int bx) {
    const int gw = bx * 8 + wave, NGW = gridDim.x * 8;
    unsigned char* ws = p.ws;
    const float* mod = (const float*)(ws + WS_MOD);
    const bf16_t* OUTB = (const bf16_t*)(ws + WS_OUT);
    bf16_t* H = (bf16_t*)(ws + WS_H);
    const int lpost = (mode == 2) ? 1 : 0, lpre = (mode == 0) ? 0 : 1;
    for (int gi = gw; gi < M / 4; gi += NGW) {
        const int r0 = 4 * gi, b = r0 >> 11;
        f32x4 gg[4][2], aa[4][2], tt[4][2];
        if (mode >= 1) {
            const float* gate = mod + (size_t)(lpost * 4 + b) * 6144 + 4096; const float* gp = p.g_post + lpost * D;
#pragma unroll
            for (int j = 0; j < 4; ++j)
#pragma unroll
                for (int h = 0; h < 2; ++h) { const int col = 8 * lane + 512 * j + 4 * h; gg[j][h] = *(const f32x4*)(gate + col) * *(const f32x4*)(gp + col); }
        }
        if (mode <= 1) {
            const float* shift = mod + (size_t)(lpre * 4 + b) * 6144; const float* scale = shift + 2048; const float* gp = p.g_pre + lpre * D;
#pragma unroll
            for (int j = 0; j < 4; ++j)
#pragma unroll
                for (int h = 0; h < 2; ++h) { const int col = 8 * lane + 512 * j + 4 * h;
                    aa[j][h] = *(const f32x4*)(gp + col) * (*(const f32x4*)(scale + col) + 1.f); tt[j][h] = *(const f32x4*)(shift + col); }
        }
#pragma unroll 1
        for (int k = 0; k < 4; ++k) {
            const int r = r0 + k;
            f32x4 v[4][2];
            if (mode == 2) {
                const bf16_t* x1b = (const bf16_t*)(ws + WS_X1B) + (size_t)r * D;
#pragma unroll
                for (int j = 0; j < 4; ++j) { const u32x4 w = *(const u32x4*)(x1b + 8 * lane + 512 * j);
                    v[j][0] = (f32x4){bf_lo(w.x), bf_hi(w.x), bf_lo(w.y), bf_hi(w.y)}; v[j][1] = (f32x4){bf_lo(w.z), bf_hi(w.z), bf_lo(w.w), bf_hi(w.w)}; }
            } else {
                const float* xin = p.x + (size_t)r * D;
#pragma unroll
                for (int j = 0; j < 4; ++j) { v[j][0] = *(const f32x4*)(xin + 8 * lane + 512 * j); v[j][1] = *(const f32x4*)(xin + 8 * lane + 512 * j + 4); }
            }
            if (mode >= 1) {
                f32x4 o[4][2]; float ss = 0.f;
#pragma unroll
                for (int j = 0; j < 4; ++j) { const u32x4 w = *(const u32x4*)(OUTB + (size_t)r * D + 8 * lane + 512 * j);
                    o[j][0] = (f32x4){bf_lo(w.x), bf_hi(w.x), bf_lo(w.y), bf_hi(w.y)}; o[j][1] = (f32x4){bf_lo(w.z), bf_hi(w.z), bf_lo(w.w), bf_hi(w.w)};
#pragma unroll
                    for (int h = 0; h < 2; ++h) ss += (o[j][h][0] * o[j][h][0] + o[j][h][1] * o[j][h][1]) + (o[j][h][2] * o[j][h][2] + o[j][h][3] * o[j][h][3]); }
                const float rstd = rsqrtf(wave_sum(ss) * (1.f / D) + EPS);
                float* xo = p.out + (size_t)r * D;
#pragma unroll
                for (int j = 0; j < 4; ++j)
#pragma unroll
                    for (int h = 0; h < 2; ++h) { const int col = 8 * lane + 512 * j + 4 * h;
                        v[j][h] = v[j][h] + gg[j][h] * (o[j][h] * rstd);
                        if (mode == 2) *(f32x4*)(xo + col) = v[j][h]; }
                if (mode == 1) {
                    bf16_t* x1b = (bf16_t*)(ws + WS_X1B) + (size_t)r * D;
#pragma unroll
                    for (int j = 0; j < 4; ++j) { u32x4 w; w.x = cvt_pk_bf16(v[j][0][0], v[j][0][1]); w.y = cvt_pk_bf16(v[j][0][2], v[j][0][3]); w.z = cvt_pk_bf16(v[j][1][0], v[j][1][1]); w.w = cvt_pk_bf16(v[j][1][2], v[j][1][3]);
                        *(u32x4*)(x1b + 8 * lane + 512 * j) = w;
                        v[j][0] = (f32x4){bf_lo(w.x), bf_hi(w.x), bf_lo(w.y), bf_hi(w.y)}; v[j][1] = (f32x4){bf_lo(w.z), bf_hi(w.z), bf_lo(w.w), bf_hi(w.w)}; }
                }
            }
            if (mode <= 1) {
                float ss = 0.f;
#pragma unroll
                for (int j = 0; j < 4; ++j)
#pragma unroll
                    for (int h = 0; h < 2; ++h) ss += (v[j][h][0] * v[j][h][0] + v[j][h][1] * v[j][h][1]) + (v[j][h][2] * v[j][h][2] + v[j][h][3] * v[j][h][3]);
                const float rstd = rsqrtf(wave_sum(ss) * (1.f / D) + EPS);
#pragma unroll
                for (int j = 0; j < 4; ++j) { f32x4 hh[2];
#pragma unroll
                    for (int h = 0; h < 2; ++h) hh[h] = (v[j][h] * rstd) * aa[j][h] + tt[j][h];
                    u32x4 w; w.x = cvt_pk_bf16(hh[0][0], hh[0][1]); w.y = cvt_pk_bf16(hh[0][2], hh[0][3]); w.z = cvt_pk_bf16(hh[1][0], hh[1][1]); w.w = cvt_pk_bf16(hh[1][2], hh[1][3]);
                    *(u32x4*)(H + (size_t)r * D + 8 * lane + 512 * j) = w; }
            }
        }
    }
}

__device__ __forceinline__ void rope_cs(int pos, int i, float& cs, float& sn) {
    constexpr float F[8] = {0.15915494309189535f, 0.03086376340470123f, 0.005985185712713705f, 0.001160663641240061f,
                            0.00022507907903927653f, 4.364795279280289e-05f, 8.464330808241401e-06f, 1.6414262627950345e-06f};
    const float rev = (float)pos * F[i];
    const float r = __builtin_amdgcn_fractf(rev);
    sn = __builtin_amdgcn_sinf(r); cs = __builtin_amdgcn_cosf(r);
}
constexpr int KS_LD = 72, VS_LD = 72;
__device__ __forceinline__ void attn_item(const Params& p, int l, int item, unsigned char* lds, int tid, int wave, int lane) {
    const int b = item >> 6, n = (item >> 2) & 15, g = item & 3;
    const int fr = lane & 15, fq = lane >> 4;
    bf16_t* Ks = (bf16_t*)lds;
    bf16_t* Vs = (bf16_t*)(lds + 256 * KS_LD * 2);
    const bf16_t* proj = (const bf16_t*)(p.ws + WS_PROJ);
    bf16_t* Y = (bf16_t*)(p.ws + WS_Y);
    const int r = wave >> 1, qh = wave & 1, hq = g * 4 + r;
    const int tokq0 = b * SEQ + n * 128 + 64 * qh;
    u32x4 qraw[4][2]; int qpos[4];
#pragma unroll
    for (int nb = 0; nb < 4; ++nb) {
        const int tok = tokq0 + 16 * nb + fr;
        const bf16_t* qp = proj + (size_t)tok * NPROJ + C_AQ + hq * 64 + 8 * fq;
        qraw[nb][0] = *(const u32x4*)qp; qraw[nb][1] = *(const u32x4*)(qp + 32); qpos[nb] = p.pos[tok];
    }
    {
        const int key = tid >> 1, half = tid & 1;
        const int s = n * 128 - 128 + key;
        u32x4 kv[4], vv[4];
#pragma unroll
        for (int c = 0; c < 4; ++c) { kv[c] = (u32x4){0u, 0u, 0u, 0u}; vv[c] = kv[c]; }
        if (s >= 0) {
            const bf16_t* kp = proj + (size_t)(b * SEQ + s) * NPROJ + C_AK + g * 64 + half * 32;
#pragma unroll
            for (int c = 0; c < 4; ++c) { kv[c] = *(const u32x4*)(kp + 8 * c); vv[c] = *(const u32x4*)(kp + 256 + 8 * c); }
            if (half == 0) {
                const int pos = p.pos[b * SEQ + s];
                unsigned a[4] = {kv[0].x, kv[0].y, kv[0].z, kv[0].w}, bb[4] = {kv[1].x, kv[1].y, kv[1].z, kv[1].w};
#pragma unroll
                for (int e = 0; e < 4; ++e) {
                    float c0, s0, c1, s1; rope_cs(pos, 2 * e, c0, s0); rope_cs(pos, 2 * e + 1, c1, s1);
                    const float t1a = bf_lo(a[e]), t1b = bf_hi(a[e]), t2a = bf_lo(bb[e]), t2b = bf_hi(bb[e]);
                    a[e] = cvt_pk_bf16(t1a * c0 - t2a * s0, t1b * c1 - t2b * s1);
                    bb[e] = cvt_pk_bf16(t2a * c0 + t1a * s0, t2b * c1 + t1b * s1);
                }
                kv[0] = (u32x4){a[0], a[1], a[2], a[3]}; kv[1] = (u32x4){bb[0], bb[1], bb[2], bb[3]};
            }
        }
#pragma unroll
        for (int c = 0; c < 4; ++c) *(u32x4*)(Ks + key * KS_LD + half * 32 + 8 * c) = kv[c];
#pragma unroll
        for (int c = 0; c < 4; ++c) *(u32x4*)(Vs + key * VS_LD + half * 32 + 8 * c) = vv[c];
    }
    __syncthreads();
    bf16x8 qf[4][2];
#pragma unroll
    for (int nb = 0; nb < 4; ++nb) {
        const u32x4 q0 = qraw[nb][0], q1 = qraw[nb][1];
        unsigned own[4] = {q0.x, q0.y, q0.z, q0.w}, par[4];
#pragma unroll
        for (int e = 0; e < 4; ++e) par[e] = __shfl_xor(own[e], 16);
        if (fq < 2) {
            const int pos = qpos[nb];
            const float sg = (fq == 0) ? -1.f : 1.f;
#pragma unroll
            for (int e = 0; e < 4; ++e) {
                float c0, s0, c1, s1; rope_cs(pos, 2 * e, c0, s0); rope_cs(pos, 2 * e + 1, c1, s1);
                const float oa = bf_lo(own[e]), ob = bf_hi(own[e]), pa = bf_lo(par[e]), pb = bf_hi(par[e]);
                own[e] = cvt_pk_bf16((oa * c0 + sg * pa * s0) * 0.125f, (ob * c1 + sg * pb * s1) * 0.125f);
            }
        } else {
#pragma unroll
            for (int e = 0; e < 4; ++e) own[e] = cvt_pk_bf16(bf_lo(own[e]) * 0.125f, bf_hi(own[e]) * 0.125f);
        }
        unsigned o1[4] = {q1.x, q1.y, q1.z, q1.w};
#pragma unroll
        for (int e = 0; e < 4; ++e) o1[e] = cvt_pk_bf16(bf_lo(o1[e]) * 0.125f, bf_hi(o1[e]) * 0.125f);
        qf[nb][0] = __builtin_bit_cast(bf16x8, (u32x4){own[0], own[1], own[2], own[3]});
        qf[nb][1] = __builtin_bit_cast(bf16x8, (u32x4){o1[0], o1[1], o1[2], o1[3]});
    }
    const float sink2 = p.sinks[l * 16 + hq] * LOG2E;
    float m_[4], l_[4];
    f32x4 o[4][4];
#pragma unroll
    for (int nb = 0; nb < 4; ++nb) { m_[nb] = sink2; l_[nb] = (fq == 0) ? 1.f : 0.f;
#pragma unroll
        for (int hb = 0; hb < 4; ++hb) o[hb][nb] = (f32x4){0.f, 0.f, 0.f, 0.f}; }
    for (int step = 0; step < 6; ++step) {
        const int kj0 = 64 * qh + 32 * step;
        if (n == 0 && kj0 + 32 <= 128) continue;
        f32x4 s[2][4];
#pragma unroll
        for (int mb = 0; mb < 2; ++mb)
#pragma unroll
            for (int nb = 0; nb < 4; ++nb) s[mb][nb] = (f32x4){0.f, 0.f, 0.f, 0.f};
#pragma unroll
        for (int mb = 0; mb < 2; ++mb)
#pragma unroll
            for (int kk = 0; kk < 2; ++kk) {
                const bf16x8 a = *(const bf16x8*)(Ks + (kj0 + 16 * mb + fr) * KS_LD + 32 * kk + 8 * fq);
#pragma unroll
                for (int nb = 0; nb < 4; ++nb) s[mb][nb] = MFMA16(a, qf[nb][kk], s[mb][nb]);
            }
        bf16x8 pb[4];
#pragma unroll
        for (int nb = 0; nb < 4; ++nb) {
            const int qi = 64 * qh + 16 * nb + fr;
            float tmax = -1e30f;
#pragma unroll
            for (int mb = 0; mb < 2; ++mb)
#pragma unroll
                for (int j = 0; j < 4; ++j) {
                    const int kj = kj0 + 16 * mb + 4 * fq + j, dist = qi + 128 - kj;
                    const bool valid = ((unsigned)dist < 128u);
                    const float v = valid ? s[mb][nb][j] : -1e30f;
                    s[mb][nb][j] = v; tmax = fmaxf(tmax, v);
                }
            tmax *= LOG2E;
            if (__builtin_amdgcn_ballot_w64(tmax > m_[nb] + 8.f) != 0ull) {
                tmax = fmaxf(tmax, __shfl_xor(tmax, 16)); tmax = fmaxf(tmax, __shfl_xor(tmax, 32));
                const float mnew = fmaxf(m_[nb], tmax), alpha = fast_exp2(m_[nb] - mnew);
                m_[nb] = mnew; l_[nb] = l_[nb] * alpha;
#pragma unroll
                for (int hb = 0; hb < 4; ++hb) o[hb][nb] = o[hb][nb] * alpha;
            }
            const float mref = m_[nb];
            float rs = 0.f;
#pragma unroll
            for (int mb = 0; mb < 2; ++mb)
#pragma unroll
                for (int j = 0; j < 4; ++j) { const float pv = fast_exp2(__builtin_fmaf(s[mb][nb][j], LOG2E, -mref)); s[mb][nb][j] = pv; rs += pv; }
            l_[nb] = l_[nb] + rs;
            pb[nb] = __builtin_bit_cast(bf16x8, (u32x4){cvt_pk_bf16(s[0][nb][0], s[0][nb][1]), cvt_pk_bf16(s[0][nb][2], s[0][nb][3]),
                                                        cvt_pk_bf16(s[1][nb][0], s[1][nb][1]), cvt_pk_bf16(s[1][nb][2], s[1][nb][3])});
        }
#pragma unroll
        for (int hb = 0; hb < 4; ++hb) {
            const bf16_t* vp = Vs + (kj0 + 4 * fq + (fr >> 2)) * VS_LD + 32 * (hb >> 1) + 8 * (fr & 3) + 4 * (hb & 1);
            const bf16x8 a = tr_operand(vp, vp + 16 * VS_LD);
#pragma unroll
            for (int nb = 0; nb < 4; ++nb) o[hb][nb] = MFMA16(a, pb[nb], o[hb][nb]);
        }
    }
#pragma unroll
    for (int nb = 0; nb < 4; ++nb) {
        const int tok = tokq0 + 16 * nb + fr;
        float lt = l_[nb]; lt += __shfl_xor(lt, 16); lt += __shfl_xor(lt, 32);
        const float inv = 1.f / lt;
#pragma unroll
        for (int hp = 0; hp < 2; ++hp) {
            const int col = hq * 64 + 32 * hp + 8 * fq;
            const u32x4 z = *(const u32x4*)(proj + (size_t)tok * NPROJ + C_Z + col);
            const f32x4 a = o[2 * hp][nb] * inv, b2 = o[2 * hp + 1][nb] * inv;
            u32x4 y; y.x = cvt_pk_bf16(a[0] * bf_lo(z.x), a[1] * bf_hi(z.x)); y.y = cvt_pk_bf16(a[2] * bf_lo(z.y), a[3] * bf_hi(z.y));
            y.z = cvt_pk_bf16(b2[0] * bf_lo(z.z), b2[1] * bf_hi(z.z)); y.w = cvt_pk_bf16(b2[2] * bf_lo(z.w), b2[3] * bf_hi(z.w));
            *(u32x4*)(Y + (size_t)tok * D + col) = y;
        }
    }
    __syncthreads();
}

constexpr int VN_LD = 72;
__device__ __forceinline__ void sg_pair_item(const Params& p, int l, int pitem, unsigned char* lds, int tid, int wave, int lane) {
    const int b2 = pitem >> 7, c = (pitem >> 3) & 15, g = pitem & 7;
    const int fr = lane & 15, fq = lane >> 4;
    bf16_t* vnT = (bf16_t*)lds;
    const bf16_t* proj = (const bf16_t*)(p.ws + WS_PROJ);
    bf16_t* Y = (bf16_t*)(p.ws + WS_Y);
    const int s = tid >> 2, qd = tid & 3;
    const int t = 16 * wave + fr;
    int tok0[2];
    tok0[0] = b2 * SEQ + c * 128; tok0[1] = (b2 + 2) * SEQ + c * 128;
    u32x4 vw[2][2]; f32x4 stq[2]; u32x4 uf[2][2], zf[2][2];
#pragma unroll
    for (int q2 = 0; q2 < 2; ++q2) {
        const bf16_t* vp = proj + (size_t)(tok0[q2] + s) * NPROJ + C_SV;
        vw[q2][0] = *(const u32x4*)(vp + 64 * g + 16 * qd); vw[q2][1] = *(const u32x4*)(vp + 64 * g + 16 * qd + 8);
        stq[q2] = *(const f32x4*)((const float*)(p.ws + WS_SGST) + (size_t)(tok0[q2] + s) * 16 + 4 * qd);
#pragma unroll
        for (int mp = 0; mp < 2; ++mp) { const int col = 64 * g + 32 * mp + 8 * fq; const size_t ro = (size_t)(tok0[q2] + t) * NPROJ;
            uf[q2][mp] = *(const u32x4*)(proj + ro + C_SU + col); zf[q2][mp] = *(const u32x4*)(proj + ro + C_Z + 1024 + col); }
    }
    bf16x8 wf[4];
    {   const bf16_t* wrow = (const bf16_t*)(p.ws + WS_SGW) + ((size_t)(l * 8 + g) * 128 + t) * 128;
#pragma unroll
        for (int kk = 0; kk < 4; ++kk) if (32 * kk <= 16 * wave + 15) wf[kk] = *(const bf16x8*)(wrow + 32 * kk + 8 * fq); }
    const float bias = p.sg_b[(l * 8 + g) * 128 + t];
    float lgv[16], lbv[16];
    {   const float* lg = p.sg_ln_g + l * 512 + 64 * g + 16 * qd; const float* lb = p.sg_ln_b + l * 512 + 64 * g + 16 * qd;
#pragma unroll
        for (int i = 0; i < 4; ++i) { const f32x4 a = *(const f32x4*)(lg + 4 * i), bb = *(const f32x4*)(lb + 4 * i);
#pragma unroll
            for (int e = 0; e < 4; ++e) { lgv[4 * i + e] = a[e]; lbv[4 * i + e] = bb[e]; } } }
#pragma unroll
    for (int q2 = 0; q2 < 2; ++q2) {
        float sum = stq[q2][0] + stq[q2][2], sq = stq[q2][1] + stq[q2][3];
        sum += __shfl_xor(sum, 1); sum += __shfl_xor(sum, 2); sq += __shfl_xor(sq, 1); sq += __shfl_xor(sq, 2);
        const float mu = sum * (1.f / 512.f), var = fmaxf(sq * (1.f / 512.f) - mu * mu, 0.f), rstd = rsqrtf(var + EPS);
        bf16_t* vq = vnT + q2 * 128 * VN_LD + s * VN_LD + 16 * qd;
#pragma unroll
        for (int i = 0; i < 2; ++i) { const unsigned ww[4] = {vw[q2][i].x, vw[q2][i].y, vw[q2][i].z, vw[q2][i].w}; unsigned o4[4];
#pragma unroll
            for (int e = 0; e < 4; ++e) { const int ch = 8 * i + 2 * e;
                o4[e] = cvt_pk_bf16((bf_lo(ww[e]) - mu) * rstd * lgv[ch] + lbv[ch], (bf_hi(ww[e]) - mu) * rstd * lgv[ch + 1] + lbv[ch + 1]); }
            *(u32x4*)(vq + 8 * i) = (u32x4){o4[0], o4[1], o4[2], o4[3]}; }
    }
    __syncthreads();
    {
        f32x4 acc[2][4];
#pragma unroll
        for (int q2 = 0; q2 < 2; ++q2)
#pragma unroll
            for (int mb = 0; mb < 4; ++mb) acc[q2][mb] = (f32x4){0.f, 0.f, 0.f, 0.f};
#pragma unroll
        for (int kk = 0; kk < 4; ++kk) {
            if (32 * kk <= 16 * wave + 15) {
                const int s0 = 32 * kk + 8 * fq;
                const bf16x8 bfr = wf[kk];
#pragma unroll
                for (int q2 = 0; q2 < 2; ++q2)
#pragma unroll
                    for (int mb = 0; mb < 4; ++mb) {
                        const bf16_t* ap = vnT + (q2 * 128 + s0 + (fr >> 2)) * VN_LD + 32 * (mb >> 1) + 8 * (fr & 3) + 4 * (mb & 1);
                        acc[q2][mb] = MFMA16(tr_operand(ap, ap + 4 * VN_LD), bfr, acc[q2][mb]); }
            }
        }
#pragma unroll
        for (int q2 = 0; q2 < 2; ++q2)
#pragma unroll
            for (int mp = 0; mp < 2; ++mp) {
                const int col = 64 * g + 32 * mp + 8 * fq;
                const u32x4 u = uf[q2][mp], z = zf[q2][mp];
                const f32x4 a = acc[q2][2 * mp] + bias, b3 = acc[q2][2 * mp + 1] + bias;
                u32x4 y; y.x = cvt_pk_bf16(bf_lo(u.x) * a[0] * bf_lo(z.x), bf_hi(u.x) * a[1] * bf_hi(z.x)); y.y = cvt_pk_bf16(bf_lo(u.y) * a[2] * bf_lo(z.y), bf_hi(u.y) * a[3] * bf_hi(z.y));
                y.z = cvt_pk_bf16(bf_lo(u.z) * b3[0] * bf_lo(z.z), bf_hi(u.z) * b3[1] * bf_hi(z.z)); y.w = cvt_pk_bf16(bf_lo(u.w) * b3[2] * bf_lo(z.w), bf_hi(u.w) * b3[3] * bf_hi(z.w));
                *(u32x4*)(Y + (size_t)(tok0[q2] + t) * D + 1024 + col) = y;
            }
    }
    __syncthreads();
}

constexpr int GL_LD = 72;
struct CgRow { f32x4 c0, c1, c2, c3; };
__device__ __forceinline__ CgRow gla_load_cg(const Params& p, int tok) {
    const float* cgp = (const float*)(p.ws + WS_CG) + (size_t)tok * 16;
    CgRow r; r.c0 = *(const f32x4*)cgp; r.c1 = *(const f32x4*)(cgp + 4); r.c2 = *(const f32x4*)(cgp + 8); r.c3 = *(const f32x4*)(cgp + 12); return r;
}
__device__ __forceinline__ float wave_scan_incl(float v) {
#define SCAN_STEP(ctrl, rmask) v += __builtin_bit_cast(float, __builtin_amdgcn_update_dpp(0, __builtin_bit_cast(int, v), (ctrl), (rmask), 0xf, false))
    SCAN_STEP(0x111, 0xf); SCAN_STEP(0x112, 0xf); SCAN_STEP(0x114, 0xf); SCAN_STEP(0x118, 0xf);
    SCAN_STEP(0x142, 0xa); SCAN_STEP(0x143, 0xc);
#undef SCAN_STEP
    return v;
}
__device__ __forceinline__ void gla_b(const float* wl, const CgRow& cr, int wave, int lane, float (&bc)[8], float (&bl)[8]) {
    const f32x4 c0 = cr.c0, c1 = cr.c1, c2 = cr.c2, c3 = cr.c3;
    const float cgv[16] = {c0[0], c0[1], c0[2], c0[3], c1[0], c1[1], c1[2], c1[3], c2[0], c2[1], c2[2], c2[3], c3[0], c3[1], c3[2], c3[3]};
    float x[8];
    {   const f32x4 b0 = *(const f32x4*)(wl + 1024 + 8 * wave), b1 = *(const f32x4*)(wl + 1024 + 8 * wave + 4);
#pragma unroll
        for (int e = 0; e < 4; ++e) { x[e] = b0[e]; x[4 + e] = b1[e]; } }
#pragma unroll
    for (int r = 0; r < 16; ++r) {
        const f32x4 w0 = *(const f32x4*)(wl + r * 64 + 8 * wave), w1 = *(const f32x4*)(wl + r * 64 + 8 * wave + 4);
#pragma unroll
        for (int e = 0; e < 4; ++e) { x[e] += cgv[r] * w0[e]; x[4 + e] += cgv[r] * w1[e]; }
    }
#pragma unroll
    for (int i = 0; i < 8; ++i) {
        float la = (fminf(x[i], 0.f) - __logf(1.f + __expf(-fabsf(x[i])))) * (1.f / 16.f);
        la = wave_scan_incl(la);
        bc[i] = la; bl[i] = __builtin_bit_cast(float, __builtin_amdgcn_readlane(__builtin_bit_cast(int, la), 63));
    }
}
struct VPair { u32x4 a, b; };
__device__ __forceinline__ VPair gla_load_v(const bf16_t* proj, int tok0, int h, int tid) {
    const int t = tid >> 3, c8 = tid & 7;
    const bf16_t* vp = proj + (size_t)(tok0 + t) * NPROJ + C_CV + h * 128 + 16 * c8;
    VPair r; r.a = *(const u32x4*)vp; r.b = *(const u32x4*)(vp + 8); return r;
}
__device__ __forceinline__ void gla_store_vT(const VPair& v, bf16_t* vT, int tid) {
    const int t = tid >> 3, c8 = tid & 7;
#pragma unroll
    for (int i = 0; i < 2; ++i) { const u32x4 w = i ? v.b : v.a; const unsigned ww[4] = {w.x, w.y, w.z, w.w};
#pragma unroll
        for (int e = 0; e < 4; ++e) { const int dv = 16 * c8 + 8 * i + 2 * e;
            vT[dv * GL_LD + t] = (bf16_t)(ww[e] & 0xffffu); vT[(dv + 1) * GL_LD + t] = (bf16_t)(ww[e] >> 16); } }
}
constexpr int GLK_LD = 72, GLV_LD = 136;
__device__ __forceinline__ void gla_local_item(const Params& p, int l, int item, unsigned char* lds, int tid, int wave, int lane) {
    const int bh = item >> 5, c = item & 31, b = bh >> 2, h = bh & 3;
    const int fr = lane & 15, fq = lane >> 4;
    const int tok0 = b * SEQ + c * 64;
    bf16_t* Kr = (bf16_t*)lds;
    bf16_t* Vr = (bf16_t*)(lds + 64 * GLK_LD * 2);
    float* wl = (float*)(lds + 64 * GLK_LD * 2 + 64 * GLV_LD * 2);
    const bf16_t* proj = (const bf16_t*)(p.ws + WS_PROJ);
    const CgRow cr = gla_load_cg(p, tok0 + lane);
    const bf16_t* rowp = proj + (size_t)(tok0 + lane) * NPROJ + h * 64 + 8 * wave;
    const u32x4 qw = *(const u32x4*)(rowp + C_CQ), kw = *(const u32x4*)(rowp + C_CK);
    const VPair vpre = gla_load_v(proj, tok0, h, tid);
    if (tid < 256) *(f32x4*)(wl + (tid >> 4) * 64 + 4 * (tid & 15)) = *(const f32x4*)(p.gla_wup + (size_t)(l * 16 + (tid >> 4)) * 256 + h * 64 + 4 * (tid & 15));
    else if (tid < 272) *(f32x4*)(wl + 1024 + 4 * (tid - 256)) = *(const f32x4*)(p.gla_bg + l * 256 + h * 64 + 4 * (tid - 256));
    __syncthreads();
    float bc[8], bl[8];
    gla_b(wl, cr, wave, lane, bc, bl);
    {
        const unsigned qq[4] = {qw.x, qw.y, qw.z, qw.w}, ww[4] = {kw.x, kw.y, kw.z, kw.w};
        unsigned qo[4], ko[4], lo4[4];
#pragma unroll
        for (int e = 0; e < 4; ++e) {
            lo4[e] = cvt_pk_bf16(bf_lo(ww[e]) * __expf(bl[2 * e] - bc[2 * e]), bf_hi(ww[e]) * __expf(bl[2 * e + 1] - bc[2 * e + 1]));
            const float e0 = __expf(bc[2 * e]), e1 = __expf(bc[2 * e + 1]);
            qo[e] = cvt_pk_bf16(bf_lo(qq[e]) * 0.125f * e0, bf_hi(qq[e]) * 0.125f * e1);
            ko[e] = cvt_pk_bf16(bf_lo(ww[e]) * fast_rcp(e0), bf_hi(ww[e]) * fast_rcp(e1));
        }
        *(u32x4*)(Kr + lane * GLK_LD + 8 * wave) = (u32x4){lo4[0], lo4[1], lo4[2], lo4[3]};
        *(u32x4*)((bf16_t*)(p.ws + WS_QD) + (size_t)item * 4096 + lane * 64 + 8 * wave) = (u32x4){qo[0], qo[1], qo[2], qo[3]};
        *(u32x4*)((bf16_t*)(p.ws + WS_KD) + (size_t)item * 4096 + lane * 64 + 8 * wave) = (u32x4){ko[0], ko[1], ko[2], ko[3]};
        if (lane == 63) { float* dec = (float*)(p.ws + WS_DEC) + (size_t)item * 64 + 8 * wave;
#pragma unroll
            for (int i = 0; i < 8; ++i) dec[i] = __expf(bl[i]); }
        bf16_t* vd = Vr + (tid >> 3) * GLV_LD + 16 * (tid & 7);
        *(u32x4*)vd = vpre.a; *(u32x4*)(vd + 8) = vpre.b;
    }
    __syncthreads();
    {
        f32x4 acc[4];
#pragma unroll
        for (int mb = 0; mb < 4; ++mb) acc[mb] = (f32x4){0.f, 0.f, 0.f, 0.f};
#pragma unroll
        for (int kk = 0; kk < 2; ++kk) {
            const int srow = 32 * kk + 8 * fq + (fr >> 2);
            const bf16_t* bp_ = Vr + srow * GLV_LD + 16 * wave + 4 * (fr & 3);
            const bf16x8 bfr = tr_operand(bp_, bp_ + 4 * GLV_LD);
#pragma unroll
            for (int mb = 0; mb < 4; ++mb) { const bf16_t* ap = Kr + srow * GLK_LD + 16 * mb + 4 * (fr & 3); acc[mb] = MFMA16(tr_operand(ap, ap + 4 * GLK_LD), bfr, acc[mb]); }
        }
        float* loct = (float*)(p.ws + WS_LOCT) + (size_t)item * 8192 + (16 * wave + fr) * 64 + 4 * fq;
#pragma unroll
        for (int mb = 0; mb < 4; ++mb) *(f32x4*)(loct + 16 * mb) = acc[mb];
    }
    __syncthreads();
}
__device__ __forceinline__ void gla_scan(const Params& p, int tid, int bx) {
    const float* loct = (const float*)(p.ws + WS_LOCT); const float* dec = (const float*)(p.ws + WS_DEC);
    bf16_t* ST = (bf16_t*)(p.ws + WS_ST);
    for (int e = bx * 512 + tid; e < 16 * 8192; e += gridDim.x * 512) {
        const int bh = e >> 13, r = e & 8191, dk = r & 63;
        float lo[32], de[32];
#pragma unroll
        for (int c = 0; c < 32; ++c) { const size_t it = (size_t)bh * 32 + c; lo[c] = loct[it * 8192 + r]; de[c] = dec[it * 64 + dk]; }
        float s = 0.f;
#pragma unroll
        for (int c = 0; c < 32; ++c) { const size_t it = (size_t)bh * 32 + c;
            ST[it * 8192 + r] = f2bf(s);
            s = s * de[c] + lo[c]; }
    }
}
constexpr int GO_LD = 72, GOV_LD = 136;
constexpr int GO_QD = 0, GO_KD = 64 * GO_LD, GO_ST = 2 * 64 * GO_LD, GO_VT = GO_ST + 128 * GO_LD, GO_IMG = GO_VT + 128 * GO_LD;
__device__ __forceinline__ void gla_out_pair(const Params& p, int l, int pit, unsigned char* lds, int tid, int wave, int lane) {
    const int bh2 = pit >> 5, c = pit & 31, h = bh2 & 3;
    const int fr = lane & 15, fq = lane >> 4;
    bf16_t* img = (bf16_t*)lds;
    float* red = (float*)(lds + 2 * GO_IMG * 2);
    const bf16_t* proj = (const bf16_t*)(p.ws + WS_PROJ);
    bf16_t* Y = (bf16_t*)(p.ws + WS_Y);
    const int tb = wave & 3, dh = wave >> 2, t = 16 * tb + fr;
    int item[2], tok[2];
    item[0] = bh2 * 32 + c; item[1] = (bh2 + 8) * 32 + c;
    tok[0] = (bh2 >> 2) * SEQ + c * 64 + t; tok[1] = ((bh2 >> 2) + 2) * SEQ + c * 64 + t;
    {
        const int r8 = tid >> 3, ch = (tid & 7) * 8;
        u32x4 cq[2], ck[2], cs[2][2], cv[2][2];
        const int tokb[2] = {(bh2 >> 2) * SEQ + c * 64, ((bh2 >> 2) + 2) * SEQ + c * 64};
#pragma unroll
        for (int q2 = 0; q2 < 2; ++q2) {
            cq[q2] = *(const u32x4*)((const bf16_t*)(p.ws + WS_QD) + (size_t)item[q2] * 4096 + r8 * 64 + ch);
            ck[q2] = *(const u32x4*)((const bf16_t*)(p.ws + WS_KD) + (size_t)item[q2] * 4096 + r8 * 64 + ch);
#pragma unroll
            for (int i = 0; i < 2; ++i) {
                cs[q2][i] = *(const u32x4*)((const bf16_t*)(p.ws + WS_ST) + (size_t)item[q2] * 8192 + (r8 + 64 * i) * 64 + ch);
                cv[q2][i] = *(const u32x4*)(proj + (size_t)(tokb[q2] + r8) * NPROJ + C_CV + h * 128 + ch + 64 * i);
            }
        }
#pragma unroll
        for (int q2 = 0; q2 < 2; ++q2) {
            bf16_t* im = img + q2 * GO_IMG;
            *(u32x4*)(im + GO_QD + r8 * GO_LD + ch) = cq[q2]; *(u32x4*)(im + GO_KD + r8 * GO_LD + ch) = ck[q2];
#pragma unroll
            for (int i = 0; i < 2; ++i) { *(u32x4*)(im + GO_ST + (r8 + 64 * i) * GO_LD + ch) = cs[q2][i]; *(u32x4*)(im + GO_VT + r8 * GOV_LD + ch + 64 * i) = cv[q2][i]; }
        }
    }
    u32x4 zf[2][2]; f32x4 gf[4];
#pragma unroll
    for (int mp = 0; mp < 2; ++mp) {
        const int dv = 64 * dh + 32 * mp + 8 * fq;
        gf[2 * mp] = *(const f32x4*)(p.gla_ng + l * 128 + dv); gf[2 * mp + 1] = *(const f32x4*)(p.gla_ng + l * 128 + dv + 4);
#pragma unroll
        for (int q2 = 0; q2 < 2; ++q2) zf[q2][mp] = *(const u32x4*)(proj + (size_t)tok[q2] * NPROJ + C_Z + 1536 + h * 128 + dv);
    }
    __syncthreads();
    f32x4 acc[2][4];
#pragma unroll
    for (int q2 = 0; q2 < 2; ++q2) {
        const bf16_t* im = img + q2 * GO_IMG;
        bf16x8 bq[2];
#pragma unroll
        for (int kk = 0; kk < 2; ++kk) bq[kk] = *(const bf16x8*)(im + GO_QD + t * GO_LD + 32 * kk + 8 * fq);
        f32x4 sc[4];
#pragma unroll
        for (int mb = 0; mb < 4; ++mb) {
            sc[mb] = (f32x4){0.f, 0.f, 0.f, 0.f};
            if (mb <= tb) {
#pragma unroll
                for (int kk = 0; kk < 2; ++kk) { const bf16x8 a = *(const bf16x8*)(im + GO_KD + (16 * mb + fr) * GO_LD + 32 * kk + 8 * fq); sc[mb] = MFMA16(a, bq[kk], sc[mb]); }
#pragma unroll
                for (int j = 0; j < 4; ++j) if (16 * mb + 4 * fq + j > t) sc[mb][j] = 0.f;
            }
        }
        bf16x8 bp[2];
#pragma unroll
        for (int k2 = 0; k2 < 2; ++k2)
            bp[k2] = __builtin_bit_cast(bf16x8, (u32x4){cvt_pk_bf16(sc[2 * k2][0], sc[2 * k2][1]), cvt_pk_bf16(sc[2 * k2][2], sc[2 * k2][3]),
                                                        cvt_pk_bf16(sc[2 * k2 + 1][0], sc[2 * k2 + 1][1]), cvt_pk_bf16(sc[2 * k2 + 1][2], sc[2 * k2 + 1][3])});
        float ssq = 0.f;
#pragma unroll
        for (int mb = 0; mb < 4; ++mb) {
            const int dvrow = 64 * dh + 32 * (mb >> 1) + 8 * (fr >> 2) + 4 * (mb & 1) + (fr & 3);
            acc[q2][mb] = (f32x4){0.f, 0.f, 0.f, 0.f};
#pragma unroll
            for (int k2 = 0; k2 < 2; ++k2) {
                const bf16_t* vp = im + GO_VT + (32 * k2 + 4 * fq + (fr >> 2)) * GOV_LD + 64 * dh + 32 * (mb >> 1) + 8 * (fr & 3) + 4 * (mb & 1);
                acc[q2][mb] = MFMA16(tr_operand(vp, vp + 16 * GOV_LD), bp[k2], acc[q2][mb]);
            }
#pragma unroll
            for (int kk = 0; kk < 2; ++kk) { const bf16x8 a = *(const bf16x8*)(im + GO_ST + dvrow * GO_LD + 32 * kk + 8 * fq); acc[q2][mb] = MFMA16(a, bq[kk], acc[q2][mb]); }
            ssq += (acc[q2][mb][0] * acc[q2][mb][0] + acc[q2][mb][1] * acc[q2][mb][1]) + (acc[q2][mb][2] * acc[q2][mb][2] + acc[q2][mb][3] * acc[q2][mb][3]);
        }
        ssq += __shfl_xor(ssq, 16); ssq += __shfl_xor(ssq, 32);
        if (fq == 0) red[(q2 * 2 + dh) * 64 + t] = ssq;
    }
    __syncthreads();
#pragma unroll
    for (int q2 = 0; q2 < 2; ++q2) {
        const float rstd = rsqrtf((red[(q2 * 2) * 64 + t] + red[(q2 * 2 + 1) * 64 + t]) * (1.f / 128.f) + EPS);
#pragma unroll
        for (int mp = 0; mp < 2; ++mp) {
            const int col = 1536 + h * 128 + 64 * dh + 32 * mp + 8 * fq;
            const u32x4 z = zf[q2][mp];
            const f32x4 a = acc[q2][2 * mp] * rstd * gf[2 * mp], b3 = acc[q2][2 * mp + 1] * rstd * gf[2 * mp + 1];
            u32x4 y; y.x = cvt_pk_bf16(a[0] * bf_lo(z.x), a[1] * bf_hi(z.x)); y.y = cvt_pk_bf16(a[2] * bf_lo(z.y), a[3] * bf_hi(z.y));
            y.z = cvt_pk_bf16(b3[0] * bf_lo(z.z), b3[1] * bf_hi(z.z)); y.w = cvt_pk_bf16(b3[2] * bf_lo(z.w), b3[3] * bf_hi(z.w));
            *(u32x4*)(Y + (size_t)tok[q2] * D + col) = y;
        }
    }
    __syncthreads();
}

#define XB_TMO      128
#define XB_XCNT(j)  (256  + 64 * (j))
#define XB_XSUB(j)  (1280 + 64 * (j))
#define XB_XGEN(j)  (2304 + 64 * (j))
#define XB_TOP      3328
#define XB_TOPGEN   3392
#define XCD_BAR_WORDS 3456
#define XB_SPIN_CAP (1u << 18)
__device__ __forceinline__ unsigned xb_ld(unsigned* p)              { return __hip_atomic_load(p, __ATOMIC_RELAXED, __HIP_MEMORY_SCOPE_AGENT); }
__device__ __forceinline__ unsigned xb_add(unsigned* p, unsigned v) { return __hip_atomic_fetch_add(p, v, __ATOMIC_RELAXED, __HIP_MEMORY_SCOPE_AGENT); }
__device__ __forceinline__ unsigned xb_xcc_id() { return (unsigned)__builtin_amdgcn_s_getreg((3 << 11) | 20) & 0xFu; }
#define XB_SPIN(cond, bar) do { unsigned _sp = 0; while (cond) { __builtin_amdgcn_s_sleep(1); \
    if ((++_sp & 255u) == 0u) { if (xb_ld(&(bar)[XB_TMO])) break; if (_sp > XB_SPIN_CAP) { atomicAdd(&(bar)[XB_TMO], 1u); break; } } } } while (0)
__device__ __forceinline__ void xcd_barrier_complete(unsigned* bar, unsigned x, unsigned& nloc, unsigned& nx) {
    const unsigned G = gridDim.x * gridDim.y * gridDim.z;
    unsigned sum, cnt, mine, sp = 0u;
    for (;;) {
        sum = 0u; cnt = 0u; mine = 0u;
#pragma unroll
        for (unsigned j = 0; j < 16; ++j) { const unsigned c = xb_ld(&bar[XB_XCNT(j)]); sum += c; cnt += (c > 0u) ? 1u : 0u; mine = (j == x) ? c : mine; }
        if (sum == G) break;
        __builtin_amdgcn_s_sleep(1);
        if ((++sp & 255u) == 0u) { if (xb_ld(&bar[XB_TMO])) break; if (sp > XB_SPIN_CAP) { atomicAdd(&bar[XB_TMO], 1u); break; } }
    }
    nloc = mine > 0u ? mine : 1u; nx = cnt > 0u ? cnt : 1u;
}
__device__ __forceinline__ void xcd_barrier(unsigned* bar, volatile LAS unsigned* st) {
    asm volatile("s_waitcnt vmcnt(0)" ::: "memory");
    __syncthreads();
    if (threadIdx.x == 0) {
        __builtin_amdgcn_s_waitcnt(0);
        const unsigned x = xb_xcc_id();
        unsigned nloc = st[0], nx = st[1];
        if (nloc == 0u) { xcd_barrier_complete(bar, x, nloc, nx); st[0] = nloc; st[1] = nx; }
        const unsigned old = xb_add(&bar[XB_XSUB(x)], 1u);
        const unsigned gen = old / nloc;
        if (old + 1u == (gen + 1u) * nloc) {
            __builtin_amdgcn_fence(__ATOMIC_RELEASE, "agent");
            asm volatile("s_waitcnt vmcnt(0)" ::: "memory");
            const unsigned og = xb_add(&bar[XB_TOP], 1u);
            const unsigned tg = og / nx;
            if (og + 1u == (tg + 1u) * nx) xb_add(&bar[XB_TOPGEN], 1u);
            else XB_SPIN(xb_ld(&bar[XB_TOPGEN]) == tg, bar);
            __builtin_amdgcn_fence(__ATOMIC_ACQUIRE, "agent");
            xb_add(&bar[XB_XGEN(x)], 1u);
            asm volatile("s_waitcnt vmcnt(0)" ::: "memory");
        } else {
            XB_SPIN(xb_ld(&bar[XB_XGEN(x)]) == gen, bar);
            __builtin_amdgcn_fence(__ATOMIC_ACQUIRE, "agent");
            asm volatile("s_waitcnt vmcnt(0)" ::: "memory");
        }
    }
    __syncthreads();
}

constexpr int N_PHASES = 14;
__global__ void __launch_bounds__(512, 2) fwd_kernel(Params p) {
    extern __shared__ __attribute__((aligned(16))) unsigned char lds[];
    const int G = gridDim.x;
    const int lo = p.ph_lo, hi = p.ph_hi;
    unsigned* const xbar = (unsigned*)(p.ws + WS_BAR);
    volatile LAS unsigned* const xst = (volatile LAS unsigned*)((LAS unsigned char*)lds + 131072 + 64);
    if (threadIdx.x < 2) xst[threadIdx.x] = 0u;
    __syncthreads();
    if (lo < 0) cg::this_grid().sync();
    if (hi - lo > 1 && threadIdx.x == 0) (void)xb_add(&xbar[XB_XCNT(xb_xcc_id())], 1u);
#ifndef PHMASK
#define PHMASK 0xffff
#endif
#define IN(k) (((PHMASK >> ((k) < 2 ? (k) : 2 + ((k) - 2) % 6)) & 1) && lo <= (k) && (k) < hi)
#define SEAM(k) do { STAMP(2 * (k)); if (IN(k) && IN((k) + 1)) { xcd_barrier(xbar, xst); } STAMP(2 * (k) + 1); } while (0)
#define FRESH() int tid = threadIdx.x; asm volatile("" : "+v"(tid)); int bx = blockIdx.x; asm volatile("" : "+s"(bx)); \
    const int lane = tid & 63, wave = __builtin_amdgcn_readfirstlane(tid >> 6); \
    const Params q = fresh_params(p); (void)lane; (void)wave; (void)bx;
    unsigned long long tacc = 0ull, tprev = (PMASK != 0ull) ? __builtin_amdgcn_s_memrealtime() : 0ull;
#define STAMP(idx) do { if (PMASK != 0ull) { const unsigned long long now_ = __builtin_amdgcn_s_memrealtime(); if ((PMASK >> (idx)) & 1ull) tacc += now_ - tprev; tprev = now_; } } while (0)
    if (IN(0)) for (int rep = 0; rep < REPN(0); ++rep) { FRESH(); mod_items(q, 0, lds, tid, wave, lane, bx); __syncthreads(); p0_transposes(q, lds, wave, lane, bx, 0); }
    SEAM(0);
    if (IN(1)) for (int rep = 0; rep < REPN(1); ++rep) { FRESH(); mod_items(q, 1, lds, tid, wave, lane, bx); __syncthreads(); STAMP(32); p0_convert(q, lds, tid, wave, lane, bx); STAMP(33); row_pass(q, 0, wave, lane, bx); }
    SEAM(1);
#pragma unroll 1
    for (int l = 0; l < 2; ++l) {
        const int pb = 2 + 6 * l;
        if (IN(pb)) for (int rep = 0; rep < REPN(2); ++rep) {
            FRESH();
            pg8::Gemm g{(const bf16_t*)(q.ws + WS_H), (const bf16_t*)(q.ws + WS_WIN + (size_t)l * WIN_BYTES), M, NPAD, D};
            pg8::StaticOrder S; S.init(M, NPAD, G, bx);
            pg8::EpiProj E{(bf16_t*)(q.ws + WS_PROJ), (float*)(q.ws + WS_CG), (float*)(q.ws + WS_SGST)};
            pg8::gemm_phase<pg8::EpiProj, pg8::StaticOrder, true, true>((LAS unsigned char*)lds, g, S, E, tid);
        }
        SEAM(pb);
        if (IN(pb + 1)) for (int rep = 0; rep < REPN(3); ++rep) {
#ifndef MIXMASK
#define MIXMASK 7
#endif
            for (int rr = 0; rr < ((MIXR >> 0) & 15); ++rr) { FRESH(); for (int it = bx; it < 256; it += G) attn_item(q, l, it, lds, tid, wave, lane); }
            STAMP(36 + 4 * l); for (int rr = 0; rr < ((MIXR >> 4) & 15); ++rr) { FRESH(); for (int it = bx; it < 256; it += G) sg_pair_item(q, l, it, lds, tid, wave, lane); } STAMP(37 + 4 * l);
            for (int rr = 0; rr < ((MIXR >> 8) & 15); ++rr) { FRESH(); for (int it = bx; it < 512; it += G) gla_local_item(q, l, it, lds, tid, wave, lane); }
        }
        SEAM(pb + 1);
        if (IN(pb + 2)) for (int rep = 0; rep < REPN(4); ++rep) { FRESH(); gla_scan(q, tid, bx); }
        SEAM(pb + 2);
        if (IN(pb + 3)) for (int rep = 0; rep < REPN(5); ++rep) { FRESH(); for (int it = bx; it < 256; it += G) gla_out_pair(q, l, it, lds, tid, wave, lane); }
        SEAM(pb + 3);
        if (IN(pb + 4)) for (int rep = 0; rep < REPN(6); ++rep) {
            FRESH();
            pg8::Gemm g{(const bf16_t*)(q.ws + WS_Y), (const bf16_t*)(q.ws + WS_WOUT + (size_t)l * WOUT_BYTES), M, D, D};
            pg8::StaticOrder S; S.init(M, D, G, bx);
            pg8::EpiOut E{(bf16_t*)(q.ws + WS_OUT)};
            pg8::gemm_phase<pg8::EpiOut, pg8::StaticOrder, true, true>((LAS unsigned char*)lds, g, S, E, tid);
        }
        SEAM(pb + 4);
        if (IN(pb + 5)) { FRESH(); row_pass(q, l + 1, wave, lane, bx); }
        if (l == 0) SEAM(pb + 5);
    }
    STAMP(26);
    if (PMASK != 0ull) { if (blockIdx.x == 0 && threadIdx.x == 0) { const unsigned long long t0 = __builtin_amdgcn_s_memrealtime(); while (__builtin_amdgcn_s_memrealtime() - t0 < tacc) __builtin_amdgcn_s_sleep(8); } }
#undef IN
#undef SEAM
#undef FRESH
}

extern "C" void kernel_launch(void* const* d_in, const int* in_sizes, int n_in, void* d_out, int out_size, void* d_ws, size_t ws_size, hipStream_t stream) {
    static int grid = 0;
    if (grid == 0) {
        if (n_in != 17 || in_sizes[0] != M * D || out_size != M * D || ws_size < WS_END) { fprintf(stderr, "kernel_launch: unexpected shapes (n_in %d, in0 %d, out %d, ws %zu)\n", n_in, n_in > 0 ? in_sizes[0] : -1, out_size, ws_size); grid = -1; return; }
        int dev = 0, cus = 0, per_cu = 0;
        if (hipGetDevice(&dev) != hipSuccess || hipDeviceGetAttribute(&cus, hipDeviceAttributeMultiprocessorCount, dev) != hipSuccess) { grid = -1; return; }
        if (hipFuncSetAttribute((const void*)fwd_kernel, hipFuncAttributeMaxDynamicSharedMemorySize, LDS_BYTES) != hipSuccess) { fprintf(stderr, "kernel_launch: hipFuncSetAttribute failed\n"); grid = -1; return; }
        if (hipOccupancyMaxActiveBlocksPerMultiprocessor(&per_cu, (const void*)fwd_kernel, 512, LDS_BYTES) != hipSuccess || per_cu < 1) { fprintf(stderr, "kernel_launch: occupancy query says %d blocks per CU\n", per_cu); per_cu = 1; }
        (void)hipGetLastError();
        grid = cus;
    }
    if (grid < 0) return;
    Params p{};
    p.x = (const float*)d_in[0]; p.c = (const float*)d_in[1]; p.pos = (const int*)d_in[2]; p.w_mod = (const float*)d_in[3]; p.b_mod = (const float*)d_in[4];
    p.g_pre = (const float*)d_in[5]; p.g_post = (const float*)d_in[6]; p.w_in = (const float*)d_in[7]; p.w_out = (const float*)d_in[8]; p.sinks = (const float*)d_in[9];
    p.sg_w = (const float*)d_in[10]; p.sg_b = (const float*)d_in[11]; p.sg_ln_g = (const float*)d_in[12]; p.sg_ln_b = (const float*)d_in[13];
    p.gla_wup = (const float*)d_in[14]; p.gla_bg = (const float*)d_in[15]; p.gla_ng = (const float*)d_in[16];
    p.out = (float*)d_out; p.ws = (unsigned char*)d_ws;
#if MK_SINGLE
    if (hipMemsetAsync((char*)d_ws + WS_BAR, 0, XCD_BAR_WORDS * 4, stream) != hipSuccess) { fprintf(stderr, "kernel_launch: memset failed\n"); return; }
    p.ph_lo = 0; p.ph_hi = N_PHASES;
    void* args[] = {&p};
    hipError_t e = hipLaunchCooperativeKernel((const void*)fwd_kernel, dim3(grid), dim3(512), args, LDS_BYTES, stream);
    if (e != hipSuccess) fprintf(stderr, "kernel_launch: cooperative launch failed: %s (grid %d)\n", hipGetErrorString(e), grid);
#else
    for (int ph = 0; ph < N_PHASES; ++ph) {
        p.ph_lo = ph; p.ph_hi = ph + 1;
        hipLaunchKernelGGL(fwd_kernel, dim3(grid), dim3(512), LDS_BYTES, stream, p);
    }
#endif
}
```

```cpp
#include <hip/hip_runtime.h>
#include <hip/hip_cooperative_groups.h>
#include <cstdio>
#include <cstdint>
namespace cg = cooperative_groups;

#ifndef REPS
#define REPS 0x11111111
#endif
#define REPN(k) ((REPS >> (4 * (k))) & 15)
#ifndef PMASK
#define PMASK 0ull
#endif
#ifndef MIXR
#define MIXR 0x111
#endif
#ifndef MK_SINGLE
#define MK_SINGLE 1
#endif

#define LAS __attribute__((address_space(3)))
typedef unsigned short bf16_t;
typedef short bf16x8 __attribute__((ext_vector_type(8)));
typedef float f32x4 __attribute__((ext_vector_type(4)));
typedef float f32x2 __attribute__((ext_vector_type(2)));
typedef unsigned u32x4 __attribute__((ext_vector_type(4)));
typedef unsigned u32x2 __attribute__((ext_vector_type(2)));

constexpr int D = 2048, NB = 4, SEQ = 2048, M = NB * SEQ;
constexpr int NPROJ = 5632;
constexpr int NPAD = 5888;
constexpr int WIN_LD = 5648;
constexpr float EPS = 1e-6f;
constexpr int C_AQ = 0, C_AK = 1024, C_AV = 1280, C_SU = 1536, C_SV = 2048, C_CQ = 2560, C_CK = 2816, C_CV = 3072, C_Z = 3584;
constexpr float LOG2E = 1.4426950408889634f;

constexpr size_t MiB = 1u << 20;
constexpr size_t WS_WIN = 0, WIN_BYTES = (size_t)NPAD * D * 2;
constexpr size_t WS_WOUT = 46 * MiB, WOUT_BYTES = (size_t)D * D * 2;
constexpr size_t WS_H = 62 * MiB, WS_PROJ = 94 * MiB, WS_CG = 182 * MiB, WS_MOD = 183 * MiB, WS_Y = 184 * MiB, WS_OUT = 216 * MiB;
constexpr size_t WS_LOCT = 248 * MiB, WS_ST = 264 * MiB, WS_DEC = 272 * MiB, WS_BAR = 273 * MiB, WS_QD = 274 * MiB, WS_KD = 278 * MiB, WS_VTG = 282 * MiB, WS_X1B = 290 * MiB, WS_SGST = 322 * MiB, WS_SGW = 323 * MiB, WS_END = 324 * MiB;

constexpr int LDS_BYTES = 135168;

struct Params {
    const float* x; const float* c; const int* pos; const float* w_mod; const float* b_mod; const float* g_pre; const float* g_post;
    const float* w_in; const float* w_out; const float* sinks; const float* sg_w; const float* sg_b; const float* sg_ln_g; const float* sg_ln_b;
    const float* gla_wup; const float* gla_bg; const float* gla_ng;
    float* out; unsigned char* ws; int ph_lo, ph_hi;
};

__device__ __forceinline__ Params fresh_params(const Params& p) {
#if defined(__HIP_DEVICE_COMPILE__)
    typedef unsigned long long u64;
    const __attribute__((address_space(4))) u64* pp = (const __attribute__((address_space(4))) u64*)__builtin_amdgcn_kernarg_segment_ptr();
    asm volatile("" : "+s"(pp));
    Params q; u64* dst = (u64*)&q;
#pragma unroll
    for (int i = 0; i < (int)(sizeof(Params) / 8); ++i) dst[i] = pp[i];
    return q;
#else
    return p;
#endif
}
static_assert(sizeof(Params) % 8 == 0, "Params is copied in 8-byte words");

typedef __bf16 bf16x2_t __attribute__((ext_vector_type(2)));
__device__ __forceinline__ unsigned cvt_pk_bf16(float lo, float hi) { const f32x2 v = {lo, hi}; const bf16x2_t b = __builtin_convertvector(v, bf16x2_t); return __builtin_bit_cast(unsigned, b); }
__device__ __forceinline__ float bf_lo(unsigned u) { return __builtin_bit_cast(float, u << 16); }
__device__ __forceinline__ float bf_hi(unsigned u) { return __builtin_bit_cast(float, u & 0xffff0000u); }
__device__ __forceinline__ float bf1(bf16_t v) { return __builtin_bit_cast(float, (unsigned)v << 16); }
__device__ __forceinline__ bf16_t f2bf(float f) { return (bf16_t)(cvt_pk_bf16(f, 0.f) & 0xffffu); }
__device__ __forceinline__ float fast_exp2(float x) { return __builtin_amdgcn_exp2f(x); }
__device__ __forceinline__ float fast_rcp(float x) { return __builtin_amdgcn_rcpf(x); }
__device__ __forceinline__ float silu_f(float x) { return x * fast_rcp(1.f + fast_exp2(-x * LOG2E)); }
__device__ __forceinline__ float gelu_tanh_f(float x) { const float u = 0.7978845608028654f * (x + 0.044715f * x * x * x); return x * fast_rcp(1.f + fast_exp2(-2.f * LOG2E * u)); }
__device__ __forceinline__ float wave_sum(float v) {
#pragma unroll
    for (int o = 1; o < 64; o <<= 1) v += __shfl_xor(v, o);
    return v;
}

typedef short v4i16_t __attribute__((ext_vector_type(4)));
__device__ __forceinline__ bf16x8 tr_operand(const void* p0, const void* p1) {
    const v4i16_t a = __builtin_amdgcn_ds_read_tr16_b64_v4i16((__attribute__((address_space(3))) v4i16_t*)p0);
    const v4i16_t b = __builtin_amdgcn_ds_read_tr16_b64_v4i16((__attribute__((address_space(3))) v4i16_t*)p1);
    return __builtin_shufflevector(a, b, 0, 1, 2, 3, 4, 5, 6, 7);
}
#define MFMA16(a, b, c) __builtin_amdgcn_mfma_f32_16x16x32_bf16((a), (b), (c), 0, 0, 0)

namespace pg8 {
#define PG8_LAS __attribute__((address_space(3)))
constexpr int BM = 256, BK = 64, HALF = 128, HTB = HALF * BK * 2, STAGE_BYTES = 8 * HTB, NXCD = 8, WGM = 8;
__host__ __device__ __forceinline__ int lds_byte(int r, int c) { const int st = (r >> 4) * 2 + (c >> 5), rr = r & 15, cc = c & 31, ob = rr * 64 + cc * 2; return st * 1024 + (ob ^ (((ob >> 9) & 1) << 5)); }
__host__ __device__ __forceinline__ void stage_rc(int b, int& R, int& C) { const int st = b / 1024, sb = b % 1024, swz = sb ^ (((sb >> 9) & 1) << 5); R = (st >> 1) * 16 + swz / 64; C = (st & 1) * 32 + (swz % 64) / 2; }
__host__ __device__ __forceinline__ int perm32(int rho) { const int n = rho >> 4, i = rho & 15; return 8 * (i >> 2) + 4 * n + (i & 3); }
struct Unit { int pm, pn; };
struct Gemm { const bf16_t* A; const bf16_t* Bt; int M, N, K; };
struct StaticOrder {
    int nM, nN, nwg, G, c;
    __host__ __device__ void init(int M_, int N_, int G_, int c_) { nM = M_ / BM; nN = N_ / BM; nwg = nM * nN; G = G_; c = c_; }
    __host__ __device__ bool next(int i, Unit& u) const {
        const long L = (long)i * G + c; if (L >= nwg) return false;
        int wgid = (int)L; { const int q = nwg / NXCD, r = nwg % NXCD, xcd = wgid % NXCD, off = wgid / NXCD; wgid = (xcd < r ? xcd * (q + 1) : r * (q + 1) + (xcd - r) * q) + off; }
        const int nig = WGM * nN, gid = wgid / nig, fm = gid * WGM, gsz = (nM - fm) < WGM ? (nM - fm) : WGM;
        u.pm = fm + ((wgid % nig) % gsz); u.pn = (wgid % nig) / gsz; return true;
    }
    __device__ __forceinline__ void a_ready(const Unit&) const {}
    __device__ __forceinline__ void done(const Unit&) const {}
};

template <class Epi, class Sched, bool ALIGN_EPI = false, bool SP2 = false>
__device__ __forceinline__ void gemm_phase(PG8_LAS unsigned char* lds, const Gemm g, const Sched& S, const Epi& E, const int tid) {
    const int wid = __builtin_amdgcn_readfirstlane(tid >> 6), lane = tid & 63, wr = wid >> 2, wc = wid & 3, fr = lane & 15, fq = lane >> 4;
    const int K = g.K, nt = K / BK;
    unsigned voffA[2], voffB[2];
#pragma unroll
    for (int i = 0; i < 2; ++i) { int R, C; stage_rc(tid * 16 + i * 8192, R, C); const int Rb = Epi::PERM ? ((R & ~31) + perm32(R & 31)) : R;
        voffA[i] = (unsigned)(R * K + C) * 2u; voffB[i] = (unsigned)(Rb * K + C) * 2u; }
    const size_t kstep = (size_t)(BK * 2);
    const size_t hstep = (size_t)HALF * K * 2;
    const size_t tstep = 2 * hstep;
    const unsigned ldsw = (unsigned)wid * 1024u;
    const int aoff = lds_byte(wr * 64 + fr, fq * 8), boff = lds_byte(wc * 32 + fr, fq * 8);
#define PG8_SA(b, h) (((b) * 2 + (h)) * HTB)
#define PG8_SB(b, h) ((4 + (b) * 2 + (h)) * HTB)
#define PG8_STAGE(bufoff, gbase, voff) do { _Pragma("unroll") for (int _i = 0; _i < 2; ++_i) \
        __builtin_amdgcn_global_load_lds((const unsigned*)((const char*)(gbase) + (voff)[_i]), (PG8_LAS unsigned*)(lds + (bufoff) + ldsw + _i * 8192), 16, 0, 0); } while (0)
#define PG8_LDA(dst, b, h) do { _Pragma("unroll") for (int m = 0; m < 4; ++m) _Pragma("unroll") for (int k = 0; k < 2; ++k) dst[m][k] = *(const PG8_LAS bf16x8*)(lds + PG8_SA(b, h) + aoff + m * 2048 + k * 1024); } while (0)
#define PG8_LDB(dst, b, h) do { _Pragma("unroll") for (int n = 0; n < 2; ++n) _Pragma("unroll") for (int k = 0; k < 2; ++k) dst[n][k] = *(const PG8_LAS bf16x8*)(lds + PG8_SB(b, h) + boff + n * 2048 + k * 1024); } while (0)
#define PG8_MMA(ai, bj, At, Bt) do { __builtin_amdgcn_s_setprio(1); _Pragma("unroll") for (int m = 0; m < 4; ++m) _Pragma("unroll") for (int n = 0; n < 2; ++n) _Pragma("unroll") for (int k = 0; k < 2; ++k) \
        acc[ai][bj][m][n] = __builtin_amdgcn_mfma_f32_16x16x32_bf16(Bt[n][k], At[m][k], acc[ai][bj][m][n], 0, 0, 0); __builtin_amdgcn_s_setprio(0); } while (0)
#define PG8_WAIT_V(n) asm volatile("s_waitcnt vmcnt(" #n ")" ::: "memory")
#define PG8_WAIT_L(n) asm volatile("s_waitcnt lgkmcnt(" #n ")" ::: "memory")
#define PG8_BAR __builtin_amdgcn_s_barrier()
#define PG8_SCHED __builtin_amdgcn_sched_barrier(0)
    Unit cur, nxt; int ui = 0;
    if (!S.next(0, cur)) return;
    f32x4 acc[2][2][4][2];
#pragma unroll
    for (int a = 0; a < 2; ++a)
#pragma unroll
        for (int b = 0; b < 2; ++b)
#pragma unroll
            for (int m = 0; m < 4; ++m)
#pragma unroll
                for (int n = 0; n < 2; ++n) acc[a][b][m][n] = (f32x4){0.f, 0.f, 0.f, 0.f};
    bf16x8 At[4][2], B0[2][2], B1[2][2];
    const char* cA = (const char*)g.A + (size_t)cur.pm * tstep; const char* cB = (const char*)g.Bt + (size_t)cur.pn * tstep;
    S.a_ready(cur);
    if constexpr (SP2) {
        PG8_STAGE(PG8_SB(0, 0), cB, voffB); PG8_STAGE(PG8_SB(0, 1), cB + hstep, voffB); PG8_STAGE(PG8_SA(0, 0), cA, voffA); PG8_STAGE(PG8_SA(0, 1), cA + hstep, voffA);
        if (wr == 1) PG8_BAR;
        PG8_WAIT_V(2); PG8_BAR;
        PG8_STAGE(PG8_SB(1, 0), cB + kstep, voffB); PG8_STAGE(PG8_SA(1, 0), cA + kstep, voffA); PG8_STAGE(PG8_SB(1, 1), cB + hstep + kstep, voffB);
        PG8_WAIT_V(6); PG8_BAR;
    } else {
        PG8_STAGE(PG8_SB(0, 0), cB, voffB); PG8_STAGE(PG8_SA(0, 0), cA, voffA); PG8_STAGE(PG8_SB(0, 1), cB + hstep, voffB); PG8_STAGE(PG8_SA(0, 1), cA + hstep, voffA);
        if (wr == 1) PG8_BAR;
        PG8_WAIT_V(4); PG8_BAR;
        PG8_STAGE(PG8_SB(1, 0), cB + kstep, voffB); PG8_STAGE(PG8_SA(1, 0), cA + kstep, voffA); PG8_STAGE(PG8_SB(1, 1), cB + hstep + kstep, voffB);
        PG8_WAIT_V(6); PG8_BAR;
    }
    for (;;) {
        const bool has_next = S.next(ui + 1, nxt);
        const char* nA = has_next ? (const char*)g.A + (size_t)nxt.pm * tstep : cA; const char* nB = has_next ? (const char*)g.Bt + (size_t)nxt.pn * tstep : cB;
        for (int t = 0; t < nt; t += 2) {
            const bool last = (t == nt - 2);
            const char* a1 = cA + (size_t)(t + 1) * kstep;
            const char* a2 = last ? nA : cA + (size_t)(t + 2) * kstep; const char* b2 = last ? nB : cB + (size_t)(t + 2) * kstep;
            const char* a3 = a2 + kstep; const char* b3 = b2 + kstep;
            if (last && has_next) S.a_ready(nxt);
            if constexpr (SP2) {
            PG8_LDB(B0, 0, 0); PG8_LDB(B1, 0, 1); PG8_SCHED; PG8_LDA(At, 0, 0); PG8_STAGE(PG8_SA(1, 1), a1 + hstep, voffA);
            PG8_WAIT_V(8); PG8_WAIT_L(0); PG8_BAR; PG8_MMA(0, 0, At, B0); PG8_MMA(0, 1, At, B1); PG8_BAR; PG8_SCHED;
            PG8_LDA(At, 0, 1); PG8_STAGE(PG8_SB(0, 0), b2, voffB); PG8_STAGE(PG8_SB(0, 1), b2 + hstep, voffB); PG8_STAGE(PG8_SA(0, 0), a2, voffA);
            PG8_WAIT_V(8); PG8_WAIT_L(0); PG8_BAR; PG8_MMA(1, 0, At, B0); PG8_MMA(1, 1, At, B1); PG8_BAR; PG8_SCHED;
            PG8_LDB(B0, 1, 0); PG8_LDB(B1, 1, 1); PG8_SCHED; PG8_LDA(At, 1, 0); PG8_STAGE(PG8_SA(0, 1), a2 + hstep, voffA);
            PG8_WAIT_V(8); PG8_WAIT_L(0); PG8_BAR; PG8_MMA(0, 0, At, B0); PG8_MMA(0, 1, At, B1); PG8_BAR; PG8_SCHED;
            PG8_LDA(At, 1, 1); PG8_STAGE(PG8_SB(1, 0), b3, voffB); PG8_STAGE(PG8_SB(1, 1), b3 + hstep, voffB); PG8_STAGE(PG8_SA(1, 0), a3, voffA);
            PG8_WAIT_V(8); PG8_WAIT_L(0); PG8_BAR; PG8_MMA(1, 0, At, B0); PG8_MMA(1, 1, At, B1); PG8_BAR; PG8_SCHED;
            } else {
            PG8_LDB(B0, 0, 0); PG8_SCHED; PG8_LDA(At, 0, 0); PG8_STAGE(PG8_SA(1, 1), a1 + hstep, voffA);
            PG8_WAIT_L(8); PG8_BAR; PG8_WAIT_L(0); PG8_MMA(0, 0, At, B0); PG8_BAR; PG8_SCHED;
            PG8_LDB(B1, 0, 1); PG8_STAGE(PG8_SB(0, 0), b2, voffB);
            PG8_BAR; PG8_WAIT_L(0); PG8_MMA(0, 1, At, B1); PG8_BAR;
            PG8_LDA(At, 0, 1); PG8_STAGE(PG8_SA(0, 0), a2, voffA);
            PG8_BAR; PG8_WAIT_L(0); PG8_MMA(1, 0, At, B0); PG8_BAR; PG8_SCHED;
            PG8_STAGE(PG8_SB(0, 1), b2 + hstep, voffB);
            PG8_WAIT_V(6); PG8_BAR; PG8_MMA(1, 1, At, B1); PG8_BAR;
            PG8_LDB(B0, 1, 0); PG8_SCHED; PG8_LDA(At, 1, 0); PG8_STAGE(PG8_SA(0, 1), a2 + hstep, voffA);
            PG8_WAIT_L(8); PG8_BAR; PG8_WAIT_L(0); PG8_MMA(0, 0, At, B0); PG8_BAR; PG8_SCHED;
            PG8_LDB(B1, 1, 1); PG8_STAGE(PG8_SB(1, 0), b3, voffB);
            PG8_BAR; PG8_WAIT_L(0); PG8_MMA(0, 1, At, B1); PG8_BAR;
            PG8_LDA(At, 1, 1); PG8_STAGE(PG8_SA(1, 0), a3, voffA);
            PG8_BAR; PG8_WAIT_L(0); PG8_MMA(1, 0, At, B0); PG8_BAR; PG8_SCHED;
            PG8_STAGE(PG8_SB(1, 1), b3 + hstep, voffB);
            PG8_WAIT_V(6); PG8_BAR; PG8_MMA(1, 1, At, B1); PG8_BAR;
            }
        }
        if constexpr (ALIGN_EPI) { if (wr == 0) PG8_BAR; }
        E(acc, cur, wr, wc, fr, fq); S.done(cur);
        if (!has_next) break;
#pragma unroll
        for (int a = 0; a < 2; ++a)
#pragma unroll
            for (int b = 0; b < 2; ++b)
#pragma unroll
                for (int m = 0; m < 4; ++m)
#pragma unroll
                    for (int n = 0; n < 2; ++n) acc[a][b][m][n] = (f32x4){0.f, 0.f, 0.f, 0.f};
        cur = nxt; cA = nA; cB = nB; ++ui;
        if constexpr (ALIGN_EPI) { if (wr == 1) PG8_BAR; }
    }
    PG8_WAIT_V(0);
    if constexpr (!ALIGN_EPI) { if (wr == 0) PG8_BAR; }
    PG8_BAR;
#undef PG8_SA
#undef PG8_SB
#undef PG8_STAGE
#undef PG8_LDA
#undef PG8_LDB
#undef PG8_MMA
#undef PG8_WAIT_V
#undef PG8_WAIT_L
#undef PG8_BAR
#undef PG8_SCHED
}

struct EpiProj {
    static constexpr bool PERM = true;
    bf16_t* P; float* CG; float* SGST;
    template <int ACT> __device__ __forceinline__ void store_tile(const f32x4 (&acc)[2][2][4][2], bf16_t* base, float* stp, int fq) const {
#pragma unroll
        for (int ai = 0; ai < 2; ++ai)
#pragma unroll
            for (int m = 0; m < 4; ++m) { bf16_t* rowp = base + (size_t)(ai * HALF + m * 16) * NPROJ;
                float rs = 0.f, rq = 0.f;
#pragma unroll
                for (int bj = 0; bj < 2; ++bj) { f32x4 v0 = acc[ai][bj][m][0], v1 = acc[ai][bj][m][1];
                    if (ACT == 1) { for (int e = 0; e < 4; ++e) { v0[e] = gelu_tanh_f(v0[e]); v1[e] = gelu_tanh_f(v1[e]); } }
                    if (ACT == 2) { for (int e = 0; e < 4; ++e) { v0[e] = silu_f(v0[e]); v1[e] = silu_f(v1[e]); } }
                    if (ACT == 1) { rs += ((v0[0] + v0[1]) + (v0[2] + v0[3])) + ((v1[0] + v1[1]) + (v1[2] + v1[3]));
                        rq += ((v0[0] * v0[0] + v0[1] * v0[1]) + (v0[2] * v0[2] + v0[3] * v0[3])) + ((v1[0] * v1[0] + v1[1] * v1[1]) + (v1[2] * v1[2] + v1[3] * v1[3])); }
                    u32x4 w; w.x = cvt_pk_bf16(v0[0], v0[1]); w.y = cvt_pk_bf16(v0[2], v0[3]); w.z = cvt_pk_bf16(v1[0], v1[1]); w.w = cvt_pk_bf16(v1[2], v1[3]);
                    *(u32x4*)(rowp + bj * HALF) = w; }
                if (ACT == 1) { if (stp) { rs += __shfl_xor(rs, 16); rs += __shfl_xor(rs, 32); rq += __shfl_xor(rq, 16); rq += __shfl_xor(rq, 32);
                    if (fq == 0) *(f32x2*)(stp + (size_t)(ai * HALF + m * 16) * 16) = (f32x2){rs, rq}; } } }
    }
    __device__ __forceinline__ void operator()(const f32x4 (&acc)[2][2][4][2], const Unit& u, int wr, int wc, int fr, int fq) const {
        const int row0 = u.pm * BM + wr * 64 + fr;
        if (u.pn < 22) {
            bf16_t* base = P + (size_t)row0 * NPROJ + u.pn * BM + wc * 32 + 8 * fq;
            if (u.pn >= 6 && u.pn < 10) store_tile<1>(acc, base, (u.pn >= 8) ? SGST + (size_t)row0 * 16 + ((u.pn - 8) * 4 + wc) * 2 : nullptr, fq);
            else if (u.pn >= 14) store_tile<2>(acc, base, nullptr, fq);
            else store_tile<0>(acc, base, nullptr, fq);
        } else if (wc == 0 && fq < 2) {
#pragma unroll
            for (int ai = 0; ai < 2; ++ai)
#pragma unroll
                for (int m = 0; m < 4; ++m) { float* p = CG + (size_t)(row0 + ai * HALF + m * 16) * 16 + 8 * fq;
                    *(f32x4*)p = acc[ai][0][m][0]; *(f32x4*)(p + 4) = acc[ai][0][m][1]; }
        }
    }
};
struct EpiOut {
    static constexpr bool PERM = true;
    bf16_t* O;
    __device__ __forceinline__ void operator()(const f32x4 (&acc)[2][2][4][2], const Unit& u, int wr, int wc, int fr, int fq) const {
        bf16_t* base = O + (size_t)(u.pm * BM + wr * 64 + fr) * D + u.pn * BM + wc * 32 + 8 * fq;
#pragma unroll
        for (int ai = 0; ai < 2; ++ai)
#pragma unroll
            for (int m = 0; m < 4; ++m) { bf16_t* rowp = base + (size_t)(ai * HALF + m * 16) * D;
#pragma unroll
                for (int bj = 0; bj < 2; ++bj) { const f32x4 v0 = acc[ai][bj][m][0], v1 = acc[ai][bj][m][1];
                    u32x4 w; w.x = cvt_pk_bf16(v0[0], v0[1]); w.y = cvt_pk_bf16(v0[2], v0[3]); w.z = cvt_pk_bf16(v1[0], v1[1]); w.w = cvt_pk_bf16(v1[2], v1[3]);
                    *(u32x4*)(rowp + bj * HALF) = w; } }
    }
};
}

__device__ __forceinline__ void p0_transpose_item(const float* W, int ldw, int n_src0, bf16_t* WT, int row_dst0, int kb, float* scr, int lane) {
    const int k0 = 64 * kb;
    {   const int kr = lane >> 3, c4 = 4 * (lane & 7);
        const float* src = W + (size_t)(k0 + kr) * ldw + n_src0 + c4;
        f32x4 v[8];
#pragma unroll
        for (int i = 0; i < 8; ++i) v[i] = __builtin_nontemporal_load((const f32x4*)(src + (size_t)(8 * i) * ldw));
#pragma unroll
        for (int i = 0; i < 8; ++i) { float* d = scr + (8 * i + kr) * 33 + c4; d[0] = v[i][0]; d[1] = v[i][1]; d[2] = v[i][2]; d[3] = v[i][3]; }
    }
    asm volatile("s_waitcnt lgkmcnt(0)" ::: "memory");
    const int c = lane & 7;
#pragma unroll
    for (int j = 0; j < 4; ++j) { const int n = (lane >> 3) + 8 * j; const float* s = scr + (8 * c) * 33 + n;
        u32x4 o; o.x = cvt_pk_bf16(s[0 * 33], s[1 * 33]); o.y = cvt_pk_bf16(s[2 * 33], s[3 * 33]); o.z = cvt_pk_bf16(s[4 * 33], s[5 * 33]); o.w = cvt_pk_bf16(s[6 * 33], s[7 * 33]);
        *(u32x4*)(WT + (size_t)(row_dst0 + n) * D + k0 + 8 * c) = o; }
    asm volatile("s_waitcnt lgkmcnt(0)" ::: "memory");
}

__device__ __forceinline__ void mod_items(const Params& p, int l, unsigned char* lds, int tid, int wave, int lane, int bx) {
    const int G = gridDim.x;
    if (bx >= 192) return;
    float* sc = (float*)lds;
    float* red = (float*)(lds + 32768);
    for (int i = tid; i < 4 * D; i += 512) { const int b = i >> 11, k = i & (D - 1); sc[k * 4 + b] = silu_f(p.c[i]); }
    __syncthreads();
    for (int it = bx; it < 192; it += G) {
        const int n0 = 32 * it;
        const int r8 = lane >> 3, c4 = lane & 7;
        const float* wp = p.w_mod + ((size_t)l * D + wave * 256 + r8) * 6144 + n0 + 4 * c4;
        f32x4 a0 = {0, 0, 0, 0}, a1 = a0, a2 = a0, a3 = a0;
#pragma unroll 8
        for (int i = 0; i < 32; ++i) {
            const f32x4 w = __builtin_nontemporal_load((const f32x4*)(wp + (size_t)(8 * i) * 6144));
            const f32x4 s = *(const f32x4*)(sc + (wave * 256 + 8 * i + r8) * 4);
            a0 += w * s[0]; a1 += w * s[1]; a2 += w * s[2]; a3 += w * s[3];
        }
#pragma unroll
        for (int e = 0; e < 4; ++e) {
#pragma unroll
            for (int o = 8; o < 64; o <<= 1) { a0[e] += __shfl_xor(a0[e], o); a1[e] += __shfl_xor(a1[e], o); a2[e] += __shfl_xor(a2[e], o); a3[e] += __shfl_xor(a3[e], o); }
        }
        if (r8 == 0) {
            *(f32x4*)(red + (wave * 4 + 0) * 32 + 4 * c4) = a0; *(f32x4*)(red + (wave * 4 + 1) * 32 + 4 * c4) = a1;
            *(f32x4*)(red + (wave * 4 + 2) * 32 + 4 * c4) = a2; *(f32x4*)(red + (wave * 4 + 3) * 32 + 4 * c4) = a3;
        }
        __syncthreads();
        if (tid < 128) { const int b = tid >> 5, col = tid & 31; float s = p.b_mod[l * 6144 + n0 + col];
#pragma unroll
            for (int w = 0; w < 8; ++w) s += red[(w * 4 + b) * 32 + col];
            ((float*)(p.ws + WS_MOD))[(l * 4 + b) * 6144 + n0 + col] = s; }
        __syncthreads();
    }
}

__device__ __forceinline__ void p0_transposes(const Params& p, unsigned char* lds, int wave, int lane, int bx, int part) {
    const int G = gridDim.x;
    unsigned char* ws = p.ws;
    float* scr = (float*)(lds + wave * 16384);
    constexpr int PER_L = 32 * 240, NIT = 2 * PER_L;
    int base, end, stride;
    if (G == 256) {
        if (part == 0) { if (bx < 192) return; base = 13824 + (bx - 192) * 24; end = base + 24; }
        else if (bx < 192) { base = 49 * bx; end = base + 49; } else { base = 9408 + (bx - 192) * 69; end = base + 69; }
        base += wave; stride = 8;
    } else { if (part == 0) return; base = bx * 8 + wave; end = NIT; stride = G * 8; }
    for (int it = base; it < end; it += stride) {
        const int l = it / PER_L, r = it % PER_L, kb = r / 240, j = r % 240;
        bf16_t* WinT = (bf16_t*)(ws + WS_WIN + (size_t)l * WIN_BYTES);
        bf16_t* WoT = (bf16_t*)(ws + WS_WOUT + (size_t)l * WOUT_BYTES);
        if (j < 112) p0_transpose_item(p.w_in + (size_t)l * D * WIN_LD, WIN_LD, 32 * j, WinT, 32 * j, kb, scr, lane);
        else if (j < 176) p0_transpose_item(p.w_in + (size_t)l * D * WIN_LD, WIN_LD, 3600 + 32 * (j - 112), WinT, 3584 + 32 * (j - 112), kb, scr, lane);
        else p0_transpose_item(p.w_out + (size_t)l * D * D, D, 32 * (j - 176), WoT, 32 * (j - 176), kb, scr, lane);
    }
}

__device__ __forceinline__ void p0_convert(const Params& p, unsigned char* lds, int tid, int wave, int lane, int bx) {
    const int G = gridDim.x;
    unsigned char* ws = p.ws;
    {
        const int gt = bx * 512 + tid, NT = G * 512;
        for (int i = gt; i < 2 * 256 * (D / 8); i += NT) {
            const int l = i / (256 * (D / 8)), r = i % (256 * (D / 8)), j = r / (D / 8), k8 = (r % (D / 8)) * 8;
            u32x4 o = {0u, 0u, 0u, 0u};
            if (j < 16) { const float* s = p.w_in + ((size_t)l * D + k8) * WIN_LD + 3584 + j;
                o.x = cvt_pk_bf16(s[0], s[WIN_LD]); o.y = cvt_pk_bf16(s[2 * WIN_LD], s[3 * WIN_LD]); o.z = cvt_pk_bf16(s[4 * WIN_LD], s[5 * WIN_LD]); o.w = cvt_pk_bf16(s[6 * WIN_LD], s[7 * WIN_LD]); }
            *(u32x4*)((bf16_t*)(ws + WS_WIN + (size_t)l * WIN_BYTES) + (size_t)(5632 + j) * D + k8) = o;
        }
    }
    {
        const int gt = bx * 512 + tid;
        if (gt < 2 * 8 * 128 * 16) {
            const int t = (gt >> 4) & 127, s0 = (gt & 15) * 8;
            const float* src = p.sg_w + (size_t)gt * 8;
            const f32x4 f0 = *(const f32x4*)src, f1 = *(const f32x4*)(src + 4);
            float w[8] = {f0[0], f0[1], f0[2], f0[3], f1[0], f1[1], f1[2], f1[3]};
#pragma unroll
            for (int e = 0; e < 8; ++e) w[e] = (s0 + e <= t) ? w[e] : 0.f;
            *(u32x4*)((bf16_t*)(ws + WS_SGW) + (size_t)gt * 8) = (u32x4){cvt_pk_bf16(w[0], w[1]), cvt_pk_bf16(w[2], w[3]), cvt_pk_bf16(w[4], w[5]), cvt_pk_bf16(w[6], w[7])};
        }
    }
    p0_transposes(p, lds, wave, lane, bx, 1);
}

__device__ __forceinline__ void row_pass(const Params& p, int mode, int wave, int lane, int bx) {
    const int gw = bx * 8 + wave, NGW = gridDim.x * 8;
    unsigned char* ws = p.ws;
    const float* mod = (const float*)(ws + WS_MOD);
    const bf16_t* OUTB = (const bf16_t*)(ws + WS_OUT);
    bf16_t* H = (bf16_t*)(ws + WS_H);
    const int lpost = (mode == 2) ? 1 : 0, lpre = (mode == 0) ? 0 : 1;
    for (int gi = gw; gi < M / 4; gi += NGW) {
        const int r0 = 4 * gi, b = r0 >> 11;
        f32x4 gg[4][2], aa[4][2], tt[4][2];
        if (mode >= 1) {
            const float* gate = mod + (size_t)(lpost * 4 + b) * 6144 + 4096; const float* gp = p.g_post + lpost * D;
#pragma unroll
            for (int j = 0; j < 4; ++j)
#pragma unroll
                for (int h = 0; h < 2; ++h) { const int col = 8 * lane + 512 * j + 4 * h; gg[j][h] = *(const f32x4*)(gate + col) * *(const f32x4*)(gp + col); }
        }
        if (mode <= 1) {
            const float* shift = mod + (size_t)(lpre * 4 + b) * 6144; const float* scale = shift + 2048; const float* gp = p.g_pre + lpre * D;
#pragma unroll
            for (int j = 0; j < 4; ++j)
#pragma unroll
                for (int h = 0; h < 2; ++h) { const int col = 8 * lane + 512 * j + 4 * h;
                    aa[j][h] = *(const f32x4*)(gp + col) * (*(const f32x4*)(scale + col) + 1.f); tt[j][h] = *(const f32x4*)(shift + col); }
        }
#pragma unroll 1
        for (int k = 0; k < 4; ++k) {
            const int r = r0 + k;
            f32x4 v[4][2];
            if (mode == 2) {
                const bf16_t* x1b = (const bf16_t*)(ws + WS_X1B) + (size_t)r * D;
#pragma unroll
                for (int j = 0; j < 4; ++j) { const u32x4 w = *(const u32x4*)(x1b + 8 * lane + 512 * j);
                    v[j][0] = (f32x4){bf_lo(w.x), bf_hi(w.x), bf_lo(w.y), bf_hi(w.y)}; v[j][1] = (f32x4){bf_lo(w.z), bf_hi(w.z), bf_lo(w.w), bf_hi(w.w)}; }
            } else {
                const float* xin = p.x + (size_t)r * D;
#pragma unroll
                for (int j = 0; j < 4; ++j) { v[j][0] = *(const f32x4*)(xin + 8 * lane + 512 * j); v[j][1] = *(const f32x4*)(xin + 8 * lane + 512 * j + 4); }
            }
            if (mode >= 1) {
                f32x4 o[4][2]; float ss = 0.f;
#pragma unroll
                for (int j = 0; j < 4; ++j) { const u32x4 w = *(const u32x4*)(OUTB + (size_t)r * D + 8 * lane + 512 * j);
                    o[j][0] = (f32x4){bf_lo(w.x), bf_hi(w.x), bf_lo(w.y), bf_hi(w.y)}; o[j][1] = (f32x4){bf_lo(w.z), bf_hi(w.z), bf_lo(w.w), bf_hi(w.w)};
#pragma unroll
                    for (int h = 0; h < 2; ++h) ss += (o[j][h][0] * o[j][h][0] + o[j][h][1] * o[j][h][1]) + (o[j][h][2] * o[j][h][2] + o[j][h][3] * o[j][h][3]); }
                const float rstd = rsqrtf(wave_sum(ss) * (1.f / D) + EPS);
                float* xo = p.out + (size_t)r * D;
#pragma unroll
                for (int j = 0; j < 4; ++j)
#pragma unroll
                    for (int h = 0; h < 2; ++h) { const int col = 8 * lane + 512 * j + 4 * h;
                        v[j][h] = v[j][h] + gg[j][h] * (o[j][h] * rstd);
                        if (mode == 2) *(f32x4*)(xo + col) = v[j][h]; }
                if (mode == 1) {
                    bf16_t* x1b = (bf16_t*)(ws + WS_X1B) + (size_t)r * D;
#pragma unroll
                    for (int j = 0; j < 4; ++j) { u32x4 w; w.x = cvt_pk_bf16(v[j][0][0], v[j][0][1]); w.y = cvt_pk_bf16(v[j][0][2], v[j][0][3]); w.z = cvt_pk_bf16(v[j][1][0], v[j][1][1]); w.w = cvt_pk_bf16(v[j][1][2], v[j][1][3]);
                        *(u32x4*)(x1b + 8 * lane + 512 * j) = w;
                        v[j][0] = (f32x4){bf_lo(w.x), bf_hi(w.x), bf_lo(w.y), bf_hi(w.y)}; v[j][1] = (f32x4){bf_lo(w.z), bf_hi(w.z), bf_lo(w.w), bf_hi(w.w)}; }
                }
            }
            if (mode <= 1) {
                float ss = 0.f;
#pragma unroll
                for (int j = 0; j < 4; ++j)
#pragma unroll
                    for (int h = 0; h < 2; ++h) ss += (v[j][h][0] * v[j][h][0] + v[j][h][1] * v[j][h][1]) + (v[j][h][2] * v[j][h][2] + v[j][h][3] * v[j][h][3]);
                const float rstd = rsqrtf(wave_sum(ss) * (1.f / D) + EPS);
#pragma unroll
                for (int j = 0; j < 4; ++j) { f32x4 hh[2];
#pragma unroll
                    for (int h = 0; h < 2; ++h) hh[h] = (v[j][h] * rstd) * aa[j][h] + tt[j][h];
                    u32x4 w; w.x = cvt_pk_bf16(hh[0][0], hh[0][1]); w.y = cvt_pk_bf16(hh[0][2], hh[0][3]); w.z = cvt_pk_bf16(hh[1][0], hh[1][1]); w.w = cvt_pk_bf16(hh[1][2], hh[1][3]);
                    *(u32x4*)(H + (size_t)r * D + 8 * lane + 512 * j) = w; }
            }
        }
    }
}

__device__ __forceinline__ void rope_cs(int pos, int i, float& cs, float& sn) {
    constexpr float F[8] = {0.15915494309189535f, 0.03086376340470123f, 0.005985185712713705f, 0.001160663641240061f,
                            0.00022507907903927653f, 4.364795279280289e-05f, 8.464330808241401e-06f, 1.6414262627950345e-06f};
    const float rev = (float)pos * F[i];
    const float r = __builtin_amdgcn_fractf(rev);
    sn = __builtin_amdgcn_sinf(r); cs = __builtin_amdgcn_cosf(r);
}
constexpr int KS_LD = 72, VS_LD = 72;
__device__ __forceinline__ void attn_item(const Params& p, int l, int item, unsigned char* lds, int tid, int wave, int lane) {
    const int b = item >> 6, n = (item >> 2) & 15, g = item & 3;
    const int fr = lane & 15, fq = lane >> 4;
    bf16_t* Ks = (bf16_t*)lds;
    bf16_t* Vs = (bf16_t*)(lds + 256 * KS_LD * 2);
    const bf16_t* proj = (const bf16_t*)(p.ws + WS_PROJ);
    bf16_t* Y = (bf16_t*)(p.ws + WS_Y);
    const int r = wave >> 1, qh = wave & 1, hq = g * 4 + r;
    const int tokq0 = b * SEQ + n * 128 + 64 * qh;
    u32x4 qraw[4][2]; int qpos[4];
#pragma unroll
    for (int nb = 0; nb < 4; ++nb) {
        const int tok = tokq0 + 16 * nb + fr;
        const bf16_t* qp = proj + (size_t)tok * NPROJ + C_AQ + hq * 64 + 8 * fq;
        qraw[nb][0] = *(const u32x4*)qp; qraw[nb][1] = *(const u32x4*)(qp + 32); qpos[nb] = p.pos[tok];
    }
    {
        const int key = tid >> 1, half = tid & 1;
        const int s = n * 128 - 128 + key;
        u32x4 kv[4], vv[4];
#pragma unroll
        for (int c = 0; c < 4; ++c) { kv[c] = (u32x4){0u, 0u, 0u, 0u}; vv[c] = kv[c]; }
        if (s >= 0) {
            const bf16_t* kp = proj + (size_t)(b * SEQ + s) * NPROJ + C_AK + g * 64 + half * 32;
#pragma unroll
            for (int c = 0; c < 4; ++c) { kv[c] = *(const u32x4*)(kp + 8 * c); vv[c] = *(const u32x4*)(kp + 256 + 8 * c); }
            if (half == 0) {
                const int pos = p.pos[b * SEQ + s];
                unsigned a[4] = {kv[0].x, kv[0].y, kv[0].z, kv[0].w}, bb[4] = {kv[1].x, kv[1].y, kv[1].z, kv[1].w};
#pragma unroll
                for (int e = 0; e < 4; ++e) {
                    float c0, s0, c1, s1; rope_cs(pos, 2 * e, c0, s0); rope_cs(pos, 2 * e + 1, c1, s1);
                    const float t1a = bf_lo(a[e]), t1b = bf_hi(a[e]), t2a = bf_lo(bb[e]), t2b = bf_hi(bb[e]);
                    a[e] = cvt_pk_bf16(t1a * c0 - t2a * s0, t1b * c1 - t2b * s1);
                    bb[e] = cvt_pk_bf16(t2a * c0 + t1a * s0, t2b * c1 + t1b * s1);
                }
                kv[0] = (u32x4){a[0], a[1], a[2], a[3]}; kv[1] = (u32x4){bb[0], bb[1], bb[2], bb[3]};
            }
        }
#pragma unroll
        for (int c = 0; c < 4; ++c) *(u32x4*)(Ks + key * KS_LD + half * 32 + 8 * c) = kv[c];
#pragma unroll
        for (int c = 0; c < 4; ++c) *(u32x4*)(Vs + key * VS_LD + half * 32 + 8 * c) = vv[c];
    }
    __syncthreads();
    bf16x8 qf[4][2];
#pragma unroll
    for (int nb = 0; nb < 4; ++nb) {
        const u32x4 q0 = qraw[nb][0], q1 = qraw[nb][1];
        unsigned own[4] = {q0.x, q0.y, q0.z, q0.w}, par[4];
#pragma unroll
        for (int e = 0; e < 4; ++e) par[e] = __shfl_xor(own[e], 16);
        if (fq < 2) {
            const int pos = qpos[nb];
            const float sg = (fq == 0) ? -1.f : 1.f;
#pragma unroll
            for (int e = 0; e < 4; ++e) {
                float c0, s0, c1, s1; rope_cs(pos, 2 * e, c0, s0); rope_cs(pos, 2 * e + 1, c1, s1);
                const float oa = bf_lo(own[e]), ob = bf_hi(own[e]), pa = bf_lo(par[e]), pb = bf_hi(par[e]);
                own[e] = cvt_pk_bf16((oa * c0 + sg * pa * s0) * 0.125f, (ob * c1 + sg * pb * s1) * 0.125f);
            }
        } else {
#pragma unroll
            for (int e = 0; e < 4; ++e) own[e] = cvt_pk_bf16(bf_lo(own[e]) * 0.125f, bf_hi(own[e]) * 0.125f);
        }
        unsigned o1[4] = {q1.x, q1.y, q1.z, q1.w};
#pragma unroll
        for (int e = 0; e < 4; ++e) o1[e] = cvt_pk_bf16(bf_lo(o1[e]) * 0.125f, bf_hi(o1[e]) * 0.125f);
        qf[nb][0] = __builtin_bit_cast(bf16x8, (u32x4){own[0], own[1], own[2], own[3]});
        qf[nb][1] = __builtin_bit_cast(bf16x8, (u32x4){o1[0], o1[1], o1[2], o1[3]});
    }
    const float sink2 = p.sinks[l * 16 + hq] * LOG2E;
    float m_[4], l_[4];
    f32x4 o[4][4];
#pragma unroll
    for (int nb = 0; nb < 4; ++nb) { m_[nb] = sink2; l_[nb] = (fq == 0) ? 1.f : 0.f;
#pragma unroll
        for (int hb = 0; hb < 4; ++hb) o[hb][nb] = (f32x4){0.f, 0.f, 0.f, 0.f}; }
#pragma unroll 2
    for (int step = 0; step < 6; ++step) {
        const int kj0 = 64 * qh + 32 * step;
        if (n == 0 && kj0 + 32 <= 128) continue;
        f32x4 s[2][4];
#pragma unroll
        for (int mb = 0; mb < 2; ++mb)
#pragma unroll
            for (int nb = 0; nb < 4; ++nb) s[mb][nb] = (f32x4){0.f, 0.f, 0.f, 0.f};
#pragma unroll
        for (int mb = 0; mb < 2; ++mb)
#pragma unroll
            for (int kk = 0; kk < 2; ++kk) {
                const bf16x8 a = *(const bf16x8*)(Ks + (kj0 + 16 * mb + fr) * KS_LD + 32 * kk + 8 * fq);
#pragma unroll
                for (int nb = 0; nb < 4; ++nb) s[mb][nb] = MFMA16(a, qf[nb][kk], s[mb][nb]);
            }
        bf16x8 pb[4];
#pragma unroll
        for (int nb = 0; nb < 4; ++nb) {
            const int qi = 64 * qh + 16 * nb + fr;
            float tmax = -1e30f;
#pragma unroll
            for (int mb = 0; mb < 2; ++mb)
#pragma unroll
                for (int j = 0; j < 4; ++j) {
                    const int kj = kj0 + 16 * mb + 4 * fq + j, dist = qi + 128 - kj;
                    const bool valid = ((unsigned)dist < 128u);
                    const float v = valid ? s[mb][nb][j] : -1e30f;
                    s[mb][nb][j] = v; tmax = fmaxf(tmax, v);
                }
            tmax *= LOG2E;
            if (__builtin_amdgcn_ballot_w64(tmax > m_[nb] + 8.f) != 0ull) {
                tmax = fmaxf(tmax, __shfl_xor(tmax, 16)); tmax = fmaxf(tmax, __shfl_xor(tmax, 32));
                const float mnew = fmaxf(m_[nb], tmax), alpha = fast_exp2(m_[nb] - mnew);
                m_[nb] = mnew; l_[nb] = l_[nb] * alpha;
#pragma unroll
                for (int hb = 0; hb < 4; ++hb) o[hb][nb] = o[hb][nb] * alpha;
            }
            const float mref = m_[nb];
            float rs = 0.f;
#pragma unroll
            for (int mb = 0; mb < 2; ++mb)
#pragma unroll
                for (int j = 0; j < 4; ++j) { const float pv = fast_exp2(__builtin_fmaf(s[mb][nb][j], LOG2E, -mref)); s[mb][nb][j] = pv; rs += pv; }
            l_[nb] = l_[nb] + rs;
            pb[nb] = __builtin_bit_cast(bf16x8, (u32x4){cvt_pk_bf16(s[0][nb][0], s[0][nb][1]), cvt_pk_bf16(s[0][nb][2], s[0][nb][3]),
                                                        cvt_pk_bf16(s[1][nb][0], s[1][nb][1]), cvt_pk_bf16(s[1][nb][2], s[1][nb][3])});
        }
#pragma unroll
        for (int hb = 0; hb < 4; ++hb) {
            const bf16_t* vp = Vs + (kj0 + 4 * fq + (fr >> 2)) * VS_LD + 32 * (hb >> 1) + 8 * (fr & 3) + 4 * (hb & 1);
            const bf16x8 a = tr_operand(vp, vp + 16 * VS_LD);
#pragma unroll
            for (int nb = 0; nb < 4; ++nb) o[hb][nb] = MFMA16(a, pb[nb], o[hb][nb]);
        }
    }
#pragma unroll
    for (int nb = 0; nb < 4; ++nb) {
        const int tok = tokq0 + 16 * nb + fr;
        float lt = l_[nb]; lt += __shfl_xor(lt, 16); lt += __shfl_xor(lt, 32);
        const float inv = 1.f / lt;
#pragma unroll
        for (int hp = 0; hp < 2; ++hp) {
            const int col = hq * 64 + 32 * hp + 8 * fq;
            const u32x4 z = *(const u32x4*)(proj + (size_t)tok * NPROJ + C_Z + col);
            const f32x4 a = o[2 * hp][nb] * inv, b2 = o[2 * hp + 1][nb] * inv;
            u32x4 y; y.x = cvt_pk_bf16(a[0] * bf_lo(z.x), a[1] * bf_hi(z.x)); y.y = cvt_pk_bf16(a[2] * bf_lo(z.y), a[3] * bf_hi(z.y));
            y.z = cvt_pk_bf16(b2[0] * bf_lo(z.z), b2[1] * bf_hi(z.z)); y.w = cvt_pk_bf16(b2[2] * bf_lo(z.w), b2[3] * bf_hi(z.w));
            *(u32x4*)(Y + (size_t)tok * D + col) = y;
        }
    }
    __syncthreads();
}

constexpr int VN_LD = 72;
__device__ __forceinline__ void sg_pair_item(const Params& p, int l, int pitem, unsigned char* lds, int tid, int wave, int lane) {
    const int b2 = pitem >> 7, c = (pitem >> 3) & 15, g = pitem & 7;
    const int fr = lane & 15, fq = lane >> 4;
    bf16_t* vnT = (bf16_t*)lds;
    const bf16_t* proj = (const bf16_t*)(p.ws + WS_PROJ);
    bf16_t* Y = (bf16_t*)(p.ws + WS_Y);
    const int s = tid >> 2, qd = tid & 3;
    const int t = 16 * wave + fr;
    int tok0[2];
    tok0[0] = b2 * SEQ + c * 128; tok0[1] = (b2 + 2) * SEQ + c * 128;
    u32x4 vw[2][2]; f32x4 stq[2]; u32x4 uf[2][2], zf[2][2];
#pragma unroll
    for (int q2 = 0; q2 < 2; ++q2) {
        const bf16_t* vp = proj + (size_t)(tok0[q2] + s) * NPROJ + C_SV;
        vw[q2][0] = *(const u32x4*)(vp + 64 * g + 16 * qd); vw[q2][1] = *(const u32x4*)(vp + 64 * g + 16 * qd + 8);
        stq[q2] = *(const f32x4*)((const float*)(p.ws + WS_SGST) + (size_t)(tok0[q2] + s) * 16 + 4 * qd);
#pragma unroll
        for (int mp = 0; mp < 2; ++mp) { const int col = 64 * g + 32 * mp + 8 * fq; const size_t ro = (size_t)(tok0[q2] + t) * NPROJ;
            uf[q2][mp] = *(const u32x4*)(proj + ro + C_SU + col); zf[q2][mp] = *(const u32x4*)(proj + ro + C_Z + 1024 + col); }
    }
    bf16x8 wf[4];
    {   const bf16_t* wrow = (const bf16_t*)(p.ws + WS_SGW) + ((size_t)(l * 8 + g) * 128 + t) * 128;
#pragma unroll
        for (int kk = 0; kk < 4; ++kk) if (32 * kk <= 16 * wave + 15) wf[kk] = *(const bf16x8*)(wrow + 32 * kk + 8 * fq); }
    const float bias = p.sg_b[(l * 8 + g) * 128 + t];
    float lgv[16], lbv[16];
    {   const float* lg = p.sg_ln_g + l * 512 + 64 * g + 16 * qd; const float* lb = p.sg_ln_b + l * 512 + 64 * g + 16 * qd;
#pragma unroll
        for (int i = 0; i < 4; ++i) { const f32x4 a = *(const f32x4*)(lg + 4 * i), bb = *(const f32x4*)(lb + 4 * i);
#pragma unroll
            for (int e = 0; e < 4; ++e) { lgv[4 * i + e] = a[e]; lbv[4 * i + e] = bb[e]; } } }
#pragma unroll
    for (int q2 = 0; q2 < 2; ++q2) {
        float sum = stq[q2][0] + stq[q2][2], sq = stq[q2][1] + stq[q2][3];
        sum += __shfl_xor(sum, 1); sum += __shfl_xor(sum, 2); sq += __shfl_xor(sq, 1); sq += __shfl_xor(sq, 2);
        const float mu = sum * (1.f / 512.f), var = fmaxf(sq * (1.f / 512.f) - mu * mu, 0.f), rstd = rsqrtf(var + EPS);
        bf16_t* vq = vnT + q2 * 128 * VN_LD + s * VN_LD + 16 * qd;
#pragma unroll
        for (int i = 0; i < 2; ++i) { const unsigned ww[4] = {vw[q2][i].x, vw[q2][i].y, vw[q2][i].z, vw[q2][i].w}; unsigned o4[4];
#pragma unroll
            for (int e = 0; e < 4; ++e) { const int ch = 8 * i + 2 * e;
                o4[e] = cvt_pk_bf16((bf_lo(ww[e]) - mu) * rstd * lgv[ch] + lbv[ch], (bf_hi(ww[e]) - mu) * rstd * lgv[ch + 1] + lbv[ch + 1]); }
            *(u32x4*)(vq + 8 * i) = (u32x4){o4[0], o4[1], o4[2], o4[3]}; }
    }
    __syncthreads();
    {
        f32x4 acc[2][4];
#pragma unroll
        for (int q2 = 0; q2 < 2; ++q2)
#pragma unroll
            for (int mb = 0; mb < 4; ++mb) acc[q2][mb] = (f32x4){0.f, 0.f, 0.f, 0.f};
#pragma unroll
        for (int kk = 0; kk < 4; ++kk) {
            if (32 * kk <= 16 * wave + 15) {
                const int s0 = 32 * kk + 8 * fq;
                const bf16x8 bfr = wf[kk];
#pragma unroll
                for (int q2 = 0; q2 < 2; ++q2)
#pragma unroll
                    for (int mb = 0; mb < 4; ++mb) {
                        const bf16_t* ap = vnT + (q2 * 128 + s0 + (fr >> 2)) * VN_LD + 32 * (mb >> 1) + 8 * (fr & 3) + 4 * (mb & 1);
                        acc[q2][mb] = MFMA16(tr_operand(ap, ap + 4 * VN_LD), bfr, acc[q2][mb]); }
            }
        }
#pragma unroll
        for (int q2 = 0; q2 < 2; ++q2)
#pragma unroll
            for (int mp = 0; mp < 2; ++mp) {
                const int col = 64 * g + 32 * mp + 8 * fq;
                const u32x4 u = uf[q2][mp], z = zf[q2][mp];
                const f32x4 a = acc[q2][2 * mp] + bias, b3 = acc[q2][2 * mp + 1] + bias;
                u32x4 y; y.x = cvt_pk_bf16(bf_lo(u.x) * a[0] * bf_lo(z.x), bf_hi(u.x) * a[1] * bf_hi(z.x)); y.y = cvt_pk_bf16(bf_lo(u.y) * a[2] * bf_lo(z.y), bf_hi(u.y) * a[3] * bf_hi(z.y));
                y.z = cvt_pk_bf16(bf_lo(u.z) * b3[0] * bf_lo(z.z), bf_hi(u.z) * b3[1] * bf_hi(z.z)); y.w = cvt_pk_bf16(bf_lo(u.w) * b3[2] * bf_lo(z.w), bf_hi(u.w) * b3[3] * bf_hi(z.w));
                *(u32x4*)(Y + (size_t)(tok0[q2] + t) * D + 1024 + col) = y;
            }
    }
    __syncthreads();
}

constexpr int GL_LD = 72;
struct CgRow { f32x4 c0, c1, c2, c3; };
__device__ __forceinline__ CgRow gla_load_cg(const Params& p, int tok) {
    const float* cgp = (const float*)(p.ws + WS_CG) + (size_t)tok * 16;
    CgRow r; r.c0 = *(const f32x4*)cgp; r.c1 = *(const f32x4*)(cgp + 4); r.c2 = *(const f32x4*)(cgp + 8); r.c3 = *(const f32x4*)(cgp + 12); return r;
}
__device__ __forceinline__ float wave_scan_incl(float v) {
#define SCAN_STEP(ctrl, rmask) v += __builtin_bit_cast(float, __builtin_amdgcn_update_dpp(0, __builtin_bit_cast(int, v), (ctrl), (rmask), 0xf, false))
    SCAN_STEP(0x111, 0xf); SCAN_STEP(0x112, 0xf); SCAN_STEP(0x114, 0xf); SCAN_STEP(0x118, 0xf);
    SCAN_STEP(0x142, 0xa); SCAN_STEP(0x143, 0xc);
#undef SCAN_STEP
    return v;
}
__device__ __forceinline__ void gla_b(const float* wl, const CgRow& cr, int wave, int lane, float (&bc)[8], float (&bl)[8]) {
    const f32x4 c0 = cr.c0, c1 = cr.c1, c2 = cr.c2, c3 = cr.c3;
    const float cgv[16] = {c0[0], c0[1], c0[2], c0[3], c1[0], c1[1], c1[2], c1[3], c2[0], c2[1], c2[2], c2[3], c3[0], c3[1], c3[2], c3[3]};
    float x[8];
    {   const f32x4 b0 = *(const f32x4*)(wl + 1024 + 8 * wave), b1 = *(const f32x4*)(wl + 1024 + 8 * wave + 4);
#pragma unroll
        for (int e = 0; e < 4; ++e) { x[e] = b0[e]; x[4 + e] = b1[e]; } }
#pragma unroll
    for (int r = 0; r < 16; ++r) {
        const f32x4 w0 = *(const f32x4*)(wl + r * 64 + 8 * wave), w1 = *(const f32x4*)(wl + r * 64 + 8 * wave + 4);
#pragma unroll
        for (int e = 0; e < 4; ++e) { x[e] += cgv[r] * w0[e]; x[4 + e] += cgv[r] * w1[e]; }
    }
#pragma unroll
    for (int i = 0; i < 8; ++i) {
        float la = (fminf(x[i], 0.f) - __logf(1.f + __expf(-fabsf(x[i])))) * (1.f / 16.f);
        la = wave_scan_incl(la);
        bc[i] = la; bl[i] = __builtin_bit_cast(float, __builtin_amdgcn_readlane(__builtin_bit_cast(int, la), 63));
    }
}
struct VPair { u32x4 a, b; };
__device__ __forceinline__ VPair gla_load_v(const bf16_t* proj, int tok0, int h, int tid) {
    const int t = tid >> 3, c8 = tid & 7;
    const bf16_t* vp = proj + (size_t)(tok0 + t) * NPROJ + C_CV + h * 128 + 16 * c8;
    VPair r; r.a = *(const u32x4*)vp; r.b = *(const u32x4*)(vp + 8); return r;
}
__device__ __forceinline__ void gla_store_vT(const VPair& v, bf16_t* vT, int tid) {
    const int t = tid >> 3, c8 = tid & 7;
#pragma unroll
    for (int i = 0; i < 2; ++i) { const u32x4 w = i ? v.b : v.a; const unsigned ww[4] = {w.x, w.y, w.z, w.w};
#pragma unroll
        for (int e = 0; e < 4; ++e) { const int dv = 16 * c8 + 8 * i + 2 * e;
            vT[dv * GL_LD + t] = (bf16_t)(ww[e] & 0xffffu); vT[(dv + 1) * GL_LD + t] = (bf16_t)(ww[e] >> 16); } }
}
constexpr int GLK_LD = 72, GLV_LD = 136;
__device__ __forceinline__ void gla_local_item(const Params& p, int l, int item, unsigned char* lds, int tid, int wave, int lane) {
    const int bh = item >> 5, c = item & 31, b = bh >> 2, h = bh & 3;
    const int fr = lane & 15, fq = lane >> 4;
    const int tok0 = b * SEQ + c * 64;
    bf16_t* Kr = (bf16_t*)lds;
    bf16_t* Vr = (bf16_t*)(lds + 64 * GLK_LD * 2);
    float* wl = (float*)(lds + 64 * GLK_LD * 2 + 64 * GLV_LD * 2);
    const bf16_t* proj = (const bf16_t*)(p.ws + WS_PROJ);
    const CgRow cr = gla_load_cg(p, tok0 + lane);
    const bf16_t* rowp = proj + (size_t)(tok0 + lane) * NPROJ + h * 64 + 8 * wave;
    const u32x4 qw = *(const u32x4*)(rowp + C_CQ), kw = *(const u32x4*)(rowp + C_CK);
    const VPair vpre = gla_load_v(proj, tok0, h, tid);
    if (tid < 256) *(f32x4*)(wl + (tid >> 4) * 64 + 4 * (tid & 15)) = *(const f32x4*)(p.gla_wup + (size_t)(l * 16 + (tid >> 4)) * 256 + h * 64 + 4 * (tid & 15));
    else if (tid < 272) *(f32x4*)(wl + 1024 + 4 * (tid - 256)) = *(const f32x4*)(p.gla_bg + l * 256 + h * 64 + 4 * (tid - 256));
    __syncthreads();
    float bc[8], bl[8];
    gla_b(wl, cr, wave, lane, bc, bl);
    {
        const unsigned qq[4] = {qw.x, qw.y, qw.z, qw.w}, ww[4] = {kw.x, kw.y, kw.z, kw.w};
        unsigned qo[4], ko[4], lo4[4];
#pragma unroll
        for (int e = 0; e < 4; ++e) {
            lo4[e] = cvt_pk_bf16(bf_lo(ww[e]) * __expf(bl[2 * e] - bc[2 * e]), bf_hi(ww[e]) * __expf(bl[2 * e + 1] - bc[2 * e + 1]));
            const float e0 = __expf(bc[2 * e]), e1 = __expf(bc[2 * e + 1]);
            qo[e] = cvt_pk_bf16(bf_lo(qq[e]) * 0.125f * e0, bf_hi(qq[e]) * 0.125f * e1);
            ko[e] = cvt_pk_bf16(bf_lo(ww[e]) * fast_rcp(e0), bf_hi(ww[e]) * fast_rcp(e1));
        }
        *(u32x4*)(Kr + lane * GLK_LD + 8 * wave) = (u32x4){lo4[0], lo4[1], lo4[2], lo4[3]};
        *(u32x4*)((bf16_t*)(p.ws + WS_QD) + (size_t)item * 4096 + lane * 64 + 8 * wave) = (u32x4){qo[0], qo[1], qo[2], qo[3]};
        *(u32x4*)((bf16_t*)(p.ws + WS_KD) + (size_t)item * 4096 + lane * 64 + 8 * wave) = (u32x4){ko[0], ko[1], ko[2], ko[3]};
        if (lane == 63) { float* dec = (float*)(p.ws + WS_DEC) + (size_t)item * 64 + 8 * wave;
#pragma unroll
            for (int i = 0; i < 8; ++i) dec[i] = __expf(bl[i]); }
        bf16_t* vd = Vr + (tid >> 3) * GLV_LD + 16 * (tid & 7);
        *(u32x4*)vd = vpre.a; *(u32x4*)(vd + 8) = vpre.b;
    }
    __syncthreads();
    {
        f32x4 acc[4];
#pragma unroll
        for (int mb = 0; mb < 4; ++mb) acc[mb] = (f32x4){0.f, 0.f, 0.f, 0.f};
#pragma unroll
        for (int kk = 0; kk < 2; ++kk) {
            const int srow = 32 * kk + 8 * fq + (fr >> 2);
            const bf16_t* bp_ = Vr + srow * GLV_LD + 16 * wave + 4 * (fr & 3);
            const bf16x8 bfr = tr_operand(bp_, bp_ + 4 * GLV_LD);
#pragma unroll
            for (int mb = 0; mb < 4; ++mb) { const bf16_t* ap = Kr + srow * GLK_LD + 16 * mb + 4 * (fr & 3); acc[mb] = MFMA16(tr_operand(ap, ap + 4 * GLK_LD), bfr, acc[mb]); }
        }
        float* loct = (float*)(p.ws + WS_LOCT) + (size_t)item * 8192 + (16 * wave + fr) * 64 + 4 * fq;
#pragma unroll
        for (int mb = 0; mb < 4; ++mb) *(f32x4*)(loct + 16 * mb) = acc[mb];
    }
    __syncthreads();
}
__device__ __forceinline__ void gla_scan(const Params& p, int tid, int bx) {
    const float* loct = (const float*)(p.ws + WS_LOCT); const float* dec = (const float*)(p.ws + WS_DEC);
    bf16_t* ST = (bf16_t*)(p.ws + WS_ST);
    for (int e = bx * 512 + tid; e < 16 * 8192; e += gridDim.x * 512) {
        const int bh = e >> 13, r = e & 8191, dk = r & 63;
        float lo[32], de[32];
#pragma unroll
        for (int c = 0; c < 32; ++c) { const size_t it = (size_t)bh * 32 + c; lo[c] = loct[it * 8192 + r]; de[c] = dec[it * 64 + dk]; }
        float s = 0.f;
#pragma unroll
        for (int c = 0; c < 32; ++c) { const size_t it = (size_t)bh * 32 + c;
            ST[it * 8192 + r] = f2bf(s);
            s = s * de[c] + lo[c]; }
    }
}
constexpr int GO_LD = 72, GOV_LD = 136;
constexpr int GO_QD = 0, GO_KD = 64 * GO_LD, GO_ST = 2 * 64 * GO_LD, GO_VT = GO_ST + 128 * GO_LD, GO_IMG = GO_VT + 128 * GO_LD;
__device__ __forceinline__ void gla_out_pair(const Params& p, int l, int pit, unsigned char* lds, int tid, int wave, int lane) {
    const int bh2 = pit >> 5, c = pit & 31, h = bh2 & 3;
    const int fr = lane & 15, fq = lane >> 4;
    bf16_t* img = (bf16_t*)lds;
    float* red = (float*)(lds + 2 * GO_IMG * 2);
    const bf16_t* proj = (const bf16_t*)(p.ws + WS_PROJ);
    bf16_t* Y = (bf16_t*)(p.ws + WS_Y);
    const int tb = wave & 3, dh = wave >> 2, t = 16 * tb + fr;
    int item[2], tok[2];
    item[0] = bh2 * 32 + c; item[1] = (bh2 + 8) * 32 + c;
    tok[0] = (bh2 >> 2) * SEQ + c * 64 + t; tok[1] = ((bh2 >> 2) + 2) * SEQ + c * 64 + t;
    {
        const int r8 = tid >> 3, ch = (tid & 7) * 8;
        u32x4 cq[2], ck[2], cs[2][2], cv[2][2];
        const int tokb[2] = {(bh2 >> 2) * SEQ + c * 64, ((bh2 >> 2) + 2) * SEQ + c * 64};
#pragma unroll
        for (int q2 = 0; q2 < 2; ++q2) {
            cq[q2] = *(const u32x4*)((const bf16_t*)(p.ws + WS_QD) + (size_t)item[q2] * 4096 + r8 * 64 + ch);
            ck[q2] = *(const u32x4*)((const bf16_t*)(p.ws + WS_KD) + (size_t)item[q2] * 4096 + r8 * 64 + ch);
#pragma unroll
            for (int i = 0; i < 2; ++i) {
                cs[q2][i] = *(const u32x4*)((const bf16_t*)(p.ws + WS_ST) + (size_t)item[q2] * 8192 + (r8 + 64 * i) * 64 + ch);
                cv[q2][i] = *(const u32x4*)(proj + (size_t)(tokb[q2] + r8) * NPROJ + C_CV + h * 128 + ch + 64 * i);
            }
        }
#pragma unroll
        for (int q2 = 0; q2 < 2; ++q2) {
            bf16_t* im = img + q2 * GO_IMG;
            *(u32x4*)(im + GO_QD + r8 * GO_LD + ch) = cq[q2]; *(u32x4*)(im + GO_KD + r8 * GO_LD + ch) = ck[q2];
#pragma unroll
            for (int i = 0; i < 2; ++i) { *(u32x4*)(im + GO_ST + (r8 + 64 * i) * GO_LD + ch) = cs[q2][i]; *(u32x4*)(im + GO_VT + r8 * GOV_LD + ch + 64 * i) = cv[q2][i]; }
        }
    }
    u32x4 zf[2][2]; f32x4 gf[4];
#pragma unroll
    for (int mp = 0; mp < 2; ++mp) {
        const int dv = 64 * dh + 32 * mp + 8 * fq;
        gf[2 * mp] = *(const f32x4*)(p.gla_ng + l * 128 + dv); gf[2 * mp + 1] = *(const f32x4*)(p.gla_ng + l * 128 + dv + 4);
#pragma unroll
        for (int q2 = 0; q2 < 2; ++q2) zf[q2][mp] = *(const u32x4*)(proj + (size_t)tok[q2] * NPROJ + C_Z + 1536 + h * 128 + dv);
    }
    __syncthreads();
    f32x4 acc[2][4];
#pragma unroll
    for (int q2 = 0; q2 < 2; ++q2) {
        const bf16_t* im = img + q2 * GO_IMG;
        bf16x8 bq[2];
#pragma unroll
        for (int kk = 0; kk < 2; ++kk) bq[kk] = *(const bf16x8*)(im + GO_QD + t * GO_LD + 32 * kk + 8 * fq);
        f32x4 sc[4];
#pragma unroll
        for (int mb = 0; mb < 4; ++mb) {
            sc[mb] = (f32x4){0.f, 0.f, 0.f, 0.f};
            if (mb <= tb) {
#pragma unroll
                for (int kk = 0; kk < 2; ++kk) { const bf16x8 a = *(const bf16x8*)(im + GO_KD + (16 * mb + fr) * GO_LD + 32 * kk + 8 * fq); sc[mb] = MFMA16(a, bq[kk], sc[mb]); }
#pragma unroll
                for (int j = 0; j < 4; ++j) if (16 * mb + 4 * fq + j > t) sc[mb][j] = 0.f;
            }
        }
        bf16x8 bp[2];
#pragma unroll
        for (int k2 = 0; k2 < 2; ++k2)
            bp[k2] = __builtin_bit_cast(bf16x8, (u32x4){cvt_pk_bf16(sc[2 * k2][0], sc[2 * k2][1]), cvt_pk_bf16(sc[2 * k2][2], sc[2 * k2][3]),
                                                        cvt_pk_bf16(sc[2 * k2 + 1][0], sc[2 * k2 + 1][1]), cvt_pk_bf16(sc[2 * k2 + 1][2], sc[2 * k2 + 1][3])});
        float ssq = 0.f;
#pragma unroll
        for (int mb = 0; mb < 4; ++mb) {
            const int dvrow = 64 * dh + 32 * (mb >> 1) + 8 * (fr >> 2) + 4 * (mb & 1) + (fr & 3);
            acc[q2][mb] = (f32x4){0.f, 0.f, 0.f, 0.f};
#pragma unroll
            for (int k2 = 0; k2 < 2; ++k2) {
                const bf16_t* vp = im + GO_VT + (32 * k2 + 4 * fq + (fr >> 2)) * GOV_LD + 64 * dh + 32 * (mb >> 1) + 8 * (fr & 3) + 4 * (mb & 1);
                acc[q2][mb] = MFMA16(tr_operand(vp, vp + 16 * GOV_LD), bp[k2], acc[q2][mb]);
            }
#pragma unroll
            for (int kk = 0; kk < 2; ++kk) { const bf16x8 a = *(const bf16x8*)(im + GO_ST + dvrow * GO_LD + 32 * kk + 8 * fq); acc[q2][mb] = MFMA16(a, bq[kk], acc[q2][mb]); }
            ssq += (acc[q2][mb][0] * acc[q2][mb][0] + acc[q2][mb][1] * acc[q2][mb][1]) + (acc[q2][mb][2] * acc[q2][mb][2] + acc[q2][mb][3] * acc[q2][mb][3]);
        }
        ssq += __shfl_xor(ssq, 16); ssq += __shfl_xor(ssq, 32);
        if (fq == 0) red[(q2 * 2 + dh) * 64 + t] = ssq;
    }
    __syncthreads();
#pragma unroll
    for (int q2 = 0; q2 < 2; ++q2) {
        const float rstd = rsqrtf((red[(q2 * 2) * 64 + t] + red[(q2 * 2 + 1) * 64 + t]) * (1.f / 128.f) + EPS);
#pragma unroll
        for (int mp = 0; mp < 2; ++mp) {
            const int col = 1536 + h * 128 + 64 * dh + 32 * mp + 8 * fq;
            const u32x4 z = zf[q2][mp];
            const f32x4 a = acc[q2][2 * mp] * rstd * gf[2 * mp], b3 = acc[q2][2 * mp + 1] * rstd * gf[2 * mp + 1];
            u32x4 y; y.x = cvt_pk_bf16(a[0] * bf_lo(z.x), a[1] * bf_hi(z.x)); y.y = cvt_pk_bf16(a[2] * bf_lo(z.y), a[3] * bf_hi(z.y));
            y.z = cvt_pk_bf16(b3[0] * bf_lo(z.z), b3[1] * bf_hi(z.z)); y.w = cvt_pk_bf16(b3[2] * bf_lo(z.w), b3[3] * bf_hi(z.w));
            *(u32x4*)(Y + (size_t)tok[q2] * D + col) = y;
        }
    }
    __syncthreads();
}

#define XB_TMO      128
#define XB_XCNT(j)  (256  + 64 * (j))
#define XB_XSUB(j)  (1280 + 64 * (j))
#define XB_XGEN(j)  (2304 + 64 * (j))
#define XB_TOP      3328
#define XB_TOPGEN   3392
#define XCD_BAR_WORDS 3456
#define XB_SPIN_CAP (1u << 18)
__device__ __forceinline__ unsigned xb_ld(unsigned* p)              { return __hip_atomic_load(p, __ATOMIC_RELAXED, __HIP_MEMORY_SCOPE_AGENT); }
__device__ __forceinline__ unsigned xb_add(unsigned* p, unsigned v) { return __hip_atomic_fetch_add(p, v, __ATOMIC_RELAXED, __HIP_MEMORY_SCOPE_AGENT); }
__device__ __forceinline__ unsigned xb_xcc_id() { return (unsigned)__builtin_amdgcn_s_getreg((3 << 11) | 20) & 0xFu; }
#define XB_SPIN(cond, bar) do { unsigned _sp = 0; while (cond) { __builtin_amdgcn_s_sleep(1); \
    if ((++_sp & 255u) == 0u) { if (xb_ld(&(bar)[XB_TMO])) break; if (_sp > XB_SPIN_CAP) { atomicAdd(&(bar)[XB_TMO], 1u); break; } } } } while (0)
__device__ __forceinline__ void xcd_barrier_complete(unsigned* bar, unsigned x, unsigned& nloc, unsigned& nx) {
    const unsigned G = gridDim.x * gridDim.y * gridDim.z;
    unsigned sum, cnt, mine, sp = 0u;
    for (;;) {
        sum = 0u; cnt = 0u; mine = 0u;
#pragma unroll
        for (unsigned j = 0; j < 16; ++j) { const unsigned c = xb_ld(&bar[XB_XCNT(j)]); sum += c; cnt += (c > 0u) ? 1u : 0u; mine = (j == x) ? c : mine; }
        if (sum == G) break;
        __builtin_amdgcn_s_sleep(1);
        if ((++sp & 255u) == 0u) { if (xb_ld(&bar[XB_TMO])) break; if (sp > XB_SPIN_CAP) { atomicAdd(&bar[XB_TMO], 1u); break; } }
    }
    nloc = mine > 0u ? mine : 1u; nx = cnt > 0u ? cnt : 1u;
}
__device__ __forceinline__ void xcd_barrier(unsigned* bar, volatile LAS unsigned* st) {
    asm volatile("s_waitcnt vmcnt(0)" ::: "memory");
    __syncthreads();
    if (threadIdx.x == 0) {
        __builtin_amdgcn_s_waitcnt(0);
        const unsigned x = xb_xcc_id();
        unsigned nloc = st[0], nx = st[1];
        if (nloc == 0u) { xcd_barrier_complete(bar, x, nloc, nx); st[0] = nloc; st[1] = nx; }
        const unsigned old = xb_add(&bar[XB_XSUB(x)], 1u);
        const unsigned gen = old / nloc;
        if (old + 1u == (gen + 1u) * nloc) {
            __builtin_amdgcn_fence(__ATOMIC_RELEASE, "agent");
            asm volatile("s_waitcnt vmcnt(0)" ::: "memory");
            const unsigned og = xb_add(&bar[XB_TOP], 1u);
            const unsigned tg = og / nx;
            if (og + 1u == (tg + 1u) * nx) xb_add(&bar[XB_TOPGEN], 1u);
            else XB_SPIN(xb_ld(&bar[XB_TOPGEN]) == tg, bar);
            __builtin_amdgcn_fence(__ATOMIC_ACQUIRE, "agent");
            xb_add(&bar[XB_XGEN(x)], 1u);
            asm volatile("s_waitcnt vmcnt(0)" ::: "memory");
        } else {
            XB_SPIN(xb_ld(&bar[XB_XGEN(x)]) == gen, bar);
            __builtin_amdgcn_fence(__ATOMIC_ACQUIRE, "agent");
            asm volatile("s_waitcnt vmcnt(0)" ::: "memory");
        }
    }
    __syncthreads();
}

constexpr int N_PHASES = 14;
__global__ void __launch_bounds__(512, 2) fwd_kernel(Params p) {
    extern __shared__ __attribute__((aligned(16))) unsigned char lds[];
    const int G = gridDim.x;
    const int lo = p.ph_lo, hi = p.ph_hi;
    unsigned* const xbar = (unsigned*)(p.ws + WS_BAR);
    volatile LAS unsigned* const xst = (volatile LAS unsigned*)((LAS unsigned char*)lds + 131072 + 64);
    if (threadIdx.x < 2) xst[threadIdx.x] = 0u;
    __syncthreads();
    if (lo < 0) cg::this_grid().sync();
    if (hi - lo > 1 && threadIdx.x == 0) (void)xb_add(&xbar[XB_XCNT(xb_xcc_id())], 1u);
#ifndef PHMASK
#define PHMASK 0xffff
#endif
#define IN(k) (((PHMASK >> ((k) < 2 ? (k) : 2 + ((k) - 2) % 6)) & 1) && lo <= (k) && (k) < hi)
#define SEAM(k) do { STAMP(2 * (k)); if (IN(k) && IN((k) + 1)) { xcd_barrier(xbar, xst); } STAMP(2 * (k) + 1); } while (0)
#define FRESH() int tid = threadIdx.x; asm volatile("" : "+v"(tid)); int bx = blockIdx.x; asm volatile("" : "+s"(bx)); \
    const int lane = tid & 63, wave = __builtin_amdgcn_readfirstlane(tid >> 6); \
    const Params q = fresh_params(p); (void)lane; (void)wave; (void)bx;
    unsigned long long tacc = 0ull, tprev = (PMASK != 0ull) ? __builtin_amdgcn_s_memrealtime() : 0ull;
#define STAMP(idx) do { if (PMASK != 0ull) { const unsigned long long now_ = __builtin_amdgcn_s_memrealtime(); if ((PMASK >> (idx)) & 1ull) tacc += now_ - tprev; tprev = now_; } } while (0)
    if (IN(0)) for (int rep = 0; rep < REPN(0); ++rep) { FRESH(); mod_items(q, 0, lds, tid, wave, lane, bx); __syncthreads(); p0_transposes(q, lds, wave, lane, bx, 0); }
    SEAM(0);
    if (IN(1)) for (int rep = 0; rep < REPN(1); ++rep) { FRESH(); mod_items(q, 1, lds, tid, wave, lane, bx); __syncthreads(); STAMP(32); p0_convert(q, lds, tid, wave, lane, bx); STAMP(33); row_pass(q, 0, wave, lane, bx); }
    SEAM(1);
#pragma unroll 1
    for (int l = 0; l < 2; ++l) {
        const int pb = 2 + 6 * l;
        if (IN(pb)) for (int rep = 0; rep < REPN(2); ++rep) {
            FRESH();
            pg8::Gemm g{(const bf16_t*)(q.ws + WS_H), (const bf16_t*)(q.ws + WS_WIN + (size_t)l * WIN_BYTES), M, NPAD, D};
            pg8::StaticOrder S; S.init(M, NPAD, G, bx);
            pg8::EpiProj E{(bf16_t*)(q.ws + WS_PROJ), (float*)(q.ws + WS_CG), (float*)(q.ws + WS_SGST)};
            pg8::gemm_phase<pg8::EpiProj, pg8::StaticOrder, true, true>((LAS unsigned char*)lds, g, S, E, tid);
        }
        SEAM(pb);
        if (IN(pb + 1)) for (int rep = 0; rep < REPN(3); ++rep) {
#ifndef MIXMASK
#define MIXMASK 7
#endif
            for (int rr = 0; rr < ((MIXR >> 0) & 15); ++rr) { FRESH(); for (int it = bx; it < 256; it += G) attn_item(q, l, it, lds, tid, wave, lane); }
            STAMP(36 + 4 * l); for (int rr = 0; rr < ((MIXR >> 4) & 15); ++rr) { FRESH(); for (int it = bx; it < 256; it += G) sg_pair_item(q, l, it, lds, tid, wave, lane); } STAMP(37 + 4 * l);
            for (int rr = 0; rr < ((MIXR >> 8) & 15); ++rr) { FRESH(); for (int it = bx; it < 512; it += G) gla_local_item(q, l, it, lds, tid, wave, lane); }
        }
        SEAM(pb + 1);
        if (IN(pb + 2)) for (int rep = 0; rep < REPN(4); ++rep) { FRESH(); gla_scan(q, tid, bx); }
        SEAM(pb + 2);
        if (IN(pb + 3)) for (int rep = 0; rep < REPN(5); ++rep) { FRESH(); for (int it = bx; it < 256; it += G) gla_out_pair(q, l, it, lds, tid, wave, lane); }
        SEAM(pb + 3);
        if (IN(pb + 4)) for (int rep = 0; rep < REPN(6); ++rep) {
            FRESH();
            pg8::Gemm g{(const bf16_t*)(q.ws + WS_Y), (const bf16_t*)(q.ws + WS_WOUT + (size_t)l * WOUT_BYTES), M, D, D};
            pg8::StaticOrder S; S.init(M, D, G, bx);
            pg8::EpiOut E{(bf16_t*)(q.ws + WS_OUT)};
            pg8::gemm_phase<pg8::EpiOut, pg8::StaticOrder, true, true>((LAS unsigned char*)lds, g, S, E, tid);
        }
        SEAM(pb + 4);
        if (IN(pb + 5)) { FRESH(); row_pass(q, l + 1, wave, lane, bx); }
        if (l == 0) SEAM(pb + 5);
    }
    STAMP(26);
    if (PMASK != 0ull) { if (blockIdx.x == 0 && threadIdx.x == 0) { const unsigned long long t0 = __builtin_amdgcn_s_memrealtime(); while (__builtin_amdgcn_s_memrealtime() - t0 < tacc) __builtin_amdgcn_s_sleep(8); } }
#undef IN
#undef SEAM
#undef FRESH
}

extern "C" void kernel_launch(void* const* d_in, const int* in_sizes, int n_in, void* d_out, int out_size, void* d_ws, size_t ws_size, hipStream_t stream) {
    static int grid = 0;
    if (grid == 0) {
        if (n_in != 17 || in_sizes[0] != M * D || out_size != M * D || ws_size < WS_END) { fprintf(stderr, "kernel_launch: unexpected shapes (n_in %d, in0 %d, out %d, ws %zu)\n", n_in, n_in > 0 ? in_sizes[0] : -1, out_size, ws_size); grid = -1; return; }
        int dev = 0, cus = 0, per_cu = 0;
        if (hipGetDevice(&dev) != hipSuccess || hipDeviceGetAttribute(&cus, hipDeviceAttributeMultiprocessorCount, dev) != hipSuccess) { grid = -1; return; }
        if (hipFuncSetAttribute((const void*)fwd_kernel, hipFuncAttributeMaxDynamicSharedMemorySize, LDS_BYTES) != hipSuccess) { fprintf(stderr, "kernel_launch: hipFuncSetAttribute failed\n"); grid = -1; return; }
        if (hipOccupancyMaxActiveBlocksPerMultiprocessor(&per_cu, (const void*)fwd_kernel, 512, LDS_BYTES) != hipSuccess || per_cu < 1) { fprintf(stderr, "kernel_launch: occupancy query says %d blocks per CU\n", per_cu); per_cu = 1; }
        (void)hipGetLastError();
        grid = cus;
    }
    if (grid < 0) return;
    Params p{};
    p.x = (const float*)d_in[0]; p.c = (const float*)d_in[1]; p.pos = (const int*)d_in[2]; p.w_mod = (const float*)d_in[3]; p.b_mod = (const float*)d_in[4];
    p.g_pre = (const float*)d_in[5]; p.g_post = (const float*)d_in[6]; p.w_in = (const float*)d_in[7]; p.w_out = (const float*)d_in[8]; p.sinks = (const float*)d_in[9];
    p.sg_w = (const float*)d_in[10]; p.sg_b = (const float*)d_in[11]; p.sg_ln_g = (const float*)d_in[12]; p.sg_ln_b = (const float*)d_in[13];
    p.gla_wup = (const float*)d_in[14]; p.gla_bg = (const float*)d_in[15]; p.gla_ng = (const float*)d_in[16];
    p.out = (float*)d_out; p.ws = (unsigned char*)d_ws;
#if MK_SINGLE
    if (hipMemsetAsync((char*)d_ws + WS_BAR, 0, XCD_BAR_WORDS * 4, stream) != hipSuccess) { fprintf(stderr, "kernel_launch: memset failed\n"); return; }
    p.ph_lo = 0; p.ph_hi = N_PHASES;
    void* args[] = {&p};
    hipError_t e = hipLaunchCooperativeKernel((const void*)fwd_kernel, dim3(grid), dim3(512), args, LDS_BYTES, stream);
    if (e != hipSuccess) fprintf(stderr, "kernel_launch: cooperative launch failed: %s (grid %d)\n", hipGetErrorString(e), grid);
#else
    for (int ph = 0; ph < N_PHASES; ++ph) {
        p.ph_lo = ph; p.ph_hi = ph + 1;
        hipLaunchKernelGGL(fwd_kernel, dim3(grid), dim3(512), LDS_BYTES, stream, p);
    }
#endif
}
```
